# Optimizing an MI355X kernel written in HIP

```python
import math
import jax, jax.numpy as jnp
from jax import lax
import numpy as np

D_MODEL = 2048
BATCH = 8
SEQ = 4096
DEPTH = 4
DEC_BATCH = 4
DEC_SEQ = 4096
PAST_LEN = 128

GRID_W = 64
Q_BLOCK = 128
HEAD_DIM = 128
ROPE_THETA = 10000.0
EPS = 1e-6
N_EVEN = (DEPTH + 1) // 2
N_ODD = DEPTH // 2
MLA_HEADS = 8
MLA_Q_LORA = 512
MLA_KV_LORA = 512
MLA_NOPE = 128
MLA_ROPE = 64
MLA_V = 128
GQA_HEADS = 8
GQA_KV_HEADS = 2
NA_HEADS = 8
NA_WIN_H = 8
NA_WIN_W = 16
DIFF_HEADS = 4
DIFF_V = 2 * HEAD_DIM
MEM_LEN = 256
MEM_HEADS = 4
D_FF = 4 * D_MODEL

AB_SPLITS = [MLA_Q_LORA, MLA_KV_LORA, MLA_ROPE, GQA_HEADS * HEAD_DIM,
             GQA_KV_HEADS * HEAD_DIM, GQA_KV_HEADS * HEAD_DIM]
CD_SPLITS = [NA_HEADS * HEAD_DIM] * 3 + [DIFF_HEADS * 2 * HEAD_DIM] * 2 + [DIFF_HEADS * DIFF_V]
AB_IN = sum(AB_SPLITS)
CD_IN = sum(CD_SPLITS)
MIX_AB = MLA_HEADS * MLA_V + GQA_HEADS * HEAD_DIM
MIX_CD = NA_HEADS * HEAD_DIM + DIFF_HEADS * DIFF_V

kernel_name = "hybrid_mla_gqa_natten_diff_encoder"


def rms_norm(x, g):
    xf = x.astype(jnp.float32)
    y = xf * lax.rsqrt(jnp.mean(xf * xf, axis=-1, keepdims=True) + EPS)
    return (y * g.astype(jnp.float32)).astype(x.dtype)


def rope_cos_sin(pos, dim):
    inv = ROPE_THETA ** (-jnp.arange(0, dim, 2, dtype=jnp.float32) / dim)
    ang = pos.astype(jnp.float32)[:, None] * inv[None, :]
    return jnp.cos(ang)[None, :, None, :], jnp.sin(ang)[None, :, None, :]


def apply_rope(x, cs):
    cos, sin = cs
    x1, x2 = jnp.split(x.astype(jnp.float32), 2, axis=-1)
    return jnp.concatenate([x1 * cos - x2 * sin, x2 * cos + x1 * sin], axis=-1).astype(x.dtype)


def axial_rope(x, cs_row, cs_col):
    half = x.shape[-1] // 2
    return jnp.concatenate([apply_rope(x[..., :half], cs_row), apply_rope(x[..., half:], cs_col)], axis=-1)


def sweep_query_blocks(fn, *qs):
    b, s = qs[0].shape[:2]
    nb = s // Q_BLOCK
    blocked = tuple(jnp.moveaxis(q.reshape(b, nb, Q_BLOCK, *q.shape[2:]), 1, 0) for q in qs)
    out = lax.map(lambda a: fn(a[0], *a[1:]), (jnp.arange(nb),) + blocked)
    return jnp.moveaxis(out, 0, 1).reshape(b, s, *out.shape[3:])


def dense_attention(q, k, v, scale):
    def block(i, qb):
        s = jnp.einsum('bqhgd,bkhd->bhgqk', qb, k).astype(jnp.float32) * scale
        p = jax.nn.softmax(s, axis=-1).astype(v.dtype)
        return jnp.einsum('bhgqk,bkhd->bqhgd', p, v)
    return sweep_query_blocks(block, q)


def mla_mixer(c_q, c_kv, k_rope, q_norm, w_q_b, kv_norm, w_kv_b, cs_rope):
    b, s, _ = c_q.shape
    q = (rms_norm(c_q, q_norm) @ w_q_b).reshape(b, s, MLA_HEADS, MLA_NOPE + MLA_ROPE)
    q = jnp.concatenate([q[..., :MLA_NOPE], apply_rope(q[..., MLA_NOPE:], cs_rope)], axis=-1)
    kv = (rms_norm(c_kv, kv_norm) @ w_kv_b).reshape(b, s, MLA_HEADS, MLA_NOPE + MLA_V)
    k_r = apply_rope(k_rope[:, :, None, :], cs_rope)
    k = jnp.concatenate([kv[..., :MLA_NOPE], jnp.broadcast_to(k_r, (b, s, MLA_HEADS, MLA_ROPE))], axis=-1)
    o = dense_attention(q[:, :, :, None, :], k, kv[..., MLA_NOPE:], (MLA_NOPE + MLA_ROPE) ** -0.5)
    return o.reshape(b, s, MLA_HEADS * MLA_V)


def gqa_mixer(q, k, v, q_norm, k_norm, cs_row, cs_col):
    b, s, _ = q.shape
    g = GQA_HEADS // GQA_KV_HEADS
    q = axial_rope(rms_norm(q.reshape(b, s, GQA_HEADS, HEAD_DIM), q_norm), cs_row, cs_col)
    k = axial_rope(rms_norm(k.reshape(b, s, GQA_KV_HEADS, HEAD_DIM), k_norm), cs_row, cs_col)
    v = v.reshape(b, s, GQA_KV_HEADS, HEAD_DIM)
    o = dense_attention(q.reshape(b, s, GQA_KV_HEADS, g, HEAD_DIM), k, v, HEAD_DIM ** -0.5)
    return o.reshape(b, s, GQA_HEADS * HEAD_DIM)


def neighbourhood_mixer(q, k, v, rpb):
    b, s, _ = q.shape
    rows = s // GRID_W
    kh = min(NA_WIN_H, rows)
    kw = NA_WIN_W
    rows_per_block = Q_BLOCK // GRID_W
    band = min(kh + rows_per_block - 1, rows)
    q = q.reshape(b, s, NA_HEADS, HEAD_DIM)
    k_grid = k.reshape(b, rows, GRID_W, NA_HEADS, HEAD_DIM)
    v_grid = v.reshape(b, rows, GRID_W, NA_HEADS, HEAD_DIM)
    key_col = jnp.tile(jnp.arange(GRID_W), band)
    key_row_local = jnp.repeat(jnp.arange(band), GRID_W)
    q_local = jnp.arange(Q_BLOCK)

    def block(i, qb):
        r0 = i * rows_per_block
        qr = r0 + q_local // GRID_W
        qc = q_local % GRID_W
        sr = jnp.clip(qr - kh // 2, 0, rows - kh)
        sc = jnp.clip(qc - kw // 2, 0, GRID_W - kw)
        b0 = jnp.clip(r0 - kh // 2, 0, rows - band)
        kb = lax.dynamic_slice_in_dim(k_grid, b0, band, axis=1).reshape(b, band * GRID_W, NA_HEADS, HEAD_DIM)
        vb = lax.dynamic_slice_in_dim(v_grid, b0, band, axis=1).reshape(b, band * GRID_W, NA_HEADS, HEAD_DIM)
        kr = b0 + key_row_local
        inside = ((kr[None, :] >= sr[:, None]) & (kr[None, :] < sr[:, None] + kh)
                  & (key_col[None, :] >= sc[:, None]) & (key_col[None, :] < sc[:, None] + kw))
        dr = jnp.clip(kr[None, :] - qr[:, None] + NA_WIN_H - 1, 0, 2 * NA_WIN_H - 2)
        dc = jnp.clip(key_col[None, :] - qc[:, None] + NA_WIN_W - 1, 0, 2 * NA_WIN_W - 2)
        bias = rpb[:, dr, dc].astype(jnp.float32)
        sco = jnp.einsum('bqhd,bkhd->bhqk', qb, kb).astype(jnp.float32) * HEAD_DIM ** -0.5 + bias[None]
        sco = jnp.where(inside[None, None], sco, -jnp.inf)
        p = jax.nn.softmax(sco, axis=-1).astype(vb.dtype)
        return jnp.einsum('bhqk,bkhd->bqhd', p, vb)

    o = sweep_query_blocks(block, q)
    return o.reshape(b, s, NA_HEADS * HEAD_DIM)


def diff_mixer(q, k, v, lam_p, subln, lambda_init, cs):
    b, s, _ = q.shape
    q = apply_rope(q.reshape(b, s, 2 * DIFF_HEADS, HEAD_DIM), cs).reshape(b, s, DIFF_HEADS, 2, HEAD_DIM)
    k = apply_rope(k.reshape(b, s, 2 * DIFF_HEADS, HEAD_DIM), cs).reshape(b, s, DIFF_HEADS, 2, HEAD_DIM)
    v = v.reshape(b, s, DIFF_HEADS, DIFF_V)
    lp = lam_p.astype(jnp.float32)
    lam = jnp.exp(jnp.sum(lp[0] * lp[1])) - jnp.exp(jnp.sum(lp[2] * lp[3])) + lambda_init

    def block(i, qb):
        sco = jnp.einsum('bqhcd,bkhcd->bchqk', qb, k).astype(jnp.float32) * HEAD_DIM ** -0.5
        p = jax.nn.softmax(sco, axis=-1)
        w = (p[:, 0] - lam * p[:, 1]).astype(v.dtype)
        return jnp.einsum('bhqk,bkhd->bqhd', w, v)

    o = sweep_query_blocks(block, q)
    o = rms_norm(o, subln) * (1.0 - lambda_init)
    return o.reshape(b, s, DIFF_HEADS * DIFF_V)


def memory_cross_attention(h, mem, mem_norm, w_q, w_kv, w_o):
    b, s, _ = h.shape
    m = rms_norm(mem, mem_norm)
    q = (h @ w_q).reshape(b, s, MEM_HEADS, HEAD_DIM)
    kv = (m @ w_kv).reshape(b, mem.shape[1], 2, MEM_HEADS, HEAD_DIM)
    sco = jnp.einsum('bqhd,bkhd->bhqk', q, kv[:, :, 0]).astype(jnp.float32) * HEAD_DIM ** -0.5
    p = jax.nn.softmax(sco, axis=-1).astype(h.dtype)
    o = jnp.einsum('bhqk,bkhd->bqhd', p, kv[:, :, 1]).reshape(b, s, MEM_HEADS * HEAD_DIM)
    return o @ w_o


def run_trunk(x, mem, p):
    b, s, _ = x.shape
    t = jnp.arange(s)
    cs_1d = rope_cos_sin(t, HEAD_DIM)
    cs_mla = rope_cos_sin(t, MLA_ROPE)
    cs_row = rope_cos_sin(t // GRID_W, HEAD_DIM // 2)
    cs_col = rope_cos_sin(t % GRID_W, HEAD_DIM // 2)
    ab_idx = np.cumsum(AB_SPLITS)[:-1].tolist()
    cd_idx = np.cumsum(CD_SPLITS)[:-1].tolist()
    for layer in range(DEPTH):
        j = layer // 2
        h = rms_norm(x, p['norm_mix'][layer])
        if layer % 2 == 0:
            c_q, c_kv, k_rope, gq, gk, gv = jnp.split(h @ p['w_in_ab'][j], ab_idx, axis=-1)
            o_a = mla_mixer(c_q, c_kv, k_rope, p['mla_q_norm'][j], p['w_q_b'][j],
                            p['mla_kv_norm'][j], p['w_kv_b'][j], cs_mla)
            o_b = gqa_mixer(gq, gk, gv, p['gqa_q_norm'][j], p['gqa_k_norm'][j], cs_row, cs_col)
            x = x + jnp.concatenate([o_a, o_b], axis=-1) @ p['w_out_ab'][j]
        else:
            nq, nk, nv, dq, dk, dv = jnp.split(h @ p['w_in_cd'][j], cd_idx, axis=-1)
            lambda_init = 0.8 - 0.6 * math.exp(-0.3 * layer)
            o_c = neighbourhood_mixer(nq, nk, nv, p['na_rpb'][j])
            o_d = diff_mixer(dq, dk, dv, p['diff_lambda'][j], p['diff_subln'][j], lambda_init, cs_1d)
            x = x + jnp.concatenate([o_c, o_d], axis=-1) @ p['w_out_cd'][j]
        h = rms_norm(x, p['norm_xattn'][layer])
        x = x + memory_cross_attention(h, mem, p['norm_mem'][layer], p['w_xq'][layer],
                                       p['w_xkv'][layer], p['w_xo'][layer])
        h = rms_norm(x, p['norm_mlp'][layer])
        x = x + jnp.square(jax.nn.relu(h @ p['w_up'][layer])) @ p['w_down'][layer]
    return rms_norm(x, p['final_norm'])


def setup_inputs(seed: int = 0) -> dict:
    key = jax.random.key(seed)
    k = jax.random.split(key, 27)

    def nrm(i, shape, scale):
        return jax.random.normal(k[i], shape, jnp.float32) * scale

    def gain(i, shape):
        return 1.0 + nrm(i, shape, 0.02)

    D = D_MODEL
    return {
        "x_prompt": nrm(0, (BATCH, SEQ, D), 1.0),
        "x_sample": nrm(1, (DEC_BATCH, DEC_SEQ, D), 1.0),
        "mem_prompt": nrm(2, (BATCH, MEM_LEN, D), 1.0),
        "mem_sample": nrm(3, (DEC_BATCH, MEM_LEN, D), 1.0),
        "norm_mix": gain(4, (DEPTH, D)),
        "w_in_ab": nrm(5, (N_EVEN, D, AB_IN), D ** -0.5),
        "mla_q_norm": gain(6, (N_EVEN, MLA_Q_LORA)),
        "w_q_b": nrm(7, (N_EVEN, MLA_Q_LORA, MLA_HEADS * (MLA_NOPE + MLA_ROPE)), MLA_Q_LORA ** -0.5),
        "mla_kv_norm": gain(8, (N_EVEN, MLA_KV_LORA)),
        "w_kv_b": nrm(9, (N_EVEN, MLA_KV_LORA, MLA_HEADS * (MLA_NOPE + MLA_V)), MLA_KV_LORA ** -0.5),
        "gqa_q_norm": gain(10, (N_EVEN, HEAD_DIM)),
        "gqa_k_norm": gain(11, (N_EVEN, HEAD_DIM)),
        "w_out_ab": nrm(12, (N_EVEN, MIX_AB, D), MIX_AB ** -0.5),
        "w_in_cd": nrm(13, (N_ODD, D, CD_IN), D ** -0.5),
        "na_rpb": nrm(14, (N_ODD, NA_HEADS, 2 * NA_WIN_H - 1, 2 * NA_WIN_W - 1), 0.02),
        "diff_lambda": nrm(15, (N_ODD, 4, HEAD_DIM), 0.1),
        "diff_subln": gain(16, (N_ODD, DIFF_V)),
        "w_out_cd": nrm(17, (N_ODD, MIX_CD, D), MIX_CD ** -0.5),
        "norm_xattn": gain(18, (DEPTH, D)),
        "norm_mem": gain(19, (DEPTH, D)),
        "w_xq": nrm(20, (DEPTH, D, MEM_HEADS * HEAD_DIM), D ** -0.5),
        "w_xkv": nrm(21, (DEPTH, D, 2 * MEM_HEADS * HEAD_DIM), D ** -0.5),
        "w_xo": nrm(22, (DEPTH, MEM_HEADS * HEAD_DIM, D), (MEM_HEADS * HEAD_DIM) ** -0.5),
        "norm_mlp": gain(23, (DEPTH, D)),
        "w_up": nrm(24, (DEPTH, D, D_FF), D ** -0.5),
        "w_down": nrm(25, (DEPTH, D_FF, D), D_FF ** -0.5),
        "final_norm": gain(26, (D,)),
    }


def reference(x_prompt, x_sample, mem_prompt, mem_sample, norm_mix, w_in_ab, mla_q_norm, w_q_b,
              mla_kv_norm, w_kv_b, gqa_q_norm, gqa_k_norm, w_out_ab, w_in_cd, na_rpb, diff_lambda,
              diff_subln, w_out_cd, norm_xattn, norm_mem, w_xq, w_xkv, w_xo, norm_mlp, w_up, w_down,
              final_norm):
    params = dict(norm_mix=norm_mix, w_in_ab=w_in_ab, mla_q_norm=mla_q_norm, w_q_b=w_q_b,
                  mla_kv_norm=mla_kv_norm, w_kv_b=w_kv_b, gqa_q_norm=gqa_q_norm, gqa_k_norm=gqa_k_norm,
                  w_out_ab=w_out_ab, w_in_cd=w_in_cd, na_rpb=na_rpb, diff_lambda=diff_lambda,
                  diff_subln=diff_subln, w_out_cd=w_out_cd, norm_xattn=norm_xattn, norm_mem=norm_mem,
                  w_xq=w_xq, w_xkv=w_xkv, w_xo=w_xo, norm_mlp=norm_mlp, w_up=w_up, w_down=w_down,
                  final_norm=final_norm)
    y_prompt = run_trunk(x_prompt, mem_prompt, params)
    y_sample = run_trunk(x_sample, mem_sample, params)
    return (y_prompt, y_sample)
```

```cpp
#include <hip/hip_runtime.h>
#include <cstdio>
#include <cstdint>

#define LAS __attribute__((address_space(3)))
#define GAS __attribute__((address_space(1)))
typedef unsigned short bf16;
typedef short bf16x8 __attribute__((ext_vector_type(8)));
typedef short s16x4 __attribute__((ext_vector_type(4)));
typedef float f32x4 __attribute__((ext_vector_type(4)));
typedef float f32x2 __attribute__((ext_vector_type(2)));
typedef float f32x16 __attribute__((ext_vector_type(16)));
typedef unsigned u32x4 __attribute__((ext_vector_type(4)));
typedef unsigned u32x2 __attribute__((ext_vector_type(2)));

constexpr int DM = 2048, SEQ = 4096, NSEQ = 12, T = NSEQ * SEQ  , T_PROMPT = 8 * SEQ;
constexpr int DEPTH = 4, MEMLEN = 256, TM = NSEQ * MEMLEN  ;
constexpr int AB_IN = 2624, AB_PAD = 2816, CD_IN = 6144, DFF = 8192;
constexpr int MLP_CHUNK = 16384, N_MLP_CHUNKS = T / MLP_CHUNK;
constexpr float EPS = 1e-6f;

__device__ __forceinline__ unsigned cvt_pk_bf16(float lo, float hi) { unsigned r; asm volatile("v_cvt_pk_bf16_f32 %0, %1, %2" : "=v"(r) : "v"(lo), "v"(hi)); return r; }
__device__ __forceinline__ float bf2f(unsigned short b) { return __builtin_bit_cast(float, ((unsigned)b) << 16); }
__device__ __forceinline__ float bflo(unsigned w) { return __builtin_bit_cast(float, w << 16); }
__device__ __forceinline__ float bfhi(unsigned w) { return __builtin_bit_cast(float, w & 0xffff0000u); }
__device__ __forceinline__ int lane_id_fresh() { int l; asm volatile("v_mbcnt_lo_u32_b32 %0, -1, 0\n\tv_mbcnt_hi_u32_b32 %0, -1, %0" : "=v"(l)); return l; }
template <int XOR> __device__ __forceinline__ float swz_xor(float v) { return __builtin_bit_cast(float, __builtin_amdgcn_ds_swizzle(__builtin_bit_cast(int, v), (XOR << 10) | 0x1f)); }
__device__ __forceinline__ float wave_sum(float v) {
    v += swz_xor<1>(v); v += swz_xor<2>(v); v += swz_xor<4>(v); v += swz_xor<8>(v); v += swz_xor<16>(v);
    auto rr = __builtin_amdgcn_permlane32_swap(__float_as_uint(v), __float_as_uint(v), false, false);
    return __uint_as_float(rr[0]) + __uint_as_float(rr[1]);
}
__device__ __forceinline__ float other_half(float v, bool lower) {
    auto rr = __builtin_amdgcn_permlane32_swap(__float_as_uint(v), __float_as_uint(v), false, false);
    return lower ? __uint_as_float(rr[1]) : __uint_as_float(rr[0]);
}

namespace pg8 {
constexpr int BM = 256, BK = 64, HALF = 128, HTB = HALF * BK * 2, STAGE_BYTES = 8 * HTB, NXCD = 8, WGM = 8;
__host__ __device__ __forceinline__ int lds_byte(int r, int c) { const int st = (r >> 4) * 2 + (c >> 5), rr = r & 15, cc = c & 31, ob = rr * 64 + cc * 2; return st * 1024 + (ob ^ (((ob >> 9) & 1) << 5)); }
__host__ __device__ __forceinline__ void stage_rc(int b, int& R, int& C) { const int st = b / 1024, sb = b % 1024, swz = sb ^ (((sb >> 9) & 1) << 5); R = (st >> 1) * 16 + swz / 64; C = (st & 1) * 32 + (swz % 64) / 2; }
__host__ __device__ __forceinline__ int perm32(int rho) { const int n = rho >> 4, i = rho & 15; return 8 * (i >> 2) + 4 * n + (i & 3); }

struct Unit { int pm, pn; };
struct Gemm { const bf16* A; const bf16* Bt; int M, N, K, lda, ldb; };

struct StaticOrder {
    int nM, nN, nwg, G, c;
    __device__ void init(int M, int N, int G_, int c_) { nM = M / BM; nN = N / BM; nwg = nM * nN; G = G_; c = c_; }
    __device__ bool next(int i, Unit& u) const {
        const long L = (long)i * G + c; if (L >= nwg) return false;
        int wgid = (int)L; { const int q = nwg / NXCD, r = nwg % NXCD, xcd = wgid % NXCD, off = wgid / NXCD; wgid = (xcd < r ? xcd * (q + 1) : r * (q + 1) + (xcd - r) * q) + off; }
        const int nig = WGM * nN, gid = wgid / nig, fm = gid * WGM, gsz = (nM - fm) < WGM ? (nM - fm) : WGM;
        u.pm = fm + ((wgid % nig) % gsz); u.pn = (wgid % nig) / gsz; return true;
    }
};

template <int ACT  > struct EpiBf16 {
    static constexpr bool PERM = true;
    bf16* O; int ldc; int split_cols; size_t split_stride;
    __device__ __forceinline__ void operator()(const f32x4 (&acc)[2][2][4][2], const Unit& u, int wr, int wc, int fr, int fq) const {
        const int row0 = u.pm * BM + wr * 64 + fr; int colt = u.pn * BM; bf16* base = O;
        if (split_cols) { const int t = colt / split_cols; base += (size_t)t * split_stride; colt -= t * split_cols; }
        const int col0 = colt + wc * 32 + 8 * fq;
#pragma unroll
        for (int ai = 0; ai < 2; ++ai)
#pragma unroll
            for (int m = 0; m < 4; ++m) { bf16* rowp = base + (size_t)(row0 + ai * HALF + m * 16) * ldc + col0;
#pragma unroll
                for (int bj = 0; bj < 2; ++bj) { f32x4 v0 = acc[ai][bj][m][0], v1 = acc[ai][bj][m][1];
                    if (ACT == 2) {
#pragma unroll
                        for (int j = 0; j < 4; ++j) { const float a = fmaxf(v0[j], 0.f), b = fmaxf(v1[j], 0.f); v0[j] = a * a; v1[j] = b * b; } }
                    u32x4 w; w.x = cvt_pk_bf16(v0[0], v0[1]); w.y = cvt_pk_bf16(v0[2], v0[3]); w.z = cvt_pk_bf16(v1[0], v1[1]); w.w = cvt_pk_bf16(v1[2], v1[3]);
                    *(u32x4*)(rowp + bj * HALF) = w; } }
    }
};
struct EpiResid {
    static constexpr bool PERM = false;
    float* C; int ldc;
    __device__ __forceinline__ void operator()(const f32x4 (&acc)[2][2][4][2], const Unit& u, int wr, int wc, int fr, int fq) const {
        const int row0 = u.pm * BM + wr * 64 + fr, col0 = u.pn * BM + wc * 32 + 4 * fq;
#pragma unroll
        for (int ai = 0; ai < 2; ++ai)
#pragma unroll
            for (int m = 0; m < 4; ++m) { float* rowp = C + (size_t)(row0 + ai * HALF + m * 16) * ldc + col0;
                f32x4 c[2][2];
#pragma unroll
                for (int bj = 0; bj < 2; ++bj)
#pragma unroll
                    for (int n = 0; n < 2; ++n) c[bj][n] = *(const f32x4*)(rowp + bj * HALF + n * 16);
#pragma unroll
                for (int bj = 0; bj < 2; ++bj)
#pragma unroll
                    for (int n = 0; n < 2; ++n) *(f32x4*)(rowp + bj * HALF + n * 16) = c[bj][n] + acc[ai][bj][m][n];
                asm volatile("" ::: "memory"); }
    }
};

template <class Epi>
__device__ __forceinline__ void gemm_phase(LAS unsigned char* lds, const Gemm g, const StaticOrder& S, const Epi& E, int wid) {
    const int lane = lane_id_fresh(), tid = wid * 64 + lane, wr = wid >> 2, wc = wid & 3, fr = lane & 15, fq = lane >> 4;
    const int K = g.K, nt = K / BK;
    unsigned voffA[2], voffB[2];
#pragma unroll
    for (int i = 0; i < 2; ++i) { int R, C; stage_rc(tid * 16 + i * 8192, R, C); const int Rb = Epi::PERM ? ((R & ~31) + perm32(R & 31)) : R;
        voffA[i] = (unsigned)(R * g.lda + C) * 2u; voffB[i] = (unsigned)(Rb * g.ldb + C) * 2u; }
    const size_t kstep = (size_t)(BK * 2);
    const size_t hstepA = (size_t)HALF * g.lda * 2, hstepB = (size_t)HALF * g.ldb * 2;
    const size_t tstepA = 2 * hstepA, tstepB = 2 * hstepB;
    const unsigned ldsw = (unsigned)wid * 1024u;
    const int aoff = lds_byte(wr * 64 + fr, fq * 8), boff = lds_byte(wc * 32 + fr, fq * 8);
#define PG8_SA(b, h) (((b) * 2 + (h)) * HTB)
#define PG8_SB(b, h) ((4 + (b) * 2 + (h)) * HTB)
#define PG8_STAGE(bufoff, gbase, voff) do { _Pragma("unroll") for (int _i = 0; _i < 2; ++_i) \
        __builtin_amdgcn_global_load_lds((const unsigned*)((const char*)(gbase) + (voff)[_i]), (LAS unsigned*)(lds + (bufoff) + ldsw + _i * 8192), 16, 0, 0); } while (0)
#define PG8_LDA(dst, b, h) do { _Pragma("unroll") for (int m = 0; m < 4; ++m) _Pragma("unroll") for (int k = 0; k < 2; ++k) dst[m][k] = *(const LAS bf16x8*)(lds + PG8_SA(b, h) + aoff + m * 2048 + k * 1024); } while (0)
#define PG8_LDB(dst, b, h) do { _Pragma("unroll") for (int n = 0; n < 2; ++n) _Pragma("unroll") for (int k = 0; k < 2; ++k) dst[n][k] = *(const LAS bf16x8*)(lds + PG8_SB(b, h) + boff + n * 2048 + k * 1024); } while (0)
#define PG8_MMA(ai, bj, At, Bt) do { __builtin_amdgcn_s_setprio(1); _Pragma("unroll") for (int m = 0; m < 4; ++m) _Pragma("unroll") for (int n = 0; n < 2; ++n) _Pragma("unroll") for (int k = 0; k < 2; ++k) \
        acc[ai][bj][m][n] = __builtin_amdgcn_mfma_f32_16x16x32_bf16(Bt[n][k], At[m][k], acc[ai][bj][m][n], 0, 0, 0); __builtin_amdgcn_s_setprio(0); } while (0)
#define PG8_WAIT_V(n) asm volatile("s_waitcnt vmcnt(" #n ")" ::: "memory")
#define PG8_WAIT_L(n) asm volatile("s_waitcnt lgkmcnt(" #n ")" ::: "memory")
#define PG8_BAR __builtin_amdgcn_s_barrier()
#define PG8_SCHED __builtin_amdgcn_sched_barrier(0)
    Unit cur, nxt; int ui = 0;
    if (!S.next(0, cur)) return;
    f32x4 acc[2][2][4][2];
#pragma unroll
    for (int a = 0; a < 2; ++a)
#pragma unroll
        for (int b = 0; b < 2; ++b)
#pragma unroll
            for (int m = 0; m < 4; ++m)
#pragma unroll
                for (int n = 0; n < 2; ++n) acc[a][b][m][n] = (f32x4){0.f, 0.f, 0.f, 0.f};
    bf16x8 At[4][2], B0[2][2], B1[2][2];
    const char* cA = (const char*)g.A + (size_t)cur.pm * tstepA; const char* cB = (const char*)g.Bt + (size_t)cur.pn * tstepB;
    PG8_STAGE(PG8_SB(0, 0), cB, voffB); PG8_STAGE(PG8_SB(0, 1), cB + hstepB, voffB); PG8_STAGE(PG8_SA(0, 0), cA, voffA); PG8_STAGE(PG8_SA(0, 1), cA + hstepA, voffA);
    if (wr == 1) PG8_BAR;
    PG8_WAIT_V(2); PG8_BAR;
    PG8_STAGE(PG8_SB(1, 0), cB + kstep, voffB); PG8_STAGE(PG8_SA(1, 0), cA + kstep, voffA); PG8_STAGE(PG8_SB(1, 1), cB + hstepB + kstep, voffB);
    PG8_WAIT_V(6); PG8_BAR;
    for (;;) {
        const bool has_next = S.next(ui + 1, nxt);
        const char* nA = has_next ? (const char*)g.A + (size_t)nxt.pm * tstepA : cA; const char* nB = has_next ? (const char*)g.Bt + (size_t)nxt.pn * tstepB : cB;
        for (int t = 0; t < nt; t += 2) {
            const bool last = (t == nt - 2);
            const char* a1 = cA + (size_t)(t + 1) * kstep;
            const char* a2 = last ? nA : cA + (size_t)(t + 2) * kstep; const char* b2 = last ? nB : cB + (size_t)(t + 2) * kstep;
            const char* a3 = a2 + kstep; const char* b3 = b2 + kstep;
            PG8_LDB(B0, 0, 0); PG8_LDB(B1, 0, 1); PG8_SCHED; PG8_LDA(At, 0, 0); PG8_STAGE(PG8_SA(1, 1), a1 + hstepA, voffA);
            PG8_WAIT_V(8); PG8_WAIT_L(0); PG8_BAR; PG8_MMA(0, 0, At, B0); PG8_MMA(0, 1, At, B1); PG8_BAR; PG8_SCHED;
            PG8_LDA(At, 0, 1); PG8_STAGE(PG8_SB(0, 0), b2, voffB); PG8_STAGE(PG8_SB(0, 1), b2 + hstepB, voffB); PG8_STAGE(PG8_SA(0, 0), a2, voffA);
            PG8_WAIT_V(8); PG8_WAIT_L(0); PG8_BAR; PG8_MMA(1, 0, At, B0); PG8_MMA(1, 1, At, B1); PG8_BAR; PG8_SCHED;
            PG8_LDB(B0, 1, 0); PG8_LDB(B1, 1, 1); PG8_SCHED; PG8_LDA(At, 1, 0); PG8_STAGE(PG8_SA(0, 1), a2 + hstepA, voffA);
            PG8_WAIT_V(8); PG8_WAIT_L(0); PG8_BAR; PG8_MMA(0, 0, At, B0); PG8_MMA(0, 1, At, B1); PG8_BAR; PG8_SCHED;
            PG8_LDA(At, 1, 1); PG8_STAGE(PG8_SB(1, 0), b3, voffB); PG8_STAGE(PG8_SB(1, 1), b3 + hstepB, voffB); PG8_STAGE(PG8_SA(1, 0), a3, voffA);
            PG8_WAIT_V(8); PG8_WAIT_L(0); PG8_BAR; PG8_MMA(1, 0, At, B0); PG8_MMA(1, 1, At, B1); PG8_BAR; PG8_SCHED;
        }
        if (wr == 0) PG8_BAR;
        E(acc, cur, wr, wc, fr, fq);
        if (!has_next) break;
#pragma unroll
        for (int a = 0; a < 2; ++a)
#pragma unroll
            for (int b = 0; b < 2; ++b)
#pragma unroll
                for (int m = 0; m < 4; ++m)
#pragma unroll
                    for (int n = 0; n < 2; ++n) acc[a][b][m][n] = (f32x4){0.f, 0.f, 0.f, 0.f};
        cur = nxt; cA = nA; cB = nB; ++ui;
        if (wr == 1) PG8_BAR;
    }
    PG8_WAIT_V(0);
    PG8_BAR;
#undef PG8_SA
#undef PG8_SB
#undef PG8_STAGE
#undef PG8_LDA
#undef PG8_LDB
#undef PG8_MMA
#undef PG8_WAIT_V
#undef PG8_WAIT_L
#undef PG8_BAR
#undef PG8_SCHED
}
}

namespace att {
#define SBAR() __builtin_amdgcn_sched_barrier(0)
constexpr int SHM_V = 64 * 128 * 2;
__device__ __forceinline__ int crow(int r, int hi) { return (r & 3) + 8 * (r >> 2) + 4 * hi; }
template <int DQK> struct Cfg {
    static constexpr int KP = DQK * 2, SHM_K = 64 * KP, OFF_K = 2 * SHM_V, OFF_WS = OFF_K + 2 * SHM_K, NPARK = (DQK == 192 ? 6 : 0), NREG = DQK / 16 - NPARK, OFF_QS = OFF_WS + 8 * 256, TOTAL = OFF_QS + 8 * 1024 * NPARK;
    static constexpr float SCALE = (DQK == 192) ? 0.07216878364870322f : 0.08838834764831845f;
    static constexpr float C = SCALE * 1.4426950408889634f;
};
constexpr float THR = 8.f;

template <int DQK>
__device__ __forceinline__ void partialSM(f32x16& p0, f32x16& p1, float& m_reg, float& mn, float& alpha) {
    constexpr float C = Cfg<DQK>::C, SCALE = Cfg<DQK>::SCALE;
    float pmax = p0[0];
#pragma unroll
    for (int r = 1; r < 16; ++r) pmax = fmaxf(pmax, p0[r]);
#pragma unroll
    for (int r = 0; r < 16; ++r) pmax = fmaxf(pmax, p1[r]);
    { auto rr = __builtin_amdgcn_permlane32_swap(__float_as_uint(pmax), __float_as_uint(pmax), false, false);
      pmax = fmaxf(__uint_as_float(rr[0]), __uint_as_float(rr[1])); }
    if (__builtin_expect(__all(pmax - m_reg <= THR / SCALE), 1)) { mn = m_reg; alpha = 1.f; }
    else { mn = fmaxf(m_reg, pmax); alpha = __builtin_amdgcn_exp2f((m_reg - mn) * C); m_reg = mn; }
    const float mnC = -mn * C;
#pragma unroll
    for (int r = 0; r < 16; ++r) p0[r] = fmaf(p0[r], C, mnC);
#pragma unroll
    for (int r = 0; r < 16; ++r) p1[r] = fmaf(p1[r], C, mnC);
#pragma unroll
    for (int r = 0; r < 16; ++r) p0[r] = __builtin_amdgcn_exp2f(p0[r]);
}
__device__ __forceinline__ void finishSM(f32x16& p0, f32x16& p1, float alpha, float& l_reg, bf16x8& pa0, bf16x8& pa1, bf16x8& pa2, bf16x8& pa3) {
#pragma unroll
    for (int r = 0; r < 16; ++r) p1[r] = __builtin_amdgcn_exp2f(p1[r]);
    float ps = 0;
#pragma unroll
    for (int r = 0; r < 16; ++r) ps += p0[r];
#pragma unroll
    for (int r = 0; r < 16; ++r) ps += p1[r];
    { auto rr = __builtin_amdgcn_permlane32_swap(__float_as_uint(ps), __float_as_uint(ps), false, false);
      ps = __uint_as_float(rr[0]) + __uint_as_float(rr[1]); }
    l_reg = l_reg * alpha + ps;
#define PK4(P, BASE, OUT) do { unsigned a0 = cvt_pk_bf16(P[BASE + 0], P[BASE + 1]), a1 = cvt_pk_bf16(P[BASE + 2], P[BASE + 3]);   \
    unsigned b0 = cvt_pk_bf16(P[BASE + 4], P[BASE + 5]), b1 = cvt_pk_bf16(P[BASE + 6], P[BASE + 7]);                              \
    auto r0 = __builtin_amdgcn_permlane32_swap(a0, b0, false, false); auto r1 = __builtin_amdgcn_permlane32_swap(a1, b1, false, false); \
    u32x4 w = {r0[0], r1[0], r0[1], r1[1]}; OUT = __builtin_bit_cast(bf16x8, w); } while (0)
    PK4(p0, 0, pa0); PK4(p0, 8, pa1); PK4(p1, 0, pa2); PK4(p1, 8, pa3);
#undef PK4
}
#define KSWZ(KP, row, colB) ((row) * (KP) + ((colB) ^ (((row) & 7) << 4)))
template <int DQK>
__device__ __forceinline__ void qkt(f32x16& p0, f32x16& p1, const LAS char* Ks, const bf16x8* qr, const LAS char* Qs, int r32, int hi) {
    constexpr int KP = Cfg<DQK>::KP;
    p0 = f32x16{}; p1 = f32x16{};
#pragma unroll
    for (int d0 = 0; d0 < DQK / 16; ++d0) { const int cb = (d0 * 16 + hi * 8) * 2;
        const bf16x8 b0 = *(const LAS bf16x8*)(Ks + KSWZ(KP, r32, cb));
        const bf16x8 b1 = *(const LAS bf16x8*)(Ks + KSWZ(KP, 32 + r32, cb));
        bf16x8 q;
        if (d0 < Cfg<DQK>::NREG) q = qr[d0]; else q = *(const LAS bf16x8*)(Qs + (d0 - Cfg<DQK>::NREG) * 1024);
        p0 = __builtin_amdgcn_mfma_f32_32x32x16_bf16(b0, q, p0, 0, 0, 0);
        p1 = __builtin_amdgcn_mfma_f32_32x32x16_bf16(b1, q, p1, 0, 0, 0); }
}
__device__ __forceinline__ int v_st(int k, int c) { const int kk = (k & ~0xC) | ((k & 4) << 1) | ((k & 8) >> 1); return ((kk >> 3) * 4 + (c >> 5)) * 512 + ((kk & 7) * 32 + (c & 31)) * 2; }
__device__ __forceinline__ int v_rd_base(int lane) { return ((lane & 3) << 3) | (((lane >> 2) & 3) << 6) | (((lane >> 4) & 1) << 5) | (((lane >> 5) & 1) << 8); }
constexpr int v_rd_off(int d0, int ks, int half) { return d0 * 512 + ks * 4096 + half * 2048; }
template <int OFF> __device__ __forceinline__ s16x4 tr_read(int vb) {
    s16x4 r; asm volatile("ds_read_b64_tr_b16 %0, %1 offset:%2" : "=&v"(r) : "v"(vb), "i"(OFF) : "memory"); return r;
}
template <int D0> __device__ __forceinline__ void pv_one(f32x16& od, int vb, bf16x8 pa0, bf16x8 pa1, bf16x8 pa2, bf16x8 pa3) {
    const s16x4 l0 = tr_read<v_rd_off(D0, 0, 0)>(vb), h0 = tr_read<v_rd_off(D0, 0, 1)>(vb), l1 = tr_read<v_rd_off(D0, 1, 0)>(vb), h1 = tr_read<v_rd_off(D0, 1, 1)>(vb);
    const s16x4 l2 = tr_read<v_rd_off(D0, 2, 0)>(vb), h2 = tr_read<v_rd_off(D0, 2, 1)>(vb), l3 = tr_read<v_rd_off(D0, 3, 0)>(vb), h3 = tr_read<v_rd_off(D0, 3, 1)>(vb);
    asm volatile("s_waitcnt lgkmcnt(0)" ::: "memory"); SBAR();
#define PKV(L, H) (bf16x8){L[0], L[1], L[2], L[3], H[0], H[1], H[2], H[3]}
    od = __builtin_amdgcn_mfma_f32_32x32x16_bf16(pa0, PKV(l0, h0), od, 0, 0, 0);
    od = __builtin_amdgcn_mfma_f32_32x32x16_bf16(pa1, PKV(l1, h1), od, 0, 0, 0);
    od = __builtin_amdgcn_mfma_f32_32x32x16_bf16(pa2, PKV(l2, h2), od, 0, 0, 0);
    od = __builtin_amdgcn_mfma_f32_32x32x16_bf16(pa3, PKV(l3, h3), od, 0, 0, 0);
#undef PKV
}
__device__ __forceinline__ void pv_d0(f32x16* o, int vb, bf16x8 pa0, bf16x8 pa1, bf16x8 pa2, bf16x8 pa3) {
    pv_one<0>(o[0], vb, pa0, pa1, pa2, pa3); pv_one<1>(o[1], vb, pa0, pa1, pa2, pa3); pv_one<2>(o[2], vb, pa0, pa1, pa2, pa3); pv_one<3>(o[3], vb, pa0, pa1, pa2, pa3);
}
__device__ __forceinline__ void store_o(const f32x16* o, float l_reg, LAS float* li_l, LAS char* lds, bf16* Ob, int ldo, int wid, int lane, int r32, int hi) {
    if (hi == 0) li_l[r32] = l_reg;
    asm volatile("s_waitcnt lgkmcnt(0)" ::: "memory");
    float rli[16];
#pragma unroll
    for (int r = 0; r < 16; ++r) rli[r] = __builtin_amdgcn_rcpf(li_l[crow(r, hi)]);
    LAS unsigned short* slab = (LAS unsigned short*)(lds + wid * 8192);
#pragma unroll
    for (int r = 0; r < 16; ++r) { const int orow = crow(r, hi);
#pragma unroll
        for (int d0 = 0; d0 < 4; ++d0) slab[orow * 128 + d0 * 32 + r32] = (unsigned short)(cvt_pk_bf16(o[d0][r] * rli[r], 0.f) & 0xffffu); }
    asm volatile("s_waitcnt lgkmcnt(0)" ::: "memory");
#pragma unroll
    for (int i = 0; i < 8; ++i) { const int id = i * 64 + lane, row = id >> 4, c16 = id & 15;
        const u32x4 w = *(const LAS u32x4*)((LAS char*)slab + row * 256 + c16 * 16);
        *(u32x4*)(Ob + (unsigned)(wid * 32 + row) * (unsigned)ldo + c16 * 8) = w; }
}

template <int DQK, int SDEPTH>
__device__ __forceinline__ void dense_unit(const bf16* __restrict__ Qb, int ldq, const bf16* __restrict__ Kh, int ldk, const bf16* __restrict__ K2h, int ldk2,
                                           const bf16* __restrict__ Vh, int ldv, bf16* __restrict__ Ob, int ldo, int seq, LAS char* lds, int wid) {
    using CF = Cfg<DQK>; constexpr int KP = CF::KP, SHM_K = CF::SHM_K, ND0 = DQK / 16;
    const int lane = lane_id_fresh(), tid = wid * 64 + lane, r32 = lane & 31, hi = lane >> 5;
    LAS char* V_lds = lds; LAS char* K_lds = lds + CF::OFF_K;
    LAS float* ws = (LAS float*)(lds + CF::OFF_WS) + wid * 64; LAS float* li_l = ws; LAS float* al_l = ws + 32;
    float m_reg = -1e30f, l_reg = 0; f32x16 o[4] = {}; bf16x8 qr[CF::NREG];
    const LAS char* Qs = lds + CF::OFF_QS + wid * (1024 * CF::NPARK) + lane * 16;
    { const unsigned qo = (unsigned)(wid * 32 + r32) * (unsigned)ldq + hi * 8;
#pragma unroll
      for (int d0 = 0; d0 < CF::NREG; ++d0) qr[d0] = *(const bf16x8*)(Qb + qo + d0 * 16);
      if constexpr (CF::NPARK > 0) {
#pragma unroll
          for (int d0 = CF::NREG; d0 < ND0; ++d0) { const bf16x8 t = *(const bf16x8*)(Qb + qo + d0 * 16); *(LAS bf16x8*)((LAS char*)Qs + (d0 - CF::NREG) * 1024) = t; } } }
    const int sr = tid >> 4, sc = (tid & 15) * 8, vst0 = v_st(sr, sc), vst1 = v_st(32 + sr, sc);
    const int kst0 = KSWZ(KP, sr, sc * 2), kst1 = KSWZ(KP, 32 + sr, sc * 2);
    const int kr2 = tid >> 3, c2 = (tid & 7) * 8, kst2 = KSWZ(KP, kr2, (128 + c2) * 2);
    const unsigned vo = (unsigned)sr * (unsigned)ldv + sc, ko = (unsigned)sr * (unsigned)ldk + sc, k2o = (unsigned)kr2 * (unsigned)ldk2 + c2;
    const int vb0 = (int)(unsigned)(uintptr_t)V_lds + v_rd_base(lane);
    struct { bf16x8 vs0, vs1, ks0, ks1, k2; } sr_[SDEPTH];
#define SLOAD(i, k0) do { const bf16* Vt_ = Vh + (size_t)(k0) * ldv; const bf16* Kt_ = Kh + (size_t)(k0) * ldk; \
    sr_[i].vs0 = *(const bf16x8*)(Vt_ + vo); sr_[i].vs1 = *(const bf16x8*)(Vt_ + (size_t)32 * ldv + vo); \
    sr_[i].ks0 = *(const bf16x8*)(Kt_ + ko); sr_[i].ks1 = *(const bf16x8*)(Kt_ + (size_t)32 * ldk + ko); \
    if constexpr (DQK == 192) sr_[i].k2 = *(const bf16x8*)(K2h + (size_t)(k0) * ldk2 + k2o); } while (0)
#define SWRITE(b, i) do { *(LAS bf16x8*)(V_lds + (b) * SHM_V + vst0) = sr_[i].vs0; *(LAS bf16x8*)(V_lds + (b) * SHM_V + vst1) = sr_[i].vs1; \
    *(LAS bf16x8*)(K_lds + (b) * SHM_K + kst0) = sr_[i].ks0; *(LAS bf16x8*)(K_lds + (b) * SHM_K + kst1) = sr_[i].ks1; \
    if constexpr (DQK == 192) *(LAS bf16x8*)(K_lds + (b) * SHM_K + kst2) = sr_[i].k2; } while (0)
#define SWAIT() do { if constexpr (SDEPTH == 1) asm volatile("s_waitcnt vmcnt(0)" ::: "memory"); else if constexpr (DQK == 192) asm volatile("s_waitcnt vmcnt(5)" ::: "memory"); else asm volatile("s_waitcnt vmcnt(4)" ::: "memory"); } while (0)
#define RESC(a) do { if (__any((a) < 1.f)) { if (hi == 0) al_l[r32] = (a); asm volatile("s_waitcnt lgkmcnt(0)" ::: "memory"); \
    _Pragma("unroll") for (int d = 0; d < 4; ++d) _Pragma("unroll") for (int r = 0; r < 16; ++r) o[d][r] *= al_l[crow(r, hi)]; } } while (0)
    f32x16 pA0, pA1, pB0, pB1; float mnA, mnB, alA, alB; bf16x8 pa0, pa1, pa2, pa3; const int NT = seq / 64;
    constexpr int SE = 0, SO = SDEPTH - 1;
    __syncthreads();
    SLOAD(SE, 0); asm volatile("s_waitcnt vmcnt(0)" ::: "memory"); SWRITE(0, SE); __syncthreads();
    qkt<DQK>(pA0, pA1, K_lds, qr, Qs, r32, hi); partialSM<DQK>(pA0, pA1, m_reg, mnA, alA);
    SLOAD(SO, 64); if constexpr (SDEPTH == 2) { if (2 < NT) SLOAD(SE, 128); }
    SWAIT(); SWRITE(1, SO); __syncthreads();
    for (int j = 1; j + 1 < NT; j += 2) {
        SBAR(); qkt<DQK>(pB0, pB1, K_lds + SHM_K, qr, Qs, r32, hi);
        finishSM(pA0, pA1, alA, l_reg, pa0, pa1, pa2, pa3); SBAR();
        SLOAD(SO, (j + SDEPTH) * 64); SBAR();
        pv_d0(o, vb0, pa0, pa1, pa2, pa3); partialSM<DQK>(pB0, pB1, m_reg, mnB, alB);
        __syncthreads(); SWAIT(); SWRITE(0, SE);
        RESC(alB); __syncthreads();
        SBAR(); qkt<DQK>(pA0, pA1, K_lds, qr, Qs, r32, hi);
        finishSM(pB0, pB1, alB, l_reg, pa0, pa1, pa2, pa3); SBAR();
        if (SDEPTH == 1 || j + 3 < NT) SLOAD(SE, (j + 1 + SDEPTH) * 64); SBAR();
        pv_d0(o, vb0 + SHM_V, pa0, pa1, pa2, pa3); partialSM<DQK>(pA0, pA1, m_reg, mnA, alA);
        __syncthreads(); SWAIT(); SWRITE(1, SO);
        RESC(alA); __syncthreads();
    }
    SBAR(); qkt<DQK>(pB0, pB1, K_lds + SHM_K, qr, Qs, r32, hi);
    finishSM(pA0, pA1, alA, l_reg, pa0, pa1, pa2, pa3); SBAR();
    pv_d0(o, vb0, pa0, pa1, pa2, pa3); partialSM<DQK>(pB0, pB1, m_reg, mnB, alB);
    __syncthreads(); RESC(alB);
    finishSM(pB0, pB1, alB, l_reg, pa0, pa1, pa2, pa3); SBAR();
    pv_d0(o, vb0 + SHM_V, pa0, pa1, pa2, pa3);
    __syncthreads();
    store_o(o, l_reg, li_l, lds, Ob, ldo, wid, lane, r32, hi);
#undef SLOAD
#undef SWRITE
#undef SWAIT
}

constexpr int NA_OFF_K = SHM_V, NA_OFF_RPB = 65536, NA_OFF_WS = 65536 + 2048, NA_TOTAL = NA_OFF_WS + 8 * 256;
__device__ __forceinline__ int clampi(int v, int lo, int hi) { return v < lo ? lo : (v > hi ? hi : v); }
__device__ __forceinline__ void na_unit(const bf16* __restrict__ Qb, int ldq, const bf16* __restrict__ Kseq, const bf16* __restrict__ Vseq, int ldk,
                                        bf16* __restrict__ Ob, int ldo, int r0, const float* __restrict__ rpb_h, LAS char* lds, int wid) {
    constexpr int KP = 256;
    const int lane = lane_id_fresh(), tid = wid * 64 + lane, r32 = lane & 31, hi = lane >> 5;
    LAS char* V_lds = lds; LAS char* K_lds = lds + NA_OFF_K; LAS float* rpb_l = (LAS float*)(lds + NA_OFF_RPB);
    LAS float* ws = (LAS float*)(lds + NA_OFF_WS) + wid * 64; LAS float* li_l = ws; LAS float* al_l = ws + 32;
    float m_reg = -1e30f, l_reg = 0; f32x16 o[4] = {}; bf16x8 qr[8];
    { const unsigned qo = (unsigned)(wid * 32 + r32) * (unsigned)ldq + hi * 8;
#pragma unroll
      for (int d0 = 0; d0 < 8; ++d0) qr[d0] = *(const bf16x8*)(Qb + qo + d0 * 16); }
    const int sr = tid >> 4, sc = (tid & 15) * 8, vst0 = v_st(sr, sc), vst1 = v_st(32 + sr, sc);
    const int kst0 = KSWZ(KP, sr, sc * 2), kst1 = KSWZ(KP, 32 + sr, sc * 2);
    const unsigned ko = (unsigned)sr * (unsigned)ldk + sc;
    const int vb0 = (int)(unsigned)(uintptr_t)V_lds + v_rd_base(lane);
    const int kr_lo = clampi(r0 - 4, 0, 56), kr_hi = clampi(r0 + 3 - 4, 0, 56) + 8;
    const int qrw = r0 + (wid >> 1), srw = clampi(qrw - 4, 0, 56);
    const int qc = (wid & 1) * 32 + r32, scq = clampi(qc - 8, 0, 48);
    __syncthreads();
    if (tid < 465) rpb_l[tid] = rpb_h[tid] * 11.313708498984761f;
    for (int kr = kr_lo; kr < kr_hi; ++kr) {
        const bf16* Kt = Kseq + (size_t)(kr * 64) * ldk; const bf16* Vt = Vseq + (size_t)(kr * 64) * ldk;
        const bf16x8 v0 = *(const bf16x8*)(Vt + ko), v1 = *(const bf16x8*)(Vt + (size_t)32 * ldk + ko), k0 = *(const bf16x8*)(Kt + ko), k1 = *(const bf16x8*)(Kt + (size_t)32 * ldk + ko);
        __syncthreads();
        *(LAS bf16x8*)(V_lds + vst0) = v0; *(LAS bf16x8*)(V_lds + vst1) = v1; *(LAS bf16x8*)(K_lds + kst0) = k0; *(LAS bf16x8*)(K_lds + kst1) = k1;
        __syncthreads();
        if (kr >= srw && kr < srw + 8) {
            f32x16 p0, p1; float mn, al; bf16x8 pa0, pa1, pa2, pa3;
            qkt<128>(p0, p1, K_lds, qr, nullptr, r32, hi);
            const LAS float* bt = rpb_l + (kr - qrw + 7) * 31 + (15 - qc);
#pragma unroll
            for (int r = 0; r < 16; ++r) { const int kc = crow(r, hi); const bool in = (kc >= scq) && (kc < scq + 16); const float b = bt[in ? kc : qc]; p0[r] = in ? p0[r] + b : -1e30f; }
#pragma unroll
            for (int r = 0; r < 16; ++r) { const int kc = 32 + crow(r, hi); const bool in = (kc >= scq) && (kc < scq + 16); const float b = bt[in ? kc : qc]; p1[r] = in ? p1[r] + b : -1e30f; }
            partialSM<128>(p0, p1, m_reg, mn, al);
            RESC(al);
            finishSM(p0, p1, al, l_reg, pa0, pa1, pa2, pa3); SBAR();
            pv_d0(o, vb0, pa0, pa1, pa2, pa3);
        }
    }
    __syncthreads();
    store_o(o, l_reg, li_l, lds, Ob, ldo, wid, lane, r32, hi);
}
#undef RESC
}

constexpr size_t MiB = 1u << 20;
constexpr size_t WS_CTL = 0, CTL_ZERO_BYTES = 1 * MiB;
constexpr size_t WS_TAB_MLA = 1 * MiB;
constexpr size_t WS_TAB_1D = 2 * MiB;
constexpr size_t WS_MN = 8 * MiB;
constexpr size_t WS_MKV = 20 * MiB;
constexpr size_t WS_WB = 32 * MiB;
constexpr size_t WB_IN = 0, WB_QB = 24 * MiB, WB_KVB = 26 * MiB, WB_OUT = 28 * MiB, WB_XQ = 36 * MiB, WB_XKV = 38 * MiB, WB_XO = 42 * MiB, WB_UP = 44 * MiB, WB_DOWN = 76 * MiB;
constexpr size_t WS_H = 144 * MiB;
constexpr size_t WS_BIG = 336 * MiB;
constexpr size_t BIG_PROJ = 0, BIG_Q = 264 * MiB, BIG_KV = 408 * MiB;
constexpr size_t BIG_SPLIT = 96 * MiB;
constexpr size_t BIG_XQ = 0, BIG_XO = 48 * MiB;
constexpr size_t BIG_U = 0;
constexpr size_t WS_END = WS_BIG + 600 * MiB;
constexpr int CW_BAR = 4096;

constexpr int RING_BYTES = 135168, MISC_OFF = RING_BYTES + 320, PTR_OFF = RING_BYTES + 1024, LDS_BYTES = 147456;
static_assert(att::Cfg<192>::TOTAL <= RING_BYTES && att::NA_TOTAL <= RING_BYTES && pg8::STAGE_BYTES <= RING_BYTES, "LDS map");

#define XB_TMO      128
#define XB_XCNT(j)  (256  + 64 * (j))
#define XB_XSUB(j)  (1280 + 64 * (j))
#define XB_XGEN(j)  (2304 + 64 * (j))
#define XB_TOP      3328
#define XB_TOPGEN   3392
#define XCD_BAR_WORDS 3456
#define XB_SPIN_CAP (1u << 18)
__device__ __forceinline__ unsigned xb_ld(unsigned* p)              { return __hip_atomic_load(p, __ATOMIC_RELAXED, __HIP_MEMORY_SCOPE_AGENT); }
__device__ __forceinline__ unsigned xb_add(unsigned* p, unsigned v) { return __hip_atomic_fetch_add(p, v, __ATOMIC_RELAXED, __HIP_MEMORY_SCOPE_AGENT); }
__device__ __forceinline__ unsigned xb_xcc_id() { return (unsigned)__builtin_amdgcn_s_getreg((3 << 11) | 20) & 0xFu; }
#define XB_SPIN(cond, bar) do { unsigned _sp = 0; while (cond) { __builtin_amdgcn_s_sleep(1); \
    if ((++_sp & 255u) == 0u) { if (xb_ld(&(bar)[XB_TMO])) break; if (_sp > XB_SPIN_CAP) { atomicAdd(&(bar)[XB_TMO], 1u); break; } } } } while (0)
struct XcdBarrier { unsigned* bar; unsigned x; volatile LAS unsigned* st; };
__device__ __forceinline__ XcdBarrier xcd_barrier_post(unsigned* bar, volatile LAS unsigned* st, int wave) {
    XcdBarrier b; b.bar = bar; b.x = xb_xcc_id(); b.st = st;
    if (wave == 0 && lane_id_fresh() == 0) (void)xb_add(&bar[XB_XCNT(b.x)], 1u);
    return b;
}
__device__ __forceinline__ void xcd_barrier_complete(unsigned* bar, unsigned x, unsigned& nloc, unsigned& nx) {
    const unsigned G = gridDim.x * gridDim.y * gridDim.z;
    unsigned sum, cnt, mine, sp = 0u;
    for (;;) {
        sum = 0u; cnt = 0u; mine = 0u;
#pragma unroll
        for (unsigned j = 0; j < 16; ++j) { const unsigned c = xb_ld(&bar[XB_XCNT(j)]); sum += c; cnt += (c > 0u) ? 1u : 0u; mine = (j == x) ? c : mine; }
        if (sum == G) break;
        __builtin_amdgcn_s_sleep(1);
        if ((++sp & 255u) == 0u) { if (xb_ld(&bar[XB_TMO])) break; if (sp > XB_SPIN_CAP) { atomicAdd(&bar[XB_TMO], 1u); break; } }
    }
    nloc = mine > 0u ? mine : 1u; nx = cnt > 0u ? cnt : 1u;
}
__device__ __forceinline__ void xcd_barrier(const XcdBarrier& b, int wave) {
    asm volatile("s_waitcnt vmcnt(0)" ::: "memory");
    __syncthreads();
    if (wave == 0 && lane_id_fresh() == 0) {
        unsigned long long bar_i = (unsigned long long)(uintptr_t)b.bar; asm volatile("" : "+s"(bar_i));
        unsigned* bar = (unsigned*)(GAS unsigned*)(uintptr_t)bar_i;
        __builtin_amdgcn_s_waitcnt(0);
        unsigned nloc = b.st[0], nx = b.st[1];
        if (nloc == 0u) { xcd_barrier_complete(bar, b.x, nloc, nx); b.st[0] = nloc; b.st[1] = nx; }
        const unsigned old = xb_add(&bar[XB_XSUB(b.x)], 1u);
        const unsigned gen = old / nloc;
        if (old + 1u == (gen + 1u) * nloc) {
            __builtin_amdgcn_fence(__ATOMIC_RELEASE, "agent");
            asm volatile("s_waitcnt vmcnt(0)" ::: "memory");
            const unsigned og = xb_add(&bar[XB_TOP], 1u);
            const unsigned tg = og / nx;
            if (og + 1u == (tg + 1u) * nx) xb_add(&bar[XB_TOPGEN], 1u);
            else XB_SPIN(xb_ld(&bar[XB_TOPGEN]) == tg, bar);
            __builtin_amdgcn_fence(__ATOMIC_ACQUIRE, "agent");
            xb_add(&bar[XB_XGEN(b.x)], 1u);
            asm volatile("s_waitcnt vmcnt(0)" ::: "memory");
        } else {
            XB_SPIN(xb_ld(&bar[XB_XGEN(b.x)]) == gen, bar);
            __builtin_amdgcn_fence(__ATOMIC_ACQUIRE, "agent");
            asm volatile("s_waitcnt vmcnt(0)" ::: "memory");
        }
    }
    __syncthreads();
}

#define LDS_WAIT() asm volatile("s_waitcnt lgkmcnt(0)" ::: "memory")
__device__ __forceinline__ void transpose_item(const float* W, int K, int N, bf16* WT, LAS float* scr, int item, int lane) {
    const int nblk = N / 32, kb = item / nblk, nb = item % nblk, k0 = 64 * kb, n0 = 32 * nb;
#pragma unroll 8
    for (int i = 0; i < 32; ++i) { const int kk = 2 * i + (lane >> 5); scr[kk * 33 + (lane & 31)] = W[(size_t)(k0 + kk) * N + n0 + (lane & 31)]; }
    LDS_WAIT(); asm volatile("" ::: "memory");
    const int c = lane & 7;
#pragma unroll
    for (int j = 0; j < 4; ++j) { const int n = (lane >> 3) + 8 * j; const LAS float* s = scr + (8 * c) * 33 + n;
        u32x4 o; o.x = cvt_pk_bf16(s[0 * 33], s[1 * 33]); o.y = cvt_pk_bf16(s[2 * 33], s[3 * 33]); o.z = cvt_pk_bf16(s[4 * 33], s[5 * 33]); o.w = cvt_pk_bf16(s[6 * 33], s[7 * 33]);
        *(u32x4*)(WT + (size_t)(n0 + n) * K + k0 + 8 * c) = o; }
    LDS_WAIT(); asm volatile("" ::: "memory");
}
__device__ __forceinline__ void convert_matrix(const float* W, int K, int N, bf16* WT, LAS float* scr, int gw, int NGW, int lane) {
    const int nitems = (K / 64) * (N / 32);
    for (int it = gw; it < nitems; it += NGW) transpose_item(W, K, N, WT, scr, it, lane);
}
__device__ __forceinline__ void norm_row_2048(const float* xrow, const float* g, bf16* orow, float* copy, int lane) {
    const f32x4* xr = (const f32x4*)xrow + lane;
    f32x4 v[8]; float s = 0.f;
#pragma unroll
    for (int j = 0; j < 8; ++j) { v[j] = xr[64 * j]; s += (v[j].x * v[j].x + v[j].y * v[j].y) + (v[j].z * v[j].z + v[j].w * v[j].w); }
    const float rstd = 1.f / sqrtf(wave_sum(s) * (1.f / 2048.f) + EPS);
    if (copy) {
#pragma unroll
        for (int j = 0; j < 8; ++j) ((f32x4*)copy + lane)[64 * j] = v[j]; }
    u32x2* o8 = (u32x2*)orow + lane;
#pragma unroll
    for (int j = 0; j < 8; ++j) { const f32x4 gg = ((const f32x4*)g + lane)[64 * j]; u32x2 w; w.x = cvt_pk_bf16(v[j].x * rstd * gg.x, v[j].y * rstd * gg.y); w.y = cvt_pk_bf16(v[j].z * rstd * gg.z, v[j].w * rstd * gg.w); o8[64 * j] = w; }
}
__device__ __forceinline__ void final_norm_row(float* xrow, const float* g, int lane) {
    f32x4* xr = (f32x4*)xrow + lane;
    f32x4 v[8]; float s = 0.f;
#pragma unroll
    for (int j = 0; j < 8; ++j) { v[j] = xr[64 * j]; s += (v[j].x * v[j].x + v[j].y * v[j].y) + (v[j].z * v[j].z + v[j].w * v[j].w); }
    const float rstd = 1.f / sqrtf(wave_sum(s) * (1.f / 2048.f) + EPS);
#pragma unroll
    for (int j = 0; j < 8; ++j) { const f32x4 gg = ((const f32x4*)g + lane)[64 * j]; xr[64 * j] = v[j] * rstd * gg; }
}
__device__ __forceinline__ void even_row_fix(bf16* row, int pos, const float* qn, const float* kvn, const float* gqn, const float* gkn, const float* tab_mla, int lane) {
    const float* cosm = tab_mla; const float* sinm = tab_mla + 4096 * 32;
#pragma unroll
    for (int part = 0; part < 2; ++part) {
        u32x4* p = (u32x4*)(row + part * 512) + lane; const u32x4 w = *p; const float* g = (part ? kvn : qn) + lane * 8;
        float x[8] = {bflo(w.x), bfhi(w.x), bflo(w.y), bfhi(w.y), bflo(w.z), bfhi(w.z), bflo(w.w), bfhi(w.w)};
        float s = 0.f;
#pragma unroll
        for (int e = 0; e < 8; ++e) s += x[e] * x[e];
        const float rstd = 1.f / sqrtf(wave_sum(s) * (1.f / 512.f) + EPS);
        const f32x4 g0 = *(const f32x4*)g, g1 = *(const f32x4*)(g + 4);
        u32x4 o; o.x = cvt_pk_bf16(x[0] * rstd * g0.x, x[1] * rstd * g0.y); o.y = cvt_pk_bf16(x[2] * rstd * g0.z, x[3] * rstd * g0.w);
        o.z = cvt_pk_bf16(x[4] * rstd * g1.x, x[5] * rstd * g1.y); o.w = cvt_pk_bf16(x[6] * rstd * g1.z, x[7] * rstd * g1.w);
        *p = o;
    }
    { bf16* p = row + 1024 + lane; const float x = bf2f(*p); const float y = other_half(x, lane < 32); const int f = lane & 31;
      const float c = cosm[pos * 32 + f], s = sinm[pos * 32 + f];
      const float r = (lane < 32) ? (x * c - y * s) : (x * c + y * s);
      *p = (bf16)(cvt_pk_bf16(r, 0.f) & 0xffffu); }
    const int prow = pos >> 6, pcol = pos & 63;
    const int e0 = 2 * lane, f0 = e0 & 31; const int tp = (e0 < 64) ? prow : pcol;
    const float c0 = cosm[tp * 32 + f0], s0 = sinm[tp * 32 + f0], c1 = cosm[tp * 32 + f0 + 1], s1 = sinm[tp * 32 + f0 + 1];
    const bool first = ((e0 & 32) == 0);
#pragma unroll 2
    for (int h = 0; h < 10; ++h) {
        unsigned* p = (unsigned*)(row + (h < 8 ? 1088 + h * 128 : 2112 + (h - 8) * 128)) + lane; const unsigned w = *p; const float* g = (h < 8 ? gqn : gkn) + e0;
        float x0 = bflo(w), x1 = bfhi(w);
        const float rstd = 1.f / sqrtf(wave_sum(x0 * x0 + x1 * x1) * (1.f / 128.f) + EPS);
        x0 = x0 * rstd * g[0]; x1 = x1 * rstd * g[1];
        const float y0 = swz_xor<16>(x0), y1 = swz_xor<16>(x1);
        const float r0 = first ? (x0 * c0 - y0 * s0) : (x0 * c0 + y0 * s0);
        const float r1 = first ? (x1 * c1 - y1 * s1) : (x1 * c1 + y1 * s1);
        *p = cvt_pk_bf16(r0, r1);
    }
}
__device__ __forceinline__ void mla_q_rope_row(bf16* row, int pos, const float* tab_mla, int lane) {
    const int h = lane >> 3, s4 = (lane & 7) * 4;
    u32x2* p1 = (u32x2*)(row + h * 192 + 128 + s4); u32x2* p2 = (u32x2*)(row + h * 192 + 160 + s4);
    const u32x2 w1 = *p1, w2 = *p2;
    const f32x4 c = *(const f32x4*)(tab_mla + pos * 32 + s4), s = *(const f32x4*)(tab_mla + 4096 * 32 + pos * 32 + s4);
    const float x1[4] = {bflo(w1.x), bfhi(w1.x), bflo(w1.y), bfhi(w1.y)}, x2[4] = {bflo(w2.x), bfhi(w2.x), bflo(w2.y), bfhi(w2.y)};
    float a[4], b[4];
#pragma unroll
    for (int e = 0; e < 4; ++e) { a[e] = x1[e] * c[e] - x2[e] * s[e]; b[e] = x2[e] * c[e] + x1[e] * s[e]; }
    u32x2 o1, o2; o1.x = cvt_pk_bf16(a[0], a[1]); o1.y = cvt_pk_bf16(a[2], a[3]); o2.x = cvt_pk_bf16(b[0], b[1]); o2.y = cvt_pk_bf16(b[2], b[3]);
    *p1 = o1; *p2 = o2;
}
__device__ __forceinline__ void rope1d_row(bf16* row, int pos, const float* tab_1d, int lane) {
    const int h = lane >> 3, s8 = (lane & 7) * 8;
    u32x4* p1 = (u32x4*)(row + h * 128 + s8); u32x4* p2 = (u32x4*)(row + h * 128 + 64 + s8);
    const u32x4 w1 = *p1, w2 = *p2;
    const float* ct = tab_1d + pos * 64 + s8; const float* st = tab_1d + 4096 * 64 + pos * 64 + s8;
    const f32x4 c0 = *(const f32x4*)ct, c1 = *(const f32x4*)(ct + 4), s0 = *(const f32x4*)st, s1 = *(const f32x4*)(st + 4);
    const float c[8] = {c0.x, c0.y, c0.z, c0.w, c1.x, c1.y, c1.z, c1.w}, s[8] = {s0.x, s0.y, s0.z, s0.w, s1.x, s1.y, s1.z, s1.w};
    const float x1[8] = {bflo(w1.x), bfhi(w1.x), bflo(w1.y), bfhi(w1.y), bflo(w1.z), bfhi(w1.z), bflo(w1.w), bfhi(w1.w)};
    const float x2[8] = {bflo(w2.x), bfhi(w2.x), bflo(w2.y), bfhi(w2.y), bflo(w2.z), bfhi(w2.z), bflo(w2.w), bfhi(w2.w)};
    float a[8], b[8];
#pragma unroll
    for (int e = 0; e < 8; ++e) { a[e] = x1[e] * c[e] - x2[e] * s[e]; b[e] = x2[e] * c[e] + x1[e] * s[e]; }
    u32x4 o1, o2; o1.x = cvt_pk_bf16(a[0], a[1]); o1.y = cvt_pk_bf16(a[2], a[3]); o1.z = cvt_pk_bf16(a[4], a[5]); o1.w = cvt_pk_bf16(a[6], a[7]);
    o2.x = cvt_pk_bf16(b[0], b[1]); o2.y = cvt_pk_bf16(b[2], b[3]); o2.z = cvt_pk_bf16(b[4], b[5]); o2.w = cvt_pk_bf16(b[6], b[7]);
    *p1 = o1; *p2 = o2;
}
__device__ __forceinline__ void diff_combine_row(const bf16* oc, bf16* out, float lam, float post, const float* subln, int lane) {
    const f32x4 g = *(const f32x4*)(subln + lane * 4);
#pragma unroll
    for (int h = 0; h < 4; ++h) {
        const u32x2 w0 = *((const u32x2*)(oc + h * 512) + lane), w1 = *((const u32x2*)(oc + h * 512 + 256) + lane);
        float d[4] = {bflo(w0.x) - lam * bflo(w1.x), bfhi(w0.x) - lam * bfhi(w1.x), bflo(w0.y) - lam * bflo(w1.y), bfhi(w0.y) - lam * bfhi(w1.y)};
        const float rstd = 1.f / sqrtf(wave_sum((d[0] * d[0] + d[1] * d[1]) + (d[2] * d[2] + d[3] * d[3])) * (1.f / 256.f) + EPS);
        u32x2 o; o.x = cvt_pk_bf16(d[0] * rstd * g.x * post, d[1] * rstd * g.y * post); o.y = cvt_pk_bf16(d[2] * rstd * g.z * post, d[3] * rstd * g.w * post);
        *((u32x2*)(out + h * 256) + lane) = o;
    }
}
__device__ __forceinline__ void sincos_d(double a, double& sn, double& cs) {
    const double k = __builtin_rint(a * 0.15915494309189533577);
    const double r = __builtin_fma(-k, 6.283185307179586476925, a) - k * 2.4492935982947064e-16 * 0.0;
    const double r2 = r * r;
    double s = -1.0 / 51090942171709440000.0;
    s = s * r2 + 1.0 / 121645100408832000.0; s = s * r2 - 1.0 / 355687428096000.0; s = s * r2 + 1.0 / 1307674368000.0; s = s * r2 - 1.0 / 6227020800.0;
    s = s * r2 + 1.0 / 39916800.0; s = s * r2 - 1.0 / 362880.0; s = s * r2 + 1.0 / 5040.0; s = s * r2 - 1.0 / 120.0; s = s * r2 + 1.0 / 6.0; s = s * r2 - 1.0;
    sn = -s * r;
    double c = 1.0 / 1124000727777607680000.0;
    c = c * r2 - 1.0 / 2432902008176640000.0; c = c * r2 + 1.0 / 6402373705728000.0; c = c * r2 - 1.0 / 20922789888000.0; c = c * r2 + 1.0 / 87178291200.0;
    c = c * r2 - 1.0 / 479001600.0; c = c * r2 + 1.0 / 3628800.0; c = c * r2 - 1.0 / 40320.0; c = c * r2 + 1.0 / 720.0; c = c * r2 - 1.0 / 24.0; c = c * r2 + 0.5; c = c * r2 - 1.0;
    cs = -c;
}

__device__ __forceinline__ void* ld_ptr(LAS unsigned long long* P, int i) {
    const unsigned long long v = P[i];
    const unsigned lo = __builtin_amdgcn_readfirstlane((unsigned)v), hi = __builtin_amdgcn_readfirstlane((unsigned)(v >> 32));
    return (void*)(GAS void*)(uintptr_t)(((unsigned long long)hi << 32) | lo);
}
struct Args { const float* in[27]; float* out; unsigned char* ws; int ph_lo, ph_hi; };
enum { I_XP = 0, I_XS, I_MP, I_MS, I_NORM_MIX, I_W_IN_AB, I_MLA_QN, I_W_QB, I_MLA_KVN, I_W_KVB, I_GQA_QN, I_GQA_KN, I_W_OUT_AB, I_W_IN_CD, I_RPB, I_DLAM, I_SUBLN, I_W_OUT_CD,
       I_NORM_XA, I_NORM_MEM, I_W_XQ, I_W_XKV, I_W_XO, I_NORM_MLP, I_W_UP, I_W_DOWN, I_FINAL };

__global__ void __launch_bounds__(512, 2) fwd(Args args) {
    extern __shared__ __attribute__((aligned(16))) unsigned char lds_raw[];
    LAS unsigned char* lds = (LAS unsigned char*)lds_raw;
    volatile LAS unsigned* MISC = (volatile LAS unsigned*)(lds + MISC_OFF);
    const int tid0 = threadIdx.x, wave = __builtin_amdgcn_readfirstlane(tid0 >> 6);
    const int G = gridDim.x; const int bx = blockIdx.x; const int vcu = (G % 8 == 0) ? (bx % 8) * (G / 8) + bx / 8 : bx;
    const int gw = vcu * 8 + wave, NGW = G * 8;
    for (int u = tid0; u < (LDS_BYTES - RING_BYTES) / 4; u += 512) ((LAS unsigned*)(lds + RING_BYTES))[u] = 0u;
    __syncthreads();
    LAS unsigned long long* PTRS = (LAS unsigned long long*)(lds + PTR_OFF);
    if (tid0 == 0) {
#pragma unroll
        for (int i = 0; i < 27; ++i) PTRS[i] = (unsigned long long)(uintptr_t)args.in[i];
        PTRS[27] = (unsigned long long)(uintptr_t)args.out; PTRS[28] = (unsigned long long)(uintptr_t)args.ws;
    }
    const int lo = args.ph_lo, hi = args.ph_hi; int ph = 0;
    __syncthreads();
#define INP(i) ((const float*)ld_ptr(PTRS, (i)))
#define WSP ((unsigned char*)ld_ptr(PTRS, 28))
#define XP ((float*)ld_ptr(PTRS, 27))
    XcdBarrier bar = xcd_barrier_post((unsigned*)(WSP + WS_CTL) + CW_BAR, MISC + 8, wave);
#ifndef PH_MASK
#define PH_MASK 0xffffffffu
#endif
#define PEN(k) (((PH_MASK) >> (k)) & 1u)
#define PH_ON (ph >= lo && ph < hi)
#define PH_LANE const int lane = lane_id_fresh(), tid = wave * 64 + lane; (void)tid; (void)lane
#define PH_END do { if (ph >= lo && ph + 1 < hi) xcd_barrier(bar, wave); ++ph; } while (0)

#define X XP
#define H ((bf16*)(WSP + WS_H))
#define BIG (WSP + WS_BIG)
#define WB (WSP + WS_WB)
#define tab_mla ((float*)(WSP + WS_TAB_MLA))
#define tab_1d ((float*)(WSP + WS_TAB_1D))
#define MN ((bf16*)(WSP + WS_MN))
#define MKV ((bf16*)(WSP + WS_MKV))
    LAS float* scr = (LAS float*)(lds + wave * 16384);

    if (PH_ON && PEN(0)) { PH_LANE;
        const int gt = vcu * 512 + tid, NT_ = G * 512;
        for (int i = gt; i < 4096 * 32; i += NT_) { const int pos = i >> 5, f = i & 31; double inv = 1.0; for (int k = 0; k < f; ++k) inv *= 0.7498942093324558273;
            const float ang = (float)pos * (float)inv; double sn, cs; sincos_d((double)ang, sn, cs); tab_mla[i] = (float)cs; tab_mla[4096 * 32 + i] = (float)sn; }
        for (int i = gt; i < 4096 * 64; i += NT_) { const int pos = i >> 6, f = i & 63; double inv = 1.0; for (int k = 0; k < f; ++k) inv *= 0.8659643233600653524;
            const float ang = (float)pos * (float)inv; double sn, cs; sincos_d((double)ang, sn, cs); tab_1d[i] = (float)cs; tab_1d[4096 * 64 + i] = (float)sn; }
    }
    PH_END;

    for (int layer = 0; layer < DEPTH; ++layer) {
        const int j = layer >> 1; const bool even = (layer & 1) == 0;
#define W_IN ((bf16*)(WB + WB_IN))
#define W_QB ((bf16*)(WB + WB_QB))
#define W_KVB ((bf16*)(WB + WB_KVB))
#define W_OUT ((bf16*)(WB + WB_OUT))
#define W_XQ ((bf16*)(WB + WB_XQ))
#define W_XKV ((bf16*)(WB + WB_XKV))
#define W_XO ((bf16*)(WB + WB_XO))
#define W_UP ((bf16*)(WB + WB_UP))
#define W_DOWN ((bf16*)(WB + WB_DOWN))

        if (PH_ON && PEN(1)) { PH_LANE;
            if (even) {
                convert_matrix(INP(I_W_IN_AB) + (size_t)j * DM * AB_IN, DM, AB_IN, W_IN, scr, gw, NGW, lane);
                for (size_t i = (size_t)gw * 64 + lane; i < (size_t)(AB_PAD - AB_IN) * DM / 8; i += (size_t)NGW * 64) { u32x4 z = (u32x4){0u, 0u, 0u, 0u}; asm volatile("" : "+v"(z)); ((u32x4*)(W_IN + (size_t)AB_IN * DM))[i] = z; }
                convert_matrix(INP(I_W_QB) + (size_t)j * 512 * 1536, 512, 1536, W_QB, scr, gw, NGW, lane);
                convert_matrix(INP(I_W_KVB) + (size_t)j * 512 * 2048, 512, 2048, W_KVB, scr, gw, NGW, lane);
                convert_matrix(INP(I_W_OUT_AB) + (size_t)j * DM * DM, DM, DM, W_OUT, scr, gw, NGW, lane);
            } else {
                convert_matrix(INP(I_W_IN_CD) + (size_t)j * DM * CD_IN, DM, CD_IN, W_IN, scr, gw, NGW, lane);
                convert_matrix(INP(I_W_OUT_CD) + (size_t)j * DM * DM, DM, DM, W_OUT, scr, gw, NGW, lane);
            }
            convert_matrix(INP(I_W_XQ) + (size_t)layer * DM * 512, DM, 512, W_XQ, scr, gw, NGW, lane);
            convert_matrix(INP(I_W_XKV) + (size_t)layer * DM * 1024, DM, 1024, W_XKV, scr, gw, NGW, lane);
            convert_matrix(INP(I_W_XO) + (size_t)layer * 512 * DM, 512, DM, W_XO, scr, gw, NGW, lane);
            convert_matrix(INP(I_W_UP) + (size_t)layer * DM * DFF, DM, DFF, W_UP, scr, gw, NGW, lane);
            convert_matrix(INP(I_W_DOWN) + (size_t)layer * DFF * DM, DFF, DM, W_DOWN, scr, gw, NGW, lane);
            const float* g = INP(I_NORM_MIX) + layer * DM;
            for (int m = gw; m < T; m += NGW) {
                if (layer == 0) { const float* src = (m < T_PROMPT) ? INP(I_XP) + (size_t)m * DM : INP(I_XS) + (size_t)(m - T_PROMPT) * DM;
                    norm_row_2048(src, g, H + (size_t)m * DM, X + (size_t)m * DM, lane); }
                else norm_row_2048(X + (size_t)m * DM, g, H + (size_t)m * DM, nullptr, lane);
            }
        }
        PH_END;

        if (even) {
            bf16* PROJ = (bf16*)(BIG + BIG_PROJ); bf16* Q = (bf16*)(BIG + BIG_Q); bf16* KV = (bf16*)(BIG + BIG_KV);
            if (PH_ON && PEN(2)) { PH_LANE;
                pg8::Gemm g{H, W_IN, T, AB_PAD, DM, DM, DM}; pg8::StaticOrder S; S.init(T, AB_PAD, G, bx);
                pg8::EpiBf16<0> E{PROJ, AB_PAD, 0, 0};
                pg8::gemm_phase(lds, g, S, E, wave);
            }
            PH_END;
            if (PH_ON && PEN(3)) { PH_LANE;
                const float* qn = INP(I_MLA_QN) + j * 512; const float* kvn = INP(I_MLA_KVN) + j * 512; const float* gqn = INP(I_GQA_QN) + j * 128; const float* gkn = INP(I_GQA_KN) + j * 128;
                for (int m = gw; m < T; m += NGW) even_row_fix(PROJ + (size_t)m * AB_PAD, m & (SEQ - 1), qn, kvn, gqn, gkn, tab_mla, lane);
            }
            PH_END;
            if (PH_ON && PEN(4)) { PH_LANE;
#pragma unroll 1
                for (int gi = 0; gi < 2; ++gi) {
                    pg8::Gemm g{PROJ + (gi ? 512 : 0), gi ? W_KVB : W_QB, T, gi ? 2048 : 1536, 512, AB_PAD, 512}; pg8::StaticOrder S; S.init(T, g.N, G, bx);
                    pg8::EpiBf16<0> E{gi ? KV : Q, g.N, 0, 0};
                    pg8::gemm_phase(lds, g, S, E, wave);
                }
            }
            PH_END;
            if (PH_ON && PEN(5)) { PH_LANE; for (int m = gw; m < T; m += NGW) mla_q_rope_row(Q + (size_t)m * 1536, m & (SEQ - 1), tab_mla, lane); }
            PH_END;
            if (PH_ON) {
                if (PEN(6))
                for (int u = vcu; u < NSEQ * 8 * 16; u += G) { const int qb = u & 15, h = (u >> 4) & 7, b = u >> 7; const size_t t0 = (size_t)b * SEQ;
                    att::dense_unit<192, 1>(Q + (t0 + qb * 256) * 1536 + h * 192, 1536, KV + t0 * 2048 + h * 256, 2048, PROJ + t0 * AB_PAD + 1024, AB_PAD,
                                         KV + t0 * 2048 + h * 256 + 128, 2048, H + (t0 + qb * 256) * DM + h * 128, DM, SEQ, (LAS char*)lds, wave); }
                if (PEN(21))
                for (int u = vcu; u < NSEQ * 8 * 16; u += G) { const int qb = u & 15, h = (u >> 4) & 7, b = u >> 7; const size_t t0 = (size_t)b * SEQ; const int kvh = h >> 2;
                    att::dense_unit<128, 2>(PROJ + (t0 + qb * 256) * AB_PAD + 1088 + h * 128, AB_PAD, PROJ + t0 * AB_PAD + 2112 + kvh * 128, AB_PAD, nullptr, 0,
                                         PROJ + t0 * AB_PAD + 2368 + kvh * 128, AB_PAD, H + (t0 + qb * 256) * DM + 1024 + h * 128, DM, SEQ, (LAS char*)lds, wave); }
            }
            PH_END;
        } else {
            bf16* NQ = (bf16*)(BIG + 0 * BIG_SPLIT); bf16* NK = (bf16*)(BIG + 1 * BIG_SPLIT); bf16* NV = (bf16*)(BIG + 2 * BIG_SPLIT);
            bf16* DQ = (bf16*)(BIG + 3 * BIG_SPLIT); bf16* DK = (bf16*)(BIG + 4 * BIG_SPLIT); bf16* DV = (bf16*)(BIG + 5 * BIG_SPLIT); bf16* OC = NQ;
            if (PH_ON && PEN(7)) { PH_LANE;
                pg8::Gemm g{H, W_IN, T, CD_IN, DM, DM, DM}; pg8::StaticOrder S; S.init(T, CD_IN, G, bx);
                pg8::EpiBf16<0> E{NQ, 1024, 1024, BIG_SPLIT / 2};
                pg8::gemm_phase(lds, g, S, E, wave);
            }
            PH_END;
            if (PH_ON && PEN(8)) { PH_LANE; for (int m = gw; m < T; m += NGW) { rope1d_row(DQ + (size_t)m * 1024, m & (SEQ - 1), tab_1d, lane); rope1d_row(DK + (size_t)m * 1024, m & (SEQ - 1), tab_1d, lane); } }
            PH_END;
            if (PH_ON && PEN(9)) { PH_LANE;
                const float* rpb = INP(I_RPB) + (size_t)j * 8 * 465;
                for (int u = vcu; u < NSEQ * 8 * 16; u += G) { const int qb = u & 15, h = (u >> 4) & 7, b = u >> 7; const size_t t0 = (size_t)b * SEQ;
                    att::na_unit(NQ + (t0 + qb * 256) * 1024 + h * 128, 1024, NK + t0 * 1024 + h * 128, NV + t0 * 1024 + h * 128, 1024,
                                 H + (t0 + qb * 256) * DM + h * 128, DM, qb * 4, rpb + h * 465, (LAS char*)lds, wave); }
            }
            PH_END;
            if (PH_ON && PEN(10)) { PH_LANE;
                for (int u = vcu; u < NSEQ * 16 * 16; u += G) { const int qb = u & 15, hh = (u >> 4) & 15, b = u >> 8; const size_t t0 = (size_t)b * SEQ;
                    const int vh = hh & 1, c = (hh >> 1) & 1, h = hh >> 2;
                    att::dense_unit<128, 2>(DQ + (t0 + qb * 256) * 1024 + (2 * h + c) * 128, 1024, DK + t0 * 1024 + (2 * h + c) * 128, 1024, nullptr, 0,
                                         DV + t0 * 1024 + h * 256 + vh * 128, 1024, OC + (t0 + qb * 256) * 2048 + h * 512 + c * 256 + vh * 128, 2048, SEQ, (LAS char*)lds, wave); }
            }
            PH_END;
            if (PH_ON && PEN(11)) { PH_LANE;
                const float* lp = INP(I_DLAM) + j * 512;
                const float a0 = lp[lane] * lp[128 + lane] + lp[64 + lane] * lp[128 + 64 + lane], a1 = lp[256 + lane] * lp[384 + lane] + lp[256 + 64 + lane] * lp[384 + 64 + lane];
                const float lam_init = (layer == 1) ? 0.35550906759096934f : 0.5560582041556406f;
                const float lam = expf(wave_sum(a0)) - expf(wave_sum(a1)) + lam_init;
                const float* subln = INP(I_SUBLN) + j * 256;
                for (int m = gw; m < T; m += NGW) diff_combine_row(OC + (size_t)m * 2048, H + (size_t)m * DM + 1024, lam, 1.f - lam_init, subln, lane);
            }
            PH_END;
        }
        if (PH_ON && PEN(12)) { PH_LANE;
            pg8::Gemm g{H, W_OUT, T, DM, DM, DM, DM}; pg8::StaticOrder S; S.init(T, DM, G, bx);
            pg8::EpiResid E{X, DM};
            pg8::gemm_phase(lds, g, S, E, wave);
        }
        PH_END;
        if (PH_ON && PEN(13)) { PH_LANE;
            const float* g = INP(I_NORM_XA) + layer * DM; const float* gm = INP(I_NORM_MEM) + layer * DM;
            for (int m = gw; m < T + TM; m += NGW) {
                if (m < T) norm_row_2048(X + (size_t)m * DM, g, H + (size_t)m * DM, nullptr, lane);
                else { const int r = m - T; const float* src = (r < 8 * MEMLEN) ? INP(I_MP) + (size_t)r * DM : INP(I_MS) + (size_t)(r - 8 * MEMLEN) * DM;
                    norm_row_2048(src, gm, MN + (size_t)r * DM, nullptr, lane); }
            }
        }
        PH_END;
        {
            bf16* XQ = (bf16*)(BIG + BIG_XQ); bf16* XO = (bf16*)(BIG + BIG_XO);
            if (PH_ON && PEN(14)) { PH_LANE;
#pragma unroll 1
                for (int gi = 0; gi < 2; ++gi) {
                    pg8::Gemm g{gi ? MN : H, gi ? W_XKV : W_XQ, gi ? TM : T, gi ? 1024 : 512, DM, DM, DM}; pg8::StaticOrder S; S.init(g.M, g.N, G, bx);
                    pg8::EpiBf16<0> E{gi ? MKV : XQ, g.N, 0, 0};
                    pg8::gemm_phase(lds, g, S, E, wave);
                }
            }
            PH_END;
            if (PH_ON && PEN(15)) { PH_LANE;
                for (int u = vcu; u < NSEQ * 4 * 16; u += G) { const int qb = u & 15, h = (u >> 4) & 3, b = u >> 6; const size_t t0 = (size_t)b * SEQ;
                    att::dense_unit<128, 2>(XQ + (t0 + qb * 256) * 512 + h * 128, 512, MKV + (size_t)b * MEMLEN * 1024 + h * 128, 1024, nullptr, 0,
                                         MKV + (size_t)b * MEMLEN * 1024 + 512 + h * 128, 1024, XO + (t0 + qb * 256) * 512 + h * 128, 512, MEMLEN, (LAS char*)lds, wave); }
            }
            PH_END;
            if (PH_ON && PEN(16)) { PH_LANE;
                pg8::Gemm g{XO, W_XO, T, DM, 512, 512, 512}; pg8::StaticOrder S; S.init(T, DM, G, bx);
                pg8::EpiResid E{X, DM};
                pg8::gemm_phase(lds, g, S, E, wave);
            }
            PH_END;
        }
        if (PH_ON && PEN(17)) { PH_LANE; const float* g = INP(I_NORM_MLP) + layer * DM; for (int m = gw; m < T; m += NGW) norm_row_2048(X + (size_t)m * DM, g, H + (size_t)m * DM, nullptr, lane); }
        PH_END;
        {
            bf16* U = (bf16*)(BIG + BIG_U);
#pragma unroll 1
            for (int ch = 0; ch < N_MLP_CHUNKS; ++ch) {
                if (PH_ON && PEN(18)) { PH_LANE;
                    pg8::Gemm g{H + (size_t)ch * MLP_CHUNK * DM, W_UP, MLP_CHUNK, DFF, DM, DM, DM}; pg8::StaticOrder S; S.init(MLP_CHUNK, DFF, G, bx);
                    pg8::EpiBf16<2> E{U, DFF, 0, 0};
                    pg8::gemm_phase(lds, g, S, E, wave);
                }
                PH_END;
                if (PH_ON && PEN(19)) { PH_LANE;
                    pg8::Gemm g{U, W_DOWN, MLP_CHUNK, DM, DFF, DFF, DFF}; pg8::StaticOrder S; S.init(MLP_CHUNK, DM, G, bx);
                    pg8::EpiResid E{X + (size_t)ch * MLP_CHUNK * DM, DM};
                    pg8::gemm_phase(lds, g, S, E, wave);
                }
                PH_END;
            }
        }
    }
    if (PH_ON && PEN(20)) { PH_LANE; const float* g = INP(I_FINAL); for (int m = gw; m < T; m += NGW) final_norm_row(X + (size_t)m * DM, g, lane); }
#undef PH_ON
#undef PH_END
}

extern "C" void kernel_launch(void* const* d_in, const int* in_sizes, int n_in, void* d_out, int out_size, void* d_ws, size_t ws_size, hipStream_t stream) {
    static int grid = 0;
    if (grid == 0) {
        if (n_in != 27 || out_size != T * DM || ws_size < WS_END) { fprintf(stderr, "kernel_launch: shape mismatch: n_in %d out %d ws %zu (need %zu)\n", n_in, out_size, ws_size, (size_t)WS_END); grid = -1; return; }
        int dev = 0, cus = 0, per_cu = 0;
        if (hipGetDevice(&dev) != hipSuccess || hipDeviceGetAttribute(&cus, hipDeviceAttributeMultiprocessorCount, dev) != hipSuccess) { grid = -1; return; }
        if (hipFuncSetAttribute((const void*)fwd, hipFuncAttributeMaxDynamicSharedMemorySize, LDS_BYTES) != hipSuccess) { fprintf(stderr, "kernel_launch: hipFuncSetAttribute failed\n"); grid = -1; return; }
        if (hipOccupancyMaxActiveBlocksPerMultiprocessor(&per_cu, (const void*)fwd, 512, LDS_BYTES) != hipSuccess || per_cu < 1) { fprintf(stderr, "kernel_launch: occupancy query says %d\n", per_cu); }
        (void)hipGetLastError();
        grid = cus;
    }
    if (grid < 0) return;
    if (hipMemsetAsync((char*)d_ws + WS_CTL, 0, CTL_ZERO_BYTES, stream) != hipSuccess) return;
    Args a{};
    for (int i = 0; i < 27; ++i) a.in[i] = (const float*)d_in[i];
    a.out = (float*)d_out; a.ws = (unsigned char*)d_ws; a.ph_lo = 0; a.ph_hi = 1 << 30;
    hipLaunchKernelGGL(fwd, dim3(grid), dim3(512), LDS_BYTES, stream, a);
    const hipError_t le = hipPeekAtLastError();
    if (le != hipSuccess) fprintf(stderr, "kernel_launch: launch failed: %s\n", hipGetErrorName(le));
}
```

```cpp
#include <hip/hip_runtime.h>
#include <cstdio>
#include <cstdint>

#define LAS __attribute__((address_space(3)))
#define GAS __attribute__((address_space(1)))
typedef unsigned short bf16;
typedef short bf16x8 __attribute__((ext_vector_type(8)));
typedef short s16x4 __attribute__((ext_vector_type(4)));
typedef float f32x4 __attribute__((ext_vector_type(4)));
typedef float f32x2 __attribute__((ext_vector_type(2)));
typedef float f32x16 __attribute__((ext_vector_type(16)));
typedef unsigned u32x4 __attribute__((ext_vector_type(4)));
typedef unsigned u32x2 __attribute__((ext_vector_type(2)));

constexpr int DM = 2048, SEQ = 4096, NSEQ = 12, T = NSEQ * SEQ  , T_PROMPT = 8 * SEQ;
constexpr int DEPTH = 4, MEMLEN = 256, TM = NSEQ * MEMLEN  ;
constexpr int AB_IN = 2624, AB_PAD = 2816, CD_IN = 6144, DFF = 8192;
constexpr int MLP_CHUNK = 16384, N_MLP_CHUNKS = T / MLP_CHUNK;
constexpr float EPS = 1e-6f;

__device__ __forceinline__ unsigned cvt_pk_bf16(float lo, float hi) { unsigned r; asm volatile("v_cvt_pk_bf16_f32 %0, %1, %2" : "=v"(r) : "v"(lo), "v"(hi)); return r; }
__device__ __forceinline__ float bf2f(unsigned short b) { return __builtin_bit_cast(float, ((unsigned)b) << 16); }
__device__ __forceinline__ float bflo(unsigned w) { return __builtin_bit_cast(float, w << 16); }
__device__ __forceinline__ float bfhi(unsigned w) { return __builtin_bit_cast(float, w & 0xffff0000u); }
__device__ __forceinline__ int lane_id_fresh() { int l; asm volatile("v_mbcnt_lo_u32_b32 %0, -1, 0\n\tv_mbcnt_hi_u32_b32 %0, -1, %0" : "=v"(l)); return l; }
template <int XOR> __device__ __forceinline__ float swz_xor(float v) { return __builtin_bit_cast(float, __builtin_amdgcn_ds_swizzle(__builtin_bit_cast(int, v), (XOR << 10) | 0x1f)); }
__device__ __forceinline__ float wave_sum(float v) {
    v += swz_xor<1>(v); v += swz_xor<2>(v); v += swz_xor<4>(v); v += swz_xor<8>(v); v += swz_xor<16>(v);
    auto rr = __builtin_amdgcn_permlane32_swap(__float_as_uint(v), __float_as_uint(v), false, false);
    return __uint_as_float(rr[0]) + __uint_as_float(rr[1]);
}
__device__ __forceinline__ float other_half(float v, bool lower) {
    auto rr = __builtin_amdgcn_permlane32_swap(__float_as_uint(v), __float_as_uint(v), false, false);
    return lower ? __uint_as_float(rr[1]) : __uint_as_float(rr[0]);
}

namespace pg8 {
constexpr int BM = 256, BK = 64, HALF = 128, HTB = HALF * BK * 2, STAGE_BYTES = 8 * HTB, NXCD = 8, WGM = 8;
__host__ __device__ __forceinline__ int lds_byte(int r, int c) { const int st = (r >> 4) * 2 + (c >> 5), rr = r & 15, cc = c & 31, ob = rr * 64 + cc * 2; return st * 1024 + (ob ^ (((ob >> 9) & 1) << 5)); }
__host__ __device__ __forceinline__ void stage_rc(int b, int& R, int& C) { const int st = b / 1024, sb = b % 1024, swz = sb ^ (((sb >> 9) & 1) << 5); R = (st >> 1) * 16 + swz / 64; C = (st & 1) * 32 + (swz % 64) / 2; }
__host__ __device__ __forceinline__ int perm32(int rho) { const int n = rho >> 4, i = rho & 15; return 8 * (i >> 2) + 4 * n + (i & 3); }

struct Unit { int pm, pn; };
struct Gemm { const bf16* A; const bf16* Bt; int M, N, K, lda, ldb; };

struct StaticOrder {
    int nM, nN, nwg, G, c;
    __device__ void init(int M, int N, int G_, int c_) { nM = M / BM; nN = N / BM; nwg = nM * nN; G = G_; c = c_; }
    __device__ bool next(int i, Unit& u) const {
        const long L = (long)i * G + c; if (L >= nwg) return false;
        int wgid = (int)L; { const int q = nwg / NXCD, r = nwg % NXCD, xcd = wgid % NXCD, off = wgid / NXCD; wgid = (xcd < r ? xcd * (q + 1) : r * (q + 1) + (xcd - r) * q) + off; }
        const int nig = WGM * nN, gid = wgid / nig, fm = gid * WGM, gsz = (nM - fm) < WGM ? (nM - fm) : WGM;
        u.pm = fm + ((wgid % nig) % gsz); u.pn = (wgid % nig) / gsz; return true;
    }
};

template <int W> __device__ __forceinline__ float row_ss(const float* ps, int row, int fq) {
    float s;
    if constexpr (W == 32) { const f32x4 a = *(const f32x4*)(ps + (size_t)row * 32 + fq * 8), b = *(const f32x4*)(ps + (size_t)row * 32 + fq * 8 + 4); s = ((a.x + a.y) + (a.z + a.w)) + ((b.x + b.y) + (b.z + b.w)); }
    else { const f32x2 a = *(const f32x2*)(ps + (size_t)row * 8 + fq * 2); s = a.x + a.y; }
    s += swz_xor<16>(s); s += other_half(s, fq < 2); return s;
}
template <int ACT  , int RSW> struct EpiBf16 {
    static constexpr bool PERM = true;
    bf16* O; int ldc; int split_cols; size_t split_stride; const float* rs_in; float rs_inv_dim; float* ss_out; size_t ss_stride;
    __device__ __forceinline__ void operator()(const f32x4 (&acc)[2][2][4][2], const Unit& u, int wr, int wc, int fr, int fq) const {
        const int row0 = u.pm * BM + wr * 64 + fr; int colt = u.pn * BM; bf16* base = O;
        if (split_cols) { const int t = colt / split_cols; base += (size_t)t * split_stride; colt -= t * split_cols; }
        const int col0 = colt + wc * 32 + 8 * fq;
        const bool do_ss = (ss_out != nullptr) && (u.pn < 4);
        float* ssp = do_ss ? ss_out + (size_t)(u.pn >> 1) * ss_stride + (u.pn & 1) * 4 + wc : nullptr;
#pragma unroll
        for (int ai = 0; ai < 2; ++ai)
#pragma unroll
            for (int m = 0; m < 4; ++m) { const int row = row0 + ai * HALF + m * 16; bf16* rowp = base + (size_t)row * ldc + col0;
                float rs = 1.f; if (rs_in) rs = 1.f / sqrtf(row_ss<RSW>(rs_in, row, fq) * rs_inv_dim + EPS);
                float ss = 0.f;
#pragma unroll
                for (int bj = 0; bj < 2; ++bj) { f32x4 v0 = acc[ai][bj][m][0] * rs, v1 = acc[ai][bj][m][1] * rs;
                    if (ACT == 2) {
#pragma unroll
                        for (int j = 0; j < 4; ++j) { const float a = fmaxf(v0[j], 0.f), b = fmaxf(v1[j], 0.f); v0[j] = a * a; v1[j] = b * b; } }
                    u32x4 w; w.x = cvt_pk_bf16(v0[0], v0[1]); w.y = cvt_pk_bf16(v0[2], v0[3]); w.z = cvt_pk_bf16(v1[0], v1[1]); w.w = cvt_pk_bf16(v1[2], v1[3]);
                    *(u32x4*)(rowp + bj * HALF) = w;
                    if (do_ss) { const float a0 = bflo(w.x), a1 = bfhi(w.x), a2 = bflo(w.y), a3 = bfhi(w.y), a4 = bflo(w.z), a5 = bfhi(w.z), a6 = bflo(w.w), a7 = bfhi(w.w);
                        ss += (a0 * a0 + a1 * a1) + (a2 * a2 + a3 * a3) + (a4 * a4 + a5 * a5) + (a6 * a6 + a7 * a7); } }
                if (do_ss) { ss += swz_xor<16>(ss); ss += other_half(ss, fq < 2); if (fq == 0) ssp[(size_t)row * 8] = ss; } }
    }
};
struct EpiResidX {
    static constexpr bool PERM = true;
    float* C; bf16* XB; float* ps; int ldc;
    __device__ __forceinline__ void operator()(const f32x4 (&acc)[2][2][4][2], const Unit& u, int wr, int wc, int fr, int fq) const {
        const int row0 = u.pm * BM + wr * 64 + fr, col0 = u.pn * BM + wc * 32 + 8 * fq;
        float* psp = ps + u.pn * 4 + wc;
#pragma unroll
        for (int ai = 0; ai < 2; ++ai) {
            f32x4 c[4][2][2];
#pragma unroll
            for (int m = 0; m < 4; ++m) { const float* rowp = C + (size_t)(row0 + ai * HALF + m * 16) * ldc + col0;
#pragma unroll
                for (int bj = 0; bj < 2; ++bj) { c[m][bj][0] = *(const f32x4*)(rowp + bj * HALF); c[m][bj][1] = *(const f32x4*)(rowp + bj * HALF + 4); } }
#pragma unroll
            for (int m = 0; m < 4; ++m) { const int row = row0 + ai * HALF + m * 16; float* rowp = C + (size_t)row * ldc + col0; bf16* xbp = XB + (size_t)row * ldc + col0;
                float ss = 0.f;
#pragma unroll
                for (int bj = 0; bj < 2; ++bj) { const f32x4 v0 = c[m][bj][0] + acc[ai][bj][m][0], v1 = c[m][bj][1] + acc[ai][bj][m][1];
                    *(f32x4*)(rowp + bj * HALF) = v0; *(f32x4*)(rowp + bj * HALF + 4) = v1;
                    u32x4 w; w.x = cvt_pk_bf16(v0[0], v0[1]); w.y = cvt_pk_bf16(v0[2], v0[3]); w.z = cvt_pk_bf16(v1[0], v1[1]); w.w = cvt_pk_bf16(v1[2], v1[3]);
                    *(u32x4*)(xbp + bj * HALF) = w;
                    ss += (v0[0] * v0[0] + v0[1] * v0[1]) + (v0[2] * v0[2] + v0[3] * v0[3]) + (v1[0] * v1[0] + v1[1] * v1[1]) + (v1[2] * v1[2] + v1[3] * v1[3]); }
                ss += swz_xor<16>(ss); ss += other_half(ss, fq < 2); if (fq == 0) psp[(size_t)row * 32] = ss; }
            asm volatile("" ::: "memory"); }
    }
};

template <class Epi>
__device__ __forceinline__ void gemm_phase(LAS unsigned char* lds, const Gemm g, const StaticOrder& S, const Epi& E, int wid) {
    const int lane = lane_id_fresh(), tid = wid * 64 + lane, wr = wid >> 2, wc = wid & 3, fr = lane & 15, fq = lane >> 4;
    const int K = g.K, nt = K / BK;
    unsigned voffA[2], voffB[2];
#pragma unroll
    for (int i = 0; i < 2; ++i) { int R, C; stage_rc(tid * 16 + i * 8192, R, C); const int Rb = Epi::PERM ? ((R & ~31) + perm32(R & 31)) : R;
        voffA[i] = (unsigned)(R * g.lda + C) * 2u; voffB[i] = (unsigned)(Rb * g.ldb + C) * 2u; }
    const size_t kstep = (size_t)(BK * 2);
    const size_t hstepA = (size_t)HALF * g.lda * 2, hstepB = (size_t)HALF * g.ldb * 2;
    const size_t tstepA = 2 * hstepA, tstepB = 2 * hstepB;
    const unsigned ldsw = (unsigned)wid * 1024u;
    const int aoff = lds_byte(wr * 64 + fr, fq * 8), boff = lds_byte(wc * 32 + fr, fq * 8);
#define PG8_SA(b, h) (((b) * 2 + (h)) * HTB)
#define PG8_SB(b, h) ((4 + (b) * 2 + (h)) * HTB)
#define PG8_STAGE(bufoff, gbase, voff) do { _Pragma("unroll") for (int _i = 0; _i < 2; ++_i) \
        __builtin_amdgcn_global_load_lds((const unsigned*)((const char*)(gbase) + (voff)[_i]), (LAS unsigned*)(lds + (bufoff) + ldsw + _i * 8192), 16, 0, 0); } while (0)
#define PG8_LDA(dst, b, h) do { _Pragma("unroll") for (int m = 0; m < 4; ++m) _Pragma("unroll") for (int k = 0; k < 2; ++k) dst[m][k] = *(const LAS bf16x8*)(lds + PG8_SA(b, h) + aoff + m * 2048 + k * 1024); } while (0)
#define PG8_LDB(dst, b, h) do { _Pragma("unroll") for (int n = 0; n < 2; ++n) _Pragma("unroll") for (int k = 0; k < 2; ++k) dst[n][k] = *(const LAS bf16x8*)(lds + PG8_SB(b, h) + boff + n * 2048 + k * 1024); } while (0)
#define PG8_MMA(ai, bj, At, Bt) do { __builtin_amdgcn_s_setprio(1); _Pragma("unroll") for (int m = 0; m < 4; ++m) _Pragma("unroll") for (int n = 0; n < 2; ++n) _Pragma("unroll") for (int k = 0; k < 2; ++k) \
        acc[ai][bj][m][n] = __builtin_amdgcn_mfma_f32_16x16x32_bf16(Bt[n][k], At[m][k], acc[ai][bj][m][n], 0, 0, 0); __builtin_amdgcn_s_setprio(0); } while (0)
#define PG8_WAIT_V(n) asm volatile("s_waitcnt vmcnt(" #n ")" ::: "memory")
#define PG8_WAIT_L(n) asm volatile("s_waitcnt lgkmcnt(" #n ")" ::: "memory")
#define PG8_BAR __builtin_amdgcn_s_barrier()
#define PG8_SCHED __builtin_amdgcn_sched_barrier(0)
    Unit cur, nxt; int ui = 0;
    if (!S.next(0, cur)) return;
    f32x4 acc[2][2][4][2];
#pragma unroll
    for (int a = 0; a < 2; ++a)
#pragma unroll
        for (int b = 0; b < 2; ++b)
#pragma unroll
            for (int m = 0; m < 4; ++m)
#pragma unroll
                for (int n = 0; n < 2; ++n) acc[a][b][m][n] = (f32x4){0.f, 0.f, 0.f, 0.f};
    bf16x8 At[4][2], B0[2][2], B1[2][2];
    const char* cA = (const char*)g.A + (size_t)cur.pm * tstepA; const char* cB = (const char*)g.Bt + (size_t)cur.pn * tstepB;
    PG8_STAGE(PG8_SB(0, 0), cB, voffB); PG8_STAGE(PG8_SB(0, 1), cB + hstepB, voffB); PG8_STAGE(PG8_SA(0, 0), cA, voffA); PG8_STAGE(PG8_SA(0, 1), cA + hstepA, voffA);
    if (wr == 1) PG8_BAR;
    PG8_WAIT_V(2); PG8_BAR;
    PG8_STAGE(PG8_SB(1, 0), cB + kstep, voffB); PG8_STAGE(PG8_SA(1, 0), cA + kstep, voffA); PG8_STAGE(PG8_SB(1, 1), cB + hstepB + kstep, voffB);
    PG8_WAIT_V(6); PG8_BAR;
    for (;;) {
        const bool has_next = S.next(ui + 1, nxt);
        const char* nA = has_next ? (const char*)g.A + (size_t)nxt.pm * tstepA : cA; const char* nB = has_next ? (const char*)g.Bt + (size_t)nxt.pn * tstepB : cB;
        for (int t = 0; t < nt; t += 2) {
            const bool last = (t == nt - 2);
            const char* a1 = cA + (size_t)(t + 1) * kstep;
            const char* a2 = last ? nA : cA + (size_t)(t + 2) * kstep; const char* b2 = last ? nB : cB + (size_t)(t + 2) * kstep;
            const char* a3 = a2 + kstep; const char* b3 = b2 + kstep;
            PG8_LDB(B0, 0, 0); PG8_LDB(B1, 0, 1); PG8_SCHED; PG8_LDA(At, 0, 0); PG8_STAGE(PG8_SA(1, 1), a1 + hstepA, voffA);
            PG8_WAIT_V(8); PG8_WAIT_L(0); PG8_BAR; PG8_MMA(0, 0, At, B0); PG8_MMA(0, 1, At, B1); PG8_BAR; PG8_SCHED;
            PG8_LDA(At, 0, 1); PG8_STAGE(PG8_SB(0, 0), b2, voffB); PG8_STAGE(PG8_SB(0, 1), b2 + hstepB, voffB); PG8_STAGE(PG8_SA(0, 0), a2, voffA);
            PG8_WAIT_V(8); PG8_WAIT_L(0); PG8_BAR; PG8_MMA(1, 0, At, B0); PG8_MMA(1, 1, At, B1); PG8_BAR; PG8_SCHED;
            PG8_LDB(B0, 1, 0); PG8_LDB(B1, 1, 1); PG8_SCHED; PG8_LDA(At, 1, 0); PG8_STAGE(PG8_SA(0, 1), a2 + hstepA, voffA);
            PG8_WAIT_V(8); PG8_WAIT_L(0); PG8_BAR; PG8_MMA(0, 0, At, B0); PG8_MMA(0, 1, At, B1); PG8_BAR; PG8_SCHED;
            PG8_LDA(At, 1, 1); PG8_STAGE(PG8_SB(1, 0), b3, voffB); PG8_STAGE(PG8_SB(1, 1), b3 + hstepB, voffB); PG8_STAGE(PG8_SA(1, 0), a3, voffA);
            PG8_WAIT_V(8); PG8_WAIT_L(0); PG8_BAR; PG8_MMA(1, 0, At, B0); PG8_MMA(1, 1, At, B1); PG8_BAR; PG8_SCHED;
        }
        if (wr == 0) PG8_BAR;
        E(acc, cur, wr, wc, fr, fq);
        if (!has_next) break;
#pragma unroll
        for (int a = 0; a < 2; ++a)
#pragma unroll
            for (int b = 0; b < 2; ++b)
#pragma unroll
                for (int m = 0; m < 4; ++m)
#pragma unroll
                    for (int n = 0; n < 2; ++n) acc[a][b][m][n] = (f32x4){0.f, 0.f, 0.f, 0.f};
        cur = nxt; cA = nA; cB = nB; ++ui;
        if (wr == 1) PG8_BAR;
    }
    PG8_WAIT_V(0);
    PG8_BAR;
#undef PG8_SA
#undef PG8_SB
#undef PG8_STAGE
#undef PG8_LDA
#undef PG8_LDB
#undef PG8_MMA
#undef PG8_WAIT_V
#undef PG8_WAIT_L
#undef PG8_BAR
#undef PG8_SCHED
}
}

namespace att {
#define SBAR() __builtin_amdgcn_sched_barrier(0)
constexpr int SHM_V = 64 * 128 * 2;
__device__ __forceinline__ int crow(int r, int hi) { return (r & 3) + 8 * (r >> 2) + 4 * hi; }
template <int DQK> struct Cfg {
    static constexpr int KP = DQK * 2, SHM_K = 64 * KP, OFF_K = 2 * SHM_V, OFF_WS = OFF_K + 2 * SHM_K, NPARK = (DQK == 192 ? 6 : 0), NREG = DQK / 16 - NPARK, OFF_QS = OFF_WS + 8 * 256, TOTAL = OFF_QS + 8 * 1024 * NPARK;
    static constexpr float SCALE = (DQK == 192) ? 0.07216878364870322f : 0.08838834764831845f;
    static constexpr float C = SCALE * 1.4426950408889634f;
};
constexpr float THR = 8.f;

template <int DQK>
__device__ __forceinline__ void partialSM(f32x16& p0, f32x16& p1, float& m_reg, float& mn, float& alpha) {
    constexpr float C = Cfg<DQK>::C, SCALE = Cfg<DQK>::SCALE;
    float pmax = p0[0];
#pragma unroll
    for (int r = 1; r < 16; ++r) pmax = fmaxf(pmax, p0[r]);
#pragma unroll
    for (int r = 0; r < 16; ++r) pmax = fmaxf(pmax, p1[r]);
    { auto rr = __builtin_amdgcn_permlane32_swap(__float_as_uint(pmax), __float_as_uint(pmax), false, false);
      pmax = fmaxf(__uint_as_float(rr[0]), __uint_as_float(rr[1])); }
    if (__builtin_expect(__all(pmax - m_reg <= THR / SCALE), 1)) { mn = m_reg; alpha = 1.f; }
    else { mn = fmaxf(m_reg, pmax); alpha = __builtin_amdgcn_exp2f((m_reg - mn) * C); m_reg = mn; }
    const float mnC = -mn * C;
#pragma unroll
    for (int r = 0; r < 16; ++r) p0[r] = fmaf(p0[r], C, mnC);
#pragma unroll
    for (int r = 0; r < 16; ++r) p1[r] = fmaf(p1[r], C, mnC);
#pragma unroll
    for (int r = 0; r < 16; ++r) p0[r] = __builtin_amdgcn_exp2f(p0[r]);
}
__device__ __forceinline__ void finishSM(f32x16& p0, f32x16& p1, float alpha, float& l_reg, bf16x8& pa0, bf16x8& pa1, bf16x8& pa2, bf16x8& pa3) {
#pragma unroll
    for (int r = 0; r < 16; ++r) p1[r] = __builtin_amdgcn_exp2f(p1[r]);
    float ps = 0;
#pragma unroll
    for (int r = 0; r < 16; ++r) ps += p0[r];
#pragma unroll
    for (int r = 0; r < 16; ++r) ps += p1[r];
    { auto rr = __builtin_amdgcn_permlane32_swap(__float_as_uint(ps), __float_as_uint(ps), false, false);
      ps = __uint_as_float(rr[0]) + __uint_as_float(rr[1]); }
    l_reg = l_reg * alpha + ps;
#define PK4(P, BASE, OUT) do { unsigned a0 = cvt_pk_bf16(P[BASE + 0], P[BASE + 1]), a1 = cvt_pk_bf16(P[BASE + 2], P[BASE + 3]);   \
    unsigned b0 = cvt_pk_bf16(P[BASE + 4], P[BASE + 5]), b1 = cvt_pk_bf16(P[BASE + 6], P[BASE + 7]);                              \
    auto r0 = __builtin_amdgcn_permlane32_swap(a0, b0, false, false); auto r1 = __builtin_amdgcn_permlane32_swap(a1, b1, false, false); \
    u32x4 w = {r0[0], r1[0], r0[1], r1[1]}; OUT = __builtin_bit_cast(bf16x8, w); } while (0)
    PK4(p0, 0, pa0); PK4(p0, 8, pa1); PK4(p1, 0, pa2); PK4(p1, 8, pa3);
#undef PK4
}
#define KSWZ(KP, row, colB) ((row) * (KP) + ((colB) ^ (((row) & 7) << 4)))
template <int DQK>
__device__ __forceinline__ void qkt(f32x16& p0, f32x16& p1, const LAS char* Ks, const bf16x8* qr, const LAS char* Qs, int r32, int hi) {
    constexpr int KP = Cfg<DQK>::KP;
    p0 = f32x16{}; p1 = f32x16{};
#pragma unroll
    for (int d0 = 0; d0 < DQK / 16; ++d0) { const int cb = (d0 * 16 + hi * 8) * 2;
        const bf16x8 b0 = *(const LAS bf16x8*)(Ks + KSWZ(KP, r32, cb));
        const bf16x8 b1 = *(const LAS bf16x8*)(Ks + KSWZ(KP, 32 + r32, cb));
        bf16x8 q;
        if (d0 < Cfg<DQK>::NREG) q = qr[d0]; else q = *(const LAS bf16x8*)(Qs + (d0 - Cfg<DQK>::NREG) * 1024);
        p0 = __builtin_amdgcn_mfma_f32_32x32x16_bf16(b0, q, p0, 0, 0, 0);
        p1 = __builtin_amdgcn_mfma_f32_32x32x16_bf16(b1, q, p1, 0, 0, 0); }
}
__device__ __forceinline__ int v_st(int k, int c) { const int kk = (k & ~0xC) | ((k & 4) << 1) | ((k & 8) >> 1); return ((kk >> 3) * 4 + (c >> 5)) * 512 + ((kk & 7) * 32 + (c & 31)) * 2; }
__device__ __forceinline__ int v_rd_base(int lane) { return ((lane & 3) << 3) | (((lane >> 2) & 3) << 6) | (((lane >> 4) & 1) << 5) | (((lane >> 5) & 1) << 8); }
constexpr int v_rd_off(int d0, int ks, int half) { return d0 * 512 + ks * 4096 + half * 2048; }
template <int OFF> __device__ __forceinline__ s16x4 tr_read(int vb) {
    s16x4 r; asm volatile("ds_read_b64_tr_b16 %0, %1 offset:%2" : "=&v"(r) : "v"(vb), "i"(OFF) : "memory"); return r;
}
template <int D0> __device__ __forceinline__ void pv_one(f32x16& od, int vb, bf16x8 pa0, bf16x8 pa1, bf16x8 pa2, bf16x8 pa3) {
    const s16x4 l0 = tr_read<v_rd_off(D0, 0, 0)>(vb), h0 = tr_read<v_rd_off(D0, 0, 1)>(vb), l1 = tr_read<v_rd_off(D0, 1, 0)>(vb), h1 = tr_read<v_rd_off(D0, 1, 1)>(vb);
    const s16x4 l2 = tr_read<v_rd_off(D0, 2, 0)>(vb), h2 = tr_read<v_rd_off(D0, 2, 1)>(vb), l3 = tr_read<v_rd_off(D0, 3, 0)>(vb), h3 = tr_read<v_rd_off(D0, 3, 1)>(vb);
    asm volatile("s_waitcnt lgkmcnt(0)" ::: "memory"); SBAR();
#define PKV(L, H) (bf16x8){L[0], L[1], L[2], L[3], H[0], H[1], H[2], H[3]}
    od = __builtin_amdgcn_mfma_f32_32x32x16_bf16(pa0, PKV(l0, h0), od, 0, 0, 0);
    od = __builtin_amdgcn_mfma_f32_32x32x16_bf16(pa1, PKV(l1, h1), od, 0, 0, 0);
    od = __builtin_amdgcn_mfma_f32_32x32x16_bf16(pa2, PKV(l2, h2), od, 0, 0, 0);
    od = __builtin_amdgcn_mfma_f32_32x32x16_bf16(pa3, PKV(l3, h3), od, 0, 0, 0);
#undef PKV
}
__device__ __forceinline__ void pv_d0(f32x16* o, int vb, bf16x8 pa0, bf16x8 pa1, bf16x8 pa2, bf16x8 pa3) {
    pv_one<0>(o[0], vb, pa0, pa1, pa2, pa3); pv_one<1>(o[1], vb, pa0, pa1, pa2, pa3); pv_one<2>(o[2], vb, pa0, pa1, pa2, pa3); pv_one<3>(o[3], vb, pa0, pa1, pa2, pa3);
}
__device__ __forceinline__ void store_o(const f32x16* o, float l_reg, LAS float* li_l, LAS char* lds, bf16* Ob, int ldo, int wid, int lane, int r32, int hi) {
    if (hi == 0) li_l[r32] = l_reg;
    asm volatile("s_waitcnt lgkmcnt(0)" ::: "memory");
    float rli[16];
#pragma unroll
    for (int r = 0; r < 16; ++r) rli[r] = __builtin_amdgcn_rcpf(li_l[crow(r, hi)]);
    LAS unsigned short* slab = (LAS unsigned short*)(lds + wid * 8192);
#pragma unroll
    for (int r = 0; r < 16; ++r) { const int orow = crow(r, hi);
#pragma unroll
        for (int d0 = 0; d0 < 4; ++d0) slab[orow * 128 + d0 * 32 + r32] = (unsigned short)(cvt_pk_bf16(o[d0][r] * rli[r], 0.f) & 0xffffu); }
    asm volatile("s_waitcnt lgkmcnt(0)" ::: "memory");
#pragma unroll
    for (int i = 0; i < 8; ++i) { const int id = i * 64 + lane, row = id >> 4, c16 = id & 15;
        const u32x4 w = *(const LAS u32x4*)((LAS char*)slab + row * 256 + c16 * 16);
        *(u32x4*)(Ob + (unsigned)(wid * 32 + row) * (unsigned)ldo + c16 * 8) = w; }
}

__device__ __forceinline__ void unpack8(bf16x8 v, float (&x)[8]) {
#pragma unroll
    for (int e = 0; e < 8; ++e) x[e] = bf2f((unsigned short)v[e]);
}
__device__ __forceinline__ bf16x8 pack8(const float (&x)[8]) {
    u32x4 w; w.x = cvt_pk_bf16(x[0], x[1]); w.y = cvt_pk_bf16(x[2], x[3]); w.z = cvt_pk_bf16(x[4], x[5]); w.w = cvt_pk_bf16(x[6], x[7]); return __builtin_bit_cast(bf16x8, w);
}
__device__ __forceinline__ void rope_pair(bf16x8& f1, bf16x8& f2, const float* ct, const float* st, float mul, const float* g1, const float* g2) {
    float x1[8], x2[8], a[8], b[8]; unpack8(f1, x1); unpack8(f2, x2);
    const f32x4 c0 = *(const f32x4*)ct, c1 = *(const f32x4*)(ct + 4), s0 = *(const f32x4*)st, s1 = *(const f32x4*)(st + 4);
    const float c[8] = {c0.x, c0.y, c0.z, c0.w, c1.x, c1.y, c1.z, c1.w}, s[8] = {s0.x, s0.y, s0.z, s0.w, s1.x, s1.y, s1.z, s1.w};
    if (g1) {
        const f32x4 ga = *(const f32x4*)g1, gb = *(const f32x4*)(g1 + 4), gc = *(const f32x4*)g2, gd = *(const f32x4*)(g2 + 4);
        const float gg1[8] = {ga.x, ga.y, ga.z, ga.w, gb.x, gb.y, gb.z, gb.w}, gg2[8] = {gc.x, gc.y, gc.z, gc.w, gd.x, gd.y, gd.z, gd.w};
#pragma unroll
        for (int e = 0; e < 8; ++e) { x1[e] = x1[e] * mul * gg1[e]; x2[e] = x2[e] * mul * gg2[e]; }
    }
#pragma unroll
    for (int e = 0; e < 8; ++e) { a[e] = x1[e] * c[e] - x2[e] * s[e]; b[e] = x2[e] * c[e] + x1[e] * s[e]; }
    f1 = pack8(a); f2 = pack8(b);
}
template <int DQK, int SDEPTH, int QMODE>
__device__ __forceinline__ void dense_unit(const bf16* __restrict__ Qb, int ldq, const bf16* __restrict__ Kh, int ldk, const bf16* __restrict__ K2h, int ldk2,
                                           const bf16* __restrict__ Vh, int ldv, bf16* __restrict__ Ob, int ldo, int seq, LAS char* lds, int wid,
                                           int qpos0, const float* __restrict__ tab, const float* __restrict__ qgain) {
    using CF = Cfg<DQK>; constexpr int KP = CF::KP, SHM_K = CF::SHM_K, ND0 = DQK / 16;
    const int lane = lane_id_fresh(), tid = wid * 64 + lane, r32 = lane & 31, hi = lane >> 5;
    LAS char* V_lds = lds; LAS char* K_lds = lds + CF::OFF_K;
    LAS float* ws = (LAS float*)(lds + CF::OFF_WS) + wid * 64; LAS float* li_l = ws; LAS float* al_l = ws + 32;
    float m_reg = -1e30f, l_reg = 0; f32x16 o[4] = {}; bf16x8 qr[CF::NREG];
    const LAS char* Qs = lds + CF::OFF_QS + wid * (1024 * CF::NPARK) + lane * 16;
    { const unsigned qo = (unsigned)(wid * 32 + r32) * (unsigned)ldq + hi * 8;
      bf16x8 qraw[ND0];
#pragma unroll
      for (int d0 = 0; d0 < ND0; ++d0) qraw[d0] = *(const bf16x8*)(Qb + qo + d0 * 16);
      const int pos = qpos0 + wid * 32 + r32;
      if constexpr (QMODE == 1) {
          const float* ct = tab + pos * 32 + hi * 8; const float* st = ct + 4096 * 32;
          rope_pair(qraw[8], qraw[10], ct, st, 1.f, nullptr, nullptr); rope_pair(qraw[9], qraw[11], ct + 16, st + 16, 1.f, nullptr, nullptr);
      } else if constexpr (QMODE == 2) {
          const float* ct = tab + pos * 64 + hi * 8; const float* st = ct + 4096 * 64;
#pragma unroll
          for (int g = 0; g < 4; ++g) rope_pair(qraw[g], qraw[g + 4], ct + g * 16, st + g * 16, 1.f, nullptr, nullptr);
      } else if constexpr (QMODE == 3) {
          float ss = 0.f;
#pragma unroll
          for (int d0 = 0; d0 < 8; ++d0) { float x[8]; unpack8(qraw[d0], x);
#pragma unroll
              for (int e = 0; e < 8; ++e) ss += x[e] * x[e]; }
          ss += other_half(ss, hi == 0);
          const float rstd = 1.f / sqrtf(ss * (1.f / 128.f) + EPS);
          const float* ctr = tab + (pos >> 6) * 32 + hi * 8; const float* str = ctr + 4096 * 32; const float* ctc = tab + (pos & 63) * 32 + hi * 8; const float* stc = ctc + 4096 * 32;
          const float* gq = qgain + hi * 8;
#pragma unroll
          for (int g = 0; g < 2; ++g) { rope_pair(qraw[g], qraw[g + 2], ctr + g * 16, str + g * 16, rstd, gq + g * 16, gq + (g + 2) * 16);
                                        rope_pair(qraw[4 + g], qraw[6 + g], ctc + g * 16, stc + g * 16, rstd, gq + (4 + g) * 16, gq + (6 + g) * 16); }
      }
#pragma unroll
      for (int d0 = 0; d0 < CF::NREG; ++d0) qr[d0] = qraw[d0];
      if constexpr (CF::NPARK > 0) {
#pragma unroll
          for (int d0 = CF::NREG; d0 < ND0; ++d0) *(LAS bf16x8*)((LAS char*)Qs + (d0 - CF::NREG) * 1024) = qraw[d0]; } }
    const int sr = tid >> 4, sc = (tid & 15) * 8, vst0 = v_st(sr, sc), vst1 = v_st(32 + sr, sc);
    const int kst0 = KSWZ(KP, sr, sc * 2), kst1 = KSWZ(KP, 32 + sr, sc * 2);
    const int kr2 = tid >> 3, c2 = (tid & 7) * 8, kst2 = KSWZ(KP, kr2, (128 + c2) * 2);
    const unsigned vo = (unsigned)sr * (unsigned)ldv + sc, ko = (unsigned)sr * (unsigned)ldk + sc, k2o = (unsigned)kr2 * (unsigned)ldk2 + c2;
    const int vb0 = (int)(unsigned)(uintptr_t)V_lds + v_rd_base(lane);
    struct { bf16x8 vs0, vs1, ks0, ks1, k2; } sr_[SDEPTH];
#define SLOAD(i, k0) do { const bf16* Vt_ = Vh + (size_t)(k0) * ldv; const bf16* Kt_ = Kh + (size_t)(k0) * ldk; \
    sr_[i].vs0 = *(const bf16x8*)(Vt_ + vo); sr_[i].vs1 = *(const bf16x8*)(Vt_ + (size_t)32 * ldv + vo); \
    sr_[i].ks0 = *(const bf16x8*)(Kt_ + ko); sr_[i].ks1 = *(const bf16x8*)(Kt_ + (size_t)32 * ldk + ko); \
    if constexpr (DQK == 192) sr_[i].k2 = *(const bf16x8*)(K2h + (size_t)(k0) * ldk2 + k2o); } while (0)
#define SWRITE(b, i) do { *(LAS bf16x8*)(V_lds + (b) * SHM_V + vst0) = sr_[i].vs0; *(LAS bf16x8*)(V_lds + (b) * SHM_V + vst1) = sr_[i].vs1; \
    *(LAS bf16x8*)(K_lds + (b) * SHM_K + kst0) = sr_[i].ks0; *(LAS bf16x8*)(K_lds + (b) * SHM_K + kst1) = sr_[i].ks1; \
    if constexpr (DQK == 192) *(LAS bf16x8*)(K_lds + (b) * SHM_K + kst2) = sr_[i].k2; } while (0)
#define SWAIT() do { if constexpr (SDEPTH == 1) asm volatile("s_waitcnt vmcnt(0)" ::: "memory"); else if constexpr (DQK == 192) asm volatile("s_waitcnt vmcnt(5)" ::: "memory"); else asm volatile("s_waitcnt vmcnt(4)" ::: "memory"); } while (0)
#define RESC(a) do { if (__any((a) < 1.f)) { if (hi == 0) al_l[r32] = (a); asm volatile("s_waitcnt lgkmcnt(0)" ::: "memory"); \
    _Pragma("unroll") for (int d = 0; d < 4; ++d) _Pragma("unroll") for (int r = 0; r < 16; ++r) o[d][r] *= al_l[crow(r, hi)]; } } while (0)
    f32x16 pA0, pA1, pB0, pB1; float mnA, mnB, alA, alB; bf16x8 pa0, pa1, pa2, pa3; const int NT = seq / 64;
    constexpr int SE = 0, SO = SDEPTH - 1;
    __syncthreads();
    SLOAD(SE, 0); asm volatile("s_waitcnt vmcnt(0)" ::: "memory"); SWRITE(0, SE); __syncthreads();
    qkt<DQK>(pA0, pA1, K_lds, qr, Qs, r32, hi); partialSM<DQK>(pA0, pA1, m_reg, mnA, alA);
    SLOAD(SO, 64); if constexpr (SDEPTH == 2) { if (2 < NT) SLOAD(SE, 128); }
    SWAIT(); SWRITE(1, SO); __syncthreads();
    for (int j = 1; j + 1 < NT; j += 2) {
        SBAR(); qkt<DQK>(pB0, pB1, K_lds + SHM_K, qr, Qs, r32, hi);
        finishSM(pA0, pA1, alA, l_reg, pa0, pa1, pa2, pa3); SBAR();
        SLOAD(SO, (j + SDEPTH) * 64); SBAR();
        pv_d0(o, vb0, pa0, pa1, pa2, pa3); partialSM<DQK>(pB0, pB1, m_reg, mnB, alB);
        __syncthreads(); SWAIT(); SWRITE(0, SE);
        RESC(alB); __syncthreads();
        SBAR(); qkt<DQK>(pA0, pA1, K_lds, qr, Qs, r32, hi);
        finishSM(pB0, pB1, alB, l_reg, pa0, pa1, pa2, pa3); SBAR();
        if (SDEPTH == 1 || j + 3 < NT) SLOAD(SE, (j + 1 + SDEPTH) * 64); SBAR();
        pv_d0(o, vb0 + SHM_V, pa0, pa1, pa2, pa3); partialSM<DQK>(pA0, pA1, m_reg, mnA, alA);
        __syncthreads(); SWAIT(); SWRITE(1, SO);
        RESC(alA); __syncthreads();
    }
    SBAR(); qkt<DQK>(pB0, pB1, K_lds + SHM_K, qr, Qs, r32, hi);
    finishSM(pA0, pA1, alA, l_reg, pa0, pa1, pa2, pa3); SBAR();
    pv_d0(o, vb0, pa0, pa1, pa2, pa3); partialSM<DQK>(pB0, pB1, m_reg, mnB, alB);
    __syncthreads(); RESC(alB);
    finishSM(pB0, pB1, alB, l_reg, pa0, pa1, pa2, pa3); SBAR();
    pv_d0(o, vb0 + SHM_V, pa0, pa1, pa2, pa3);
    __syncthreads();
    store_o(o, l_reg, li_l, lds, Ob, ldo, wid, lane, r32, hi);
#undef SLOAD
#undef SWRITE
#undef SWAIT
}

constexpr int NA_OFF_K = SHM_V, NA_OFF_RPB = 65536, NA_OFF_WS = 65536 + 2048, NA_TOTAL = NA_OFF_WS + 8 * 256;
__device__ __forceinline__ int clampi(int v, int lo, int hi) { return v < lo ? lo : (v > hi ? hi : v); }
__device__ __forceinline__ void na_unit(const bf16* __restrict__ Qb, int ldq, const bf16* __restrict__ Kseq, const bf16* __restrict__ Vseq, int ldk,
                                        bf16* __restrict__ Ob, int ldo, int r0, const float* __restrict__ rpb_h, LAS char* lds, int wid) {
    constexpr int KP = 256;
    const int lane = lane_id_fresh(), tid = wid * 64 + lane, r32 = lane & 31, hi = lane >> 5;
    LAS char* V_lds = lds; LAS char* K_lds = lds + NA_OFF_K; LAS float* rpb_l = (LAS float*)(lds + NA_OFF_RPB);
    LAS float* ws = (LAS float*)(lds + NA_OFF_WS) + wid * 64; LAS float* li_l = ws; LAS float* al_l = ws + 32;
    float m_reg = -1e30f, l_reg = 0; f32x16 o[4] = {}; bf16x8 qr[8];
    { const unsigned qo = (unsigned)(wid * 32 + r32) * (unsigned)ldq + hi * 8;
#pragma unroll
      for (int d0 = 0; d0 < 8; ++d0) qr[d0] = *(const bf16x8*)(Qb + qo + d0 * 16); }
    const int sr = tid >> 4, sc = (tid & 15) * 8, vst0 = v_st(sr, sc), vst1 = v_st(32 + sr, sc);
    const int kst0 = KSWZ(KP, sr, sc * 2), kst1 = KSWZ(KP, 32 + sr, sc * 2);
    const unsigned ko = (unsigned)sr * (unsigned)ldk + sc;
    const int vb0 = (int)(unsigned)(uintptr_t)V_lds + v_rd_base(lane);
    const int kr_lo = clampi(r0 - 4, 0, 56), kr_hi = clampi(r0 + 3 - 4, 0, 56) + 8;
    const int qrw = r0 + (wid >> 1), srw = clampi(qrw - 4, 0, 56);
    const int qc = (wid & 1) * 32 + r32, scq = clampi(qc - 8, 0, 48);
    __syncthreads();
    if (tid < 465) rpb_l[tid] = rpb_h[tid] * 11.313708498984761f;
    for (int kr = kr_lo; kr < kr_hi; ++kr) {
        const bf16* Kt = Kseq + (size_t)(kr * 64) * ldk; const bf16* Vt = Vseq + (size_t)(kr * 64) * ldk;
        const bf16x8 v0 = *(const bf16x8*)(Vt + ko), v1 = *(const bf16x8*)(Vt + (size_t)32 * ldk + ko), k0 = *(const bf16x8*)(Kt + ko), k1 = *(const bf16x8*)(Kt + (size_t)32 * ldk + ko);
        __syncthreads();
        *(LAS bf16x8*)(V_lds + vst0) = v0; *(LAS bf16x8*)(V_lds + vst1) = v1; *(LAS bf16x8*)(K_lds + kst0) = k0; *(LAS bf16x8*)(K_lds + kst1) = k1;
        __syncthreads();
        if (kr >= srw && kr < srw + 8) {
            f32x16 p0, p1; float mn, al; bf16x8 pa0, pa1, pa2, pa3;
            qkt<128>(p0, p1, K_lds, qr, nullptr, r32, hi);
            const LAS float* bt = rpb_l + (kr - qrw + 7) * 31 + (15 - qc);
#pragma unroll
            for (int r = 0; r < 16; ++r) { const int kc = crow(r, hi); const bool in = (kc >= scq) && (kc < scq + 16); const float b = bt[in ? kc : qc]; p0[r] = in ? p0[r] + b : -1e30f; }
#pragma unroll
            for (int r = 0; r < 16; ++r) { const int kc = 32 + crow(r, hi); const bool in = (kc >= scq) && (kc < scq + 16); const float b = bt[in ? kc : qc]; p1[r] = in ? p1[r] + b : -1e30f; }
            partialSM<128>(p0, p1, m_reg, mn, al);
            RESC(al);
            finishSM(p0, p1, al, l_reg, pa0, pa1, pa2, pa3); SBAR();
            pv_d0(o, vb0, pa0, pa1, pa2, pa3);
        }
    }
    __syncthreads();
    store_o(o, l_reg, li_l, lds, Ob, ldo, wid, lane, r32, hi);
}
#undef RESC
}

constexpr size_t MiB = 1u << 20;
constexpr size_t WS_CTL = 0, CTL_ZERO_BYTES = 1 * MiB;
constexpr size_t WS_TAB_MLA = 5 * MiB;
constexpr size_t WS_TAB_1D = 6 * MiB;
constexpr size_t WS_MN = 8 * MiB;
constexpr size_t WS_MKV = 20 * MiB;
constexpr size_t WS_WB = 32 * MiB;
constexpr size_t WB_IN = 0, WB_QB = 24 * MiB, WB_KVB = 26 * MiB, WB_OUT = 28 * MiB, WB_XQ = 36 * MiB, WB_XKV = 38 * MiB, WB_XO = 42 * MiB, WB_UP = 44 * MiB, WB_DOWN = 76 * MiB;
constexpr size_t WS_H = 144 * MiB;
constexpr size_t WS_BIG = 336 * MiB;
constexpr size_t BIG_PROJ = 0, BIG_Q = 264 * MiB, BIG_KV = 408 * MiB;
constexpr size_t BIG_SPLIT = 96 * MiB;
constexpr size_t BIG_XQ = 0, BIG_XO = 48 * MiB;
constexpr size_t BIG_U = 0;
constexpr size_t BIG_XBA = 400 * MiB;
constexpr size_t WS_PS = WS_BIG + 600 * MiB;
constexpr size_t PS_BYTES = (size_t)T * 32 * 4, PSC_BYTES = (size_t)T * 8 * 4;
constexpr size_t WS_END = WS_PS + 3 * PS_BYTES + 2 * PSC_BYTES;
constexpr int CW_BAR = 4096;

constexpr int RING_BYTES = 135168, MISC_OFF = RING_BYTES + 320, PTR_OFF = RING_BYTES + 1024, LDS_BYTES = 147456;
static_assert(att::Cfg<192>::TOTAL <= RING_BYTES && att::NA_TOTAL <= RING_BYTES && pg8::STAGE_BYTES <= RING_BYTES, "LDS map");

#define XB_TMO      128
#define XB_XCNT(j)  (256  + 64 * (j))
#define XB_XSUB(j)  (1280 + 64 * (j))
#define XB_XGEN(j)  (2304 + 64 * (j))
#define XB_TOP      3328
#define XB_TOPGEN   3392
#define XCD_BAR_WORDS 3456
#define XB_SPIN_CAP (1u << 18)
__device__ __forceinline__ unsigned xb_ld(unsigned* p)              { return __hip_atomic_load(p, __ATOMIC_RELAXED, __HIP_MEMORY_SCOPE_AGENT); }
__device__ __forceinline__ unsigned xb_add(unsigned* p, unsigned v) { return __hip_atomic_fetch_add(p, v, __ATOMIC_RELAXED, __HIP_MEMORY_SCOPE_AGENT); }
__device__ __forceinline__ unsigned xb_xcc_id() { return (unsigned)__builtin_amdgcn_s_getreg((3 << 11) | 20) & 0xFu; }
#define XB_SPIN(cond, bar) do { unsigned _sp = 0; while (cond) { __builtin_amdgcn_s_sleep(1); \
    if ((++_sp & 255u) == 0u) { if (xb_ld(&(bar)[XB_TMO])) break; if (_sp > XB_SPIN_CAP) { atomicAdd(&(bar)[XB_TMO], 1u); break; } } } } while (0)
struct XcdBarrier { unsigned* bar; unsigned x; volatile LAS unsigned* st; };
__device__ __forceinline__ XcdBarrier xcd_barrier_post(unsigned* bar, volatile LAS unsigned* st, int wave) {
    XcdBarrier b; b.bar = bar; b.x = xb_xcc_id(); b.st = st;
    if (wave == 0 && lane_id_fresh() == 0) (void)xb_add(&bar[XB_XCNT(b.x)], 1u);
    return b;
}
__device__ __forceinline__ void xcd_barrier_complete(unsigned* bar, unsigned x, unsigned& nloc, unsigned& nx) {
    const unsigned G = gridDim.x * gridDim.y * gridDim.z;
    unsigned sum, cnt, mine, sp = 0u;
    for (;;) {
        sum = 0u; cnt = 0u; mine = 0u;
#pragma unroll
        for (unsigned j = 0; j < 16; ++j) { const unsigned c = xb_ld(&bar[XB_XCNT(j)]); sum += c; cnt += (c > 0u) ? 1u : 0u; mine = (j == x) ? c : mine; }
        if (sum == G) break;
        __builtin_amdgcn_s_sleep(1);
        if ((++sp & 255u) == 0u) { if (xb_ld(&bar[XB_TMO])) break; if (sp > XB_SPIN_CAP) { atomicAdd(&bar[XB_TMO], 1u); break; } }
    }
    nloc = mine > 0u ? mine : 1u; nx = cnt > 0u ? cnt : 1u;
}
__device__ __forceinline__ void xcd_barrier(const XcdBarrier& b, int wave) {
    asm volatile("s_waitcnt vmcnt(0)" ::: "memory");
    __syncthreads();
    if (wave == 0 && lane_id_fresh() == 0) {
        unsigned long long bar_i = (unsigned long long)(uintptr_t)b.bar; asm volatile("" : "+s"(bar_i));
        unsigned* bar = (unsigned*)(GAS unsigned*)(uintptr_t)bar_i;
        __builtin_amdgcn_s_waitcnt(0);
        unsigned nloc = b.st[0], nx = b.st[1];
        if (nloc == 0u) { xcd_barrier_complete(bar, b.x, nloc, nx); b.st[0] = nloc; b.st[1] = nx; }
        const unsigned old = xb_add(&bar[XB_XSUB(b.x)], 1u);
        const unsigned gen = old / nloc;
        if (old + 1u == (gen + 1u) * nloc) {
            __builtin_amdgcn_fence(__ATOMIC_RELEASE, "agent");
            asm volatile("s_waitcnt vmcnt(0)" ::: "memory");
            const unsigned og = xb_add(&bar[XB_TOP], 1u);
            const unsigned tg = og / nx;
            if (og + 1u == (tg + 1u) * nx) xb_add(&bar[XB_TOPGEN], 1u);
            else XB_SPIN(xb_ld(&bar[XB_TOPGEN]) == tg, bar);
            __builtin_amdgcn_fence(__ATOMIC_ACQUIRE, "agent");
            xb_add(&bar[XB_XGEN(b.x)], 1u);
            asm volatile("s_waitcnt vmcnt(0)" ::: "memory");
        } else {
            XB_SPIN(xb_ld(&bar[XB_XGEN(b.x)]) == gen, bar);
            __builtin_amdgcn_fence(__ATOMIC_ACQUIRE, "agent");
            asm volatile("s_waitcnt vmcnt(0)" ::: "memory");
        }
    }
    __syncthreads();
}

#define LDS_WAIT() asm volatile("s_waitcnt lgkmcnt(0)" ::: "memory")
__device__ __forceinline__ void transpose_item(const float* W, int K, int N, bf16* WT, const float* gain, LAS float* scr, int item, int lane) {
    const int nblk = N / 32, kb = item / nblk, nb = item % nblk, k0 = 64 * kb, n0 = 32 * nb;
#pragma unroll 8
    for (int i = 0; i < 32; ++i) { const int kk = 2 * i + (lane >> 5); const float gk = gain ? gain[k0 + kk] : 1.f; scr[kk * 33 + (lane & 31)] = W[(size_t)(k0 + kk) * N + n0 + (lane & 31)] * gk; }
    LDS_WAIT(); asm volatile("" ::: "memory");
    const int c = lane & 7;
#pragma unroll
    for (int j = 0; j < 4; ++j) { const int n = (lane >> 3) + 8 * j; const LAS float* s = scr + (8 * c) * 33 + n;
        u32x4 o; o.x = cvt_pk_bf16(s[0 * 33], s[1 * 33]); o.y = cvt_pk_bf16(s[2 * 33], s[3 * 33]); o.z = cvt_pk_bf16(s[4 * 33], s[5 * 33]); o.w = cvt_pk_bf16(s[6 * 33], s[7 * 33]);
        *(u32x4*)(WT + (size_t)(n0 + n) * K + k0 + 8 * c) = o; }
    LDS_WAIT(); asm volatile("" ::: "memory");
}
__device__ __forceinline__ void convert_matrix(const float* W, int K, int N, bf16* WT, const float* gain, LAS float* scr, int gw, int NGW, int lane) {
    const int nitems = (K / 64) * (N / 32);
    for (int it = gw; it < nitems; it += NGW) transpose_item(W, K, N, WT, gain, scr, it, lane);
}
__device__ __forceinline__ void init_row_2048(const float* xrow, float* copy, bf16* xb, float* ssp, int lane) {
    const f32x4* xr = (const f32x4*)xrow + lane;
    f32x4 v[8]; float s = 0.f;
#pragma unroll
    for (int j = 0; j < 8; ++j) { v[j] = xr[64 * j]; s += (v[j].x * v[j].x + v[j].y * v[j].y) + (v[j].z * v[j].z + v[j].w * v[j].w); }
    s = wave_sum(s);
#pragma unroll
    for (int j = 0; j < 8; ++j) ((f32x4*)copy + lane)[64 * j] = v[j];
    u32x2* o8 = (u32x2*)xb + lane;
#pragma unroll
    for (int j = 0; j < 8; ++j) { u32x2 w; w.x = cvt_pk_bf16(v[j].x, v[j].y); w.y = cvt_pk_bf16(v[j].z, v[j].w); o8[64 * j] = w; }
    if (lane < 32) ssp[lane] = (lane == 0) ? s : 0.f;
}
__device__ __forceinline__ void norm_row_2048(const float* xrow, const float* g, bf16* orow, float* copy, int lane) {
    const f32x4* xr = (const f32x4*)xrow + lane;
    f32x4 v[8]; float s = 0.f;
#pragma unroll
    for (int j = 0; j < 8; ++j) { v[j] = xr[64 * j]; s += (v[j].x * v[j].x + v[j].y * v[j].y) + (v[j].z * v[j].z + v[j].w * v[j].w); }
    const float rstd = 1.f / sqrtf(wave_sum(s) * (1.f / 2048.f) + EPS);
    if (copy) {
#pragma unroll
        for (int j = 0; j < 8; ++j) ((f32x4*)copy + lane)[64 * j] = v[j]; }
    u32x2* o8 = (u32x2*)orow + lane;
#pragma unroll
    for (int j = 0; j < 8; ++j) { const f32x4 gg = ((const f32x4*)g + lane)[64 * j]; u32x2 w; w.x = cvt_pk_bf16(v[j].x * rstd * gg.x, v[j].y * rstd * gg.y); w.y = cvt_pk_bf16(v[j].z * rstd * gg.z, v[j].w * rstd * gg.w); o8[64 * j] = w; }
}
__device__ __forceinline__ void final_norm_row(float* xrow, const float* g, float ss, int lane) {
    f32x4* xr = (f32x4*)xrow + lane;
    f32x4 v[8];
#pragma unroll
    for (int j = 0; j < 8; ++j) v[j] = xr[64 * j];
    const float rstd = 1.f / sqrtf(ss * (1.f / 2048.f) + EPS);
#pragma unroll
    for (int j = 0; j < 8; ++j) { const f32x4 gg = ((const f32x4*)g + lane)[64 * j]; xr[64 * j] = v[j] * rstd * gg; }
}
__device__ __forceinline__ void even_row_fix(bf16* row, int pos, const float* qn, const float* kvn, const float* gqn, const float* gkn, const float* tab_mla, int lane) {
    const float* cosm = tab_mla; const float* sinm = tab_mla + 4096 * 32;
#pragma unroll
    for (int part = 0; part < 2; ++part) {
        u32x4* p = (u32x4*)(row + part * 512) + lane; const u32x4 w = *p; const float* g = (part ? kvn : qn) + lane * 8;
        float x[8] = {bflo(w.x), bfhi(w.x), bflo(w.y), bfhi(w.y), bflo(w.z), bfhi(w.z), bflo(w.w), bfhi(w.w)};
        float s = 0.f;
#pragma unroll
        for (int e = 0; e < 8; ++e) s += x[e] * x[e];
        const float rstd = 1.f / sqrtf(wave_sum(s) * (1.f / 512.f) + EPS);
        const f32x4 g0 = *(const f32x4*)g, g1 = *(const f32x4*)(g + 4);
        u32x4 o; o.x = cvt_pk_bf16(x[0] * rstd * g0.x, x[1] * rstd * g0.y); o.y = cvt_pk_bf16(x[2] * rstd * g0.z, x[3] * rstd * g0.w);
        o.z = cvt_pk_bf16(x[4] * rstd * g1.x, x[5] * rstd * g1.y); o.w = cvt_pk_bf16(x[6] * rstd * g1.z, x[7] * rstd * g1.w);
        *p = o;
    }
    { bf16* p = row + 1024 + lane; const float x = bf2f(*p); const float y = other_half(x, lane < 32); const int f = lane & 31;
      const float c = cosm[pos * 32 + f], s = sinm[pos * 32 + f];
      const float r = (lane < 32) ? (x * c - y * s) : (x * c + y * s);
      *p = (bf16)(cvt_pk_bf16(r, 0.f) & 0xffffu); }
    const int prow = pos >> 6, pcol = pos & 63;
    const int e0 = 2 * lane, f0 = e0 & 31; const int tp = (e0 < 64) ? prow : pcol;
    const float c0 = cosm[tp * 32 + f0], s0 = sinm[tp * 32 + f0], c1 = cosm[tp * 32 + f0 + 1], s1 = sinm[tp * 32 + f0 + 1];
    const bool first = ((e0 & 32) == 0);
#pragma unroll 2
    for (int h = 0; h < 10; ++h) {
        unsigned* p = (unsigned*)(row + (h < 8 ? 1088 + h * 128 : 2112 + (h - 8) * 128)) + lane; const unsigned w = *p; const float* g = (h < 8 ? gqn : gkn) + e0;
        float x0 = bflo(w), x1 = bfhi(w);
        const float rstd = 1.f / sqrtf(wave_sum(x0 * x0 + x1 * x1) * (1.f / 128.f) + EPS);
        x0 = x0 * rstd * g[0]; x1 = x1 * rstd * g[1];
        const float y0 = swz_xor<16>(x0), y1 = swz_xor<16>(x1);
        const float r0 = first ? (x0 * c0 - y0 * s0) : (x0 * c0 + y0 * s0);
        const float r1 = first ? (x1 * c1 - y1 * s1) : (x1 * c1 + y1 * s1);
        *p = cvt_pk_bf16(r0, r1);
    }
}
__device__ __forceinline__ void even_row_fix_k(bf16* row, int pos, const float* gkn, const float* tab_mla, int lane) {
    const float* cosm = tab_mla; const float* sinm = tab_mla + 4096 * 32;
    { bf16* p = row + 1024 + lane; const float x = bf2f(*p); const float y = other_half(x, lane < 32); const int f = lane & 31;
      const float c = cosm[pos * 32 + f], s = sinm[pos * 32 + f];
      const float r = (lane < 32) ? (x * c - y * s) : (x * c + y * s);
      *p = (bf16)(cvt_pk_bf16(r, 0.f) & 0xffffu); }
    const int prow = pos >> 6, pcol = pos & 63;
    const int e0 = 2 * lane, f0 = e0 & 31; const int tp = (e0 < 64) ? prow : pcol;
    const float c0 = cosm[tp * 32 + f0], s0 = sinm[tp * 32 + f0], c1 = cosm[tp * 32 + f0 + 1], s1 = sinm[tp * 32 + f0 + 1];
    const bool first = ((e0 & 32) == 0);
#pragma unroll
    for (int h = 0; h < 2; ++h) {
        unsigned* p = (unsigned*)(row + 2112 + h * 128) + lane; const unsigned w = *p; const float* g = gkn + e0;
        float x0 = bflo(w), x1 = bfhi(w);
        const float rstd = 1.f / sqrtf(wave_sum(x0 * x0 + x1 * x1) * (1.f / 128.f) + EPS);
        x0 = x0 * rstd * g[0]; x1 = x1 * rstd * g[1];
        const float y0 = swz_xor<16>(x0), y1 = swz_xor<16>(x1);
        const float r0 = first ? (x0 * c0 - y0 * s0) : (x0 * c0 + y0 * s0);
        const float r1 = first ? (x1 * c1 - y1 * s1) : (x1 * c1 + y1 * s1);
        *p = cvt_pk_bf16(r0, r1);
    }
}
__device__ __forceinline__ void mla_q_rope_row(bf16* row, int pos, const float* tab_mla, int lane) {
    const int h = lane >> 3, s4 = (lane & 7) * 4;
    u32x2* p1 = (u32x2*)(row + h * 192 + 128 + s4); u32x2* p2 = (u32x2*)(row + h * 192 + 160 + s4);
    const u32x2 w1 = *p1, w2 = *p2;
    const f32x4 c = *(const f32x4*)(tab_mla + pos * 32 + s4), s = *(const f32x4*)(tab_mla + 4096 * 32 + pos * 32 + s4);
    const float x1[4] = {bflo(w1.x), bfhi(w1.x), bflo(w1.y), bfhi(w1.y)}, x2[4] = {bflo(w2.x), bfhi(w2.x), bflo(w2.y), bfhi(w2.y)};
    float a[4], b[4];
#pragma unroll
    for (int e = 0; e < 4; ++e) { a[e] = x1[e] * c[e] - x2[e] * s[e]; b[e] = x2[e] * c[e] + x1[e] * s[e]; }
    u32x2 o1, o2; o1.x = cvt_pk_bf16(a[0], a[1]); o1.y = cvt_pk_bf16(a[2], a[3]); o2.x = cvt_pk_bf16(b[0], b[1]); o2.y = cvt_pk_bf16(b[2], b[3]);
    *p1 = o1; *p2 = o2;
}
__device__ __forceinline__ void rope1d_row(bf16* row, int pos, const float* tab_1d, int lane) {
    const int h = lane >> 3, s8 = (lane & 7) * 8;
    u32x4* p1 = (u32x4*)(row + h * 128 + s8); u32x4* p2 = (u32x4*)(row + h * 128 + 64 + s8);
    const u32x4 w1 = *p1, w2 = *p2;
    const float* ct = tab_1d + pos * 64 + s8; const float* st = tab_1d + 4096 * 64 + pos * 64 + s8;
    const f32x4 c0 = *(const f32x4*)ct, c1 = *(const f32x4*)(ct + 4), s0 = *(const f32x4*)st, s1 = *(const f32x4*)(st + 4);
    const float c[8] = {c0.x, c0.y, c0.z, c0.w, c1.x, c1.y, c1.z, c1.w}, s[8] = {s0.x, s0.y, s0.z, s0.w, s1.x, s1.y, s1.z, s1.w};
    const float x1[8] = {bflo(w1.x), bfhi(w1.x), bflo(w1.y), bfhi(w1.y), bflo(w1.z), bfhi(w1.z), bflo(w1.w), bfhi(w1.w)};
    const float x2[8] = {bflo(w2.x), bfhi(w2.x), bflo(w2.y), bfhi(w2.y), bflo(w2.z), bfhi(w2.z), bflo(w2.w), bfhi(w2.w)};
    float a[8], b[8];
#pragma unroll
    for (int e = 0; e < 8; ++e) { a[e] = x1[e] * c[e] - x2[e] * s[e]; b[e] = x2[e] * c[e] + x1[e] * s[e]; }
    u32x4 o1, o2; o1.x = cvt_pk_bf16(a[0], a[1]); o1.y = cvt_pk_bf16(a[2], a[3]); o1.z = cvt_pk_bf16(a[4], a[5]); o1.w = cvt_pk_bf16(a[6], a[7]);
    o2.x = cvt_pk_bf16(b[0], b[1]); o2.y = cvt_pk_bf16(b[2], b[3]); o2.z = cvt_pk_bf16(b[4], b[5]); o2.w = cvt_pk_bf16(b[6], b[7]);
    *p1 = o1; *p2 = o2;
}
__device__ __forceinline__ void diff_combine_row(const bf16* oc, bf16* out, float lam, float post, const float* subln, int lane) {
    const f32x4 g = *(const f32x4*)(subln + lane * 4);
#pragma unroll
    for (int h = 0; h < 4; ++h) {
        const u32x2 w0 = *((const u32x2*)(oc + h * 512) + lane), w1 = *((const u32x2*)(oc + h * 512 + 256) + lane);
        float d[4] = {bflo(w0.x) - lam * bflo(w1.x), bfhi(w0.x) - lam * bfhi(w1.x), bflo(w0.y) - lam * bflo(w1.y), bfhi(w0.y) - lam * bfhi(w1.y)};
        const float rstd = 1.f / sqrtf(wave_sum((d[0] * d[0] + d[1] * d[1]) + (d[2] * d[2] + d[3] * d[3])) * (1.f / 256.f) + EPS);
        u32x2 o; o.x = cvt_pk_bf16(d[0] * rstd * g.x * post, d[1] * rstd * g.y * post); o.y = cvt_pk_bf16(d[2] * rstd * g.z * post, d[3] * rstd * g.w * post);
        *((u32x2*)(out + h * 256) + lane) = o;
    }
}
__device__ __forceinline__ void sincos_d(double a, double& sn, double& cs) {
    const double k = __builtin_rint(a * 0.15915494309189533577);
    const double r = __builtin_fma(-k, 6.283185307179586476925, a) - k * 2.4492935982947064e-16 * 0.0;
    const double r2 = r * r;
    double s = -1.0 / 51090942171709440000.0;
    s = s * r2 + 1.0 / 121645100408832000.0; s = s * r2 - 1.0 / 355687428096000.0; s = s * r2 + 1.0 / 1307674368000.0; s = s * r2 - 1.0 / 6227020800.0;
    s = s * r2 + 1.0 / 39916800.0; s = s * r2 - 1.0 / 362880.0; s = s * r2 + 1.0 / 5040.0; s = s * r2 - 1.0 / 120.0; s = s * r2 + 1.0 / 6.0; s = s * r2 - 1.0;
    sn = -s * r;
    double c = 1.0 / 1124000727777607680000.0;
    c = c * r2 - 1.0 / 2432902008176640000.0; c = c * r2 + 1.0 / 6402373705728000.0; c = c * r2 - 1.0 / 20922789888000.0; c = c * r2 + 1.0 / 87178291200.0;
    c = c * r2 - 1.0 / 479001600.0; c = c * r2 + 1.0 / 3628800.0; c = c * r2 - 1.0 / 40320.0; c = c * r2 + 1.0 / 720.0; c = c * r2 - 1.0 / 24.0; c = c * r2 + 0.5; c = c * r2 - 1.0;
    cs = -c;
}

__device__ __forceinline__ void* ld_ptr(LAS unsigned long long* P, int i) {
    const unsigned long long v = P[i];
    const unsigned lo = __builtin_amdgcn_readfirstlane((unsigned)v), hi = __builtin_amdgcn_readfirstlane((unsigned)(v >> 32));
    return (void*)(GAS void*)(uintptr_t)(((unsigned long long)hi << 32) | lo);
}
struct Args { const float* in[27]; float* out; unsigned char* ws; int ph_lo, ph_hi; };
enum { I_XP = 0, I_XS, I_MP, I_MS, I_NORM_MIX, I_W_IN_AB, I_MLA_QN, I_W_QB, I_MLA_KVN, I_W_KVB, I_GQA_QN, I_GQA_KN, I_W_OUT_AB, I_W_IN_CD, I_RPB, I_DLAM, I_SUBLN, I_W_OUT_CD,
       I_NORM_XA, I_NORM_MEM, I_W_XQ, I_W_XKV, I_W_XO, I_NORM_MLP, I_W_UP, I_W_DOWN, I_FINAL };

__global__ void __launch_bounds__(512, 2) fwd(Args args) {
    extern __shared__ __attribute__((aligned(16))) unsigned char lds_raw[];
    LAS unsigned char* lds = (LAS unsigned char*)lds_raw;
    volatile LAS unsigned* MISC = (volatile LAS unsigned*)(lds + MISC_OFF);
    const int tid0 = threadIdx.x, wave = __builtin_amdgcn_readfirstlane(tid0 >> 6);
    const int G = gridDim.x; const int bx = blockIdx.x; const int vcu = (G % 8 == 0) ? (bx % 8) * (G / 8) + bx / 8 : bx;
    const int gw = vcu * 8 + wave, NGW = G * 8;
    for (int u = tid0; u < (LDS_BYTES - RING_BYTES) / 4; u += 512) ((LAS unsigned*)(lds + RING_BYTES))[u] = 0u;
    __syncthreads();
    LAS unsigned long long* PTRS = (LAS unsigned long long*)(lds + PTR_OFF);
    if (tid0 == 0) {
#pragma unroll
        for (int i = 0; i < 27; ++i) PTRS[i] = (unsigned long long)(uintptr_t)args.in[i];
        PTRS[27] = (unsigned long long)(uintptr_t)args.out; PTRS[28] = (unsigned long long)(uintptr_t)args.ws;
    }
    const int lo = args.ph_lo, hi = args.ph_hi; int ph = 0;
    __syncthreads();
#define INP(i) ((const float*)ld_ptr(PTRS, (i)))
#define WSP ((unsigned char*)ld_ptr(PTRS, 28))
#define XP ((float*)ld_ptr(PTRS, 27))
    XcdBarrier bar = xcd_barrier_post((unsigned*)(WSP + WS_CTL) + CW_BAR, MISC + 8, wave);
#ifndef PH_MASK
#define PH_MASK 0xffffffffu
#endif
#define PEN(k) (((PH_MASK) >> (k)) & 1u)
#ifndef PROBE_REP
#define PROBE_REP 0u
#endif
#define REPS(k) (1 + (int)(((PROBE_REP) >> (k)) & 1u))
#define PH_ON (ph >= lo && ph < hi)
#define PH_LANE const int lane = lane_id_fresh(), tid = wave * 64 + lane; (void)tid; (void)lane
#define PH_END do { if (ph >= lo && ph + 1 < hi) xcd_barrier(bar, wave); ++ph; } while (0)

#define X XP
#define H ((bf16*)(WSP + WS_H))
#define BIG (WSP + WS_BIG)
#define WB (WSP + WS_WB)
#define tab_mla ((float*)(WSP + WS_TAB_MLA))
#define tab_1d ((float*)(WSP + WS_TAB_1D))
#define MN ((bf16*)(WSP + WS_MN))
#define MKV ((bf16*)(WSP + WS_MKV))
#define PSQ(i) ((float*)(WSP + WS_PS + (size_t)(i) * PS_BYTES))
#define PSC(i) ((float*)(WSP + WS_PS + 3 * PS_BYTES + (size_t)(i) * PSC_BYTES))
#define XBH H
#define XBA ((bf16*)(BIG + BIG_XBA))
    LAS float* scr = (LAS float*)(lds + wave * 16384);

    if (PH_ON && PEN(0)) for (int rep_ = 0; rep_ < REPS(0); ++rep_) { PH_LANE;
        const int gt = vcu * 512 + tid, NT_ = G * 512;
        for (int i = gt; i < 4096 * 32; i += NT_) { const int pos = i >> 5, f = i & 31; double inv = 1.0; for (int k = 0; k < f; ++k) inv *= 0.7498942093324558273;
            const float ang = (float)pos * (float)inv; double sn, cs; sincos_d((double)ang, sn, cs); tab_mla[i] = (float)cs; tab_mla[4096 * 32 + i] = (float)sn; }
        for (int i = gt; i < 4096 * 64; i += NT_) { const int pos = i >> 6, f = i & 63; double inv = 1.0; for (int k = 0; k < f; ++k) inv *= 0.8659643233600653524;
            const float ang = (float)pos * (float)inv; double sn, cs; sincos_d((double)ang, sn, cs); tab_1d[i] = (float)cs; tab_1d[4096 * 64 + i] = (float)sn; }
        float* ss0 = PSQ(0);
        for (int m = gw; m < T; m += NGW) { const float* src = (m < T_PROMPT) ? INP(I_XP) + (size_t)m * DM : INP(I_XS) + (size_t)(m - T_PROMPT) * DM;
            init_row_2048(src, X + (size_t)m * DM, XBH + (size_t)m * DM, ss0 + (size_t)m * 32, lane); }
    }
    PH_END;

    for (int layer = 0; layer < DEPTH; ++layer) {
        const int j = layer >> 1; const bool even = (layer & 1) == 0;
#define W_IN ((bf16*)(WB + WB_IN))
#define W_QB ((bf16*)(WB + WB_QB))
#define W_KVB ((bf16*)(WB + WB_KVB))
#define W_OUT ((bf16*)(WB + WB_OUT))
#define W_XQ ((bf16*)(WB + WB_XQ))
#define W_XKV ((bf16*)(WB + WB_XKV))
#define W_XO ((bf16*)(WB + WB_XO))
#define W_UP ((bf16*)(WB + WB_UP))
#define W_DOWN ((bf16*)(WB + WB_DOWN))

        if (PH_ON && PEN(1)) for (int rep_ = 0; rep_ < REPS(1); ++rep_) { PH_LANE;
            const float* gmix = INP(I_NORM_MIX) + layer * DM;
            if (even) {
                convert_matrix(INP(I_W_IN_AB) + (size_t)j * DM * AB_IN, DM, AB_IN, W_IN, gmix, scr, gw, NGW, lane);
                for (size_t i = (size_t)gw * 64 + lane; i < (size_t)(AB_PAD - AB_IN) * DM / 8; i += (size_t)NGW * 64) { u32x4 z = (u32x4){0u, 0u, 0u, 0u}; asm volatile("" : "+v"(z)); ((u32x4*)(W_IN + (size_t)AB_IN * DM))[i] = z; }
                convert_matrix(INP(I_W_QB) + (size_t)j * 512 * 1536, 512, 1536, W_QB, INP(I_MLA_QN) + j * 512, scr, gw, NGW, lane);
                convert_matrix(INP(I_W_KVB) + (size_t)j * 512 * 2048, 512, 2048, W_KVB, INP(I_MLA_KVN) + j * 512, scr, gw, NGW, lane);
                convert_matrix(INP(I_W_OUT_AB) + (size_t)j * DM * DM, DM, DM, W_OUT, nullptr, scr, gw, NGW, lane);
            } else {
                convert_matrix(INP(I_W_IN_CD) + (size_t)j * DM * CD_IN, DM, CD_IN, W_IN, gmix, scr, gw, NGW, lane);
                convert_matrix(INP(I_W_OUT_CD) + (size_t)j * DM * DM, DM, DM, W_OUT, nullptr, scr, gw, NGW, lane);
            }
            convert_matrix(INP(I_W_XQ) + (size_t)layer * DM * 512, DM, 512, W_XQ, INP(I_NORM_XA) + layer * DM, scr, gw, NGW, lane);
            convert_matrix(INP(I_W_XKV) + (size_t)layer * DM * 1024, DM, 1024, W_XKV, nullptr, scr, gw, NGW, lane);
            convert_matrix(INP(I_W_XO) + (size_t)layer * 512 * DM, 512, DM, W_XO, nullptr, scr, gw, NGW, lane);
            convert_matrix(INP(I_W_UP) + (size_t)layer * DM * DFF, DM, DFF, W_UP, INP(I_NORM_MLP) + layer * DM, scr, gw, NGW, lane);
            convert_matrix(INP(I_W_DOWN) + (size_t)layer * DFF * DM, DFF, DM, W_DOWN, nullptr, scr, gw, NGW, lane);
            const float* gm = INP(I_NORM_MEM) + layer * DM;
            for (int r = gw; r < TM; r += NGW) { const float* src = (r < 8 * MEMLEN) ? INP(I_MP) + (size_t)r * DM : INP(I_MS) + (size_t)(r - 8 * MEMLEN) * DM;
                norm_row_2048(src, gm, MN + (size_t)r * DM, nullptr, lane); }
        }
        PH_END;

        if (even) {
            bf16* PROJ = (bf16*)(BIG + BIG_PROJ); bf16* Q = (bf16*)(BIG + BIG_Q); bf16* KV = (bf16*)(BIG + BIG_KV);
            if (PH_ON && PEN(2)) for (int rep_ = 0; rep_ < REPS(2); ++rep_) { PH_LANE;
                pg8::Gemm g{XBH, W_IN, T, AB_PAD, DM, DM, DM}; pg8::StaticOrder S; S.init(T, AB_PAD, G, bx);
                pg8::EpiBf16<0, 32> E{PROJ, AB_PAD, 0, 0, PSQ(0), 1.f / 2048.f, PSC(0), PSC_BYTES / 4};
                pg8::gemm_phase(lds, g, S, E, wave);
            }
            PH_END;
            if (PH_ON && PEN(3)) for (int rep_ = 0; rep_ < REPS(3); ++rep_) { PH_LANE;
                const float* gkn = INP(I_GQA_KN) + j * 128;
                for (int m = gw; m < T; m += NGW) even_row_fix_k(PROJ + (size_t)m * AB_PAD, m & (SEQ - 1), gkn, tab_mla, lane);
            }
            if (PH_ON && PEN(4)) for (int rep_ = 0; rep_ < REPS(4); ++rep_) { PH_LANE;
#pragma unroll 1
                for (int gi = 0; gi < 2; ++gi) {
                    pg8::Gemm g{PROJ + (gi ? 512 : 0), gi ? W_KVB : W_QB, T, gi ? 2048 : 1536, 512, AB_PAD, 512}; pg8::StaticOrder S; S.init(T, g.N, G, bx);
                    pg8::EpiBf16<0, 8> E{gi ? KV : Q, g.N, 0, 0, PSC(gi), 1.f / 512.f, nullptr, 0};
                    pg8::gemm_phase(lds, g, S, E, wave);
                }
            }
            PH_END;
            if (PH_ON) {
                for (int rep_ = 0; rep_ < REPS(6); ++rep_)
                for (int u = vcu; u < NSEQ * 8 * 16; u += G) { const int qb = u & 15, h = (u >> 4) & 7, b = u >> 7; const size_t t0 = (size_t)b * SEQ;
                    att::dense_unit<192, 1, 1>(Q + (t0 + qb * 256) * 1536 + h * 192, 1536, KV + t0 * 2048 + h * 256, 2048, PROJ + t0 * AB_PAD + 1024, AB_PAD,
                                         KV + t0 * 2048 + h * 256 + 128, 2048, H + (t0 + qb * 256) * DM + h * 128, DM, SEQ, (LAS char*)lds, wave, qb * 256, tab_mla, nullptr); }
                for (int rep_ = 0; rep_ < REPS(21); ++rep_)
                for (int u = vcu; u < NSEQ * 8 * 16; u += G) { const int qb = u & 15, h = (u >> 4) & 7, b = u >> 7; const size_t t0 = (size_t)b * SEQ; const int kvh = h >> 2;
                    att::dense_unit<128, 2, 3>(PROJ + (t0 + qb * 256) * AB_PAD + 1088 + h * 128, AB_PAD, PROJ + t0 * AB_PAD + 2112 + kvh * 128, AB_PAD, nullptr, 0,
                                         PROJ + t0 * AB_PAD + 2368 + kvh * 128, AB_PAD, H + (t0 + qb * 256) * DM + 1024 + h * 128, DM, SEQ, (LAS char*)lds, wave, qb * 256, tab_mla, INP(I_GQA_QN) + j * 128); }
            }
            PH_END;
        } else {
            bf16* NQ = (bf16*)(BIG + 0 * BIG_SPLIT); bf16* NK = (bf16*)(BIG + 1 * BIG_SPLIT); bf16* NV = (bf16*)(BIG + 2 * BIG_SPLIT);
            bf16* DQ = (bf16*)(BIG + 3 * BIG_SPLIT); bf16* DK = (bf16*)(BIG + 4 * BIG_SPLIT); bf16* DV = (bf16*)(BIG + 5 * BIG_SPLIT); bf16* OC = NQ;
            if (PH_ON && PEN(7)) for (int rep_ = 0; rep_ < REPS(7); ++rep_) { PH_LANE;
                pg8::Gemm g{XBH, W_IN, T, CD_IN, DM, DM, DM}; pg8::StaticOrder S; S.init(T, CD_IN, G, bx);
                pg8::EpiBf16<0, 32> E{NQ, 1024, 1024, BIG_SPLIT / 2, PSQ(0), 1.f / 2048.f, nullptr, 0};
                pg8::gemm_phase(lds, g, S, E, wave);
            }
            PH_END;
            if (PH_ON && PEN(8)) for (int rep_ = 0; rep_ < REPS(8); ++rep_) { PH_LANE; for (int m = gw; m < T; m += NGW) rope1d_row(DK + (size_t)m * 1024, m & (SEQ - 1), tab_1d, lane); }
            if (PH_ON && PEN(9)) for (int rep_ = 0; rep_ < REPS(9); ++rep_) { PH_LANE;
                const float* rpb = INP(I_RPB) + (size_t)j * 8 * 465;
                for (int u = vcu; u < NSEQ * 8 * 16; u += G) { const int qb = u & 15, h = (u >> 4) & 7, b = u >> 7; const size_t t0 = (size_t)b * SEQ;
                    att::na_unit(NQ + (t0 + qb * 256) * 1024 + h * 128, 1024, NK + t0 * 1024 + h * 128, NV + t0 * 1024 + h * 128, 1024,
                                 H + (t0 + qb * 256) * DM + h * 128, DM, qb * 4, rpb + h * 465, (LAS char*)lds, wave); }
            }
            PH_END;
            if (PH_ON && PEN(10)) for (int rep_ = 0; rep_ < REPS(10); ++rep_) { PH_LANE;
                for (int u = vcu; u < NSEQ * 16 * 16; u += G) { const int qb = u & 15, hh = (u >> 4) & 15, b = u >> 8; const size_t t0 = (size_t)b * SEQ;
                    const int vh = hh & 1, c = (hh >> 1) & 1, h = hh >> 2;
                    att::dense_unit<128, 2, 2>(DQ + (t0 + qb * 256) * 1024 + (2 * h + c) * 128, 1024, DK + t0 * 1024 + (2 * h + c) * 128, 1024, nullptr, 0,
                                         DV + t0 * 1024 + h * 256 + vh * 128, 1024, OC + (t0 + qb * 256) * 2048 + h * 512 + c * 256 + vh * 128, 2048, SEQ, (LAS char*)lds, wave, qb * 256, tab_1d, nullptr); }
            }
            PH_END;
            if (PH_ON && PEN(11)) for (int rep_ = 0; rep_ < REPS(11); ++rep_) { PH_LANE;
                const float* lp = INP(I_DLAM) + j * 512;
                const float a0 = lp[lane] * lp[128 + lane] + lp[64 + lane] * lp[128 + 64 + lane], a1 = lp[256 + lane] * lp[384 + lane] + lp[256 + 64 + lane] * lp[384 + 64 + lane];
                const float lam_init = (layer == 1) ? 0.35550906759096934f : 0.5560582041556406f;
                const float lam = expf(wave_sum(a0)) - expf(wave_sum(a1)) + lam_init;
                const float* subln = INP(I_SUBLN) + j * 256;
                for (int m = gw; m < T; m += NGW) diff_combine_row(OC + (size_t)m * 2048, H + (size_t)m * DM + 1024, lam, 1.f - lam_init, subln, lane);
            }
            PH_END;
        }
        if (PH_ON && PEN(12)) for (int rep_ = 0; rep_ < REPS(12); ++rep_) { PH_LANE;
            pg8::Gemm g{H, W_OUT, T, DM, DM, DM, DM}; pg8::StaticOrder S; S.init(T, DM, G, bx);
            pg8::EpiResidX E{X, XBA, PSQ(1), DM};
            pg8::gemm_phase(lds, g, S, E, wave);
        }
        PH_END;
        {
            bf16* XQ = (bf16*)(BIG + BIG_XQ); bf16* XO = (bf16*)(BIG + BIG_XO);
            if (PH_ON && PEN(14)) for (int rep_ = 0; rep_ < REPS(14); ++rep_) { PH_LANE;
#pragma unroll 1
                for (int gi = 0; gi < 2; ++gi) {
                    pg8::Gemm g{gi ? MN : XBA, gi ? W_XKV : W_XQ, gi ? TM : T, gi ? 1024 : 512, DM, DM, DM}; pg8::StaticOrder S; S.init(g.M, g.N, G, bx);
                    pg8::EpiBf16<0, 32> E{gi ? MKV : XQ, g.N, 0, 0, gi ? nullptr : PSQ(1), 1.f / 2048.f, nullptr, 0};
                    pg8::gemm_phase(lds, g, S, E, wave);
                }
            }
            PH_END;
            if (PH_ON && PEN(15)) for (int rep_ = 0; rep_ < REPS(15); ++rep_) { PH_LANE;
                for (int u = vcu; u < NSEQ * 4 * 16; u += G) { const int qb = u & 15, h = (u >> 4) & 3, b = u >> 6; const size_t t0 = (size_t)b * SEQ;
                    att::dense_unit<128, 2, 0>(XQ + (t0 + qb * 256) * 512 + h * 128, 512, MKV + (size_t)b * MEMLEN * 1024 + h * 128, 1024, nullptr, 0,
                                         MKV + (size_t)b * MEMLEN * 1024 + 512 + h * 128, 1024, XO + (t0 + qb * 256) * 512 + h * 128, 512, MEMLEN, (LAS char*)lds, wave, 0, nullptr, nullptr); }
            }
            PH_END;
            if (PH_ON && PEN(16)) for (int rep_ = 0; rep_ < REPS(16); ++rep_) { PH_LANE;
                pg8::Gemm g{XO, W_XO, T, DM, 512, 512, 512}; pg8::StaticOrder S; S.init(T, DM, G, bx);
                pg8::EpiResidX E{X, XBA, PSQ(2), DM};
                pg8::gemm_phase(lds, g, S, E, wave);
            }
            PH_END;
        }
        {
            bf16* U = (bf16*)(BIG + BIG_U);
#pragma unroll 1
            for (int ch = 0; ch < N_MLP_CHUNKS; ++ch) {
                if (PH_ON && PEN(18)) for (int rep_ = 0; rep_ < REPS(18); ++rep_) { PH_LANE;
                    pg8::Gemm g{XBA + (size_t)ch * MLP_CHUNK * DM, W_UP, MLP_CHUNK, DFF, DM, DM, DM}; pg8::StaticOrder S; S.init(MLP_CHUNK, DFF, G, bx);
                    pg8::EpiBf16<2, 32> E{U, DFF, 0, 0, PSQ(2) + (size_t)ch * MLP_CHUNK * 32, 1.f / 2048.f, nullptr, 0};
                    pg8::gemm_phase(lds, g, S, E, wave);
                }
                PH_END;
                if (PH_ON && PEN(19)) for (int rep_ = 0; rep_ < REPS(19); ++rep_) { PH_LANE;
                    pg8::Gemm g{U, W_DOWN, MLP_CHUNK, DM, DFF, DFF, DFF}; pg8::StaticOrder S; S.init(MLP_CHUNK, DM, G, bx);
                    pg8::EpiResidX E{X + (size_t)ch * MLP_CHUNK * DM, XBH + (size_t)ch * MLP_CHUNK * DM, PSQ(0) + (size_t)ch * MLP_CHUNK * 32, DM};
                    pg8::gemm_phase(lds, g, S, E, wave);
                }
                PH_END;
            }
        }
    }
    if (PH_ON && PEN(20)) for (int rep_ = 0; rep_ < REPS(20); ++rep_) { PH_LANE; const float* g = INP(I_FINAL); const float* ssf = PSQ(0);
        for (int m = gw; m < T; m += NGW) final_norm_row(X + (size_t)m * DM, g, wave_sum(lane < 32 ? ssf[(size_t)m * 32 + lane] : 0.f), lane); }
#undef PH_ON
#undef PH_END
}

extern "C" void kernel_launch(void* const* d_in, const int* in_sizes, int n_in, void* d_out, int out_size, void* d_ws, size_t ws_size, hipStream_t stream) {
    static int grid = 0;
    if (grid == 0) {
        if (n_in != 27 || out_size != T * DM || ws_size < WS_END) { fprintf(stderr, "kernel_launch: shape mismatch: n_in %d out %d ws %zu (need %zu)\n", n_in, out_size, ws_size, (size_t)WS_END); grid = -1; return; }
        int dev = 0, cus = 0, per_cu = 0;
        if (hipGetDevice(&dev) != hipSuccess || hipDeviceGetAttribute(&cus, hipDeviceAttributeMultiprocessorCount, dev) != hipSuccess) { grid = -1; return; }
        if (hipFuncSetAttribute((const void*)fwd, hipFuncAttributeMaxDynamicSharedMemorySize, LDS_BYTES) != hipSuccess) { fprintf(stderr, "kernel_launch: hipFuncSetAttribute failed\n"); grid = -1; return; }
        if (hipOccupancyMaxActiveBlocksPerMultiprocessor(&per_cu, (const void*)fwd, 512, LDS_BYTES) != hipSuccess || per_cu < 1) { fprintf(stderr, "kernel_launch: occupancy query says %d\n", per_cu); }
        (void)hipGetLastError();
        grid = cus;
    }
    if (grid < 0) return;
    if (hipMemsetAsync((char*)d_ws + WS_CTL, 0, CTL_ZERO_BYTES, stream) != hipSuccess) return;
    Args a{};
    for (int i = 0; i < 27; ++i) a.in[i] = (const float*)d_in[i];
    a.out = (float*)d_out; a.ws = (unsigned char*)d_ws; a.ph_lo = 0; a.ph_hi = 1 << 30;
    hipLaunchKernelGGL(fwd, dim3(grid), dim3(512), LDS_BYTES, stream, a);
    const hipError_t le = hipPeekAtLastError();
    if (le != hipSuccess) fprintf(stderr, "kernel_launch: launch failed: %s\n", hipGetErrorName(le));
}
```

```cpp
#include <hip/hip_runtime.h>
#include <cstdio>
#include <cstdint>

#define LAS __attribute__((address_space(3)))
#define GAS __attribute__((address_space(1)))
typedef unsigned short bf16;
typedef short bf16x8 __attribute__((ext_vector_type(8)));
typedef short s16x4 __attribute__((ext_vector_type(4)));
typedef float f32x4 __attribute__((ext_vector_type(4)));
typedef float f32x2 __attribute__((ext_vector_type(2)));
typedef float f32x16 __attribute__((ext_vector_type(16)));
typedef unsigned u32x4 __attribute__((ext_vector_type(4)));
typedef unsigned u32x2 __attribute__((ext_vector_type(2)));

constexpr int DM = 2048, SEQ = 4096, NSEQ = 12, T = NSEQ * SEQ  , T_PROMPT = 8 * SEQ;
constexpr int DEPTH = 4, MEMLEN = 256, TM = NSEQ * MEMLEN  ;
constexpr int AB_IN = 2624, AB_PAD = 2816, CD_IN = 6144, DFF = 8192;
constexpr int MLP_CHUNK = 8192, N_MLP_CHUNKS = T / MLP_CHUNK;
constexpr size_t U_BYTES = (size_t)MLP_CHUNK * DFF * 2;
constexpr float EPS = 1e-6f;

__device__ __forceinline__ unsigned cvt_pk_bf16(float lo, float hi) { unsigned r; asm volatile("v_cvt_pk_bf16_f32 %0, %1, %2" : "=v"(r) : "v"(lo), "v"(hi)); return r; }
__device__ __forceinline__ float bf2f(unsigned short b) { return __builtin_bit_cast(float, ((unsigned)b) << 16); }
__device__ __forceinline__ float bflo(unsigned w) { return __builtin_bit_cast(float, w << 16); }
__device__ __forceinline__ float bfhi(unsigned w) { return __builtin_bit_cast(float, w & 0xffff0000u); }
__device__ __forceinline__ int lane_id_fresh() { int l; asm volatile("v_mbcnt_lo_u32_b32 %0, -1, 0\n\tv_mbcnt_hi_u32_b32 %0, -1, %0" : "=v"(l)); return l; }
template <int XOR> __device__ __forceinline__ float swz_xor(float v) { return __builtin_bit_cast(float, __builtin_amdgcn_ds_swizzle(__builtin_bit_cast(int, v), (XOR << 10) | 0x1f)); }
__device__ __forceinline__ float wave_sum(float v) {
    v += swz_xor<1>(v); v += swz_xor<2>(v); v += swz_xor<4>(v); v += swz_xor<8>(v); v += swz_xor<16>(v);
    auto rr = __builtin_amdgcn_permlane32_swap(__float_as_uint(v), __float_as_uint(v), false, false);
    return __uint_as_float(rr[0]) + __uint_as_float(rr[1]);
}
__device__ __forceinline__ float other_half(float v, bool lower) {
    auto rr = __builtin_amdgcn_permlane32_swap(__float_as_uint(v), __float_as_uint(v), false, false);
    return lower ? __uint_as_float(rr[1]) : __uint_as_float(rr[0]);
}

namespace pg8 {
constexpr int BM = 256, BK = 64, HALF = 128, HTB = HALF * BK * 2, STAGE_BYTES = 8 * HTB, NXCD = 8, WGM = 8;
__host__ __device__ __forceinline__ int lds_byte(int r, int c) { const int st = (r >> 4) * 2 + (c >> 5), rr = r & 15, cc = c & 31, ob = rr * 64 + cc * 2; return st * 1024 + (ob ^ (((ob >> 9) & 1) << 5)); }
__host__ __device__ __forceinline__ void stage_rc(int b, int& R, int& C) { const int st = b / 1024, sb = b % 1024, swz = sb ^ (((sb >> 9) & 1) << 5); R = (st >> 1) * 16 + swz / 64; C = (st & 1) * 32 + (swz % 64) / 2; }
__host__ __device__ __forceinline__ int perm32(int rho) { const int n = rho >> 4, i = rho & 15; return 8 * (i >> 2) + 4 * n + (i & 3); }

struct Unit { int pm, pn; };
struct Gemm { const bf16* A; const bf16* Bt; int M, N, K, lda, ldb; };

struct StaticOrder {
    int nM, nN, nwg, G, c, wgm;
    __device__ void init(int M, int N, int G_, int c_, int wgm_ = WGM) { nM = M / BM; nN = N / BM; nwg = nM * nN; G = G_; c = c_; wgm = wgm_; }
    __device__ bool next(int i, Unit& u) const {
        const long L = (long)i * G + c; if (L >= nwg) return false;
        int wgid = (int)L; { const int q = nwg / NXCD, r = nwg % NXCD, xcd = wgid % NXCD, off = wgid / NXCD; wgid = (xcd < r ? xcd * (q + 1) : r * (q + 1) + (xcd - r) * q) + off; }
        const int nig = wgm * nN, gid = wgid / nig, fm = gid * wgm, gsz = (nM - fm) < wgm ? (nM - fm) : wgm;
        u.pm = fm + ((wgid % nig) % gsz); u.pn = (wgid % nig) / gsz; return true;
    }
};

template <int W> __device__ __forceinline__ float row_ss(const float* ps, int row, int fq) {
    float s;
    if constexpr (W == 32) { const f32x4 a = *(const f32x4*)(ps + (size_t)row * 32 + fq * 8), b = *(const f32x4*)(ps + (size_t)row * 32 + fq * 8 + 4); s = ((a.x + a.y) + (a.z + a.w)) + ((b.x + b.y) + (b.z + b.w)); }
    else { const f32x2 a = *(const f32x2*)(ps + (size_t)row * 8 + fq * 2); s = a.x + a.y; }
    s += swz_xor<16>(s); s += other_half(s, fq < 2); return s;
}
__device__ __forceinline__ void store_row_sums(const float (&s8)[8], float* slot0, int slots_per_row, int row0, int fq) {
#pragma unroll
    for (int k = 0; k < 2; ++k) {
        const float v = fq == 0 ? s8[4 * k] : (fq == 1 ? s8[4 * k + 1] : (fq == 2 ? s8[4 * k + 2] : s8[4 * k + 3]));
        slot0[(size_t)(row0 + k * HALF + fq * 16) * slots_per_row] = v; }
}
constexpr int RS_LDS_OFF = 135168 + 2048;
template <int ACT  , int RSW> struct EpiBf16 {
    static constexpr bool PERM = true;
    bf16* O; int ldc; int split_cols; size_t split_stride; const float* rs_in; float rs_inv_dim; float* ss_out; size_t ss_stride; int rs_off;
    struct RsPf { f32x4 a[2], b[2]; f32x2 c[2]; };
    __device__ __forceinline__ void rs_issue(RsPf& p, int pm, int wr, int wc, int fr, int fq) const {
#pragma unroll
        for (int ai = 0; ai < 2; ++ai) { const size_t row = (size_t)pm * BM + wr * 64 + fr + ai * HALF + wc * 16;
            if constexpr (RSW == 32) { const float* q = rs_in + row * 32 + fq * 8;
                asm volatile("global_load_dwordx4 %0, %2, off\n\tglobal_load_dwordx4 %1, %2, off offset:16" : "=&v"(p.a[ai]), "=&v"(p.b[ai]) : "v"(q) : "memory"); }
            else { const float* q = rs_in + row * 8 + fq * 2;
                asm volatile("global_load_dwordx2 %0, %1, off" : "=&v"(p.c[ai]) : "v"(q) : "memory"); } }
    }
    template <int NYOUNGER>
    __device__ __forceinline__ void rs_finish(RsPf p, LAS unsigned char* lds, int parity, int wr, int wc, int fr, int fq) const {
        static_assert(NYOUNGER == 8 || NYOUNGER == 16, "count");
        if constexpr (RSW == 32) {
            if constexpr (NYOUNGER == 16) asm volatile("s_waitcnt vmcnt(16)" : "+v"(p.a[0]), "+v"(p.b[0]), "+v"(p.a[1]), "+v"(p.b[1]) :: "memory");
            else asm volatile("s_waitcnt vmcnt(8)" : "+v"(p.a[0]), "+v"(p.b[0]), "+v"(p.a[1]), "+v"(p.b[1]) :: "memory");
        } else {
            if constexpr (NYOUNGER == 16) asm volatile("s_waitcnt vmcnt(16)" : "+v"(p.c[0]), "+v"(p.c[1]) :: "memory");
            else asm volatile("s_waitcnt vmcnt(8)" : "+v"(p.c[0]), "+v"(p.c[1]) :: "memory");
        }
        LAS float* rsl = (LAS float*)(lds + RS_LDS_OFF) + parity * 256;
#pragma unroll
        for (int ai = 0; ai < 2; ++ai) { float s;
            if constexpr (RSW == 32) s = ((p.a[ai].x + p.a[ai].y) + (p.a[ai].z + p.a[ai].w)) + ((p.b[ai].x + p.b[ai].y) + (p.b[ai].z + p.b[ai].w)); else s = p.c[ai].x + p.c[ai].y;
            s += swz_xor<16>(s); s += other_half(s, fq < 2);
            const float rs = 1.f / sqrtf(s * rs_inv_dim + EPS);
            if (fq == 0) rsl[wr * 64 + fr + ai * HALF + wc * 16] = rs; }
        asm volatile("s_waitcnt lgkmcnt(0)" ::: "memory");
    }
    __device__ __forceinline__ void operator()(const f32x4 (&acc)[2][2][4][2], const Unit& u, int wr, int wc, int fr, int fq, LAS unsigned char* lds, int parity, const Unit& nx, bool has_next) const {
        RsPf pf; rs_issue(pf, has_next ? nx.pm : u.pm, wr, wc, fr, fq);
        const LAS float* rsl = (const LAS float*)(lds + RS_LDS_OFF) + parity * 256 + wr * 64 + fr;
        const int row0 = u.pm * BM + wr * 64 + fr; int colt = u.pn * BM; bf16* base = O;
        if (split_cols) { const int t = colt / split_cols; base += (size_t)t * split_stride; colt -= t * split_cols; }
        const int col0 = colt + wc * 32 + 8 * fq;
        const bool do_ss = (ss_out != nullptr) && (u.pn < 4);
        float* ssp = do_ss ? ss_out + (size_t)(u.pn >> 1) * ss_stride + (u.pn & 1) * 4 + wc : nullptr;
        float s8[8] = {0.f, 0.f, 0.f, 0.f, 0.f, 0.f, 0.f, 0.f};
#pragma unroll
        for (int ai = 0; ai < 2; ++ai)
#pragma unroll
            for (int m = 0; m < 4; ++m) { const int row = row0 + ai * HALF + m * 16; bf16* rowp = base + (size_t)row * ldc + col0;
                float rs = rsl[ai * HALF + m * 16]; rs = rs_off ? 1.f : rs;
                float ss = 0.f;
#pragma unroll
                for (int bj = 0; bj < 2; ++bj) { f32x4 v0 = acc[ai][bj][m][0] * rs, v1 = acc[ai][bj][m][1] * rs;
                    if (ACT == 2) {
#pragma unroll
                        for (int j = 0; j < 4; ++j) { const float a = fmaxf(v0[j], 0.f), b = fmaxf(v1[j], 0.f); v0[j] = a * a; v1[j] = b * b; } }
                    u32x4 w; w.x = cvt_pk_bf16(v0[0], v0[1]); w.y = cvt_pk_bf16(v0[2], v0[3]); w.z = cvt_pk_bf16(v1[0], v1[1]); w.w = cvt_pk_bf16(v1[2], v1[3]);
                    *(u32x4*)(rowp + bj * HALF) = w;
                    if (do_ss) { const float a0 = bflo(w.x), a1 = bfhi(w.x), a2 = bflo(w.y), a3 = bfhi(w.y), a4 = bflo(w.z), a5 = bfhi(w.z), a6 = bflo(w.w), a7 = bfhi(w.w);
                        ss += (a0 * a0 + a1 * a1) + (a2 * a2 + a3 * a3) + (a4 * a4 + a5 * a5) + (a6 * a6 + a7 * a7); } }
                if (do_ss) { ss += swz_xor<16>(ss); ss += other_half(ss, fq < 2); s8[ai * 4 + m] = ss; } }
        if (do_ss) store_row_sums(s8, ssp, 8, row0, fq);
        rs_finish<16>(pf, lds, parity ^ 1, wr, wc, fr, fq);
    }
};
struct EpiResidX {
    static constexpr bool PERM = true;
    const bf16* XBin; bf16* XBout; float* ps; int ldc; float scale;
    struct RsPf {};
    __device__ __forceinline__ void rs_issue(RsPf&, int, int, int, int, int) const {}
    template <int NYOUNGER> __device__ __forceinline__ void rs_finish(const RsPf&, LAS unsigned char*, int, int, int, int, int) const {}
    __device__ __forceinline__ void operator()(const f32x4 (&acc)[2][2][4][2], const Unit& u, int wr, int wc, int fr, int fq, LAS unsigned char*, int, const Unit&, bool) const {
        const int row0 = u.pm * BM + wr * 64 + fr, col0 = u.pn * BM + wc * 32 + 8 * fq;
        float* psp = ps + u.pn * 4 + wc;
        float s8[8];
        u32x4 ch[2][4][2];
#pragma unroll
        for (int ai = 0; ai < 2; ++ai)
#pragma unroll
            for (int m = 0; m < 4; ++m) { const bf16* q = XBin + (size_t)(row0 + ai * HALF + m * 16) * ldc + col0;
                asm volatile("global_load_dwordx4 %0, %2, off\n\tglobal_load_dwordx4 %1, %2, off offset:256" : "=&v"(ch[ai][m][0]), "=&v"(ch[ai][m][1]) : "v"(q) : "memory"); }
        static_assert(HALF * 2 == 256, "the second load's immediate offset");
#pragma unroll
        for (int ai = 0; ai < 2; ++ai)
#pragma unroll
            for (int m = 0; m < 4; ++m) { const int row = row0 + ai * HALF + m * 16; const size_t off = (size_t)row * ldc + col0;
                float ss = 0.f;
                asm volatile("s_waitcnt vmcnt(14)" : "+v"(ch[ai][m][0]), "+v"(ch[ai][m][1]) :: "memory");
#pragma unroll
                for (int bj = 0; bj < 2; ++bj) { const u32x4 h4 = ch[ai][m][bj]; const f32x4 a0 = acc[ai][bj][m][0] * scale, a1 = acc[ai][bj][m][1] * scale;
                    u32x4 wh; wh.x = cvt_pk_bf16(bflo(h4.x) + a0[0], bfhi(h4.x) + a0[1]); wh.y = cvt_pk_bf16(bflo(h4.y) + a0[2], bfhi(h4.y) + a0[3]);
                    wh.z = cvt_pk_bf16(bflo(h4.z) + a1[0], bfhi(h4.z) + a1[1]); wh.w = cvt_pk_bf16(bflo(h4.w) + a1[2], bfhi(h4.w) + a1[3]);
                    *(u32x4*)(XBout + off + bj * HALF) = wh;
                    const float y0 = bflo(wh.x), y1 = bfhi(wh.x), y2 = bflo(wh.y), y3 = bfhi(wh.y), y4 = bflo(wh.z), y5 = bfhi(wh.z), y6 = bflo(wh.w), y7 = bfhi(wh.w);
                    ss += (y0 * y0 + y1 * y1) + (y2 * y2 + y3 * y3) + (y4 * y4 + y5 * y5) + (y6 * y6 + y7 * y7); }
                ss += swz_xor<16>(ss); ss += other_half(ss, fq < 2); s8[ai * 4 + m] = ss; }
        store_row_sums(s8, psp, 32, row0, fq);
    }
};

template <class Epi>
__device__ __forceinline__ void gemm_phase(LAS unsigned char* lds, const Gemm g, const StaticOrder& S, const Epi& E, int wid, int skew_ticks = 0) {
    if (skew_ticks > 0) {
        const unsigned long long t0 = __builtin_amdgcn_s_memrealtime();
        while (__builtin_amdgcn_s_memrealtime() - t0 < (unsigned long long)skew_ticks) __builtin_amdgcn_s_sleep(8);
    }
    const int lane = lane_id_fresh(), tid = wid * 64 + lane, wr = wid >> 2, wc = wid & 3, fr = lane & 15, fq = lane >> 4;
    const int K = g.K, nt = K / BK;
    unsigned voffA[2], voffB[2];
#pragma unroll
    for (int i = 0; i < 2; ++i) { int R, C; stage_rc(tid * 16 + i * 8192, R, C); const int Rb = Epi::PERM ? ((R & ~31) + perm32(R & 31)) : R;
        voffA[i] = (unsigned)(R * g.lda + C) * 2u; voffB[i] = (unsigned)(Rb * g.ldb + C) * 2u; }
    const size_t kstep = (size_t)(BK * 2);
    const size_t hstepA = (size_t)HALF * g.lda * 2, hstepB = (size_t)HALF * g.ldb * 2;
    const size_t tstepA = 2 * hstepA, tstepB = 2 * hstepB;
    const unsigned ldsw = (unsigned)wid * 1024u;
    const int aoff = lds_byte(wr * 64 + fr, fq * 8), boff = lds_byte(wc * 32 + fr, fq * 8);
#define PG8_SA(b, h) (((b) * 2 + (h)) * HTB)
#define PG8_SB(b, h) ((4 + (b) * 2 + (h)) * HTB)
#define PG8_STAGE(bufoff, gbase, voff) do { _Pragma("unroll") for (int _i = 0; _i < 2; ++_i) \
        __builtin_amdgcn_global_load_lds((const unsigned*)((const char*)(gbase) + (voff)[_i]), (LAS unsigned*)(lds + (bufoff) + ldsw + _i * 8192), 16, 0, 0); } while (0)
#define PG8_LDA(dst, b, h) do { _Pragma("unroll") for (int m = 0; m < 4; ++m) _Pragma("unroll") for (int k = 0; k < 2; ++k) dst[m][k] = *(const LAS bf16x8*)(lds + PG8_SA(b, h) + aoff + m * 2048 + k * 1024); } while (0)
#define PG8_LDB(dst, b, h) do { _Pragma("unroll") for (int n = 0; n < 2; ++n) _Pragma("unroll") for (int k = 0; k < 2; ++k) dst[n][k] = *(const LAS bf16x8*)(lds + PG8_SB(b, h) + boff + n * 2048 + k * 1024); } while (0)
#define PG8_MMA(ai, bj, At, Bt) do { __builtin_amdgcn_s_setprio(1); _Pragma("unroll") for (int m = 0; m < 4; ++m) _Pragma("unroll") for (int n = 0; n < 2; ++n) _Pragma("unroll") for (int k = 0; k < 2; ++k) \
        acc[ai][bj][m][n] = __builtin_amdgcn_mfma_f32_16x16x32_bf16(Bt[n][k], At[m][k], acc[ai][bj][m][n], 0, 0, 0); __builtin_amdgcn_s_setprio(0); } while (0)
#define PG8_WAIT_V(n) asm volatile("s_waitcnt vmcnt(" #n ")" ::: "memory")
#define PG8_WAIT_L(n) asm volatile("s_waitcnt lgkmcnt(" #n ")" ::: "memory")
#define PG8_BAR __builtin_amdgcn_s_barrier()
#define PG8_SCHED __builtin_amdgcn_sched_barrier(0)
    Unit cur, nxt; int ui = 0;
    if (!S.next(0, cur)) return;
    f32x4 acc[2][2][4][2];
#pragma unroll
    for (int a = 0; a < 2; ++a)
#pragma unroll
        for (int b = 0; b < 2; ++b)
#pragma unroll
            for (int m = 0; m < 4; ++m)
#pragma unroll
                for (int n = 0; n < 2; ++n) acc[a][b][m][n] = (f32x4){0.f, 0.f, 0.f, 0.f};
    bf16x8 At[4][2], B0[2][2], B1[2][2];
    const char* cA = (const char*)g.A + (size_t)cur.pm * tstepA; const char* cB = (const char*)g.Bt + (size_t)cur.pn * tstepB;
    typename Epi::RsPf pf0; E.rs_issue(pf0, cur.pm, wr, wc, fr, fq);
    PG8_STAGE(PG8_SB(0, 0), cB, voffB); PG8_STAGE(PG8_SB(0, 1), cB + hstepB, voffB); PG8_STAGE(PG8_SA(0, 0), cA, voffA); PG8_STAGE(PG8_SA(0, 1), cA + hstepA, voffA);
    if (wr == 1) PG8_BAR;
    PG8_WAIT_V(2); PG8_BAR;
    E.template rs_finish<8>(pf0, lds, 0, wr, wc, fr, fq);
    PG8_STAGE(PG8_SB(1, 0), cB + kstep, voffB); PG8_STAGE(PG8_SA(1, 0), cA + kstep, voffA); PG8_STAGE(PG8_SB(1, 1), cB + hstepB + kstep, voffB);
    PG8_WAIT_V(6); PG8_BAR;
    for (;;) {
        const bool has_next = S.next(ui + 1, nxt);
        const char* nA = has_next ? (const char*)g.A + (size_t)nxt.pm * tstepA : cA; const char* nB = has_next ? (const char*)g.Bt + (size_t)nxt.pn * tstepB : cB;
        for (int t = 0; t < nt; t += 2) {
            const bool last = (t == nt - 2);
            const char* a1 = cA + (size_t)(t + 1) * kstep;
            const char* a2 = last ? nA : cA + (size_t)(t + 2) * kstep; const char* b2 = last ? nB : cB + (size_t)(t + 2) * kstep;
            const char* a3 = a2 + kstep; const char* b3 = b2 + kstep;
            PG8_LDB(B0, 0, 0); PG8_LDB(B1, 0, 1); PG8_SCHED; PG8_LDA(At, 0, 0); PG8_STAGE(PG8_SA(1, 1), a1 + hstepA, voffA);
            PG8_WAIT_V(8); PG8_WAIT_L(0); PG8_BAR; PG8_MMA(0, 0, At, B0); PG8_MMA(0, 1, At, B1); PG8_BAR; PG8_SCHED;
            PG8_LDA(At, 0, 1); PG8_STAGE(PG8_SB(0, 0), b2, voffB); PG8_STAGE(PG8_SB(0, 1), b2 + hstepB, voffB); PG8_STAGE(PG8_SA(0, 0), a2, voffA);
            PG8_WAIT_V(8); PG8_WAIT_L(0); PG8_BAR; PG8_MMA(1, 0, At, B0); PG8_MMA(1, 1, At, B1); PG8_BAR; PG8_SCHED;
            PG8_LDB(B0, 1, 0); PG8_LDB(B1, 1, 1); PG8_SCHED; PG8_LDA(At, 1, 0); PG8_STAGE(PG8_SA(0, 1), a2 + hstepA, voffA);
            PG8_WAIT_V(8); PG8_WAIT_L(0); PG8_BAR; PG8_MMA(0, 0, At, B0); PG8_MMA(0, 1, At, B1); PG8_BAR; PG8_SCHED;
            PG8_LDA(At, 1, 1); PG8_STAGE(PG8_SB(1, 0), b3, voffB); PG8_STAGE(PG8_SB(1, 1), b3 + hstepB, voffB); PG8_STAGE(PG8_SA(1, 0), a3, voffA);
            PG8_WAIT_V(8); PG8_WAIT_L(0); PG8_BAR; PG8_MMA(1, 0, At, B0); PG8_MMA(1, 1, At, B1); PG8_BAR; PG8_SCHED;
        }
        if (wr == 0) PG8_BAR;
        E(acc, cur, wr, wc, fr, fq, lds, ui & 1, nxt, has_next);
        if (!has_next) break;
#pragma unroll
        for (int a = 0; a < 2; ++a)
#pragma unroll
            for (int b = 0; b < 2; ++b)
#pragma unroll
                for (int m = 0; m < 4; ++m)
#pragma unroll
                    for (int n = 0; n < 2; ++n) acc[a][b][m][n] = (f32x4){0.f, 0.f, 0.f, 0.f};
        cur = nxt; cA = nA; cB = nB; ++ui;
        if (wr == 1) PG8_BAR;
    }
    PG8_WAIT_V(0);
    PG8_BAR;
#undef PG8_SA
#undef PG8_SB
#undef PG8_STAGE
#undef PG8_LDA
#undef PG8_LDB
#undef PG8_MMA
#undef PG8_WAIT_V
#undef PG8_WAIT_L
#undef PG8_BAR
#undef PG8_SCHED
}
}

namespace att {
#define SBAR() __builtin_amdgcn_sched_barrier(0)
constexpr int SHM_V = 64 * 128 * 2;
__device__ __forceinline__ int crow(int r, int hi) { return (r & 3) + 8 * (r >> 2) + 4 * hi; }
template <int DQK> struct Cfg {
    static constexpr int KP = DQK * 2, SHM_K = 64 * KP, OFF_K = 2 * SHM_V, OFF_WS = OFF_K + 2 * SHM_K, NPARK = (DQK == 192 ? 6 : 0), NREG = DQK / 16 - NPARK, OFF_QS = OFF_WS + 8 * 256, TOTAL = OFF_QS + 8 * 1024 * NPARK;
    static constexpr float SCALE = (DQK == 192) ? 0.07216878364870322f : 0.08838834764831845f;
    static constexpr float C = SCALE * 1.4426950408889634f;
};
constexpr float THR = 8.f;

template <int DQK>
__device__ __forceinline__ void partialSM(f32x16& p0, f32x16& p1, float& m_reg, float& mn, float& alpha) {
    constexpr float C = Cfg<DQK>::C, SCALE = Cfg<DQK>::SCALE;
    float pmax = p0[0];
#pragma unroll
    for (int r = 1; r < 16; ++r) pmax = fmaxf(pmax, p0[r]);
#pragma unroll
    for (int r = 0; r < 16; ++r) pmax = fmaxf(pmax, p1[r]);
    { auto rr = __builtin_amdgcn_permlane32_swap(__float_as_uint(pmax), __float_as_uint(pmax), false, false);
      pmax = fmaxf(__uint_as_float(rr[0]), __uint_as_float(rr[1])); }
    if (__builtin_expect(__all(pmax - m_reg <= THR / SCALE), 1)) { mn = m_reg; alpha = 1.f; }
    else { mn = fmaxf(m_reg, pmax); alpha = __builtin_amdgcn_exp2f((m_reg - mn) * C); m_reg = mn; }
    const float mnC = -mn * C;
#pragma unroll
    for (int r = 0; r < 16; ++r) p0[r] = fmaf(p0[r], C, mnC);
#pragma unroll
    for (int r = 0; r < 16; ++r) p1[r] = fmaf(p1[r], C, mnC);
#pragma unroll
    for (int r = 0; r < 16; ++r) p0[r] = __builtin_amdgcn_exp2f(p0[r]);
}
__device__ __forceinline__ void finishSM(f32x16& p0, f32x16& p1, float alpha, float& l_reg, bf16x8& pa0, bf16x8& pa1, bf16x8& pa2, bf16x8& pa3) {
#pragma unroll
    for (int r = 0; r < 16; ++r) p1[r] = __builtin_amdgcn_exp2f(p1[r]);
    float ps = 0;
#pragma unroll
    for (int r = 0; r < 16; ++r) ps += p0[r];
#pragma unroll
    for (int r = 0; r < 16; ++r) ps += p1[r];
    { auto rr = __builtin_amdgcn_permlane32_swap(__float_as_uint(ps), __float_as_uint(ps), false, false);
      ps = __uint_as_float(rr[0]) + __uint_as_float(rr[1]); }
    l_reg = l_reg * alpha + ps;
#define PK4(P, BASE, OUT) do { unsigned a0 = cvt_pk_bf16(P[BASE + 0], P[BASE + 1]), a1 = cvt_pk_bf16(P[BASE + 2], P[BASE + 3]);   \
    unsigned b0 = cvt_pk_bf16(P[BASE + 4], P[BASE + 5]), b1 = cvt_pk_bf16(P[BASE + 6], P[BASE + 7]);                              \
    auto r0 = __builtin_amdgcn_permlane32_swap(a0, b0, false, false); auto r1 = __builtin_amdgcn_permlane32_swap(a1, b1, false, false); \
    u32x4 w = {r0[0], r1[0], r0[1], r1[1]}; OUT = __builtin_bit_cast(bf16x8, w); } while (0)
    PK4(p0, 0, pa0); PK4(p0, 8, pa1); PK4(p1, 0, pa2); PK4(p1, 8, pa3);
#undef PK4
}
#define KSWZ(KP, row, colB) ((row) * (KP) + ((colB) ^ (((KP) == 256 ? ((row) & 15) : (((row) >> 1) & 7)) << 4)))
template <int DQK, int NREG = Cfg<DQK>::NREG>
__device__ __forceinline__ void qkt(f32x16& p0, f32x16& p1, const LAS char* Ks, const bf16x8* qr, const LAS char* Qs, int r32, int hi) {
    constexpr int KP = Cfg<DQK>::KP;
    p0 = f32x16{}; p1 = f32x16{};
#pragma unroll
    for (int d0 = 0; d0 < DQK / 16; ++d0) { const int cb = (d0 * 16 + hi * 8) * 2;
        const bf16x8 b0 = *(const LAS bf16x8*)(Ks + KSWZ(KP, r32, cb));
        const bf16x8 b1 = *(const LAS bf16x8*)(Ks + KSWZ(KP, 32 + r32, cb));
        bf16x8 q;
        if (d0 < NREG) q = qr[d0]; else q = *(const LAS bf16x8*)(Qs + (d0 - NREG) * 1024);
        p0 = __builtin_amdgcn_mfma_f32_32x32x16_bf16(b0, q, p0, 0, 0, 0);
        p1 = __builtin_amdgcn_mfma_f32_32x32x16_bf16(b1, q, p1, 0, 0, 0); }
}
__device__ __forceinline__ int v_st(int k, int c) { const int kk = (k & ~0xC) | ((k & 4) << 1) | ((k & 8) >> 1); return ((kk >> 3) * 4 + (c >> 5)) * 512 + ((kk & 7) * 32 + (c & 31)) * 2; }
__device__ __forceinline__ int v_rd_base(int lane) { return ((lane & 3) << 3) | (((lane >> 2) & 3) << 6) | (((lane >> 4) & 1) << 5) | (((lane >> 5) & 1) << 8); }
constexpr int v_rd_off(int d0, int ks, int half) { return d0 * 512 + ks * 4096 + half * 2048; }
template <int OFF> __device__ __forceinline__ s16x4 tr_read(int vb) {
    s16x4 r; asm volatile("ds_read_b64_tr_b16 %0, %1 offset:%2" : "=&v"(r) : "v"(vb), "i"(OFF) : "memory"); return r;
}
template <int D0> __device__ __forceinline__ void pv_one(f32x16& od, int vb, bf16x8 pa0, bf16x8 pa1, bf16x8 pa2, bf16x8 pa3) {
    const s16x4 l0 = tr_read<v_rd_off(D0, 0, 0)>(vb), h0 = tr_read<v_rd_off(D0, 0, 1)>(vb), l1 = tr_read<v_rd_off(D0, 1, 0)>(vb), h1 = tr_read<v_rd_off(D0, 1, 1)>(vb);
    const s16x4 l2 = tr_read<v_rd_off(D0, 2, 0)>(vb), h2 = tr_read<v_rd_off(D0, 2, 1)>(vb), l3 = tr_read<v_rd_off(D0, 3, 0)>(vb), h3 = tr_read<v_rd_off(D0, 3, 1)>(vb);
    asm volatile("s_waitcnt lgkmcnt(0)" ::: "memory"); SBAR();
#define PKV(L, H) (bf16x8){L[0], L[1], L[2], L[3], H[0], H[1], H[2], H[3]}
    od = __builtin_amdgcn_mfma_f32_32x32x16_bf16(pa0, PKV(l0, h0), od, 0, 0, 0);
    od = __builtin_amdgcn_mfma_f32_32x32x16_bf16(pa1, PKV(l1, h1), od, 0, 0, 0);
    od = __builtin_amdgcn_mfma_f32_32x32x16_bf16(pa2, PKV(l2, h2), od, 0, 0, 0);
    od = __builtin_amdgcn_mfma_f32_32x32x16_bf16(pa3, PKV(l3, h3), od, 0, 0, 0);
#undef PKV
}
__device__ __forceinline__ void pv_d0(f32x16* o, int vb, bf16x8 pa0, bf16x8 pa1, bf16x8 pa2, bf16x8 pa3) {
    pv_one<0>(o[0], vb, pa0, pa1, pa2, pa3); pv_one<1>(o[1], vb, pa0, pa1, pa2, pa3); pv_one<2>(o[2], vb, pa0, pa1, pa2, pa3); pv_one<3>(o[3], vb, pa0, pa1, pa2, pa3);
}
__device__ __forceinline__ void store_o(const f32x16* o, float l_reg, LAS float* li_l, LAS char* lds, bf16* Ob, int ldo, int wid, int lane, int r32, int hi) {
    if (hi == 0) li_l[r32] = l_reg;
    asm volatile("s_waitcnt lgkmcnt(0)" ::: "memory");
    float rli[16];
#pragma unroll
    for (int r = 0; r < 16; ++r) rli[r] = __builtin_amdgcn_rcpf(li_l[crow(r, hi)]);
    LAS unsigned short* slab = (LAS unsigned short*)(lds + wid * 8192);
#pragma unroll
    for (int r = 0; r < 16; ++r) { const int orow = crow(r, hi);
#pragma unroll
        for (int d0 = 0; d0 < 4; ++d0) slab[orow * 128 + d0 * 32 + r32] = (unsigned short)(cvt_pk_bf16(o[d0][r] * rli[r], 0.f) & 0xffffu); }
    asm volatile("s_waitcnt lgkmcnt(0)" ::: "memory");
#pragma unroll
    for (int i = 0; i < 8; ++i) { const int id = i * 64 + lane, row = id >> 4, c16 = id & 15;
        const u32x4 w = *(const LAS u32x4*)((LAS char*)slab + row * 256 + c16 * 16);
        *(u32x4*)(Ob + (unsigned)(wid * 32 + row) * (unsigned)ldo + c16 * 8) = w; }
}

__device__ __forceinline__ void unpack8(bf16x8 v, float (&x)[8]) {
#pragma unroll
    for (int e = 0; e < 8; ++e) x[e] = bf2f((unsigned short)v[e]);
}
__device__ __forceinline__ bf16x8 pack8(const float (&x)[8]) {
    u32x4 w; w.x = cvt_pk_bf16(x[0], x[1]); w.y = cvt_pk_bf16(x[2], x[3]); w.z = cvt_pk_bf16(x[4], x[5]); w.w = cvt_pk_bf16(x[6], x[7]); return __builtin_bit_cast(bf16x8, w);
}
__device__ __forceinline__ void rope_pair(bf16x8& f1, bf16x8& f2, const float* ct, const float* st, float mul, const float* g1, const float* g2) {
    float x1[8], x2[8], a[8], b[8]; unpack8(f1, x1); unpack8(f2, x2);
    const f32x4 c0 = *(const f32x4*)ct, c1 = *(const f32x4*)(ct + 4), s0 = *(const f32x4*)st, s1 = *(const f32x4*)(st + 4);
    const float c[8] = {c0.x, c0.y, c0.z, c0.w, c1.x, c1.y, c1.z, c1.w}, s[8] = {s0.x, s0.y, s0.z, s0.w, s1.x, s1.y, s1.z, s1.w};
    if (g1) {
        const f32x4 ga = *(const f32x4*)g1, gb = *(const f32x4*)(g1 + 4), gc = *(const f32x4*)g2, gd = *(const f32x4*)(g2 + 4);
        const float gg1[8] = {ga.x, ga.y, ga.z, ga.w, gb.x, gb.y, gb.z, gb.w}, gg2[8] = {gc.x, gc.y, gc.z, gc.w, gd.x, gd.y, gd.z, gd.w};
#pragma unroll
        for (int e = 0; e < 8; ++e) { x1[e] = x1[e] * mul * gg1[e]; x2[e] = x2[e] * mul * gg2[e]; }
    }
#pragma unroll
    for (int e = 0; e < 8; ++e) { a[e] = x1[e] * c[e] - x2[e] * s[e]; b[e] = x2[e] * c[e] + x1[e] * s[e]; }
    f1 = pack8(a); f2 = pack8(b);
}
template <int ND0, int QMODE>
__device__ __forceinline__ void load_q(bf16x8 (&qraw)[ND0], const bf16* __restrict__ Qb, int ldq, int wid, int r32, int hi, int qpos0, const float* __restrict__ tab, const float* __restrict__ qgain) {
    const unsigned qo = (unsigned)(wid * 32 + r32) * (unsigned)ldq + hi * 8;
#pragma unroll
    for (int d0 = 0; d0 < ND0; ++d0) qraw[d0] = *(const bf16x8*)(Qb + qo + d0 * 16);
    const int pos = qpos0 + wid * 32 + r32;
    if constexpr (QMODE == 1) {
        const float* ct = tab + pos * 32 + hi * 8; const float* st = ct + 4096 * 32;
        rope_pair(qraw[8], qraw[10], ct, st, 1.f, nullptr, nullptr); rope_pair(qraw[9], qraw[11], ct + 16, st + 16, 1.f, nullptr, nullptr);
    } else if constexpr (QMODE == 2) {
        const float* ct = tab + pos * 64 + hi * 8; const float* st = ct + 4096 * 64;
#pragma unroll
        for (int g = 0; g < 4; ++g) rope_pair(qraw[g], qraw[g + 4], ct + g * 16, st + g * 16, 1.f, nullptr, nullptr);
    } else if constexpr (QMODE == 3) {
        float ss = 0.f;
#pragma unroll
        for (int d0 = 0; d0 < 8; ++d0) { float x[8]; unpack8(qraw[d0], x);
#pragma unroll
            for (int e = 0; e < 8; ++e) ss += x[e] * x[e]; }
        ss += other_half(ss, hi == 0);
        const float rstd = 1.f / sqrtf(ss * (1.f / 128.f) + EPS);
        const float* ctr = tab + (pos >> 6) * 32 + hi * 8; const float* str = ctr + 4096 * 32; const float* ctc = tab + (pos & 63) * 32 + hi * 8; const float* stc = ctc + 4096 * 32;
        const float* gq = qgain + hi * 8;
#pragma unroll
        for (int g = 0; g < 2; ++g) { rope_pair(qraw[g], qraw[g + 2], ctr + g * 16, str + g * 16, rstd, gq + g * 16, gq + (g + 2) * 16);
                                      rope_pair(qraw[4 + g], qraw[6 + g], ctc + g * 16, stc + g * 16, rstd, gq + (4 + g) * 16, gq + (6 + g) * 16); }
    }
}
template <int DQK, int SDEPTH, int QMODE>
__device__ __forceinline__ void dense_unit(const bf16* __restrict__ Qb, int ldq, const bf16* __restrict__ Kh, int ldk, const bf16* __restrict__ K2h, int ldk2,
                                           const bf16* __restrict__ Vh, int ldv, bf16* __restrict__ Ob, int ldo, int seq, LAS char* lds, int wid,
                                           int qpos0, const float* __restrict__ tab, const float* __restrict__ qgain) {
    using CF = Cfg<DQK>; constexpr int KP = CF::KP, SHM_K = CF::SHM_K, ND0 = DQK / 16;
    const int lane = lane_id_fresh(), tid = wid * 64 + lane, r32 = lane & 31, hi = lane >> 5;
    LAS char* V_lds = lds; LAS char* K_lds = lds + CF::OFF_K;
    LAS float* ws = (LAS float*)(lds + CF::OFF_WS) + wid * 64; LAS float* li_l = ws; LAS float* al_l = ws + 32;
    float m_reg = -1e30f, l_reg = 0; f32x16 o[4] = {}; bf16x8 qr[CF::NREG];
    const LAS char* Qs = lds + CF::OFF_QS + wid * (1024 * CF::NPARK) + lane * 16;
    { bf16x8 qraw[ND0]; load_q<ND0, QMODE>(qraw, Qb, ldq, wid, r32, hi, qpos0, tab, qgain);
#pragma unroll
      for (int d0 = 0; d0 < CF::NREG; ++d0) qr[d0] = qraw[d0];
      if constexpr (CF::NPARK > 0) {
#pragma unroll
          for (int d0 = CF::NREG; d0 < ND0; ++d0) *(LAS bf16x8*)((LAS char*)Qs + (d0 - CF::NREG) * 1024) = qraw[d0]; } }
    const int sr = tid >> 4, sc = (tid & 15) * 8, vst0 = v_st(sr, sc), vst1 = v_st(32 + sr, sc);
    const int kst0 = KSWZ(KP, sr, sc * 2), kst1 = KSWZ(KP, 32 + sr, sc * 2);
    const int kr2 = tid >> 3, c2 = (tid & 7) * 8, kst2 = KSWZ(KP, kr2, (128 + c2) * 2);
    const unsigned vo = (unsigned)sr * (unsigned)ldv + sc, ko = (unsigned)sr * (unsigned)ldk + sc, k2o = (unsigned)kr2 * (unsigned)ldk2 + c2;
    const int vb0 = (int)(unsigned)(uintptr_t)V_lds + v_rd_base(lane);
    struct { bf16x8 vs0, vs1, ks0, ks1, k2; } sr_[SDEPTH];
#define SLOAD(i, k0) do { const bf16* Vt_ = Vh + (size_t)(k0) * ldv; const bf16* Kt_ = Kh + (size_t)(k0) * ldk; \
    sr_[i].vs0 = *(const bf16x8*)(Vt_ + vo); sr_[i].vs1 = *(const bf16x8*)(Vt_ + (size_t)32 * ldv + vo); \
    sr_[i].ks0 = *(const bf16x8*)(Kt_ + ko); sr_[i].ks1 = *(const bf16x8*)(Kt_ + (size_t)32 * ldk + ko); \
    if constexpr (DQK == 192) sr_[i].k2 = *(const bf16x8*)(K2h + (size_t)(k0) * ldk2 + k2o); } while (0)
#define SWRITE(b, i) do { *(LAS bf16x8*)(V_lds + (b) * SHM_V + vst0) = sr_[i].vs0; *(LAS bf16x8*)(V_lds + (b) * SHM_V + vst1) = sr_[i].vs1; \
    *(LAS bf16x8*)(K_lds + (b) * SHM_K + kst0) = sr_[i].ks0; *(LAS bf16x8*)(K_lds + (b) * SHM_K + kst1) = sr_[i].ks1; \
    if constexpr (DQK == 192) *(LAS bf16x8*)(K_lds + (b) * SHM_K + kst2) = sr_[i].k2; } while (0)
#define SWAIT() do { if constexpr (SDEPTH == 1) asm volatile("s_waitcnt vmcnt(0)" ::: "memory"); else if constexpr (DQK == 192) asm volatile("s_waitcnt vmcnt(5)" ::: "memory"); else asm volatile("s_waitcnt vmcnt(4)" ::: "memory"); } while (0)
#define RESC(a) do { if (__any((a) < 1.f)) { if (hi == 0) al_l[r32] = (a); asm volatile("s_waitcnt lgkmcnt(0)" ::: "memory"); \
    _Pragma("unroll") for (int d = 0; d < 4; ++d) _Pragma("unroll") for (int r = 0; r < 16; ++r) o[d][r] *= al_l[crow(r, hi)]; } } while (0)
    f32x16 pA0, pA1, pB0, pB1; float mnA, mnB, alA, alB; bf16x8 pa0, pa1, pa2, pa3; const int NT = seq / 64;
    constexpr int SE = 0, SO = SDEPTH - 1;
    __syncthreads();
    SLOAD(SE, 0); asm volatile("s_waitcnt vmcnt(0)" ::: "memory"); SWRITE(0, SE); __syncthreads();
    qkt<DQK>(pA0, pA1, K_lds, qr, Qs, r32, hi); partialSM<DQK>(pA0, pA1, m_reg, mnA, alA);
    SLOAD(SO, 64); if constexpr (SDEPTH == 2) { if (2 < NT) SLOAD(SE, 128); }
    SWAIT(); SWRITE(1, SO); __syncthreads();
    for (int j = 1; j + 1 < NT; j += 2) {
        SBAR(); qkt<DQK>(pB0, pB1, K_lds + SHM_K, qr, Qs, r32, hi);
        finishSM(pA0, pA1, alA, l_reg, pa0, pa1, pa2, pa3); SBAR();
        SLOAD(SO, (j + SDEPTH) * 64); SBAR();
        pv_d0(o, vb0, pa0, pa1, pa2, pa3); partialSM<DQK>(pB0, pB1, m_reg, mnB, alB);
        __syncthreads(); SWAIT(); SWRITE(0, SE);
        RESC(alB); __syncthreads();
        SBAR(); qkt<DQK>(pA0, pA1, K_lds, qr, Qs, r32, hi);
        finishSM(pB0, pB1, alB, l_reg, pa0, pa1, pa2, pa3); SBAR();
        if (SDEPTH == 1 || j + 3 < NT) SLOAD(SE, (j + 1 + SDEPTH) * 64); SBAR();
        pv_d0(o, vb0 + SHM_V, pa0, pa1, pa2, pa3); partialSM<DQK>(pA0, pA1, m_reg, mnA, alA);
        __syncthreads(); SWAIT(); SWRITE(1, SO);
        RESC(alA); __syncthreads();
    }
    SBAR(); qkt<DQK>(pB0, pB1, K_lds + SHM_K, qr, Qs, r32, hi);
    finishSM(pA0, pA1, alA, l_reg, pa0, pa1, pa2, pa3); SBAR();
    pv_d0(o, vb0, pa0, pa1, pa2, pa3); partialSM<DQK>(pB0, pB1, m_reg, mnB, alB);
    __syncthreads(); RESC(alB);
    finishSM(pB0, pB1, alB, l_reg, pa0, pa1, pa2, pa3); SBAR();
    pv_d0(o, vb0 + SHM_V, pa0, pa1, pa2, pa3);
    __syncthreads();
    store_o(o, l_reg, li_l, lds, Ob, ldo, wid, lane, r32, hi);
#undef SLOAD
#undef SWRITE
#undef SWAIT
}

constexpr int R3_SLOT = 32768, R3_OFF_WS = 3 * R3_SLOT, R3_TOTAL = R3_OFF_WS + 8 * 256;
template <int QMODE>
__device__ __forceinline__ void dense_unit3(const bf16* __restrict__ Qb, int ldq, const bf16* __restrict__ Kh, int ldk, const bf16* __restrict__ Vh, int ldv, bf16* __restrict__ Ob, int ldo, int seq,
                                            LAS char* lds, int wid, int qpos0, const float* __restrict__ tab, const float* __restrict__ qgain) {
    constexpr int KP = 256;
    const int lane = lane_id_fresh(), tid = wid * 64 + lane, r32 = lane & 31, hi = lane >> 5;
    LAS float* ws = (LAS float*)(lds + R3_OFF_WS) + wid * 64; LAS float* li_l = ws; LAS float* al_l = ws + 32;
    float m_reg = -1e30f, l_reg = 0; f32x16 o[4] = {}; bf16x8 qr[8];
    load_q<8, QMODE>(qr, Qb, ldq, wid, r32, hi, qpos0, tab, qgain);
    const int sr = tid >> 4, sc = (tid & 15) * 8, vst0 = v_st(sr, sc), vst1 = v_st(32 + sr, sc);
    const int kst0 = 16384 + KSWZ(KP, sr, sc * 2), kst1 = 16384 + KSWZ(KP, 32 + sr, sc * 2);
    const unsigned vo = (unsigned)sr * (unsigned)ldv + sc, ko = (unsigned)sr * (unsigned)ldk + sc;
    const int vbase = (int)(unsigned)(uintptr_t)lds + v_rd_base(lane);
    struct { bf16x8 vs0, vs1, ks0, ks1; } sr_[2];
#define SLOAD3(i, k0) do { const bf16* Vt_ = Vh + (size_t)(k0) * ldv; const bf16* Kt_ = Kh + (size_t)(k0) * ldk; \
    sr_[i].vs0 = *(const bf16x8*)(Vt_ + vo); sr_[i].vs1 = *(const bf16x8*)(Vt_ + (size_t)32 * ldv + vo); \
    sr_[i].ks0 = *(const bf16x8*)(Kt_ + ko); sr_[i].ks1 = *(const bf16x8*)(Kt_ + (size_t)32 * ldk + ko); } while (0)
#define SWRITE3(soff, i) do { *(LAS bf16x8*)(lds + (soff) + vst0) = sr_[i].vs0; *(LAS bf16x8*)(lds + (soff) + vst1) = sr_[i].vs1; \
    *(LAS bf16x8*)(lds + (soff) + kst0) = sr_[i].ks0; *(LAS bf16x8*)(lds + (soff) + kst1) = sr_[i].ks1; } while (0)
#define SWAIT3() asm volatile("s_waitcnt vmcnt(4)" ::: "memory")
#define RESC3(a) do { if (__any((a) < 1.f)) { if (hi == 0) al_l[r32] = (a); asm volatile("s_waitcnt lgkmcnt(0)" ::: "memory"); \
    _Pragma("unroll") for (int d = 0; d < 4; ++d) _Pragma("unroll") for (int r = 0; r < 16; ++r) o[d][r] *= al_l[crow(r, hi)]; } } while (0)
    f32x16 pA0, pA1, pB0, pB1; float mnA, mnB, alA, alB; bf16x8 pa0, pa1, pa2, pa3; const int NT = seq / 64;
    __syncthreads();
    SLOAD3(0, 0); SLOAD3(1, 64);
    SWAIT3(); SWRITE3(0, 0);
    if (2 < NT) SLOAD3(0, 128);
    __syncthreads();
    qkt<128>(pA0, pA1, lds + 16384, qr, nullptr, r32, hi); partialSM<128>(pA0, pA1, m_reg, mnA, alA);
    SWAIT3(); SWRITE3(R3_SLOT, 1);
    int sK = R3_SLOT, sV = 0, sW = 2 * R3_SLOT;
    for (int t = 1; t + 1 < NT; t += 2) {
        __syncthreads();
        SBAR(); qkt<128>(pB0, pB1, lds + sK + 16384, qr, nullptr, r32, hi);
        finishSM(pA0, pA1, alA, l_reg, pa0, pa1, pa2, pa3); SBAR();
        if (t + 2 < NT) SLOAD3(1, (t + 2) * 64); SBAR();
        pv_d0(o, vbase + sV, pa0, pa1, pa2, pa3); partialSM<128>(pB0, pB1, m_reg, mnB, alB);
        SWAIT3(); SWRITE3(sW, 0);
        RESC3(alB);
        { const int n = sV; sV = sK; sK = sW; sW = n; }
        __syncthreads();
        SBAR(); qkt<128>(pA0, pA1, lds + sK + 16384, qr, nullptr, r32, hi);
        finishSM(pB0, pB1, alB, l_reg, pa0, pa1, pa2, pa3); SBAR();
        if (t + 3 < NT) SLOAD3(0, (t + 3) * 64); SBAR();
        pv_d0(o, vbase + sV, pa0, pa1, pa2, pa3); partialSM<128>(pA0, pA1, m_reg, mnA, alA);
        SWAIT3(); if (t + 2 < NT) SWRITE3(sW, 1);
        RESC3(alA);
        { const int n = sV; sV = sK; sK = sW; sW = n; }
    }
    __syncthreads();
    SBAR(); qkt<128>(pB0, pB1, lds + sK + 16384, qr, nullptr, r32, hi);
    finishSM(pA0, pA1, alA, l_reg, pa0, pa1, pa2, pa3); SBAR();
    pv_d0(o, vbase + sV, pa0, pa1, pa2, pa3); partialSM<128>(pB0, pB1, m_reg, mnB, alB);
    RESC3(alB);
    finishSM(pB0, pB1, alB, l_reg, pa0, pa1, pa2, pa3); SBAR();
    pv_d0(o, vbase + sK, pa0, pa1, pa2, pa3);
    __syncthreads();
    store_o(o, l_reg, li_l, lds, Ob, ldo, wid, lane, r32, hi);
#undef SLOAD3
#undef SWRITE3
#undef SWAIT3
#undef RESC3
}

constexpr int DV_SLOT = 49152, DV_OFF_K = 32768, DV_OFF_WS = 131072, DV_TOTAL = DV_OFF_WS + 8 * 256;
__device__ __forceinline__ void dense_unit_dv256(const bf16* __restrict__ Qb, int ldq, const bf16* __restrict__ Kh, int ldk, const bf16* __restrict__ Vh, int ldv, bf16* __restrict__ Ob, int ldo, int seq,
                                                 LAS char* lds, int wid, int qpos0, const float* __restrict__ tab) {
    constexpr int KP = 256;
    const int lane = lane_id_fresh(), tid = wid * 64 + lane, r32 = lane & 31, hi = lane >> 5;
    LAS float* ws = (LAS float*)(lds + DV_OFF_WS) + wid * 64; LAS float* li_l = ws; LAS float* al_l = ws + 32;
    __syncthreads();
    float m_reg = -1e30f, l_reg = 0; f32x16 o[8] = {}; bf16x8 qr[4];
    const LAS char* Qs = lds + 2 * DV_SLOT + wid * 4096 + lane * 16;
    { bf16x8 qraw[8]; load_q<8, 2>(qraw, Qb, ldq, wid, r32, hi, qpos0, tab, nullptr);
#pragma unroll
      for (int d0 = 0; d0 < 4; ++d0) qr[d0] = qraw[d0];
#pragma unroll
      for (int d0 = 4; d0 < 8; ++d0) *(LAS bf16x8*)((LAS char*)Qs + (d0 - 4) * 1024) = qraw[d0]; }
    const int sr = tid >> 4, sc = (tid & 15) * 8, vst0 = v_st(sr, sc), vst1 = v_st(32 + sr, sc);
    const int kst0 = DV_OFF_K + KSWZ(KP, sr, sc * 2), kst1 = DV_OFF_K + KSWZ(KP, 32 + sr, sc * 2);
    const unsigned vo = (unsigned)sr * (unsigned)ldv + sc, ko = (unsigned)sr * (unsigned)ldk + sc;
    const int vbase = (int)(unsigned)(uintptr_t)lds + v_rd_base(lane);
    bf16x8 sv0, sv1, sv2, sv3, sk0, sk1;
#define DLOAD(k0) do { const bf16* Vt_ = Vh + (size_t)(k0) * ldv; const bf16* Kt_ = Kh + (size_t)(k0) * ldk; \
    sv0 = *(const bf16x8*)(Vt_ + vo); sv1 = *(const bf16x8*)(Vt_ + (size_t)32 * ldv + vo); sv2 = *(const bf16x8*)(Vt_ + vo + 128); sv3 = *(const bf16x8*)(Vt_ + (size_t)32 * ldv + vo + 128); \
    sk0 = *(const bf16x8*)(Kt_ + ko); sk1 = *(const bf16x8*)(Kt_ + (size_t)32 * ldk + ko); } while (0)
#define DWRITE(soff) do { *(LAS bf16x8*)(lds + (soff) + vst0) = sv0; *(LAS bf16x8*)(lds + (soff) + vst1) = sv1; *(LAS bf16x8*)(lds + (soff) + 16384 + vst0) = sv2; *(LAS bf16x8*)(lds + (soff) + 16384 + vst1) = sv3; \
    *(LAS bf16x8*)(lds + (soff) + kst0) = sk0; *(LAS bf16x8*)(lds + (soff) + kst1) = sk1; } while (0)
    const int NT = seq / 64;
    __syncthreads();
    DLOAD(0); asm volatile("s_waitcnt vmcnt(0)" ::: "memory"); DWRITE(0);
    __syncthreads();
    int sC = 0, sN = DV_SLOT;
    for (int t = 0; t < NT; ++t) {
        f32x16 p0, p1; float mn, al; bf16x8 pa0, pa1, pa2, pa3;
        SBAR(); qkt<128, 4>(p0, p1, lds + sC + DV_OFF_K, qr, Qs, r32, hi);
        partialSM<128>(p0, p1, m_reg, mn, al);
        if (__any(al < 1.f)) { if (hi == 0) al_l[r32] = al; asm volatile("s_waitcnt lgkmcnt(0)" ::: "memory");
#pragma unroll
            for (int d = 0; d < 8; ++d)
#pragma unroll
                for (int r = 0; r < 16; ++r) o[d][r] *= al_l[crow(r, hi)]; }
        finishSM(p0, p1, al, l_reg, pa0, pa1, pa2, pa3); SBAR();
        if (t + 1 < NT) DLOAD((t + 1) * 64);
        SBAR();
        pv_d0(o, vbase + sC, pa0, pa1, pa2, pa3);
        pv_d0(o + 4, vbase + sC + 16384, pa0, pa1, pa2, pa3);
        if (t + 1 < NT) { asm volatile("s_waitcnt vmcnt(0)" ::: "memory"); DWRITE(sN); }
        __syncthreads();
        { const int n = sC; sC = sN; sN = n; }
    }
    if (hi == 0) li_l[r32] = l_reg;
    asm volatile("s_waitcnt lgkmcnt(0)" ::: "memory");
    float rli[16];
#pragma unroll
    for (int r = 0; r < 16; ++r) rli[r] = __builtin_amdgcn_rcpf(li_l[crow(r, hi)]);
    LAS unsigned short* slab = (LAS unsigned short*)(lds + wid * 16384);
#pragma unroll
    for (int r = 0; r < 16; ++r) { const int orow = crow(r, hi);
#pragma unroll
        for (int d0 = 0; d0 < 8; ++d0) slab[orow * 256 + d0 * 32 + r32] = (unsigned short)(cvt_pk_bf16(o[d0][r] * rli[r], 0.f) & 0xffffu); }
    asm volatile("s_waitcnt lgkmcnt(0)" ::: "memory");
#pragma unroll
    for (int i = 0; i < 16; ++i) { const int id = i * 64 + lane, row = id >> 5, c16 = id & 31;
        const u32x4 w = *(const LAS u32x4*)((LAS char*)slab + row * 512 + c16 * 16);
        *(u32x4*)(Ob + (unsigned)(wid * 32 + row) * (unsigned)ldo + c16 * 8) = w; }
#undef DLOAD
#undef DWRITE
}

constexpr int NA_OFF_K = SHM_V, NA_OFF_RPB = 65536, NA_OFF_WS = 65536 + 2048, NA_TOTAL = NA_OFF_WS + 8 * 256;
__device__ __forceinline__ int clampi(int v, int lo, int hi) { return v < lo ? lo : (v > hi ? hi : v); }
__device__ __forceinline__ void na_unit(const bf16* __restrict__ Qb, int ldq, const bf16* __restrict__ Kseq, const bf16* __restrict__ Vseq, int ldk,
                                        bf16* __restrict__ Ob, int ldo, int r0, const float* __restrict__ rpb_h, LAS char* lds, int wid) {
    constexpr int KP = 256;
    const int lane = lane_id_fresh(), tid = wid * 64 + lane, r32 = lane & 31, hi = lane >> 5;
    LAS char* V_lds = lds; LAS char* K_lds = lds + NA_OFF_K; LAS float* rpb_l = (LAS float*)(lds + NA_OFF_RPB);
    LAS float* ws = (LAS float*)(lds + NA_OFF_WS) + wid * 64; LAS float* li_l = ws; LAS float* al_l = ws + 32;
    float m_reg = -1e30f, l_reg = 0; f32x16 o[4] = {}; bf16x8 qr[8];
    { const unsigned qo = (unsigned)(wid * 32 + r32) * (unsigned)ldq + hi * 8;
#pragma unroll
      for (int d0 = 0; d0 < 8; ++d0) qr[d0] = *(const bf16x8*)(Qb + qo + d0 * 16); }
    const int sr = tid >> 4, sc = (tid & 15) * 8, vst0 = v_st(sr, sc), vst1 = v_st(32 + sr, sc);
    const int kst0 = KSWZ(KP, sr, sc * 2), kst1 = KSWZ(KP, 32 + sr, sc * 2);
    const unsigned ko = (unsigned)sr * (unsigned)ldk + sc;
    const int vb0 = (int)(unsigned)(uintptr_t)V_lds + v_rd_base(lane);
    const int kr_lo = clampi(r0 - 4, 0, 56), kr_hi = clampi(r0 + 3 - 4, 0, 56) + 8;
    const int qrw = r0 + (wid >> 1), srw = clampi(qrw - 4, 0, 56);
    const int qc = (wid & 1) * 32 + r32, scq = clampi(qc - 8, 0, 48);
    __syncthreads();
    if (tid < 465) rpb_l[tid] = rpb_h[tid] * 11.313708498984761f;
    bf16x8 va0, va1, ka0, ka1, vb0_, vb1_, kb0, kb1;
#define NA_LOAD(V0, V1, K0, K1, kr_) do { const bf16* Kt = Kseq + (size_t)((kr_) * 64) * ldk; const bf16* Vt = Vseq + (size_t)((kr_) * 64) * ldk; \
      V0 = *(const bf16x8*)(Vt + ko); V1 = *(const bf16x8*)(Vt + (size_t)32 * ldk + ko); K0 = *(const bf16x8*)(Kt + ko); K1 = *(const bf16x8*)(Kt + (size_t)32 * ldk + ko); } while (0)
#define NA_STEP(V0, V1, K0, K1, kr_) do { \
        __syncthreads();                                            \
        *(LAS bf16x8*)(V_lds + vst0) = V0; *(LAS bf16x8*)(V_lds + vst1) = V1; *(LAS bf16x8*)(K_lds + kst0) = K0; *(LAS bf16x8*)(K_lds + kst1) = K1; \
        __syncthreads(); \
        if ((kr_) + 2 < kr_hi) NA_LOAD(V0, V1, K0, K1, (kr_) + 2);     \
        if ((kr_) >= srw && (kr_) < srw + 8) {                      \
            f32x16 p0, p1; float mn, al; bf16x8 pa0, pa1, pa2, pa3; \
            qkt<128>(p0, p1, K_lds, qr, nullptr, r32, hi); \
            const LAS float* bt = rpb_l + ((kr_) - qrw + 7) * 31 + (15 - qc); \
            _Pragma("unroll") for (int r = 0; r < 16; ++r) { const int kc = crow(r, hi); const bool in = (kc >= scq) && (kc < scq + 16); const float b = bt[in ? kc : qc]; p0[r] = in ? p0[r] + b : -1e30f; } \
            _Pragma("unroll") for (int r = 0; r < 16; ++r) { const int kc = 32 + crow(r, hi); const bool in = (kc >= scq) && (kc < scq + 16); const float b = bt[in ? kc : qc]; p1[r] = in ? p1[r] + b : -1e30f; } \
            partialSM<128>(p0, p1, m_reg, mn, al); \
            RESC(al); \
            finishSM(p0, p1, al, l_reg, pa0, pa1, pa2, pa3); SBAR(); \
            pv_d0(o, vb0, pa0, pa1, pa2, pa3); \
        } } while (0)
    NA_LOAD(va0, va1, ka0, ka1, kr_lo);
    if (kr_lo + 1 < kr_hi) NA_LOAD(vb0_, vb1_, kb0, kb1, kr_lo + 1);
    for (int kr = kr_lo; kr < kr_hi; kr += 2) {
        NA_STEP(va0, va1, ka0, ka1, kr);
        if (kr + 1 < kr_hi) NA_STEP(vb0_, vb1_, kb0, kb1, kr + 1);
    }
#undef NA_LOAD
#undef NA_STEP
    __syncthreads();
    store_o(o, l_reg, li_l, lds, Ob, ldo, wid, lane, r32, hi);
}
template <int D0> __device__ __forceinline__ void na2_pv(f32x16& od, int vbA, int vbB, bf16x8 pa0, bf16x8 pa1) {
    const s16x4 l0 = tr_read<v_rd_off(D0, 0, 0)>(vbA), h0 = tr_read<v_rd_off(D0, 0, 1)>(vbA), l1 = tr_read<v_rd_off(D0, 0, 0)>(vbB), h1 = tr_read<v_rd_off(D0, 0, 1)>(vbB);
    asm volatile("s_waitcnt lgkmcnt(0)" ::: "memory"); SBAR();
    od = __builtin_amdgcn_mfma_f32_32x32x16_bf16(pa0, (bf16x8){l0[0], l0[1], l0[2], l0[3], h0[0], h0[1], h0[2], h0[3]}, od, 0, 0, 0);
    od = __builtin_amdgcn_mfma_f32_32x32x16_bf16(pa1, (bf16x8){l1[0], l1[1], l1[2], l1[3], h1[0], h1[1], h1[2], h1[3]}, od, 0, 0, 0);
}
__device__ __forceinline__ void na_unit2(const bf16* __restrict__ Qb, int ldq, const bf16* __restrict__ Kseq, const bf16* __restrict__ Vseq, int ldk,
                                         bf16* __restrict__ Ob, int ldo, int r0, const float* __restrict__ rpb_h, LAS char* lds, int wid) {
    constexpr int KP = 256; constexpr float NEG = -3.0e38f;
    const int lane = lane_id_fresh(), tid = wid * 64 + lane, r32 = lane & 31, hi = lane >> 5;
    LAS char* V_lds = lds; LAS char* K_lds = lds + NA_OFF_K; LAS float* rpb_l = (LAS float*)(lds + NA_OFF_RPB);
    LAS float* ws = (LAS float*)(lds + NA_OFF_WS) + wid * 64; LAS float* li_l = ws; LAS float* al_l = ws + 32;
    float m_reg = -1e30f, l_reg = 0; f32x16 o[4] = {}; bf16x8 qr[8];
    const int typ = wid & 3, rp = wid >> 2, c15 = r32 & 15;
    const int g0 = (typ == 3) ? 0 : typ, g1 = (typ == 3) ? 3 : typ + 1;
    const int qc = (typ == 3) ? (c15 < 8 ? c15 : 48 + c15) : 8 + 16 * typ + c15;
    const int qrl = 2 * rp + (r32 >> 4), qrow = r0 + qrl;
    { const unsigned qo = (unsigned)(qrl * 64 + qc) * (unsigned)ldq + hi * 8;
#pragma unroll
      for (int d0 = 0; d0 < 8; ++d0) qr[d0] = *(const bf16x8*)(Qb + qo + d0 * 16); }
    const int sr = tid >> 4, sc = (tid & 15) * 8, vst0 = v_st(sr, sc), vst1 = v_st(32 + sr, sc);
    const int kst0 = KSWZ(KP, sr, sc * 2), kst1 = KSWZ(KP, 32 + sr, sc * 2);
    const unsigned ko = (unsigned)sr * (unsigned)ldk + sc;
    const int vbA = (int)(unsigned)(uintptr_t)V_lds + v_rd_base(lane) + g0 * 4096, vbB = (int)(unsigned)(uintptr_t)V_lds + v_rd_base(lane) + g1 * 4096;
    const int krow = 16 * (r32 < 16 ? g0 : g1) + c15;
    const LAS char* Kl = K_lds + krow * KP;
    const int kr_lo = clampi(r0 - 4, 0, 56), kr_hi = clampi(r0 + 3 - 4, 0, 56) + 8;
    const int s_lo = clampi(r0 + 2 * rp - 4, 0, 56), s_hi = clampi(r0 + 2 * rp + 1 - 4, 0, 56) + 8;
    const int srq = clampi(qrow - 4, 0, 56), scq = clampi(qc - 8, 0, 48);
    __syncthreads();
    if (tid < 465) rpb_l[tid] = rpb_h[tid] * 11.313708498984761f;
    bf16x8 va0, va1, ka0, ka1, vb0_, vb1_, kb0, kb1;
#define NA_LOAD(V0, V1, K0, K1, kr_) do { const bf16* Kt = Kseq + (size_t)((kr_) * 64) * ldk; const bf16* Vt = Vseq + (size_t)((kr_) * 64) * ldk; \
      V0 = *(const bf16x8*)(Vt + ko); V1 = *(const bf16x8*)(Vt + (size_t)32 * ldk + ko); K0 = *(const bf16x8*)(Kt + ko); K1 = *(const bf16x8*)(Kt + (size_t)32 * ldk + ko); } while (0)
#define NA_STEP(V0, V1, K0, K1, kr_) do { \
        __syncthreads();                                            \
        *(LAS bf16x8*)(V_lds + vst0) = V0; *(LAS bf16x8*)(V_lds + vst1) = V1; *(LAS bf16x8*)(K_lds + kst0) = K0; *(LAS bf16x8*)(K_lds + kst1) = K1; \
        __syncthreads(); \
        if ((kr_) + 2 < kr_hi) NA_LOAD(V0, V1, K0, K1, (kr_) + 2);     \
        if ((kr_) >= s_lo && (kr_) < s_hi) {                        \
            f32x16 p = {}; \
            _Pragma("unroll") for (int d0 = 0; d0 < 8; ++d0) { const int cb = (d0 * 16 + hi * 8) * 2; \
                const bf16x8 kf = *(const LAS bf16x8*)(Kl + (cb ^ (c15 << 4))); p = __builtin_amdgcn_mfma_f32_32x32x16_bf16(kf, qr[d0], p, 0, 0, 0); } \
            const bool rowin = ((kr_) >= srq) && ((kr_) < srq + 8); \
            const LAS float* bt = rpb_l + clampi((kr_) - qrow + 7, 0, 14) * 31 + (15 - qc); \
            _Pragma("unroll") for (int r = 0; r < 16; ++r) { const int kc = 16 * (r < 8 ? g0 : g1) + (r & 3) + 8 * ((r >> 2) & 1) + 4 * hi; \
                const bool in = rowin && (kc >= scq) && (kc < scq + 16); const float b = bt[in ? kc : qc]; p[r] = in ? p[r] + b : NEG; } \
              \
            float pmax = p[0]; _Pragma("unroll") for (int r = 1; r < 16; ++r) pmax = fmaxf(pmax, p[r]); \
            { auto rr = __builtin_amdgcn_permlane32_swap(__float_as_uint(pmax), __float_as_uint(pmax), false, false); pmax = fmaxf(__uint_as_float(rr[0]), __uint_as_float(rr[1])); } \
            float mn, al; \
            if (__builtin_expect(__all(pmax - m_reg <= THR / Cfg<128>::SCALE), 1)) { mn = m_reg; al = 1.f; } \
            else { mn = fmaxf(m_reg, pmax); al = __builtin_amdgcn_exp2f((m_reg - mn) * Cfg<128>::C); m_reg = mn; } \
            const float mnC = -mn * Cfg<128>::C; float ps = 0; \
            _Pragma("unroll") for (int r = 0; r < 16; ++r) { p[r] = __builtin_amdgcn_exp2f(fmaf(p[r], Cfg<128>::C, mnC)); ps += p[r]; } \
            { auto rr = __builtin_amdgcn_permlane32_swap(__float_as_uint(ps), __float_as_uint(ps), false, false); ps = __uint_as_float(rr[0]) + __uint_as_float(rr[1]); } \
            RESC(al); \
            l_reg = l_reg * al + ps; \
            bf16x8 pa0, pa1; \
            { unsigned a0 = cvt_pk_bf16(p[0], p[1]), a1 = cvt_pk_bf16(p[2], p[3]), b0 = cvt_pk_bf16(p[4], p[5]), b1 = cvt_pk_bf16(p[6], p[7]); \
              auto x0 = __builtin_amdgcn_permlane32_swap(a0, b0, false, false); auto x1 = __builtin_amdgcn_permlane32_swap(a1, b1, false, false); \
              u32x4 w = {x0[0], x1[0], x0[1], x1[1]}; pa0 = __builtin_bit_cast(bf16x8, w); } \
            { unsigned a0 = cvt_pk_bf16(p[8], p[9]), a1 = cvt_pk_bf16(p[10], p[11]), b0 = cvt_pk_bf16(p[12], p[13]), b1 = cvt_pk_bf16(p[14], p[15]); \
              auto x0 = __builtin_amdgcn_permlane32_swap(a0, b0, false, false); auto x1 = __builtin_amdgcn_permlane32_swap(a1, b1, false, false); \
              u32x4 w = {x0[0], x1[0], x0[1], x1[1]}; pa1 = __builtin_bit_cast(bf16x8, w); } \
            SBAR(); \
            na2_pv<0>(o[0], vbA, vbB, pa0, pa1); na2_pv<1>(o[1], vbA, vbB, pa0, pa1); na2_pv<2>(o[2], vbA, vbB, pa0, pa1); na2_pv<3>(o[3], vbA, vbB, pa0, pa1); \
        } } while (0)
    NA_LOAD(va0, va1, ka0, ka1, kr_lo);
    if (kr_lo + 1 < kr_hi) NA_LOAD(vb0_, vb1_, kb0, kb1, kr_lo + 1);
    for (int kr = kr_lo; kr < kr_hi; kr += 2) {
        NA_STEP(va0, va1, ka0, ka1, kr);
        if (kr + 1 < kr_hi) NA_STEP(vb0_, vb1_, kb0, kb1, kr + 1);
    }
#undef NA_LOAD
#undef NA_STEP
    __syncthreads();
    if (hi == 0) li_l[r32] = l_reg;
    asm volatile("s_waitcnt lgkmcnt(0)" ::: "memory");
    float rli[16];
#pragma unroll
    for (int r = 0; r < 16; ++r) rli[r] = __builtin_amdgcn_rcpf(li_l[crow(r, hi)]);
    LAS unsigned short* slab = (LAS unsigned short*)(lds + wid * 8192);
#pragma unroll
    for (int r = 0; r < 16; ++r) { const int orow = crow(r, hi);
#pragma unroll
        for (int d0 = 0; d0 < 4; ++d0) slab[orow * 128 + d0 * 32 + r32] = (unsigned short)(cvt_pk_bf16(o[d0][r] * rli[r], 0.f) & 0xffffu); }
    asm volatile("s_waitcnt lgkmcnt(0)" ::: "memory");
#pragma unroll
    for (int i = 0; i < 8; ++i) { const int id = i * 64 + lane, q = id >> 4, c16 = id & 15, q15 = q & 15;
        const int col = (typ == 3) ? (q15 < 8 ? q15 : 48 + q15) : 8 + 16 * typ + q15;
        const u32x4 w = *(const LAS u32x4*)((LAS char*)slab + q * 256 + c16 * 16);
        *(u32x4*)(Ob + (unsigned)((2 * rp + (q >> 4)) * 64 + col) * (unsigned)ldo + c16 * 8) = w; }
}
#undef RESC
}

constexpr size_t MiB = 1u << 20;
constexpr size_t WS_CTL = 0, CTL_ZERO_BYTES = 1 * MiB;
constexpr size_t WS_TAB_MLA = 5 * MiB;
constexpr size_t WS_TAB_1D = 6 * MiB;
constexpr size_t WS_MN = 8 * MiB;
constexpr size_t WS_MKV = 20 * MiB;
constexpr size_t WS_WB = 32 * MiB;
constexpr size_t WB_IN = 0, WB_QB = 24 * MiB, WB_KVB = 26 * MiB, WB_OUT = 28 * MiB, WB_XQ = 36 * MiB, WB_XKV = 38 * MiB, WB_XO = 42 * MiB, WB_UP = 44 * MiB, WB_DOWN = 76 * MiB;
constexpr size_t WS_H = 144 * MiB;
constexpr size_t WS_BIG = 336 * MiB;
constexpr size_t BIG_PROJ = 0, BIG_Q = 264 * MiB, BIG_KV = 408 * MiB;
constexpr size_t BIG_SPLIT = 96 * MiB;
constexpr size_t BIG_XQ = 0, BIG_XO = 48 * MiB;
constexpr size_t BIG_U = 0;
constexpr size_t BIG_XBA = 400 * MiB;
constexpr size_t WS_PS = WS_BIG + 600 * MiB;
constexpr size_t PS_BYTES = (size_t)T * 32 * 4, PSC_BYTES = (size_t)T * 8 * 4;
constexpr size_t WS_END = WS_PS + 3 * PS_BYTES + 2 * PSC_BYTES;
constexpr int CW_BAR = 4096;
constexpr int SKEW_TICKS = 0;

constexpr int RING_BYTES = 135168, MISC_OFF = RING_BYTES + 320, PTR_OFF = RING_BYTES + 1024, LDS_BYTES = 147456;
static_assert(pg8::RS_LDS_OFF == RING_BYTES + 2048 && pg8::RS_LDS_OFF + 2048 <= LDS_BYTES && PTR_OFF + 29 * 8 <= pg8::RS_LDS_OFF, "row-scale staging area");
static_assert(att::DV_TOTAL <= RING_BYTES && att::Cfg<192>::TOTAL <= RING_BYTES && att::NA_TOTAL <= RING_BYTES && pg8::STAGE_BYTES <= RING_BYTES, "LDS map");

#define XB_TMO      128
#define XB_XCNT(j)  (256  + 64 * (j))
#define XB_XSUB(j)  (1280 + 64 * (j))
#define XB_XGEN(j)  (2304 + 64 * (j))
#define XB_TOP      3328
#define XB_TOPGEN   3392
#define XCD_BAR_WORDS 3456
#define XB_SPIN_CAP (1u << 18)
__device__ __forceinline__ unsigned xb_ld(unsigned* p)              { return __hip_atomic_load(p, __ATOMIC_RELAXED, __HIP_MEMORY_SCOPE_AGENT); }
__device__ __forceinline__ unsigned xb_add(unsigned* p, unsigned v) { return __hip_atomic_fetch_add(p, v, __ATOMIC_RELAXED, __HIP_MEMORY_SCOPE_AGENT); }
__device__ __forceinline__ unsigned xb_xcc_id() { return (unsigned)__builtin_amdgcn_s_getreg((3 << 11) | 20) & 0xFu; }
#define XB_SPIN(cond, bar) do { unsigned _sp = 0; while (cond) { __builtin_amdgcn_s_sleep(1); \
    if ((++_sp & 255u) == 0u) { if (xb_ld(&(bar)[XB_TMO])) break; if (_sp > XB_SPIN_CAP) { atomicAdd(&(bar)[XB_TMO], 1u); break; } } } } while (0)
struct XcdBarrier { unsigned* bar; unsigned x; volatile LAS unsigned* st; };
__device__ __forceinline__ XcdBarrier xcd_barrier_post(unsigned* bar, volatile LAS unsigned* st, int wave) {
    XcdBarrier b; b.bar = bar; b.x = xb_xcc_id(); b.st = st;
    if (wave == 0 && lane_id_fresh() == 0) (void)xb_add(&bar[XB_XCNT(b.x)], 1u);
    return b;
}
__device__ __forceinline__ void xcd_barrier_complete(unsigned* bar, unsigned x, unsigned& nloc, unsigned& nx) {
    const unsigned G = gridDim.x * gridDim.y * gridDim.z;
    unsigned sum, cnt, mine, sp = 0u;
    for (;;) {
        sum = 0u; cnt = 0u; mine = 0u;
#pragma unroll
        for (unsigned j = 0; j < 16; ++j) { const unsigned c = xb_ld(&bar[XB_XCNT(j)]); sum += c; cnt += (c > 0u) ? 1u : 0u; mine = (j == x) ? c : mine; }
        if (sum == G) break;
        __builtin_amdgcn_s_sleep(1);
        if ((++sp & 255u) == 0u) { if (xb_ld(&bar[XB_TMO])) break; if (sp > XB_SPIN_CAP) { atomicAdd(&bar[XB_TMO], 1u); break; } }
    }
    nloc = mine > 0u ? mine : 1u; nx = cnt > 0u ? cnt : 1u;
}
__device__ __forceinline__ void xcd_barrier(const XcdBarrier& b, int wave) {
    asm volatile("s_waitcnt vmcnt(0)" ::: "memory");
    __syncthreads();
    if (wave == 0 && lane_id_fresh() == 0) {
        unsigned long long bar_i = (unsigned long long)(uintptr_t)b.bar; asm volatile("" : "+s"(bar_i));
        unsigned* bar = (unsigned*)(GAS unsigned*)(uintptr_t)bar_i;
        __builtin_amdgcn_s_waitcnt(0);
        unsigned nloc = b.st[0], nx = b.st[1];
        if (nloc == 0u) { xcd_barrier_complete(bar, b.x, nloc, nx); b.st[0] = nloc; b.st[1] = nx; }
        const unsigned old = xb_add(&bar[XB_XSUB(b.x)], 1u);
        const unsigned gen = old / nloc;
        if (old + 1u == (gen + 1u) * nloc) {
            __builtin_amdgcn_fence(__ATOMIC_RELEASE, "agent");
            asm volatile("s_waitcnt vmcnt(0)" ::: "memory");
            const unsigned og = xb_add(&bar[XB_TOP], 1u);
            const unsigned tg = og / nx;
            if (og + 1u == (tg + 1u) * nx) xb_add(&bar[XB_TOPGEN], 1u);
            else XB_SPIN(xb_ld(&bar[XB_TOPGEN]) == tg, bar);
            __builtin_amdgcn_fence(__ATOMIC_ACQUIRE, "agent");
            xb_add(&bar[XB_XGEN(b.x)], 1u);
            asm volatile("s_waitcnt vmcnt(0)" ::: "memory");
        } else {
            XB_SPIN(xb_ld(&bar[XB_XGEN(b.x)]) == gen, bar);
            __builtin_amdgcn_fence(__ATOMIC_ACQUIRE, "agent");
            asm volatile("s_waitcnt vmcnt(0)" ::: "memory");
        }
    }
    __syncthreads();
}

#define LDS_WAIT() asm volatile("s_waitcnt lgkmcnt(0)" ::: "memory")
constexpr int TR_PITCH = 65, TR_BYTES = 64 * TR_PITCH * 4;
static_assert(8 * TR_BYTES <= RING_BYTES, "transpose scratch");
__device__ __forceinline__ void transpose_item(const float* W, int K, int N, bf16* WT, const float* gain, LAS float* scr, int item, int lane) {
    const int nblk = N / 64, kb = item / nblk, nb = item % nblk, k0 = 64 * kb, n0 = 64 * nb;
    const int lr = lane >> 4, lc = (lane & 15) * 4;
#pragma unroll
    for (int h = 0; h < 2; ++h) {
        f32x4 v[8];
#pragma unroll
        for (int i = 0; i < 8; ++i) v[i] = *(const f32x4*)(W + (size_t)(k0 + 32 * h + 4 * i + lr) * N + n0 + lc);
#pragma unroll
        for (int i = 0; i < 8; ++i) { const int kk = 32 * h + 4 * i + lr; const float gk = gain ? gain[k0 + kk] : 1.f; LAS float* d = scr + kk * TR_PITCH + lc;
            d[0] = v[i].x * gk; d[1] = v[i].y * gk; d[2] = v[i].z * gk; d[3] = v[i].w * gk; }
    }
    LDS_WAIT(); asm volatile("" ::: "memory");
    const int c = lane & 7;
#pragma unroll
    for (int j = 0; j < 8; ++j) { const int n = (lane >> 3) + 8 * j; const LAS float* s = scr + (8 * c) * TR_PITCH + n;
        u32x4 o; o.x = cvt_pk_bf16(s[0 * TR_PITCH], s[1 * TR_PITCH]); o.y = cvt_pk_bf16(s[2 * TR_PITCH], s[3 * TR_PITCH]); o.z = cvt_pk_bf16(s[4 * TR_PITCH], s[5 * TR_PITCH]); o.w = cvt_pk_bf16(s[6 * TR_PITCH], s[7 * TR_PITCH]);
        *(u32x4*)(WT + (size_t)(n0 + n) * K + k0 + 8 * c) = o; }
    LDS_WAIT(); asm volatile("" ::: "memory");
}
__device__ __forceinline__ void convert_matrix(const float* W, int K, int N, bf16* WT, const float* gain, LAS float* scr, int gw, int NGW, int lane) {
    const int nitems = (K / 64) * (N / 64);
    for (int it = gw; it < nitems; it += NGW) transpose_item(W, K, N, WT, gain, scr, it, lane);
}
__device__ __forceinline__ void init_row_2048(const float* xrow, bf16* xh, float* ssp, int lane) {
    const f32x4* xr = (const f32x4*)xrow + lane;
    u32x2 w[8]; float s = 0.f;
#pragma unroll
    for (int j = 0; j < 8; ++j) { const f32x4 v = xr[64 * j]; w[j].x = cvt_pk_bf16(v.x, v.y); w[j].y = cvt_pk_bf16(v.z, v.w);
        const float y0 = bflo(w[j].x), y1 = bfhi(w[j].x), y2 = bflo(w[j].y), y3 = bfhi(w[j].y); s += (y0 * y0 + y1 * y1) + (y2 * y2 + y3 * y3); }
    s = wave_sum(s);
    u32x2* oh = (u32x2*)xh + lane;
#pragma unroll
    for (int j = 0; j < 8; ++j) oh[64 * j] = w[j];
    if (lane < 32) ssp[lane] = (lane == 0) ? s : 0.f;
}
__device__ __forceinline__ void init_rows2_2048(const float* xrow0, const float* xrow1, bf16* xh0, bf16* xh1, float* ssp0, float* ssp1, int lane) {
    f32x4 v0[8], v1[8];
#pragma unroll
    for (int j = 0; j < 8; ++j) { v0[j] = ((const f32x4*)xrow0 + lane)[64 * j]; v1[j] = ((const f32x4*)xrow1 + lane)[64 * j]; }
#pragma unroll
    for (int i = 0; i < 2; ++i) { u32x2 w[8]; float s = 0.f;
#pragma unroll
        for (int j = 0; j < 8; ++j) { const f32x4 v = i ? v1[j] : v0[j]; w[j].x = cvt_pk_bf16(v.x, v.y); w[j].y = cvt_pk_bf16(v.z, v.w);
            const float y0 = bflo(w[j].x), y1 = bfhi(w[j].x), y2 = bflo(w[j].y), y3 = bfhi(w[j].y); s += (y0 * y0 + y1 * y1) + (y2 * y2 + y3 * y3); }
        s = wave_sum(s);
        u32x2* oh = (u32x2*)(i ? xh1 : xh0) + lane;
#pragma unroll
        for (int j = 0; j < 8; ++j) oh[64 * j] = w[j];
        if (lane < 32) (i ? ssp1 : ssp0)[lane] = (lane == 0) ? s : 0.f; }
}
__device__ __forceinline__ void norm_row_2048(const float* xrow, const float* g, bf16* orow, float* copy, int lane) {
    const f32x4* xr = (const f32x4*)xrow + lane;
    f32x4 v[8]; float s = 0.f;
#pragma unroll
    for (int j = 0; j < 8; ++j) { v[j] = xr[64 * j]; s += (v[j].x * v[j].x + v[j].y * v[j].y) + (v[j].z * v[j].z + v[j].w * v[j].w); }
    const float rstd = 1.f / sqrtf(wave_sum(s) * (1.f / 2048.f) + EPS);
    if (copy) {
#pragma unroll
        for (int j = 0; j < 8; ++j) ((f32x4*)copy + lane)[64 * j] = v[j]; }
    u32x2* o8 = (u32x2*)orow + lane;
#pragma unroll
    for (int j = 0; j < 8; ++j) { const f32x4 gg = ((const f32x4*)g + lane)[64 * j]; u32x2 w; w.x = cvt_pk_bf16(v[j].x * rstd * gg.x, v[j].y * rstd * gg.y); w.y = cvt_pk_bf16(v[j].z * rstd * gg.z, v[j].w * rstd * gg.w); o8[64 * j] = w; }
}
__device__ __forceinline__ void final_norm_row(const bf16* xh, float* orow, const float* g, float ss, int lane) {
    const float rstd = 1.f / sqrtf(ss * (1.f / 2048.f) + EPS);
    const u32x2* ph = (const u32x2*)xh + lane; f32x4* po = (f32x4*)orow + lane;
#pragma unroll
    for (int j = 0; j < 8; ++j) { const u32x2 h = ph[64 * j]; const f32x4 gg = ((const f32x4*)g + lane)[64 * j];
        f32x4 o; o.x = bflo(h.x) * rstd * gg.x; o.y = bfhi(h.x) * rstd * gg.y; o.z = bflo(h.y) * rstd * gg.z; o.w = bfhi(h.y) * rstd * gg.w;
        po[64 * j] = o; }
}
template <int R>
__device__ __forceinline__ void final_norm_rows(const bf16* xh, float* out, const f32x4 (&gg)[8], const float* ssf, int m0, int mstep, int lane) {
    u32x2 h[R][8]; float ssv[R];
#pragma unroll
    for (int i = 0; i < R; ++i) { const size_t m = (size_t)(m0 + i * mstep); const u32x2* ph = (const u32x2*)(xh + m * DM) + lane;
        ssv[i] = lane < 32 ? ssf[m * 32 + lane] : 0.f;
#pragma unroll
        for (int j = 0; j < 8; ++j) h[i][j] = ph[64 * j]; }
#pragma unroll
    for (int i = 0; i < R; ++i) { const size_t m = (size_t)(m0 + i * mstep); f32x4* po = (f32x4*)(out + m * DM) + lane;
        const float rstd = 1.f / sqrtf(wave_sum(ssv[i]) * (1.f / 2048.f) + EPS);
#pragma unroll
        for (int j = 0; j < 8; ++j) { f32x4 o; o.x = bflo(h[i][j].x) * rstd * gg[j].x; o.y = bfhi(h[i][j].x) * rstd * gg[j].y; o.z = bflo(h[i][j].y) * rstd * gg[j].z; o.w = bfhi(h[i][j].y) * rstd * gg[j].w;
            po[64 * j] = o; } }
}
__device__ __forceinline__ void even_row_fix(bf16* row, int pos, const float* qn, const float* kvn, const float* gqn, const float* gkn, const float* tab_mla, int lane) {
    const float* cosm = tab_mla; const float* sinm = tab_mla + 4096 * 32;
#pragma unroll
    for (int part = 0; part < 2; ++part) {
        u32x4* p = (u32x4*)(row + part * 512) + lane; const u32x4 w = *p; const float* g = (part ? kvn : qn) + lane * 8;
        float x[8] = {bflo(w.x), bfhi(w.x), bflo(w.y), bfhi(w.y), bflo(w.z), bfhi(w.z), bflo(w.w), bfhi(w.w)};
        float s = 0.f;
#pragma unroll
        for (int e = 0; e < 8; ++e) s += x[e] * x[e];
        const float rstd = 1.f / sqrtf(wave_sum(s) * (1.f / 512.f) + EPS);
        const f32x4 g0 = *(const f32x4*)g, g1 = *(const f32x4*)(g + 4);
        u32x4 o; o.x = cvt_pk_bf16(x[0] * rstd * g0.x, x[1] * rstd * g0.y); o.y = cvt_pk_bf16(x[2] * rstd * g0.z, x[3] * rstd * g0.w);
        o.z = cvt_pk_bf16(x[4] * rstd * g1.x, x[5] * rstd * g1.y); o.w = cvt_pk_bf16(x[6] * rstd * g1.z, x[7] * rstd * g1.w);
        *p = o;
    }
    { bf16* p = row + 1024 + lane; const float x = bf2f(*p); const float y = other_half(x, lane < 32); const int f = lane & 31;
      const float c = cosm[pos * 32 + f], s = sinm[pos * 32 + f];
      const float r = (lane < 32) ? (x * c - y * s) : (x * c + y * s);
      *p = (bf16)(cvt_pk_bf16(r, 0.f) & 0xffffu); }
    const int prow = pos >> 6, pcol = pos & 63;
    const int e0 = 2 * lane, f0 = e0 & 31; const int tp = (e0 < 64) ? prow : pcol;
    const float c0 = cosm[tp * 32 + f0], s0 = sinm[tp * 32 + f0], c1 = cosm[tp * 32 + f0 + 1], s1 = sinm[tp * 32 + f0 + 1];
    const bool first = ((e0 & 32) == 0);
#pragma unroll 2
    for (int h = 0; h < 10; ++h) {
        unsigned* p = (unsigned*)(row + (h < 8 ? 1088 + h * 128 : 2112 + (h - 8) * 128)) + lane; const unsigned w = *p; const float* g = (h < 8 ? gqn : gkn) + e0;
        float x0 = bflo(w), x1 = bfhi(w);
        const float rstd = 1.f / sqrtf(wave_sum(x0 * x0 + x1 * x1) * (1.f / 128.f) + EPS);
        x0 = x0 * rstd * g[0]; x1 = x1 * rstd * g[1];
        const float y0 = swz_xor<16>(x0), y1 = swz_xor<16>(x1);
        const float r0 = first ? (x0 * c0 - y0 * s0) : (x0 * c0 + y0 * s0);
        const float r1 = first ? (x1 * c1 - y1 * s1) : (x1 * c1 + y1 * s1);
        *p = cvt_pk_bf16(r0, r1);
    }
}
__device__ __forceinline__ void even_row_fix_k(bf16* row, int pos, const float* gkn, const float* tab_mla, int lane) {
    const float* cosm = tab_mla; const float* sinm = tab_mla + 4096 * 32;
    { bf16* p = row + 1024 + lane; const float x = bf2f(*p); const float y = other_half(x, lane < 32); const int f = lane & 31;
      const float c = cosm[pos * 32 + f], s = sinm[pos * 32 + f];
      const float r = (lane < 32) ? (x * c - y * s) : (x * c + y * s);
      *p = (bf16)(cvt_pk_bf16(r, 0.f) & 0xffffu); }
    const int prow = pos >> 6, pcol = pos & 63;
    const int e0 = 2 * lane, f0 = e0 & 31; const int tp = (e0 < 64) ? prow : pcol;
    const float c0 = cosm[tp * 32 + f0], s0 = sinm[tp * 32 + f0], c1 = cosm[tp * 32 + f0 + 1], s1 = sinm[tp * 32 + f0 + 1];
    const bool first = ((e0 & 32) == 0);
#pragma unroll
    for (int h = 0; h < 2; ++h) {
        unsigned* p = (unsigned*)(row + 2112 + h * 128) + lane; const unsigned w = *p; const float* g = gkn + e0;
        float x0 = bflo(w), x1 = bfhi(w);
        const float rstd = 1.f / sqrtf(wave_sum(x0 * x0 + x1 * x1) * (1.f / 128.f) + EPS);
        x0 = x0 * rstd * g[0]; x1 = x1 * rstd * g[1];
        const float y0 = swz_xor<16>(x0), y1 = swz_xor<16>(x1);
        const float r0 = first ? (x0 * c0 - y0 * s0) : (x0 * c0 + y0 * s0);
        const float r1 = first ? (x1 * c1 - y1 * s1) : (x1 * c1 + y1 * s1);
        *p = cvt_pk_bf16(r0, r1);
    }
}
template <int R>
__device__ __forceinline__ void even_rows_fix_k(bf16* proj, int m0, int mstep, const float* gkn, const float* tab_mla, int lane) {
    const float* cosm = tab_mla; const float* sinm = tab_mla + 4096 * 32;
    const int f = lane & 31, e0 = 2 * lane, f0 = e0 & 31; const bool first = ((e0 & 32) == 0);
    const float g0 = gkn[e0], g1 = gkn[e0 + 1];
    unsigned short kx[R]; unsigned w0[R], w1[R]; float kc[R], ks[R], c0[R], s0[R], c1[R], s1[R];
#pragma unroll
    for (int i = 0; i < R; ++i) { const int m = m0 + i * mstep, pos = m & (SEQ - 1); bf16* row = proj + (size_t)m * AB_PAD;
        kx[i] = *(row + 1024 + lane); kc[i] = cosm[pos * 32 + f]; ks[i] = sinm[pos * 32 + f];
        const int tp = (e0 < 64) ? (pos >> 6) : (pos & 63);
        c0[i] = cosm[tp * 32 + f0]; s0[i] = sinm[tp * 32 + f0]; c1[i] = cosm[tp * 32 + f0 + 1]; s1[i] = sinm[tp * 32 + f0 + 1];
        w0[i] = *((const unsigned*)(row + 2112) + lane); w1[i] = *((const unsigned*)(row + 2112 + 128) + lane); }
#pragma unroll
    for (int i = 0; i < R; ++i) { const int m = m0 + i * mstep; bf16* row = proj + (size_t)m * AB_PAD;
        { const float x = bf2f(kx[i]); const float y = other_half(x, lane < 32);
          const float r = (lane < 32) ? (x * kc[i] - y * ks[i]) : (x * kc[i] + y * ks[i]);
          *(row + 1024 + lane) = (bf16)(cvt_pk_bf16(r, 0.f) & 0xffffu); }
#pragma unroll
        for (int h = 0; h < 2; ++h) { const unsigned w = h ? w1[i] : w0[i];
            float x0 = bflo(w), x1 = bfhi(w);
            const float rstd = 1.f / sqrtf(wave_sum(x0 * x0 + x1 * x1) * (1.f / 128.f) + EPS);
            x0 = x0 * rstd * g0; x1 = x1 * rstd * g1;
            const float y0 = swz_xor<16>(x0), y1 = swz_xor<16>(x1);
            const float r0 = first ? (x0 * c0[i] - y0 * s0[i]) : (x0 * c0[i] + y0 * s0[i]);
            const float r1 = first ? (x1 * c1[i] - y1 * s1[i]) : (x1 * c1[i] + y1 * s1[i]);
            *((unsigned*)(row + 2112 + h * 128) + lane) = cvt_pk_bf16(r0, r1); } }
}
__device__ __forceinline__ void mla_q_rope_row(bf16* row, int pos, const float* tab_mla, int lane) {
    const int h = lane >> 3, s4 = (lane & 7) * 4;
    u32x2* p1 = (u32x2*)(row + h * 192 + 128 + s4); u32x2* p2 = (u32x2*)(row + h * 192 + 160 + s4);
    const u32x2 w1 = *p1, w2 = *p2;
    const f32x4 c = *(const f32x4*)(tab_mla + pos * 32 + s4), s = *(const f32x4*)(tab_mla + 4096 * 32 + pos * 32 + s4);
    const float x1[4] = {bflo(w1.x), bfhi(w1.x), bflo(w1.y), bfhi(w1.y)}, x2[4] = {bflo(w2.x), bfhi(w2.x), bflo(w2.y), bfhi(w2.y)};
    float a[4], b[4];
#pragma unroll
    for (int e = 0; e < 4; ++e) { a[e] = x1[e] * c[e] - x2[e] * s[e]; b[e] = x2[e] * c[e] + x1[e] * s[e]; }
    u32x2 o1, o2; o1.x = cvt_pk_bf16(a[0], a[1]); o1.y = cvt_pk_bf16(a[2], a[3]); o2.x = cvt_pk_bf16(b[0], b[1]); o2.y = cvt_pk_bf16(b[2], b[3]);
    *p1 = o1; *p2 = o2;
}
__device__ __forceinline__ void rope1d_row(bf16* row, int pos, const float* tab_1d, int lane) {
    const int h = lane >> 3, s8 = (lane & 7) * 8;
    u32x4* p1 = (u32x4*)(row + h * 128 + s8); u32x4* p2 = (u32x4*)(row + h * 128 + 64 + s8);
    const u32x4 w1 = *p1, w2 = *p2;
    const float* ct = tab_1d + pos * 64 + s8; const float* st = tab_1d + 4096 * 64 + pos * 64 + s8;
    const f32x4 c0 = *(const f32x4*)ct, c1 = *(const f32x4*)(ct + 4), s0 = *(const f32x4*)st, s1 = *(const f32x4*)(st + 4);
    const float c[8] = {c0.x, c0.y, c0.z, c0.w, c1.x, c1.y, c1.z, c1.w}, s[8] = {s0.x, s0.y, s0.z, s0.w, s1.x, s1.y, s1.z, s1.w};
    const float x1[8] = {bflo(w1.x), bfhi(w1.x), bflo(w1.y), bfhi(w1.y), bflo(w1.z), bfhi(w1.z), bflo(w1.w), bfhi(w1.w)};
    const float x2[8] = {bflo(w2.x), bfhi(w2.x), bflo(w2.y), bfhi(w2.y), bflo(w2.z), bfhi(w2.z), bflo(w2.w), bfhi(w2.w)};
    float a[8], b[8];
#pragma unroll
    for (int e = 0; e < 8; ++e) { a[e] = x1[e] * c[e] - x2[e] * s[e]; b[e] = x2[e] * c[e] + x1[e] * s[e]; }
    u32x4 o1, o2; o1.x = cvt_pk_bf16(a[0], a[1]); o1.y = cvt_pk_bf16(a[2], a[3]); o1.z = cvt_pk_bf16(a[4], a[5]); o1.w = cvt_pk_bf16(a[6], a[7]);
    o2.x = cvt_pk_bf16(b[0], b[1]); o2.y = cvt_pk_bf16(b[2], b[3]); o2.z = cvt_pk_bf16(b[4], b[5]); o2.w = cvt_pk_bf16(b[6], b[7]);
    *p1 = o1; *p2 = o2;
}
__device__ __forceinline__ void rope1d_rows4(bf16* base, size_t ld, int m0, int mstep, const float* tab_1d, int lane) {
    const int h = lane >> 3, s8 = (lane & 7) * 8;
    u32x4 w1[4], w2[4]; f32x4 c0[4], c1[4], s0[4], s1[4];
#pragma unroll
    for (int i = 0; i < 4; ++i) { const int m = m0 + i * mstep, pos = m & (SEQ - 1); bf16* row = base + (size_t)m * ld;
        w1[i] = *(const u32x4*)(row + h * 128 + s8); w2[i] = *(const u32x4*)(row + h * 128 + 64 + s8);
        const float* ct = tab_1d + pos * 64 + s8; const float* st = tab_1d + 4096 * 64 + pos * 64 + s8;
        c0[i] = *(const f32x4*)ct; c1[i] = *(const f32x4*)(ct + 4); s0[i] = *(const f32x4*)st; s1[i] = *(const f32x4*)(st + 4); }
#pragma unroll
    for (int i = 0; i < 4; ++i) { const int m = m0 + i * mstep; bf16* row = base + (size_t)m * ld;
        const float c[8] = {c0[i].x, c0[i].y, c0[i].z, c0[i].w, c1[i].x, c1[i].y, c1[i].z, c1[i].w}, s[8] = {s0[i].x, s0[i].y, s0[i].z, s0[i].w, s1[i].x, s1[i].y, s1[i].z, s1[i].w};
        const float x1[8] = {bflo(w1[i].x), bfhi(w1[i].x), bflo(w1[i].y), bfhi(w1[i].y), bflo(w1[i].z), bfhi(w1[i].z), bflo(w1[i].w), bfhi(w1[i].w)};
        const float x2[8] = {bflo(w2[i].x), bfhi(w2[i].x), bflo(w2[i].y), bfhi(w2[i].y), bflo(w2[i].z), bfhi(w2[i].z), bflo(w2[i].w), bfhi(w2[i].w)};
        float a[8], b[8];
#pragma unroll
        for (int e = 0; e < 8; ++e) { a[e] = x1[e] * c[e] - x2[e] * s[e]; b[e] = x2[e] * c[e] + x1[e] * s[e]; }
        u32x4 o1, o2; o1.x = cvt_pk_bf16(a[0], a[1]); o1.y = cvt_pk_bf16(a[2], a[3]); o1.z = cvt_pk_bf16(a[4], a[5]); o1.w = cvt_pk_bf16(a[6], a[7]);
        o2.x = cvt_pk_bf16(b[0], b[1]); o2.y = cvt_pk_bf16(b[2], b[3]); o2.z = cvt_pk_bf16(b[4], b[5]); o2.w = cvt_pk_bf16(b[6], b[7]);
        *(u32x4*)(row + h * 128 + s8) = o1; *(u32x4*)(row + h * 128 + 64 + s8) = o2; }
}
__device__ __forceinline__ void diff_combine_row(const bf16* oc, bf16* out, float lam, float post, const float* subln, int lane) {
    const f32x4 g = *(const f32x4*)(subln + lane * 4);
#pragma unroll
    for (int h = 0; h < 4; ++h) {
        const u32x2 w0 = *((const u32x2*)(oc + h * 512) + lane), w1 = *((const u32x2*)(oc + h * 512 + 256) + lane);
        float d[4] = {bflo(w0.x) - lam * bflo(w1.x), bfhi(w0.x) - lam * bfhi(w1.x), bflo(w0.y) - lam * bflo(w1.y), bfhi(w0.y) - lam * bfhi(w1.y)};
        const float rstd = 1.f / sqrtf(wave_sum((d[0] * d[0] + d[1] * d[1]) + (d[2] * d[2] + d[3] * d[3])) * (1.f / 256.f) + EPS);
        u32x2 o; o.x = cvt_pk_bf16(d[0] * rstd * g.x * post, d[1] * rstd * g.y * post); o.y = cvt_pk_bf16(d[2] * rstd * g.z * post, d[3] * rstd * g.w * post);
        *((u32x2*)(out + h * 256) + lane) = o;
    }
}
template <int R>
__device__ __forceinline__ void diff_combine_rows(const bf16* ocb, bf16* outb, size_t ldo, int m0, int mstep, float lam, float post, const float* subln, int lane) {
    const f32x4 g = *(const f32x4*)(subln + lane * 4);
    u32x2 w0[R][4], w1[R][4];
#pragma unroll
    for (int i = 0; i < R; ++i) { const bf16* oc = ocb + (size_t)(m0 + i * mstep) * 2048;
#pragma unroll
        for (int h = 0; h < 4; ++h) { w0[i][h] = *((const u32x2*)(oc + h * 512) + lane); w1[i][h] = *((const u32x2*)(oc + h * 512 + 256) + lane); } }
#pragma unroll
    for (int i = 0; i < R; ++i) { bf16* out = outb + (size_t)(m0 + i * mstep) * ldo;
#pragma unroll
        for (int h = 0; h < 4; ++h) { const u32x2 a = w0[i][h], b = w1[i][h];
            float d[4] = {bflo(a.x) - lam * bflo(b.x), bfhi(a.x) - lam * bfhi(b.x), bflo(a.y) - lam * bflo(b.y), bfhi(a.y) - lam * bfhi(b.y)};
            const float rstd = 1.f / sqrtf(wave_sum((d[0] * d[0] + d[1] * d[1]) + (d[2] * d[2] + d[3] * d[3])) * (1.f / 256.f) + EPS);
            u32x2 o; o.x = cvt_pk_bf16(d[0] * rstd * g.x * post, d[1] * rstd * g.y * post); o.y = cvt_pk_bf16(d[2] * rstd * g.z * post, d[3] * rstd * g.w * post);
            *((u32x2*)(out + h * 256) + lane) = o; } }
}
__device__ __forceinline__ void sincos_d(double a, double& sn, double& cs) {
    const double k = __builtin_rint(a * 0.15915494309189533577);
    const double r = __builtin_fma(-k, 6.283185307179586476925, a) - k * 2.4492935982947064e-16 * 0.0;
    const double r2 = r * r;
    double s = -1.0 / 51090942171709440000.0;
    s = s * r2 + 1.0 / 121645100408832000.0; s = s * r2 - 1.0 / 355687428096000.0; s = s * r2 + 1.0 / 1307674368000.0; s = s * r2 - 1.0 / 6227020800.0;
    s = s * r2 + 1.0 / 39916800.0; s = s * r2 - 1.0 / 362880.0; s = s * r2 + 1.0 / 5040.0; s = s * r2 - 1.0 / 120.0; s = s * r2 + 1.0 / 6.0; s = s * r2 - 1.0;
    sn = -s * r;
    double c = 1.0 / 1124000727777607680000.0;
    c = c * r2 - 1.0 / 2432902008176640000.0; c = c * r2 + 1.0 / 6402373705728000.0; c = c * r2 - 1.0 / 20922789888000.0; c = c * r2 + 1.0 / 87178291200.0;
    c = c * r2 - 1.0 / 479001600.0; c = c * r2 + 1.0 / 3628800.0; c = c * r2 - 1.0 / 40320.0; c = c * r2 + 1.0 / 720.0; c = c * r2 - 1.0 / 24.0; c = c * r2 + 0.5; c = c * r2 - 1.0;
    cs = -c;
}

__device__ __forceinline__ void* ld_ptr(LAS unsigned long long* P, int i) {
    const unsigned long long v = P[i];
    const unsigned lo = __builtin_amdgcn_readfirstlane((unsigned)v), hi = __builtin_amdgcn_readfirstlane((unsigned)(v >> 32));
    return (void*)(GAS void*)(uintptr_t)(((unsigned long long)hi << 32) | lo);
}
struct Args { const float* in[27]; float* out; unsigned char* ws; int ph_lo, ph_hi; };
enum { I_XP = 0, I_XS, I_MP, I_MS, I_NORM_MIX, I_W_IN_AB, I_MLA_QN, I_W_QB, I_MLA_KVN, I_W_KVB, I_GQA_QN, I_GQA_KN, I_W_OUT_AB, I_W_IN_CD, I_RPB, I_DLAM, I_SUBLN, I_W_OUT_CD,
       I_NORM_XA, I_NORM_MEM, I_W_XQ, I_W_XKV, I_W_XO, I_NORM_MLP, I_W_UP, I_W_DOWN, I_FINAL };

__global__ void __launch_bounds__(512, 2) fwd(Args args) {
    extern __shared__ __attribute__((aligned(16))) unsigned char lds_raw[];
    LAS unsigned char* lds = (LAS unsigned char*)lds_raw;
    volatile LAS unsigned* MISC = (volatile LAS unsigned*)(lds + MISC_OFF);
    const int tid0 = threadIdx.x, wave = __builtin_amdgcn_readfirstlane(tid0 >> 6);
    const int G = gridDim.x; const int bx = blockIdx.x; const int vcu = (G % 8 == 0) ? (bx % 8) * (G / 8) + bx / 8 : bx;
    const int gw = vcu * 8 + wave, NGW = G * 8;
    for (int u = tid0; u < (LDS_BYTES - RING_BYTES) / 4; u += 512) ((LAS unsigned*)(lds + RING_BYTES))[u] = 0u;
    __syncthreads();
    LAS unsigned long long* PTRS = (LAS unsigned long long*)(lds + PTR_OFF);
    if (tid0 == 0) {
#pragma unroll
        for (int i = 0; i < 27; ++i) PTRS[i] = (unsigned long long)(uintptr_t)args.in[i];
        PTRS[27] = (unsigned long long)(uintptr_t)args.out; PTRS[28] = (unsigned long long)(uintptr_t)args.ws;
    }
    const int lo = args.ph_lo, hi = args.ph_hi; int ph = 0;
    __syncthreads();
#define INP(i) ((const float*)ld_ptr(PTRS, (i)))
#define WSP ((unsigned char*)ld_ptr(PTRS, 28))
#define XP ((float*)ld_ptr(PTRS, 27))
    XcdBarrier bar = xcd_barrier_post((unsigned*)(WSP + WS_CTL) + CW_BAR, MISC + 8, wave);
#ifndef PH_MASK
#define PH_MASK 0xffffffffu
#endif
#define PEN(k) (((PH_MASK) >> (k)) & 1u)
#ifndef PROBE_REP
#define PROBE_REP 0u
#endif
#define REPS(k) (1 + (int)(((PROBE_REP) >> (k)) & 1u))
#define PH_ON (ph >= lo && ph < hi)
#define PH_LANE const int lane = lane_id_fresh(), tid = wave * 64 + lane; (void)tid; (void)lane; int gw_s_ = gw; asm volatile("" : "+s"(gw_s_)); const int gw = gw_s_; (void)gw
#define PH_END do { if (ph >= lo && ph + 1 < hi) xcd_barrier(bar, wave); ++ph; } while (0)

#define X XP
#define H ((bf16*)(WSP + WS_H))
#define BIG (WSP + WS_BIG)
#define WB (WSP + WS_WB)
#define tab_mla ((float*)(WSP + WS_TAB_MLA))
#define tab_1d ((float*)(WSP + WS_TAB_1D))
#define MN ((bf16*)(WSP + WS_MN))
#define MKV ((bf16*)(WSP + WS_MKV))
#define HFIN H
#define PSQ(i) ((float*)(WSP + WS_PS + (size_t)(i) * PS_BYTES))
#define PSC(i) ((float*)(WSP + WS_PS + 3 * PS_BYTES + (size_t)(i) * PSC_BYTES))
#define XBH ((bf16*)XP)
#define XBA XBH
    LAS float* scr = (LAS float*)(lds + wave * TR_BYTES);

    if (PH_ON && PEN(0)) for (int rep_ = 0; rep_ < REPS(0); ++rep_) { PH_LANE;
        const int gt = vcu * 512 + tid, NT_ = G * 512;
        for (int i = gt; i < 4096 * 32; i += NT_) { const int pos = i >> 5, f = i & 31; double inv = 1.0; for (int k = 0; k < f; ++k) inv *= 0.7498942093324558273;
            const float ang = (float)pos * (float)inv; double sn, cs; sincos_d((double)ang, sn, cs); tab_mla[i] = (float)cs; tab_mla[4096 * 32 + i] = (float)sn; }
        for (int i = gt; i < 4096 * 64; i += NT_) { const int pos = i >> 6, f = i & 63; double inv = 1.0; for (int k = 0; k < f; ++k) inv *= 0.8659643233600653524;
            const float ang = (float)pos * (float)inv; double sn, cs; sincos_d((double)ang, sn, cs); tab_1d[i] = (float)cs; tab_1d[4096 * 64 + i] = (float)sn; }
        float* ss0 = PSQ(0);
        int m = gw;
        for (; m + NGW < T; m += 2 * NGW) { const int m1 = m + NGW;
            const float* src0 = (m < T_PROMPT) ? INP(I_XP) + (size_t)m * DM : INP(I_XS) + (size_t)(m - T_PROMPT) * DM;
            const float* src1 = (m1 < T_PROMPT) ? INP(I_XP) + (size_t)m1 * DM : INP(I_XS) + (size_t)(m1 - T_PROMPT) * DM;
            init_rows2_2048(src0, src1, XBH + (size_t)m * DM, XBH + (size_t)m1 * DM, ss0 + (size_t)m * 32, ss0 + (size_t)m1 * 32, lane); }
        for (; m < T; m += NGW) { const float* src = (m < T_PROMPT) ? INP(I_XP) + (size_t)m * DM : INP(I_XS) + (size_t)(m - T_PROMPT) * DM;
            init_row_2048(src, XBH + (size_t)m * DM, ss0 + (size_t)m * 32, lane); }
    }

    for (int layer = 0; layer < DEPTH; ++layer) {
        const int j = layer >> 1; const bool even = (layer & 1) == 0;
#define W_IN ((bf16*)(WB + WB_IN))
#define W_QB ((bf16*)(WB + WB_QB))
#define W_KVB ((bf16*)(WB + WB_KVB))
#define W_OUT ((bf16*)(WB + WB_OUT))
#define W_XQ ((bf16*)(WB + WB_XQ))
#define W_XKV ((bf16*)(WB + WB_XKV))
#define W_XO ((bf16*)(WB + WB_XO))
#define W_UP ((bf16*)(WB + WB_UP))
#define W_DOWN ((bf16*)(WB + WB_DOWN))

        if (PH_ON && PEN(1)) for (int rep_ = 0; rep_ < REPS(1); ++rep_) { PH_LANE;
            const float* gmix = INP(I_NORM_MIX) + layer * DM;
            if (even) {
                convert_matrix(INP(I_W_IN_AB) + (size_t)j * DM * AB_IN, DM, AB_IN, W_IN, gmix, scr, gw, NGW, lane);
                for (size_t i = (size_t)gw * 64 + lane; i < (size_t)(AB_PAD - AB_IN) * DM / 8; i += (size_t)NGW * 64) { u32x4 z = (u32x4){0u, 0u, 0u, 0u}; asm volatile("" : "+v"(z)); ((u32x4*)(W_IN + (size_t)AB_IN * DM))[i] = z; }
                convert_matrix(INP(I_W_QB) + (size_t)j * 512 * 1536, 512, 1536, W_QB, INP(I_MLA_QN) + j * 512, scr, gw, NGW, lane);
                convert_matrix(INP(I_W_KVB) + (size_t)j * 512 * 2048, 512, 2048, W_KVB, INP(I_MLA_KVN) + j * 512, scr, gw, NGW, lane);
                convert_matrix(INP(I_W_OUT_AB) + (size_t)j * DM * DM, DM, DM, W_OUT, nullptr, scr, gw, NGW, lane);
            } else {
                convert_matrix(INP(I_W_IN_CD) + (size_t)j * DM * CD_IN, DM, CD_IN, W_IN, gmix, scr, gw, NGW, lane);
                convert_matrix(INP(I_W_OUT_CD) + (size_t)j * DM * DM, DM, DM, W_OUT, nullptr, scr, gw, NGW, lane);
            }
            convert_matrix(INP(I_W_XQ) + (size_t)layer * DM * 512, DM, 512, W_XQ, INP(I_NORM_XA) + layer * DM, scr, gw, NGW, lane);
            convert_matrix(INP(I_W_XKV) + (size_t)layer * DM * 1024, DM, 1024, W_XKV, nullptr, scr, gw, NGW, lane);
            convert_matrix(INP(I_W_XO) + (size_t)layer * 512 * DM, 512, DM, W_XO, nullptr, scr, gw, NGW, lane);
            convert_matrix(INP(I_W_UP) + (size_t)layer * DM * DFF, DM, DFF, W_UP, INP(I_NORM_MLP) + layer * DM, scr, gw, NGW, lane);
            convert_matrix(INP(I_W_DOWN) + (size_t)layer * DFF * DM, DFF, DM, W_DOWN, nullptr, scr, gw, NGW, lane);
            const float* gm = INP(I_NORM_MEM) + layer * DM;
            for (int r = gw; r < TM; r += NGW) { const float* src = (r < 8 * MEMLEN) ? INP(I_MP) + (size_t)r * DM : INP(I_MS) + (size_t)(r - 8 * MEMLEN) * DM;
                norm_row_2048(src, gm, MN + (size_t)r * DM, nullptr, lane); }
        }
        PH_END;

        if (even) {
            bf16* PROJ = (bf16*)(BIG + BIG_PROJ); bf16* Q = (bf16*)(BIG + BIG_Q); bf16* KV = (bf16*)(BIG + BIG_KV);
            if (PH_ON && PEN(2)) for (int rep_ = 0; rep_ < REPS(2); ++rep_) { PH_LANE;
                pg8::Gemm g{XBH, W_IN, T, AB_PAD, DM, DM, DM}; pg8::StaticOrder S; S.init(T, AB_PAD, G, bx, 3);
                pg8::EpiBf16<0, 32> E{PROJ, AB_PAD, 0, 0, PSQ(0), 1.f / 2048.f, PSC(0), PSC_BYTES / 4};
                pg8::gemm_phase(lds, g, S, E, wave);
            }
            PH_END;
            if (PH_ON && PEN(3)) for (int rep_ = 0; rep_ < REPS(3); ++rep_) { PH_LANE;
                const float* gkn = INP(I_GQA_KN) + j * 128;
                int m = gw;
                for (; m + 7 * NGW < T; m += 8 * NGW) even_rows_fix_k<8>(PROJ, m, NGW, gkn, tab_mla, lane);
                for (; m < T; m += NGW) even_row_fix_k(PROJ + (size_t)m * AB_PAD, m & (SEQ - 1), gkn, tab_mla, lane);
            }
            if (PH_ON && PEN(4)) for (int rep_ = 0; rep_ < REPS(4); ++rep_) { PH_LANE;
#pragma unroll 1
                for (int gi = 0; gi < 2; ++gi) {
                    pg8::Gemm g{PROJ + (gi ? 512 : 0), gi ? W_KVB : W_QB, T, gi ? 2048 : 1536, 512, AB_PAD, 512}; pg8::StaticOrder S; S.init(T, g.N, G, bx, 4);
                    pg8::EpiBf16<0, 8> E{gi ? KV : Q, g.N, 0, 0, PSC(gi), 1.f / 512.f, nullptr, 0};
                    pg8::gemm_phase(lds, g, S, E, wave);
                }
            }
            PH_END;
            if (PH_ON) {
                for (int rep_ = 0; rep_ < REPS(6); ++rep_)
                for (int u = vcu; u < NSEQ * 8 * 16; u += G) { const int qb = u & 15, h = (u >> 4) & 7, b = u >> 7; const size_t t0 = (size_t)b * SEQ;
                    att::dense_unit<192, 1, 1>(Q + (t0 + qb * 256) * 1536 + h * 192, 1536, KV + t0 * 2048 + h * 256, 2048, PROJ + t0 * AB_PAD + 1024, AB_PAD,
                                         KV + t0 * 2048 + h * 256 + 128, 2048, H + (t0 + qb * 256) * DM + h * 128, DM, SEQ, (LAS char*)lds, wave, qb * 256, tab_mla, nullptr); }
                for (int rep_ = 0; rep_ < REPS(21); ++rep_)
                for (int u = vcu; u < NSEQ * 8 * 16; u += G) { const int qb = u & 15, h = (u >> 4) & 7, b = u >> 7; const size_t t0 = (size_t)b * SEQ; const int kvh = h >> 2;
                    att::dense_unit3<3>(PROJ + (t0 + qb * 256) * AB_PAD + 1088 + h * 128, AB_PAD, PROJ + t0 * AB_PAD + 2112 + kvh * 128, AB_PAD,
                                         PROJ + t0 * AB_PAD + 2368 + kvh * 128, AB_PAD, H + (t0 + qb * 256) * DM + 1024 + h * 128, DM, SEQ, (LAS char*)lds, wave, qb * 256, tab_mla, INP(I_GQA_QN) + j * 128); }
            }
            PH_END;
        } else {
            bf16* NQ = (bf16*)(BIG + 0 * BIG_SPLIT); bf16* NK = (bf16*)(BIG + 1 * BIG_SPLIT); bf16* NV = (bf16*)(BIG + 2 * BIG_SPLIT);
            bf16* DQ = (bf16*)(BIG + 3 * BIG_SPLIT); bf16* DK = (bf16*)(BIG + 4 * BIG_SPLIT); bf16* DV = (bf16*)(BIG + 5 * BIG_SPLIT); bf16* OC = NQ;
            if (PH_ON && PEN(7)) for (int rep_ = 0; rep_ < REPS(7); ++rep_) { PH_LANE;
                pg8::Gemm g{XBH, W_IN, T, CD_IN, DM, DM, DM}; pg8::StaticOrder S; S.init(T, CD_IN, G, bx, 4);
                pg8::EpiBf16<0, 32> E{NQ, 1024, 1024, BIG_SPLIT / 2, PSQ(0), 1.f / 2048.f, nullptr, 0};
                pg8::gemm_phase(lds, g, S, E, wave);
            }
            PH_END;
            if (PH_ON && PEN(9)) for (int rep_ = 0; rep_ < REPS(9); ++rep_) { PH_LANE;
                const float* rpb = INP(I_RPB) + (size_t)j * 8 * 465;
                const int nslot = (NSEQ * 8 * 16 / G) < 6 ? ((NSEQ * 8 * 16 / G) < 1 ? 1 : (NSEQ * 8 * 16 / G)) : 6;
                for (int u = vcu, it_ = 0; u < NSEQ * 8 * 16; u += G, ++it_) { const int qb = u & 15, h = (u >> 4) & 7, b = u >> 7; const size_t t0 = (size_t)b * SEQ;
                    att::na_unit2(NQ + (t0 + qb * 256) * 1024 + h * 128, 1024, NK + t0 * 1024 + h * 128, NV + t0 * 1024 + h * 128, 1024,
                                 H + (t0 + qb * 256) * DM + h * 128, DM, qb * 4, rpb + h * 465, (LAS char*)lds, wave);
                    if (rep_ == 0 && PEN(8) && it_ == bx % nslot) {
                        int m = gw;
                        for (; m + 3 * NGW < T; m += 4 * NGW) rope1d_rows4(DK, 1024, m, NGW, tab_1d, lane);
                        for (; m < T; m += NGW) rope1d_row(DK + (size_t)m * 1024, m & (SEQ - 1), tab_1d, lane);
                    } }
            }
            PH_END;
            if (PH_ON && PEN(10)) for (int rep_ = 0; rep_ < REPS(10); ++rep_) { PH_LANE;
                for (int u = vcu; u < NSEQ * 8 * 16; u += G) { const int qb = u & 15, hc = (u >> 4) & 7, b = u >> 7; const size_t t0 = (size_t)b * SEQ;
                    const int c = hc & 1, h = hc >> 1;
                    att::dense_unit_dv256(DQ + (t0 + qb * 256) * 1024 + (2 * h + c) * 128, 1024, DK + t0 * 1024 + (2 * h + c) * 128, 1024, DV + t0 * 1024 + h * 256, 1024,
                                          OC + (t0 + qb * 256) * 2048 + h * 512 + c * 256, 2048, SEQ, (LAS char*)lds, wave, qb * 256, tab_1d); }
            }
            PH_END;
            if (PH_ON && PEN(11)) for (int rep_ = 0; rep_ < REPS(11); ++rep_) { PH_LANE;
                const float* lp = INP(I_DLAM) + j * 512;
                const float a0 = lp[lane] * lp[128 + lane] + lp[64 + lane] * lp[128 + 64 + lane], a1 = lp[256 + lane] * lp[384 + lane] + lp[256 + 64 + lane] * lp[384 + 64 + lane];
                const float lam_init = (layer == 1) ? 0.35550906759096934f : 0.5560582041556406f;
                const float lam = expf(wave_sum(a0)) - expf(wave_sum(a1)) + lam_init;
                const float* subln = INP(I_SUBLN) + j * 256;
                int m = gw;
                for (; m + 3 * NGW < T; m += 4 * NGW) diff_combine_rows<4>(OC, H + 1024, DM, m, NGW, lam, 1.f - lam_init, subln, lane);
                for (; m < T; m += NGW) diff_combine_row(OC + (size_t)m * 2048, H + (size_t)m * DM + 1024, lam, 1.f - lam_init, subln, lane);
            }
            PH_END;
        }
        if (PH_ON && PEN(12)) for (int rep_ = 0; rep_ < REPS(12); ++rep_) { PH_LANE;
            pg8::Gemm g{H, W_OUT, T, DM, DM, DM, DM}; pg8::StaticOrder S; S.init(T, DM, G, bx, 4);
            pg8::EpiResidX E{XBH, XBH, PSQ(1), DM, (rep_ == REPS(12) - 1) ? 1.f : 0.f};
            pg8::gemm_phase(lds, g, S, E, wave, ((bx >> 3) & 7) * SKEW_TICKS);
        }
        PH_END;
        {
            bf16* XQ = (bf16*)(BIG + BIG_XQ); bf16* XO = (bf16*)(BIG + BIG_XO);
            if (PH_ON && PEN(14)) for (int rep_ = 0; rep_ < REPS(14); ++rep_) { PH_LANE;
#pragma unroll 1
                for (int gi = 0; gi < 2; ++gi) {
                    pg8::Gemm g{gi ? MN : XBA, gi ? W_XKV : W_XQ, gi ? TM : T, gi ? 1024 : 512, DM, DM, DM}; pg8::StaticOrder S; S.init(g.M, g.N, G, gi ? (bx + (G >> 1)) % G : bx);
                    pg8::EpiBf16<0, 32> E{gi ? MKV : XQ, g.N, 0, 0, PSQ(1), 1.f / 2048.f, nullptr, 0, gi};
                    pg8::gemm_phase(lds, g, S, E, wave);
                }
            }
            PH_END;
            if (PH_ON && PEN(15)) for (int rep_ = 0; rep_ < REPS(15); ++rep_) { PH_LANE;
                for (int u = vcu; u < NSEQ * 4 * 16; u += G) { const int qb = u & 15, h = (u >> 4) & 3, b = u >> 6; const size_t t0 = (size_t)b * SEQ;
                    att::dense_unit3<0>(XQ + (t0 + qb * 256) * 512 + h * 128, 512, MKV + (size_t)b * MEMLEN * 1024 + h * 128, 1024,
                                         MKV + (size_t)b * MEMLEN * 1024 + 512 + h * 128, 1024, XO + (t0 + qb * 256) * 512 + h * 128, 512, MEMLEN, (LAS char*)lds, wave, 0, nullptr, nullptr); }
            }
            PH_END;
            if (PH_ON && PEN(16)) for (int rep_ = 0; rep_ < REPS(16); ++rep_) { PH_LANE;
                pg8::Gemm g{XO, W_XO, T, DM, 512, 512, 512}; pg8::StaticOrder S; S.init(T, DM, G, bx, 4);
                pg8::EpiResidX E{XBH, XBH, PSQ(2), DM, (rep_ == REPS(16) - 1) ? 1.f : 0.f};
                pg8::gemm_phase(lds, g, S, E, wave, ((bx >> 3) & 7) * SKEW_TICKS);
            }
            PH_END;
        }
        {
#pragma unroll 1
            for (int ch = -1; ch < N_MLP_CHUNKS; ++ch) {
                if (PH_ON && PEN(19)) for (int rep_ = 0; rep_ < REPS(19); ++rep_) { PH_LANE;
                    if (ch >= 0) {
                        pg8::Gemm g{(bf16*)(BIG + (size_t)(ch & 1) * U_BYTES), W_DOWN, MLP_CHUNK, DM, DFF, DFF, DFF}; pg8::StaticOrder S; S.init(MLP_CHUNK, DM, G, bx, 4);
                        const size_t co = (size_t)ch * MLP_CHUNK * DM; const bool lastl = (layer == DEPTH - 1);
                        pg8::EpiResidX E{XBH + co, (lastl ? HFIN : XBH) + co, PSQ(0) + (size_t)ch * MLP_CHUNK * 32, DM, (rep_ == REPS(19) - 1) ? 1.f : 0.f};
                        pg8::gemm_phase(lds, g, S, E, wave);
                    }
                    if (ch + 1 < N_MLP_CHUNKS) { const int cn = ch + 1;
                        pg8::Gemm g{XBA + (size_t)cn * MLP_CHUNK * DM, W_UP, MLP_CHUNK, DFF, DM, DM, DM}; pg8::StaticOrder S; S.init(MLP_CHUNK, DFF, G, bx, 8);
                        pg8::EpiBf16<2, 32> E{(bf16*)(BIG + (size_t)(cn & 1) * U_BYTES), DFF, 0, 0, PSQ(2) + (size_t)cn * MLP_CHUNK * 32, 1.f / 2048.f, nullptr, 0};
                        pg8::gemm_phase(lds, g, S, E, wave);
                    }
                }
                PH_END;
            }
        }
    }
    if (PH_ON && PEN(20)) for (int rep_ = 0; rep_ < REPS(20); ++rep_) { PH_LANE; const float* g = INP(I_FINAL); const float* ssf = PSQ(0);
        f32x4 gg[8];
#pragma unroll
        for (int jj = 0; jj < 8; ++jj) gg[jj] = ((const f32x4*)g + lane)[64 * jj];
        int m = gw;
        for (; m + 3 * NGW < T; m += 4 * NGW) final_norm_rows<4>(HFIN, X, gg, ssf, m, NGW, lane);
        for (; m < T; m += NGW) final_norm_row(HFIN + (size_t)m * DM, X + (size_t)m * DM, g, wave_sum(lane < 32 ? ssf[(size_t)m * 32 + lane] : 0.f), lane); }
#undef PH_ON
#undef PH_END
}

extern "C" void kernel_launch(void* const* d_in, const int* in_sizes, int n_in, void* d_out, int out_size, void* d_ws, size_t ws_size, hipStream_t stream) {
    static int grid = 0;
    if (grid == 0) {
        if (n_in != 27 || out_size != T * DM || ws_size < WS_END) { fprintf(stderr, "kernel_launch: shape mismatch: n_in %d out %d ws %zu (need %zu)\n", n_in, out_size, ws_size, (size_t)WS_END); grid = -1; return; }
        int dev = 0, cus = 0, per_cu = 0;
        if (hipGetDevice(&dev) != hipSuccess || hipDeviceGetAttribute(&cus, hipDeviceAttributeMultiprocessorCount, dev) != hipSuccess) { grid = -1; return; }
        if (hipFuncSetAttribute((const void*)fwd, hipFuncAttributeMaxDynamicSharedMemorySize, LDS_BYTES) != hipSuccess) { fprintf(stderr, "kernel_launch: hipFuncSetAttribute failed\n"); grid = -1; return; }
        if (hipOccupancyMaxActiveBlocksPerMultiprocessor(&per_cu, (const void*)fwd, 512, LDS_BYTES) != hipSuccess || per_cu < 1) { fprintf(stderr, "kernel_launch: occupancy query says %d\n", per_cu); }
        (void)hipGetLastError();
        grid = cus;
    }
    if (grid < 0) return;
    if (hipMemsetAsync((char*)d_ws + WS_CTL, 0, CTL_ZERO_BYTES, stream) != hipSuccess) return;
    Args a{};
    for (int i = 0; i < 27; ++i) a.in[i] = (const float*)d_in[i];
    a.out = (float*)d_out; a.ws = (unsigned char*)d_ws; a.ph_lo = 0; a.ph_hi = 1 << 30;
    hipLaunchKernelGGL(fwd, dim3(grid), dim3(512), LDS_BYTES, stream, a);
    const hipError_t le = hipPeekAtLastError();
    if (le != hipSuccess) fprintf(stderr, "kernel_launch: launch failed: %s\n", hipGetErrorName(le));
}
```

```cpp
#include <hip/hip_runtime.h>
#include <cstdio>
#include <cstdint>

#define LAS __attribute__((address_space(3)))
#define GAS __attribute__((address_space(1)))
typedef unsigned short bf16;
typedef short bf16x8 __attribute__((ext_vector_type(8)));
typedef short s16x4 __attribute__((ext_vector_type(4)));
typedef float f32x4 __attribute__((ext_vector_type(4)));
typedef float f32x2 __attribute__((ext_vector_type(2)));
typedef float f32x16 __attribute__((ext_vector_type(16)));
typedef unsigned u32x4 __attribute__((ext_vector_type(4)));
typedef unsigned u32x2 __attribute__((ext_vector_type(2)));

constexpr int DM = 2048, SEQ = 4096, NSEQ = 12, T = NSEQ * SEQ  , T_PROMPT = 8 * SEQ;
constexpr int DEPTH = 4, MEMLEN = 256, TM = NSEQ * MEMLEN  ;
constexpr int AB_IN = 2624, AB_PAD = 2816, CD_IN = 6144, DFF = 8192;
constexpr int MLP_CHUNK = 8192, N_MLP_CHUNKS = T / MLP_CHUNK;
constexpr size_t U_BYTES = (size_t)MLP_CHUNK * DFF * 2;
constexpr float EPS = 1e-6f;

__device__ __forceinline__ unsigned cvt_pk_bf16(float lo, float hi) { unsigned r; asm volatile("v_cvt_pk_bf16_f32 %0, %1, %2" : "=v"(r) : "v"(lo), "v"(hi)); return r; }
__device__ __forceinline__ float bf2f(unsigned short b) { return __builtin_bit_cast(float, ((unsigned)b) << 16); }
__device__ __forceinline__ float bflo(unsigned w) { return __builtin_bit_cast(float, w << 16); }
__device__ __forceinline__ float bfhi(unsigned w) { return __builtin_bit_cast(float, w & 0xffff0000u); }
__device__ __forceinline__ int lane_id_fresh() { int l; asm volatile("v_mbcnt_lo_u32_b32 %0, -1, 0\n\tv_mbcnt_hi_u32_b32 %0, -1, %0" : "=v"(l)); return l; }
template <int XOR> __device__ __forceinline__ float swz_xor(float v) { return __builtin_bit_cast(float, __builtin_amdgcn_ds_swizzle(__builtin_bit_cast(int, v), (XOR << 10) | 0x1f)); }
__device__ __forceinline__ float wave_sum(float v) {
    v += swz_xor<1>(v); v += swz_xor<2>(v); v += swz_xor<4>(v); v += swz_xor<8>(v); v += swz_xor<16>(v);
    auto rr = __builtin_amdgcn_permlane32_swap(__float_as_uint(v), __float_as_uint(v), false, false);
    return __uint_as_float(rr[0]) + __uint_as_float(rr[1]);
}
__device__ __forceinline__ float other_half(float v, bool lower) {
    auto rr = __builtin_amdgcn_permlane32_swap(__float_as_uint(v), __float_as_uint(v), false, false);
    return lower ? __uint_as_float(rr[1]) : __uint_as_float(rr[0]);
}

namespace pg8 {
constexpr int BM = 256, BK = 64, HALF = 128, HTB = HALF * BK * 2, STAGE_BYTES = 8 * HTB, NXCD = 8, WGM = 8;
__host__ __device__ __forceinline__ int lds_byte(int r, int c) { const int st = (r >> 4) * 2 + (c >> 5), rr = r & 15, cc = c & 31, ob = rr * 64 + cc * 2; return st * 1024 + (ob ^ (((ob >> 9) & 1) << 5)); }
__host__ __device__ __forceinline__ void stage_rc(int b, int& R, int& C) { const int st = b / 1024, sb = b % 1024, swz = sb ^ (((sb >> 9) & 1) << 5); R = (st >> 1) * 16 + swz / 64; C = (st & 1) * 32 + (swz % 64) / 2; }
__host__ __device__ __forceinline__ int perm32(int rho) { const int n = rho >> 4, i = rho & 15; return 8 * (i >> 2) + 4 * n + (i & 3); }

struct Unit { int pm, pn; };
struct Gemm { const bf16* A; const bf16* Bt; int M, N, K, lda, ldb; };

struct StaticOrder {
    int nM, nN, nwg, G, c, wgm;
    __device__ void init(int M, int N, int G_, int c_, int wgm_ = WGM) { nM = M / BM; nN = N / BM; nwg = nM * nN; G = G_; c = c_; wgm = wgm_; }
    __device__ bool next(int i, Unit& u) const {
        const long L = (long)i * G + c; if (L >= nwg) return false;
        int wgid = (int)L; { const int q = nwg / NXCD, r = nwg % NXCD, xcd = wgid % NXCD, off = wgid / NXCD; wgid = (xcd < r ? xcd * (q + 1) : r * (q + 1) + (xcd - r) * q) + off; }
        const int nig = wgm * nN, gid = wgid / nig, fm = gid * wgm, gsz = (nM - fm) < wgm ? (nM - fm) : wgm;
        u.pm = fm + ((wgid % nig) % gsz); u.pn = (wgid % nig) / gsz; return true;
    }
};

template <int W> __device__ __forceinline__ float row_ss(const float* ps, int row, int fq) {
    float s;
    if constexpr (W == 32) { const f32x4 a = *(const f32x4*)(ps + (size_t)row * 32 + fq * 8), b = *(const f32x4*)(ps + (size_t)row * 32 + fq * 8 + 4); s = ((a.x + a.y) + (a.z + a.w)) + ((b.x + b.y) + (b.z + b.w)); }
    else { const f32x2 a = *(const f32x2*)(ps + (size_t)row * 8 + fq * 2); s = a.x + a.y; }
    s += swz_xor<16>(s); s += other_half(s, fq < 2); return s;
}
__device__ __forceinline__ void store_row_sums(const float (&s8)[8], float* slot0, int slots_per_row, int row0, int fq) {
#pragma unroll
    for (int k = 0; k < 2; ++k) {
        const float v = fq == 0 ? s8[4 * k] : (fq == 1 ? s8[4 * k + 1] : (fq == 2 ? s8[4 * k + 2] : s8[4 * k + 3]));
        slot0[(size_t)(row0 + k * HALF + fq * 16) * slots_per_row] = v; }
}
constexpr int RS_LDS_OFF = 135168 + 2048;
template <int ACT  , int RSW> struct EpiBf16 {
    static constexpr bool PERM = true;
    bf16* O; int ldc; int split_cols; size_t split_stride; const float* rs_in; float rs_inv_dim; float* ss_out; size_t ss_stride; int rs_off;
    struct RsPf { f32x4 a[2], b[2]; f32x2 c[2]; };
    __device__ __forceinline__ void rs_issue(RsPf& p, int pm, int wr, int wc, int fr, int fq) const {
#pragma unroll
        for (int ai = 0; ai < 2; ++ai) { const size_t row = (size_t)pm * BM + wr * 64 + fr + ai * HALF + wc * 16;
            if constexpr (RSW == 32) { const float* q = rs_in + row * 32 + fq * 8;
                asm volatile("global_load_dwordx4 %0, %2, off\n\tglobal_load_dwordx4 %1, %2, off offset:16" : "=&v"(p.a[ai]), "=&v"(p.b[ai]) : "v"(q) : "memory"); }
            else { const float* q = rs_in + row * 8 + fq * 2;
                asm volatile("global_load_dwordx2 %0, %1, off" : "=&v"(p.c[ai]) : "v"(q) : "memory"); } }
    }
    template <int NYOUNGER>
    __device__ __forceinline__ void rs_finish(RsPf p, LAS unsigned char* lds, int parity, int wr, int wc, int fr, int fq) const {
        static_assert(NYOUNGER == 8 || NYOUNGER == 16, "count");
        if constexpr (RSW == 32) {
            if constexpr (NYOUNGER == 16) asm volatile("s_waitcnt vmcnt(16)" : "+v"(p.a[0]), "+v"(p.b[0]), "+v"(p.a[1]), "+v"(p.b[1]) :: "memory");
            else asm volatile("s_waitcnt vmcnt(8)" : "+v"(p.a[0]), "+v"(p.b[0]), "+v"(p.a[1]), "+v"(p.b[1]) :: "memory");
        } else {
            if constexpr (NYOUNGER == 16) asm volatile("s_waitcnt vmcnt(16)" : "+v"(p.c[0]), "+v"(p.c[1]) :: "memory");
            else asm volatile("s_waitcnt vmcnt(8)" : "+v"(p.c[0]), "+v"(p.c[1]) :: "memory");
        }
        LAS float* rsl = (LAS float*)(lds + RS_LDS_OFF) + parity * 256;
#pragma unroll
        for (int ai = 0; ai < 2; ++ai) { float s;
            if constexpr (RSW == 32) s = ((p.a[ai].x + p.a[ai].y) + (p.a[ai].z + p.a[ai].w)) + ((p.b[ai].x + p.b[ai].y) + (p.b[ai].z + p.b[ai].w)); else s = p.c[ai].x + p.c[ai].y;
            s += swz_xor<16>(s); s += other_half(s, fq < 2);
            const float rs = 1.f / sqrtf(s * rs_inv_dim + EPS);
            if (fq == 0) rsl[wr * 64 + fr + ai * HALF + wc * 16] = rs; }
        asm volatile("s_waitcnt lgkmcnt(0)" ::: "memory");
    }
    __device__ __forceinline__ void operator()(const f32x4 (&acc)[2][2][4][2], const Unit& u, int wr, int wc, int fr, int fq, LAS unsigned char* lds, int parity, const Unit& nx, bool has_next) const {
        RsPf pf; rs_issue(pf, has_next ? nx.pm : u.pm, wr, wc, fr, fq);
        const LAS float* rsl = (const LAS float*)(lds + RS_LDS_OFF) + parity * 256 + wr * 64 + fr;
        const int row0 = u.pm * BM + wr * 64 + fr; int colt = u.pn * BM; bf16* base = O;
        if (split_cols) { const int t = colt / split_cols; base += (size_t)t * split_stride; colt -= t * split_cols; }
        const int col0 = colt + wc * 32 + 8 * fq;
        const bool do_ss = (ss_out != nullptr) && (u.pn < 4);
        float* ssp = do_ss ? ss_out + (size_t)(u.pn >> 1) * ss_stride + (u.pn & 1) * 4 + wc : nullptr;
        float s8[8] = {0.f, 0.f, 0.f, 0.f, 0.f, 0.f, 0.f, 0.f};
#pragma unroll
        for (int ai = 0; ai < 2; ++ai)
#pragma unroll
            for (int m = 0; m < 4; ++m) { const int row = row0 + ai * HALF + m * 16; bf16* rowp = base + (size_t)row * ldc + col0;
                float rs = rsl[ai * HALF + m * 16]; rs = rs_off ? 1.f : rs;
                float ss = 0.f;
#pragma unroll
                for (int bj = 0; bj < 2; ++bj) { f32x4 v0 = acc[ai][bj][m][0] * rs, v1 = acc[ai][bj][m][1] * rs;
                    if (ACT == 2) {
#pragma unroll
                        for (int j = 0; j < 4; ++j) { const float a = fmaxf(v0[j], 0.f), b = fmaxf(v1[j], 0.f); v0[j] = a * a; v1[j] = b * b; } }
                    u32x4 w; w.x = cvt_pk_bf16(v0[0], v0[1]); w.y = cvt_pk_bf16(v0[2], v0[3]); w.z = cvt_pk_bf16(v1[0], v1[1]); w.w = cvt_pk_bf16(v1[2], v1[3]);
                    *(u32x4*)(rowp + bj * HALF) = w;
                    if (do_ss) { const float a0 = bflo(w.x), a1 = bfhi(w.x), a2 = bflo(w.y), a3 = bfhi(w.y), a4 = bflo(w.z), a5 = bfhi(w.z), a6 = bflo(w.w), a7 = bfhi(w.w);
                        ss += (a0 * a0 + a1 * a1) + (a2 * a2 + a3 * a3) + (a4 * a4 + a5 * a5) + (a6 * a6 + a7 * a7); } }
                if (do_ss) { ss += swz_xor<16>(ss); ss += other_half(ss, fq < 2); s8[ai * 4 + m] = ss; } }
        if (do_ss) store_row_sums(s8, ssp, 8, row0, fq);
        rs_finish<16>(pf, lds, parity ^ 1, wr, wc, fr, fq);
    }
};
struct EpiResidX {
    static constexpr bool PERM = true;
    const bf16* XBin; bf16* XBout; float* ps; int ldc; float scale;
    struct RsPf {};
    __device__ __forceinline__ void rs_issue(RsPf&, int, int, int, int, int) const {}
    template <int NYOUNGER> __device__ __forceinline__ void rs_finish(const RsPf&, LAS unsigned char*, int, int, int, int, int) const {}
    __device__ __forceinline__ void operator()(const f32x4 (&acc)[2][2][4][2], const Unit& u, int wr, int wc, int fr, int fq, LAS unsigned char*, int, const Unit&, bool) const {
        const int row0 = u.pm * BM + wr * 64 + fr, col0 = u.pn * BM + wc * 32 + 8 * fq;
        float* psp = ps + u.pn * 4 + wc;
        float s8[8];
        u32x4 ch[2][4][2];
#pragma unroll
        for (int ai = 0; ai < 2; ++ai)
#pragma unroll
            for (int m = 0; m < 4; ++m) { const bf16* q = XBin + (size_t)(row0 + ai * HALF + m * 16) * ldc + col0;
                asm volatile("global_load_dwordx4 %0, %2, off\n\tglobal_load_dwordx4 %1, %2, off offset:256" : "=&v"(ch[ai][m][0]), "=&v"(ch[ai][m][1]) : "v"(q) : "memory"); }
        static_assert(HALF * 2 == 256, "the second load's immediate offset");
#pragma unroll
        for (int ai = 0; ai < 2; ++ai)
#pragma unroll
            for (int m = 0; m < 4; ++m) { const int row = row0 + ai * HALF + m * 16; const size_t off = (size_t)row * ldc + col0;
                float ss = 0.f;
                asm volatile("s_waitcnt vmcnt(14)" : "+v"(ch[ai][m][0]), "+v"(ch[ai][m][1]) :: "memory");
#pragma unroll
                for (int bj = 0; bj < 2; ++bj) { const u32x4 h4 = ch[ai][m][bj]; const f32x4 a0 = acc[ai][bj][m][0] * scale, a1 = acc[ai][bj][m][1] * scale;
                    u32x4 wh; wh.x = cvt_pk_bf16(bflo(h4.x) + a0[0], bfhi(h4.x) + a0[1]); wh.y = cvt_pk_bf16(bflo(h4.y) + a0[2], bfhi(h4.y) + a0[3]);
                    wh.z = cvt_pk_bf16(bflo(h4.z) + a1[0], bfhi(h4.z) + a1[1]); wh.w = cvt_pk_bf16(bflo(h4.w) + a1[2], bfhi(h4.w) + a1[3]);
                    *(u32x4*)(XBout + off + bj * HALF) = wh;
                    const float y0 = bflo(wh.x), y1 = bfhi(wh.x), y2 = bflo(wh.y), y3 = bfhi(wh.y), y4 = bflo(wh.z), y5 = bfhi(wh.z), y6 = bflo(wh.w), y7 = bfhi(wh.w);
                    ss += (y0 * y0 + y1 * y1) + (y2 * y2 + y3 * y3) + (y4 * y4 + y5 * y5) + (y6 * y6 + y7 * y7); }
                ss += swz_xor<16>(ss); ss += other_half(ss, fq < 2); s8[ai * 4 + m] = ss; }
        store_row_sums(s8, psp, 32, row0, fq);
    }
};

template <class Epi>
__device__ __forceinline__ void gemm_phase(LAS unsigned char* lds, const Gemm g, const StaticOrder& S, const Epi& E, int wid, int skew_ticks = 0) {
    if (skew_ticks > 0) {
        const unsigned long long t0 = __builtin_amdgcn_s_memrealtime();
        while (__builtin_amdgcn_s_memrealtime() - t0 < (unsigned long long)skew_ticks) __builtin_amdgcn_s_sleep(8);
    }
    const int lane = lane_id_fresh(), tid = wid * 64 + lane, wr = wid >> 2, wc = wid & 3, fr = lane & 15, fq = lane >> 4;
    const int K = g.K, nt = K / BK;
    unsigned voffA[2], voffB[2];
#pragma unroll
    for (int i = 0; i < 2; ++i) { int R, C; stage_rc(tid * 16 + i * 8192, R, C); const int Rb = Epi::PERM ? ((R & ~31) + perm32(R & 31)) : R;
        voffA[i] = (unsigned)(R * g.lda + C) * 2u; voffB[i] = (unsigned)(Rb * g.ldb + C) * 2u; }
    const size_t kstep = (size_t)(BK * 2);
    const size_t hstepA = (size_t)HALF * g.lda * 2, hstepB = (size_t)HALF * g.ldb * 2;
    const size_t tstepA = 2 * hstepA, tstepB = 2 * hstepB;
    const unsigned ldsw = (unsigned)wid * 1024u;
    const int aoff = lds_byte(wr * 64 + fr, fq * 8), boff = lds_byte(wc * 32 + fr, fq * 8);
#define PG8_SA(b, h) (((b) * 2 + (h)) * HTB)
#define PG8_SB(b, h) ((4 + (b) * 2 + (h)) * HTB)
#define PG8_STAGE(bufoff, gbase, voff) do { _Pragma("unroll") for (int _i = 0; _i < 2; ++_i) \
        __builtin_amdgcn_global_load_lds((const unsigned*)((const char*)(gbase) + (voff)[_i]), (LAS unsigned*)(lds + (bufoff) + ldsw + _i * 8192), 16, 0, 0); } while (0)
#define PG8_LDA(dst, b, h) do { _Pragma("unroll") for (int m = 0; m < 4; ++m) _Pragma("unroll") for (int k = 0; k < 2; ++k) dst[m][k] = *(const LAS bf16x8*)(lds + PG8_SA(b, h) + aoff + m * 2048 + k * 1024); } while (0)
#define PG8_LDB(dst, b, h) do { _Pragma("unroll") for (int n = 0; n < 2; ++n) _Pragma("unroll") for (int k = 0; k < 2; ++k) dst[n][k] = *(const LAS bf16x8*)(lds + PG8_SB(b, h) + boff + n * 2048 + k * 1024); } while (0)
#define PG8_MMA(ai, bj, At, Bt) do { __builtin_amdgcn_s_setprio(1); _Pragma("unroll") for (int m = 0; m < 4; ++m) _Pragma("unroll") for (int n = 0; n < 2; ++n) _Pragma("unroll") for (int k = 0; k < 2; ++k) \
        acc[ai][bj][m][n] = __builtin_amdgcn_mfma_f32_16x16x32_bf16(Bt[n][k], At[m][k], acc[ai][bj][m][n], 0, 0, 0); __builtin_amdgcn_s_setprio(0); } while (0)
#define PG8_WAIT_V(n) asm volatile("s_waitcnt vmcnt(" #n ")" ::: "memory")
#define PG8_WAIT_L(n) asm volatile("s_waitcnt lgkmcnt(" #n ")" ::: "memory")
#define PG8_BAR __builtin_amdgcn_s_barrier()
#define PG8_SCHED __builtin_amdgcn_sched_barrier(0)
    Unit cur, nxt; int ui = 0;
    if (!S.next(0, cur)) return;
    f32x4 acc[2][2][4][2];
#pragma unroll
    for (int a = 0; a < 2; ++a)
#pragma unroll
        for (int b = 0; b < 2; ++b)
#pragma unroll
            for (int m = 0; m < 4; ++m)
#pragma unroll
                for (int n = 0; n < 2; ++n) acc[a][b][m][n] = (f32x4){0.f, 0.f, 0.f, 0.f};
    bf16x8 At[4][2], B0[2][2], B1[2][2];
    const char* cA = (const char*)g.A + (size_t)cur.pm * tstepA; const char* cB = (const char*)g.Bt + (size_t)cur.pn * tstepB;
    typename Epi::RsPf pf0; E.rs_issue(pf0, cur.pm, wr, wc, fr, fq);
    PG8_STAGE(PG8_SB(0, 0), cB, voffB); PG8_STAGE(PG8_SB(0, 1), cB + hstepB, voffB); PG8_STAGE(PG8_SA(0, 0), cA, voffA); PG8_STAGE(PG8_SA(0, 1), cA + hstepA, voffA);
    if (wr == 1) PG8_BAR;
    PG8_WAIT_V(2); PG8_BAR;
    E.template rs_finish<8>(pf0, lds, 0, wr, wc, fr, fq);
    PG8_STAGE(PG8_SB(1, 0), cB + kstep, voffB); PG8_STAGE(PG8_SA(1, 0), cA + kstep, voffA); PG8_STAGE(PG8_SB(1, 1), cB + hstepB + kstep, voffB);
    PG8_WAIT_V(6); PG8_BAR;
    for (;;) {
        const bool has_next = S.next(ui + 1, nxt);
        const char* nA = has_next ? (const char*)g.A + (size_t)nxt.pm * tstepA : cA; const char* nB = has_next ? (const char*)g.Bt + (size_t)nxt.pn * tstepB : cB;
        for (int t = 0; t < nt; t += 2) {
            const bool last = (t == nt - 2);
            const char* a1 = cA + (size_t)(t + 1) * kstep;
            const char* a2 = last ? nA : cA + (size_t)(t + 2) * kstep; const char* b2 = last ? nB : cB + (size_t)(t + 2) * kstep;
            const char* a3 = a2 + kstep; const char* b3 = b2 + kstep;
            PG8_LDB(B0, 0, 0); PG8_LDB(B1, 0, 1); PG8_SCHED; PG8_LDA(At, 0, 0); PG8_STAGE(PG8_SA(1, 1), a1 + hstepA, voffA);
            PG8_WAIT_V(8); PG8_WAIT_L(0); PG8_BAR; PG8_MMA(0, 0, At, B0); PG8_MMA(0, 1, At, B1); PG8_BAR; PG8_SCHED;
            PG8_LDA(At, 0, 1); PG8_STAGE(PG8_SB(0, 0), b2, voffB); PG8_STAGE(PG8_SB(0, 1), b2 + hstepB, voffB); PG8_STAGE(PG8_SA(0, 0), a2, voffA);
            PG8_WAIT_V(8); PG8_WAIT_L(0); PG8_BAR; PG8_MMA(1, 0, At, B0); PG8_MMA(1, 1, At, B1); PG8_BAR; PG8_SCHED;
            PG8_LDB(B0, 1, 0); PG8_LDB(B1, 1, 1); PG8_SCHED; PG8_LDA(At, 1, 0); PG8_STAGE(PG8_SA(0, 1), a2 + hstepA, voffA);
            PG8_WAIT_V(8); PG8_WAIT_L(0); PG8_BAR; PG8_MMA(0, 0, At, B0); PG8_MMA(0, 1, At, B1); PG8_BAR; PG8_SCHED;
            PG8_LDA(At, 1, 1); PG8_STAGE(PG8_SB(1, 0), b3, voffB); PG8_STAGE(PG8_SB(1, 1), b3 + hstepB, voffB); PG8_STAGE(PG8_SA(1, 0), a3, voffA);
            PG8_WAIT_V(8); PG8_WAIT_L(0); PG8_BAR; PG8_MMA(1, 0, At, B0); PG8_MMA(1, 1, At, B1); PG8_BAR; PG8_SCHED;
        }
        if (wr == 0) PG8_BAR;
        E(acc, cur, wr, wc, fr, fq, lds, ui & 1, nxt, has_next);
        if (!has_next) break;
#pragma unroll
        for (int a = 0; a < 2; ++a)
#pragma unroll
            for (int b = 0; b < 2; ++b)
#pragma unroll
                for (int m = 0; m < 4; ++m)
#pragma unroll
                    for (int n = 0; n < 2; ++n) acc[a][b][m][n] = (f32x4){0.f, 0.f, 0.f, 0.f};
        cur = nxt; cA = nA; cB = nB; ++ui;
        if (wr == 1) PG8_BAR;
    }
    PG8_WAIT_V(0);
    PG8_BAR;
#undef PG8_SA
#undef PG8_SB
#undef PG8_STAGE
#undef PG8_LDA
#undef PG8_LDB
#undef PG8_MMA
#undef PG8_WAIT_V
#undef PG8_WAIT_L
#undef PG8_BAR
#undef PG8_SCHED
}
}

namespace att {
#define SBAR() __builtin_amdgcn_sched_barrier(0)
constexpr int SHM_V = 64 * 128 * 2;
__device__ __forceinline__ int crow(int r, int hi) { return (r & 3) + 8 * (r >> 2) + 4 * hi; }
template <int DQK> struct Cfg {
    static constexpr int KP = DQK * 2, SHM_K = 64 * KP, OFF_K = 2 * SHM_V, OFF_WS = OFF_K + 2 * SHM_K, NPARK = (DQK == 192 ? 6 : 0), NREG = DQK / 16 - NPARK, OFF_QS = OFF_WS + 8 * 256, TOTAL = OFF_QS + 8 * 1024 * NPARK;
    static constexpr float SCALE = (DQK == 192) ? 0.07216878364870322f : 0.08838834764831845f;
    static constexpr float C = SCALE * 1.4426950408889634f;
};
constexpr float THR = 8.f;

template <int DQK>
__device__ __forceinline__ void partialSM(f32x16& p0, f32x16& p1, float& m_reg, float& mn, float& alpha) {
    constexpr float C = Cfg<DQK>::C, SCALE = Cfg<DQK>::SCALE;
    float pmax = p0[0];
#pragma unroll
    for (int r = 1; r < 16; ++r) pmax = fmaxf(pmax, p0[r]);
#pragma unroll
    for (int r = 0; r < 16; ++r) pmax = fmaxf(pmax, p1[r]);
    { auto rr = __builtin_amdgcn_permlane32_swap(__float_as_uint(pmax), __float_as_uint(pmax), false, false);
      pmax = fmaxf(__uint_as_float(rr[0]), __uint_as_float(rr[1])); }
    if (__builtin_expect(__all(pmax - m_reg <= THR / SCALE), 1)) { mn = m_reg; alpha = 1.f; }
    else { mn = fmaxf(m_reg, pmax); alpha = __builtin_amdgcn_exp2f((m_reg - mn) * C); m_reg = mn; }
    const float mnC = -mn * C;
#pragma unroll
    for (int r = 0; r < 16; ++r) p0[r] = fmaf(p0[r], C, mnC);
#pragma unroll
    for (int r = 0; r < 16; ++r) p1[r] = fmaf(p1[r], C, mnC);
#pragma unroll
    for (int r = 0; r < 16; ++r) p0[r] = __builtin_amdgcn_exp2f(p0[r]);
}
__device__ __forceinline__ void finishSM(f32x16& p0, f32x16& p1, float alpha, float& l_reg, bf16x8& pa0, bf16x8& pa1, bf16x8& pa2, bf16x8& pa3) {
#pragma unroll
    for (int r = 0; r < 16; ++r) p1[r] = __builtin_amdgcn_exp2f(p1[r]);
    float ps = 0;
#pragma unroll
    for (int r = 0; r < 16; ++r) ps += p0[r];
#pragma unroll
    for (int r = 0; r < 16; ++r) ps += p1[r];
    { auto rr = __builtin_amdgcn_permlane32_swap(__float_as_uint(ps), __float_as_uint(ps), false, false);
      ps = __uint_as_float(rr[0]) + __uint_as_float(rr[1]); }
    l_reg = l_reg * alpha + ps;
#define PK4(P, BASE, OUT) do { unsigned a0 = cvt_pk_bf16(P[BASE + 0], P[BASE + 1]), a1 = cvt_pk_bf16(P[BASE + 2], P[BASE + 3]);   \
    unsigned b0 = cvt_pk_bf16(P[BASE + 4], P[BASE + 5]), b1 = cvt_pk_bf16(P[BASE + 6], P[BASE + 7]);                              \
    auto r0 = __builtin_amdgcn_permlane32_swap(a0, b0, false, false); auto r1 = __builtin_amdgcn_permlane32_swap(a1, b1, false, false); \
    u32x4 w = {r0[0], r1[0], r0[1], r1[1]}; OUT = __builtin_bit_cast(bf16x8, w); } while (0)
    PK4(p0, 0, pa0); PK4(p0, 8, pa1); PK4(p1, 0, pa2); PK4(p1, 8, pa3);
#undef PK4
}
#define KSWZ(KP, row, colB) ((row) * (KP) + ((colB) ^ (((KP) == 256 ? ((row) & 15) : (((row) >> 1) & 7)) << 4)))
template <int DQK, int NREG = Cfg<DQK>::NREG>
__device__ __forceinline__ void qkt(f32x16& p0, f32x16& p1, const LAS char* Ks, const bf16x8* qr, const LAS char* Qs, int r32, int hi) {
    constexpr int KP = Cfg<DQK>::KP;
    p0 = f32x16{}; p1 = f32x16{};
#pragma unroll
    for (int d0 = 0; d0 < DQK / 16; ++d0) { const int cb = (d0 * 16 + hi * 8) * 2;
        const bf16x8 b0 = *(const LAS bf16x8*)(Ks + KSWZ(KP, r32, cb));
        const bf16x8 b1 = *(const LAS bf16x8*)(Ks + KSWZ(KP, 32 + r32, cb));
        bf16x8 q;
        if (d0 < NREG) q = qr[d0]; else q = *(const LAS bf16x8*)(Qs + (d0 - NREG) * 1024);
        p0 = __builtin_amdgcn_mfma_f32_32x32x16_bf16(b0, q, p0, 0, 0, 0);
        p1 = __builtin_amdgcn_mfma_f32_32x32x16_bf16(b1, q, p1, 0, 0, 0); }
}
__device__ __forceinline__ int v_st(int k, int c) { const int kk = (k & ~0xC) | ((k & 4) << 1) | ((k & 8) >> 1); return ((kk >> 3) * 4 + (c >> 5)) * 512 + ((kk & 7) * 32 + (c & 31)) * 2; }
__device__ __forceinline__ int v_rd_base(int lane) { return ((lane & 3) << 3) | (((lane >> 2) & 3) << 6) | (((lane >> 4) & 1) << 5) | (((lane >> 5) & 1) << 8); }
constexpr int v_rd_off(int d0, int ks, int half) { return d0 * 512 + ks * 4096 + half * 2048; }
template <int OFF> __device__ __forceinline__ s16x4 tr_read(int vb) {
    s16x4 r; asm volatile("ds_read_b64_tr_b16 %0, %1 offset:%2" : "=&v"(r) : "v"(vb), "i"(OFF) : "memory"); return r;
}
template <int D0> __device__ __forceinline__ void pv_one(f32x16& od, int vb, bf16x8 pa0, bf16x8 pa1, bf16x8 pa2, bf16x8 pa3) {
    const s16x4 l0 = tr_read<v_rd_off(D0, 0, 0)>(vb), h0 = tr_read<v_rd_off(D0, 0, 1)>(vb), l1 = tr_read<v_rd_off(D0, 1, 0)>(vb), h1 = tr_read<v_rd_off(D0, 1, 1)>(vb);
    const s16x4 l2 = tr_read<v_rd_off(D0, 2, 0)>(vb), h2 = tr_read<v_rd_off(D0, 2, 1)>(vb), l3 = tr_read<v_rd_off(D0, 3, 0)>(vb), h3 = tr_read<v_rd_off(D0, 3, 1)>(vb);
    asm volatile("s_waitcnt lgkmcnt(0)" ::: "memory"); SBAR();
#define PKV(L, H) (bf16x8){L[0], L[1], L[2], L[3], H[0], H[1], H[2], H[3]}
    od = __builtin_amdgcn_mfma_f32_32x32x16_bf16(pa0, PKV(l0, h0), od, 0, 0, 0);
    od = __builtin_amdgcn_mfma_f32_32x32x16_bf16(pa1, PKV(l1, h1), od, 0, 0, 0);
    od = __builtin_amdgcn_mfma_f32_32x32x16_bf16(pa2, PKV(l2, h2), od, 0, 0, 0);
    od = __builtin_amdgcn_mfma_f32_32x32x16_bf16(pa3, PKV(l3, h3), od, 0, 0, 0);
#undef PKV
}
__device__ __forceinline__ void pv_d0(f32x16* o, int vb, bf16x8 pa0, bf16x8 pa1, bf16x8 pa2, bf16x8 pa3) {
    pv_one<0>(o[0], vb, pa0, pa1, pa2, pa3); pv_one<1>(o[1], vb, pa0, pa1, pa2, pa3); pv_one<2>(o[2], vb, pa0, pa1, pa2, pa3); pv_one<3>(o[3], vb, pa0, pa1, pa2, pa3);
}
__device__ __forceinline__ void store_o(const f32x16* o, float l_reg, LAS float* li_l, LAS char* lds, bf16* Ob, int ldo, int wid, int lane, int r32, int hi) {
    if (hi == 0) li_l[r32] = l_reg;
    asm volatile("s_waitcnt lgkmcnt(0)" ::: "memory");
    float rli[16];
#pragma unroll
    for (int r = 0; r < 16; ++r) rli[r] = __builtin_amdgcn_rcpf(li_l[crow(r, hi)]);
    LAS unsigned short* slab = (LAS unsigned short*)(lds + wid * 8192);
#pragma unroll
    for (int r = 0; r < 16; ++r) { const int orow = crow(r, hi);
#pragma unroll
        for (int d0 = 0; d0 < 4; ++d0) slab[orow * 128 + d0 * 32 + r32] = (unsigned short)(cvt_pk_bf16(o[d0][r] * rli[r], 0.f) & 0xffffu); }
    asm volatile("s_waitcnt lgkmcnt(0)" ::: "memory");
#pragma unroll
    for (int i = 0; i < 8; ++i) { const int id = i * 64 + lane, row = id >> 4, c16 = id & 15;
        const u32x4 w = *(const LAS u32x4*)((LAS char*)slab + row * 256 + c16 * 16);
        *(u32x4*)(Ob + (unsigned)(wid * 32 + row) * (unsigned)ldo + c16 * 8) = w; }
}

__device__ __forceinline__ void unpack8(bf16x8 v, float (&x)[8]) {
#pragma unroll
    for (int e = 0; e < 8; ++e) x[e] = bf2f((unsigned short)v[e]);
}
__device__ __forceinline__ bf16x8 pack8(const float (&x)[8]) {
    u32x4 w; w.x = cvt_pk_bf16(x[0], x[1]); w.y = cvt_pk_bf16(x[2], x[3]); w.z = cvt_pk_bf16(x[4], x[5]); w.w = cvt_pk_bf16(x[6], x[7]); return __builtin_bit_cast(bf16x8, w);
}
__device__ __forceinline__ void rope_pair(bf16x8& f1, bf16x8& f2, const float* ct, const float* st, float mul, const float* g1, const float* g2) {
    float x1[8], x2[8], a[8], b[8]; unpack8(f1, x1); unpack8(f2, x2);
    const f32x4 c0 = *(const f32x4*)ct, c1 = *(const f32x4*)(ct + 4), s0 = *(const f32x4*)st, s1 = *(const f32x4*)(st + 4);
    const float c[8] = {c0.x, c0.y, c0.z, c0.w, c1.x, c1.y, c1.z, c1.w}, s[8] = {s0.x, s0.y, s0.z, s0.w, s1.x, s1.y, s1.z, s1.w};
    if (g1) {
        const f32x4 ga = *(const f32x4*)g1, gb = *(const f32x4*)(g1 + 4), gc = *(const f32x4*)g2, gd = *(const f32x4*)(g2 + 4);
        const float gg1[8] = {ga.x, ga.y, ga.z, ga.w, gb.x, gb.y, gb.z, gb.w}, gg2[8] = {gc.x, gc.y, gc.z, gc.w, gd.x, gd.y, gd.z, gd.w};
#pragma unroll
        for (int e = 0; e < 8; ++e) { x1[e] = x1[e] * mul * gg1[e]; x2[e] = x2[e] * mul * gg2[e]; }
    }
#pragma unroll
    for (int e = 0; e < 8; ++e) { a[e] = x1[e] * c[e] - x2[e] * s[e]; b[e] = x2[e] * c[e] + x1[e] * s[e]; }
    f1 = pack8(a); f2 = pack8(b);
}
template <int ND0, int QMODE>
__device__ __forceinline__ void load_q(bf16x8 (&qraw)[ND0], const bf16* __restrict__ Qb, int ldq, int wid, int r32, int hi, int qpos0, const float* __restrict__ tab, const float* __restrict__ qgain) {
    const unsigned qo = (unsigned)(wid * 32 + r32) * (unsigned)ldq + hi * 8;
#pragma unroll
    for (int d0 = 0; d0 < ND0; ++d0) qraw[d0] = *(const bf16x8*)(Qb + qo + d0 * 16);
    const int pos = qpos0 + wid * 32 + r32;
    if constexpr (QMODE == 1) {
        const float* ct = tab + pos * 32 + hi * 8; const float* st = ct + 4096 * 32;
        rope_pair(qraw[8], qraw[10], ct, st, 1.f, nullptr, nullptr); rope_pair(qraw[9], qraw[11], ct + 16, st + 16, 1.f, nullptr, nullptr);
    } else if constexpr (QMODE == 2) {
        const float* ct = tab + pos * 64 + hi * 8; const float* st = ct + 4096 * 64;
#pragma unroll
        for (int g = 0; g < 4; ++g) rope_pair(qraw[g], qraw[g + 4], ct + g * 16, st + g * 16, 1.f, nullptr, nullptr);
    } else if constexpr (QMODE == 3) {
        float ss = 0.f;
#pragma unroll
        for (int d0 = 0; d0 < 8; ++d0) { float x[8]; unpack8(qraw[d0], x);
#pragma unroll
            for (int e = 0; e < 8; ++e) ss += x[e] * x[e]; }
        ss += other_half(ss, hi == 0);
        const float rstd = 1.f / sqrtf(ss * (1.f / 128.f) + EPS);
        const float* ctr = tab + (pos >> 6) * 32 + hi * 8; const float* str = ctr + 4096 * 32; const float* ctc = tab + (pos & 63) * 32 + hi * 8; const float* stc = ctc + 4096 * 32;
        const float* gq = qgain + hi * 8;
#pragma unroll
        for (int g = 0; g < 2; ++g) { rope_pair(qraw[g], qraw[g + 2], ctr + g * 16, str + g * 16, rstd, gq + g * 16, gq + (g + 2) * 16);
                                      rope_pair(qraw[4 + g], qraw[6 + g], ctc + g * 16, stc + g * 16, rstd, gq + (4 + g) * 16, gq + (6 + g) * 16); }
    }
}
template <int DQK, int SDEPTH, int QMODE>
__device__ __forceinline__ void dense_unit(const bf16* __restrict__ Qb, int ldq, const bf16* __restrict__ Kh, int ldk, const bf16* __restrict__ K2h, int ldk2,
                                           const bf16* __restrict__ Vh, int ldv, bf16* __restrict__ Ob, int ldo, int seq, LAS char* lds, int wid,
                                           int qpos0, const float* __restrict__ tab, const float* __restrict__ qgain) {
    using CF = Cfg<DQK>; constexpr int KP = CF::KP, SHM_K = CF::SHM_K, ND0 = DQK / 16;
    const int lane = lane_id_fresh(), tid = wid * 64 + lane, r32 = lane & 31, hi = lane >> 5;
    LAS char* V_lds = lds; LAS char* K_lds = lds + CF::OFF_K;
    LAS float* ws = (LAS float*)(lds + CF::OFF_WS) + wid * 64; LAS float* li_l = ws; LAS float* al_l = ws + 32;
    float m_reg = -1e30f, l_reg = 0; f32x16 o[4] = {}; bf16x8 qr[CF::NREG];
    const LAS char* Qs = lds + CF::OFF_QS + wid * (1024 * CF::NPARK) + lane * 16;
    { bf16x8 qraw[ND0]; load_q<ND0, QMODE>(qraw, Qb, ldq, wid, r32, hi, qpos0, tab, qgain);
#pragma unroll
      for (int d0 = 0; d0 < CF::NREG; ++d0) qr[d0] = qraw[d0];
      if constexpr (CF::NPARK > 0) {
#pragma unroll
          for (int d0 = CF::NREG; d0 < ND0; ++d0) *(LAS bf16x8*)((LAS char*)Qs + (d0 - CF::NREG) * 1024) = qraw[d0]; } }
    const int sr = tid >> 4, sc = (tid & 15) * 8, vst0 = v_st(sr, sc), vst1 = v_st(32 + sr, sc);
    const int kst0 = KSWZ(KP, sr, sc * 2), kst1 = KSWZ(KP, 32 + sr, sc * 2);
    const int kr2 = tid >> 3, c2 = (tid & 7) * 8, kst2 = KSWZ(KP, kr2, (128 + c2) * 2);
    const unsigned vo = (unsigned)sr * (unsigned)ldv + sc, ko = (unsigned)sr * (unsigned)ldk + sc, k2o = (unsigned)kr2 * (unsigned)ldk2 + c2;
    const int vb0 = (int)(unsigned)(uintptr_t)V_lds + v_rd_base(lane);
    struct { bf16x8 vs0, vs1, ks0, ks1, k2; } sr_[SDEPTH];
#define SLOAD(i, k0) do { const bf16* Vt_ = Vh + (size_t)(k0) * ldv; const bf16* Kt_ = Kh + (size_t)(k0) * ldk; \
    sr_[i].vs0 = *(const bf16x8*)(Vt_ + vo); sr_[i].vs1 = *(const bf16x8*)(Vt_ + (size_t)32 * ldv + vo); \
    sr_[i].ks0 = *(const bf16x8*)(Kt_ + ko); sr_[i].ks1 = *(const bf16x8*)(Kt_ + (size_t)32 * ldk + ko); \
    if constexpr (DQK == 192) sr_[i].k2 = *(const bf16x8*)(K2h + (size_t)(k0) * ldk2 + k2o); } while (0)
#define SWRITE(b, i) do { *(LAS bf16x8*)(V_lds + (b) * SHM_V + vst0) = sr_[i].vs0; *(LAS bf16x8*)(V_lds + (b) * SHM_V + vst1) = sr_[i].vs1; \
    *(LAS bf16x8*)(K_lds + (b) * SHM_K + kst0) = sr_[i].ks0; *(LAS bf16x8*)(K_lds + (b) * SHM_K + kst1) = sr_[i].ks1; \
    if constexpr (DQK == 192) *(LAS bf16x8*)(K_lds + (b) * SHM_K + kst2) = sr_[i].k2; } while (0)
#define SWAIT() do { if constexpr (SDEPTH == 1) asm volatile("s_waitcnt vmcnt(0)" ::: "memory"); else if constexpr (DQK == 192) asm volatile("s_waitcnt vmcnt(5)" ::: "memory"); else asm volatile("s_waitcnt vmcnt(4)" ::: "memory"); } while (0)
#define RESC(a) do { if (__any((a) < 1.f)) { if (hi == 0) al_l[r32] = (a); asm volatile("s_waitcnt lgkmcnt(0)" ::: "memory"); \
    _Pragma("unroll") for (int d = 0; d < 4; ++d) _Pragma("unroll") for (int r = 0; r < 16; ++r) o[d][r] *= al_l[crow(r, hi)]; } } while (0)
    f32x16 pA0, pA1, pB0, pB1; float mnA, mnB, alA, alB; bf16x8 pa0, pa1, pa2, pa3; const int NT = seq / 64;
    constexpr int SE = 0, SO = SDEPTH - 1;
    __syncthreads();
    SLOAD(SE, 0); asm volatile("s_waitcnt vmcnt(0)" ::: "memory"); SWRITE(0, SE); __syncthreads();
    qkt<DQK>(pA0, pA1, K_lds, qr, Qs, r32, hi); partialSM<DQK>(pA0, pA1, m_reg, mnA, alA);
    SLOAD(SO, 64); if constexpr (SDEPTH == 2) { if (2 < NT) SLOAD(SE, 128); }
    SWAIT(); SWRITE(1, SO); __syncthreads();
    for (int j = 1; j + 1 < NT; j += 2) {
        SBAR(); qkt<DQK>(pB0, pB1, K_lds + SHM_K, qr, Qs, r32, hi);
        finishSM(pA0, pA1, alA, l_reg, pa0, pa1, pa2, pa3); SBAR();
        SLOAD(SO, (j + SDEPTH) * 64); SBAR();
        pv_d0(o, vb0, pa0, pa1, pa2, pa3); partialSM<DQK>(pB0, pB1, m_reg, mnB, alB);
        __syncthreads(); SWAIT(); SWRITE(0, SE);
        RESC(alB); __syncthreads();
        SBAR(); qkt<DQK>(pA0, pA1, K_lds, qr, Qs, r32, hi);
        finishSM(pB0, pB1, alB, l_reg, pa0, pa1, pa2, pa3); SBAR();
        if (SDEPTH == 1 || j + 3 < NT) SLOAD(SE, (j + 1 + SDEPTH) * 64); SBAR();
        pv_d0(o, vb0 + SHM_V, pa0, pa1, pa2, pa3); partialSM<DQK>(pA0, pA1, m_reg, mnA, alA);
        __syncthreads(); SWAIT(); SWRITE(1, SO);
        RESC(alA); __syncthreads();
    }
    SBAR(); qkt<DQK>(pB0, pB1, K_lds + SHM_K, qr, Qs, r32, hi);
    finishSM(pA0, pA1, alA, l_reg, pa0, pa1, pa2, pa3); SBAR();
    pv_d0(o, vb0, pa0, pa1, pa2, pa3); partialSM<DQK>(pB0, pB1, m_reg, mnB, alB);
    __syncthreads(); RESC(alB);
    finishSM(pB0, pB1, alB, l_reg, pa0, pa1, pa2, pa3); SBAR();
    pv_d0(o, vb0 + SHM_V, pa0, pa1, pa2, pa3);
    __syncthreads();
    store_o(o, l_reg, li_l, lds, Ob, ldo, wid, lane, r32, hi);
#undef SLOAD
#undef SWRITE
#undef SWAIT
}

constexpr int R3_SLOT = 32768, R3_OFF_WS = 3 * R3_SLOT, R3_TOTAL = R3_OFF_WS + 8 * 256;
template <int QMODE>
__device__ __forceinline__ void dense_unit3(const bf16* __restrict__ Qb, int ldq, const bf16* __restrict__ Kh, int ldk, const bf16* __restrict__ Vh, int ldv, bf16* __restrict__ Ob, int ldo, int seq,
                                            LAS char* lds, int wid, int qpos0, const float* __restrict__ tab, const float* __restrict__ qgain) {
    constexpr int KP = 256;
    const int lane = lane_id_fresh(), tid = wid * 64 + lane, r32 = lane & 31, hi = lane >> 5;
    LAS float* ws = (LAS float*)(lds + R3_OFF_WS) + wid * 64; LAS float* li_l = ws; LAS float* al_l = ws + 32;
    float m_reg = -1e30f, l_reg = 0; f32x16 o[4] = {}; bf16x8 qr[8];
    load_q<8, QMODE>(qr, Qb, ldq, wid, r32, hi, qpos0, tab, qgain);
    const int sr = tid >> 4, sc = (tid & 15) * 8, vst0 = v_st(sr, sc), vst1 = v_st(32 + sr, sc);
    const int kst0 = 16384 + KSWZ(KP, sr, sc * 2), kst1 = 16384 + KSWZ(KP, 32 + sr, sc * 2);
    const unsigned vo = (unsigned)sr * (unsigned)ldv + sc, ko = (unsigned)sr * (unsigned)ldk + sc;
    const int vbase = (int)(unsigned)(uintptr_t)lds + v_rd_base(lane);
    struct { bf16x8 vs0, vs1, ks0, ks1; } sr_[2];
#define SLOAD3(i, k0) do { const bf16* Vt_ = Vh + (size_t)(k0) * ldv; const bf16* Kt_ = Kh + (size_t)(k0) * ldk; \
    sr_[i].vs0 = *(const bf16x8*)(Vt_ + vo); sr_[i].vs1 = *(const bf16x8*)(Vt_ + (size_t)32 * ldv + vo); \
    sr_[i].ks0 = *(const bf16x8*)(Kt_ + ko); sr_[i].ks1 = *(const bf16x8*)(Kt_ + (size_t)32 * ldk + ko); } while (0)
#define SWRITE3(soff, i) do { *(LAS bf16x8*)(lds + (soff) + vst0) = sr_[i].vs0; *(LAS bf16x8*)(lds + (soff) + vst1) = sr_[i].vs1; \
    *(LAS bf16x8*)(lds + (soff) + kst0) = sr_[i].ks0; *(LAS bf16x8*)(lds + (soff) + kst1) = sr_[i].ks1; } while (0)
#define SWAIT3() asm volatile("s_waitcnt vmcnt(4)" ::: "memory")
#define RESC3(a) do { if (__any((a) < 1.f)) { if (hi == 0) al_l[r32] = (a); asm volatile("s_waitcnt lgkmcnt(0)" ::: "memory"); \
    _Pragma("unroll") for (int d = 0; d < 4; ++d) _Pragma("unroll") for (int r = 0; r < 16; ++r) o[d][r] *= al_l[crow(r, hi)]; } } while (0)
    f32x16 pA0, pA1, pB0, pB1; float mnA, mnB, alA, alB; bf16x8 pa0, pa1, pa2, pa3; const int NT = seq / 64;
    __syncthreads();
    SLOAD3(0, 0); SLOAD3(1, 64);
    SWAIT3(); SWRITE3(0, 0);
    if (2 < NT) SLOAD3(0, 128);
    __syncthreads();
    qkt<128>(pA0, pA1, lds + 16384, qr, nullptr, r32, hi); partialSM<128>(pA0, pA1, m_reg, mnA, alA);
    SWAIT3(); SWRITE3(R3_SLOT, 1);
    int sK = R3_SLOT, sV = 0, sW = 2 * R3_SLOT;
    for (int t = 1; t + 1 < NT; t += 2) {
        __syncthreads();
        SBAR(); qkt<128>(pB0, pB1, lds + sK + 16384, qr, nullptr, r32, hi);
        finishSM(pA0, pA1, alA, l_reg, pa0, pa1, pa2, pa3); SBAR();
        if (t + 2 < NT) SLOAD3(1, (t + 2) * 64); SBAR();
        pv_d0(o, vbase + sV, pa0, pa1, pa2, pa3); partialSM<128>(pB0, pB1, m_reg, mnB, alB);
        SWAIT3(); SWRITE3(sW, 0);
        RESC3(alB);
        { const int n = sV; sV = sK; sK = sW; sW = n; }
        __syncthreads();
        SBAR(); qkt<128>(pA0, pA1, lds + sK + 16384, qr, nullptr, r32, hi);
        finishSM(pB0, pB1, alB, l_reg, pa0, pa1, pa2, pa3); SBAR();
        if (t + 3 < NT) SLOAD3(0, (t + 3) * 64); SBAR();
        pv_d0(o, vbase + sV, pa0, pa1, pa2, pa3); partialSM<128>(pA0, pA1, m_reg, mnA, alA);
        SWAIT3(); if (t + 2 < NT) SWRITE3(sW, 1);
        RESC3(alA);
        { const int n = sV; sV = sK; sK = sW; sW = n; }
    }
    __syncthreads();
    SBAR(); qkt<128>(pB0, pB1, lds + sK + 16384, qr, nullptr, r32, hi);
    finishSM(pA0, pA1, alA, l_reg, pa0, pa1, pa2, pa3); SBAR();
    pv_d0(o, vbase + sV, pa0, pa1, pa2, pa3); partialSM<128>(pB0, pB1, m_reg, mnB, alB);
    RESC3(alB);
    finishSM(pB0, pB1, alB, l_reg, pa0, pa1, pa2, pa3); SBAR();
    pv_d0(o, vbase + sK, pa0, pa1, pa2, pa3);
    __syncthreads();
    store_o(o, l_reg, li_l, lds, Ob, ldo, wid, lane, r32, hi);
#undef SLOAD3
#undef SWRITE3
#undef SWAIT3
#undef RESC3
}

constexpr int DV_SLOT = 49152, DV_OFF_K = 32768, DV_OFF_WS = 131072, DV_TOTAL = DV_OFF_WS + 8 * 256;
__device__ __forceinline__ void dense_unit_dv256(const bf16* __restrict__ Qb, int ldq, const bf16* __restrict__ Kh, int ldk, const bf16* __restrict__ Vh, int ldv, bf16* __restrict__ Ob, int ldo, int seq,
                                                 LAS char* lds, int wid, int qpos0, const float* __restrict__ tab) {
    constexpr int KP = 256;
    const int lane = lane_id_fresh(), tid = wid * 64 + lane, r32 = lane & 31, hi = lane >> 5;
    LAS float* ws = (LAS float*)(lds + DV_OFF_WS) + wid * 64; LAS float* li_l = ws; LAS float* al_l = ws + 32;
    __syncthreads();
    float m_reg = -1e30f, l_reg = 0; f32x16 o[8] = {}; bf16x8 qr[4];
    const LAS char* Qs = lds + 2 * DV_SLOT + wid * 4096 + lane * 16;
    { bf16x8 qraw[8]; load_q<8, 2>(qraw, Qb, ldq, wid, r32, hi, qpos0, tab, nullptr);
#pragma unroll
      for (int d0 = 0; d0 < 4; ++d0) qr[d0] = qraw[d0];
#pragma unroll
      for (int d0 = 4; d0 < 8; ++d0) *(LAS bf16x8*)((LAS char*)Qs + (d0 - 4) * 1024) = qraw[d0]; }
    const int sr = tid >> 4, sc = (tid & 15) * 8, vst0 = v_st(sr, sc), vst1 = v_st(32 + sr, sc);
    const int kst0 = DV_OFF_K + KSWZ(KP, sr, sc * 2), kst1 = DV_OFF_K + KSWZ(KP, 32 + sr, sc * 2);
    const unsigned vo = (unsigned)sr * (unsigned)ldv + sc, ko = (unsigned)sr * (unsigned)ldk + sc;
    const int vbase = (int)(unsigned)(uintptr_t)lds + v_rd_base(lane);
    bf16x8 sv0, sv1, sv2, sv3, sk0, sk1;
#define DLOAD(k0) do { const bf16* Vt_ = Vh + (size_t)(k0) * ldv; const bf16* Kt_ = Kh + (size_t)(k0) * ldk; \
    sv0 = *(const bf16x8*)(Vt_ + vo); sv1 = *(const bf16x8*)(Vt_ + (size_t)32 * ldv + vo); sv2 = *(const bf16x8*)(Vt_ + vo + 128); sv3 = *(const bf16x8*)(Vt_ + (size_t)32 * ldv + vo + 128); \
    sk0 = *(const bf16x8*)(Kt_ + ko); sk1 = *(const bf16x8*)(Kt_ + (size_t)32 * ldk + ko); } while (0)
#define DWRITE(soff) do { *(LAS bf16x8*)(lds + (soff) + vst0) = sv0; *(LAS bf16x8*)(lds + (soff) + vst1) = sv1; *(LAS bf16x8*)(lds + (soff) + 16384 + vst0) = sv2; *(LAS bf16x8*)(lds + (soff) + 16384 + vst1) = sv3; \
    *(LAS bf16x8*)(lds + (soff) + kst0) = sk0; *(LAS bf16x8*)(lds + (soff) + kst1) = sk1; } while (0)
    const int NT = seq / 64;
    __syncthreads();
    DLOAD(0); asm volatile("s_waitcnt vmcnt(0)" ::: "memory"); DWRITE(0);
    __syncthreads();
    int sC = 0, sN = DV_SLOT;
    for (int t = 0; t < NT; ++t) {
        f32x16 p0, p1; float mn, al; bf16x8 pa0, pa1, pa2, pa3;
        SBAR(); qkt<128, 4>(p0, p1, lds + sC + DV_OFF_K, qr, Qs, r32, hi);
        partialSM<128>(p0, p1, m_reg, mn, al);
        if (__any(al < 1.f)) { if (hi == 0) al_l[r32] = al; asm volatile("s_waitcnt lgkmcnt(0)" ::: "memory");
#pragma unroll
            for (int d = 0; d < 8; ++d)
#pragma unroll
                for (int r = 0; r < 16; ++r) o[d][r] *= al_l[crow(r, hi)]; }
        finishSM(p0, p1, al, l_reg, pa0, pa1, pa2, pa3); SBAR();
        if (t + 1 < NT) DLOAD((t + 1) * 64);
        SBAR();
        pv_d0(o, vbase + sC, pa0, pa1, pa2, pa3);
        pv_d0(o + 4, vbase + sC + 16384, pa0, pa1, pa2, pa3);
        if (t + 1 < NT) { asm volatile("s_waitcnt vmcnt(0)" ::: "memory"); DWRITE(sN); }
        __syncthreads();
        { const int n = sC; sC = sN; sN = n; }
    }
    if (hi == 0) li_l[r32] = l_reg;
    asm volatile("s_waitcnt lgkmcnt(0)" ::: "memory");
    float rli[16];
#pragma unroll
    for (int r = 0; r < 16; ++r) rli[r] = __builtin_amdgcn_rcpf(li_l[crow(r, hi)]);
    LAS unsigned short* slab = (LAS unsigned short*)(lds + wid * 16384);
#pragma unroll
    for (int r = 0; r < 16; ++r) { const int orow = crow(r, hi);
#pragma unroll
        for (int d0 = 0; d0 < 8; ++d0) slab[orow * 256 + d0 * 32 + r32] = (unsigned short)(cvt_pk_bf16(o[d0][r] * rli[r], 0.f) & 0xffffu); }
    asm volatile("s_waitcnt lgkmcnt(0)" ::: "memory");
#pragma unroll
    for (int i = 0; i < 16; ++i) { const int id = i * 64 + lane, row = id >> 5, c16 = id & 31;
        const u32x4 w = *(const LAS u32x4*)((LAS char*)slab + row * 512 + c16 * 16);
        *(u32x4*)(Ob + (unsigned)(wid * 32 + row) * (unsigned)ldo + c16 * 8) = w; }
#undef DLOAD
#undef DWRITE
}

constexpr int NA_OFF_K = SHM_V, NA_OFF_RPB = 65536, NA_OFF_WS = 65536 + 2048, NA_TOTAL = NA_OFF_WS + 8 * 256;
__device__ __forceinline__ int clampi(int v, int lo, int hi) { return v < lo ? lo : (v > hi ? hi : v); }
__device__ __forceinline__ void na_unit(const bf16* __restrict__ Qb, int ldq, const bf16* __restrict__ Kseq, const bf16* __restrict__ Vseq, int ldk,
                                        bf16* __restrict__ Ob, int ldo, int r0, const float* __restrict__ rpb_h, LAS char* lds, int wid) {
    constexpr int KP = 256;
    const int lane = lane_id_fresh(), tid = wid * 64 + lane, r32 = lane & 31, hi = lane >> 5;
    LAS char* V_lds = lds; LAS char* K_lds = lds + NA_OFF_K; LAS float* rpb_l = (LAS float*)(lds + NA_OFF_RPB);
    LAS float* ws = (LAS float*)(lds + NA_OFF_WS) + wid * 64; LAS float* li_l = ws; LAS float* al_l = ws + 32;
    float m_reg = -1e30f, l_reg = 0; f32x16 o[4] = {}; bf16x8 qr[8];
    { const unsigned qo = (unsigned)(wid * 32 + r32) * (unsigned)ldq + hi * 8;
#pragma unroll
      for (int d0 = 0; d0 < 8; ++d0) qr[d0] = *(const bf16x8*)(Qb + qo + d0 * 16); }
    const int sr = tid >> 4, sc = (tid & 15) * 8, vst0 = v_st(sr, sc), vst1 = v_st(32 + sr, sc);
    const int kst0 = KSWZ(KP, sr, sc * 2), kst1 = KSWZ(KP, 32 + sr, sc * 2);
    const unsigned ko = (unsigned)sr * (unsigned)ldk + sc;
    const int vb0 = (int)(unsigned)(uintptr_t)V_lds + v_rd_base(lane);
    const int kr_lo = clampi(r0 - 4, 0, 56), kr_hi = clampi(r0 + 3 - 4, 0, 56) + 8;
    const int qrw = r0 + (wid >> 1), srw = clampi(qrw - 4, 0, 56);
    const int qc = (wid & 1) * 32 + r32, scq = clampi(qc - 8, 0, 48);
    __syncthreads();
    if (tid < 465) rpb_l[tid] = rpb_h[tid] * 11.313708498984761f;
    bf16x8 va0, va1, ka0, ka1, vb0_, vb1_, kb0, kb1;
#define NA_LOAD(V0, V1, K0, K1, kr_) do { const bf16* Kt = Kseq + (size_t)((kr_) * 64) * ldk; const bf16* Vt = Vseq + (size_t)((kr_) * 64) * ldk; \
      V0 = *(const bf16x8*)(Vt + ko); V1 = *(const bf16x8*)(Vt + (size_t)32 * ldk + ko); K0 = *(const bf16x8*)(Kt + ko); K1 = *(const bf16x8*)(Kt + (size_t)32 * ldk + ko); } while (0)
#define NA_STEP(V0, V1, K0, K1, kr_) do { \
        __syncthreads();                                            \
        *(LAS bf16x8*)(V_lds + vst0) = V0; *(LAS bf16x8*)(V_lds + vst1) = V1; *(LAS bf16x8*)(K_lds + kst0) = K0; *(LAS bf16x8*)(K_lds + kst1) = K1; \
        __syncthreads(); \
        if ((kr_) + 2 < kr_hi) NA_LOAD(V0, V1, K0, K1, (kr_) + 2);     \
        if ((kr_) >= srw && (kr_) < srw + 8) {                      \
            f32x16 p0, p1; float mn, al; bf16x8 pa0, pa1, pa2, pa3; \
            qkt<128>(p0, p1, K_lds, qr, nullptr, r32, hi); \
            const LAS float* bt = rpb_l + ((kr_) - qrw + 7) * 31 + (15 - qc); \
            _Pragma("unroll") for (int r = 0; r < 16; ++r) { const int kc = crow(r, hi); const bool in = (kc >= scq) && (kc < scq + 16); const float b = bt[in ? kc : qc]; p0[r] = in ? p0[r] + b : -1e30f; } \
            _Pragma("unroll") for (int r = 0; r < 16; ++r) { const int kc = 32 + crow(r, hi); const bool in = (kc >= scq) && (kc < scq + 16); const float b = bt[in ? kc : qc]; p1[r] = in ? p1[r] + b : -1e30f; } \
            partialSM<128>(p0, p1, m_reg, mn, al); \
            RESC(al); \
            finishSM(p0, p1, al, l_reg, pa0, pa1, pa2, pa3); SBAR(); \
            pv_d0(o, vb0, pa0, pa1, pa2, pa3); \
        } } while (0)
    NA_LOAD(va0, va1, ka0, ka1, kr_lo);
    if (kr_lo + 1 < kr_hi) NA_LOAD(vb0_, vb1_, kb0, kb1, kr_lo + 1);
    for (int kr = kr_lo; kr < kr_hi; kr += 2) {
        NA_STEP(va0, va1, ka0, ka1, kr);
        if (kr + 1 < kr_hi) NA_STEP(vb0_, vb1_, kb0, kb1, kr + 1);
    }
#undef NA_LOAD
#undef NA_STEP
    __syncthreads();
    store_o(o, l_reg, li_l, lds, Ob, ldo, wid, lane, r32, hi);
}
template <int D0> __device__ __forceinline__ void na2_pv(f32x16& od, int vbA, int vbB, bf16x8 pa0, bf16x8 pa1) {
    const s16x4 l0 = tr_read<v_rd_off(D0, 0, 0)>(vbA), h0 = tr_read<v_rd_off(D0, 0, 1)>(vbA), l1 = tr_read<v_rd_off(D0, 0, 0)>(vbB), h1 = tr_read<v_rd_off(D0, 0, 1)>(vbB);
    asm volatile("s_waitcnt lgkmcnt(0)" ::: "memory"); SBAR();
    od = __builtin_amdgcn_mfma_f32_32x32x16_bf16(pa0, (bf16x8){l0[0], l0[1], l0[2], l0[3], h0[0], h0[1], h0[2], h0[3]}, od, 0, 0, 0);
    od = __builtin_amdgcn_mfma_f32_32x32x16_bf16(pa1, (bf16x8){l1[0], l1[1], l1[2], l1[3], h1[0], h1[1], h1[2], h1[3]}, od, 0, 0, 0);
}
__device__ __forceinline__ void na_unit2(const bf16* __restrict__ Qb, int ldq, const bf16* __restrict__ Kseq, const bf16* __restrict__ Vseq, int ldk,
                                         bf16* __restrict__ Ob, int ldo, int r0, const float* __restrict__ rpb_h, LAS char* lds, int wid) {
    constexpr int KP = 256; constexpr float NEG = -3.0e38f;
    const int lane = lane_id_fresh(), tid = wid * 64 + lane, r32 = lane & 31, hi = lane >> 5;
    LAS char* V_lds = lds; LAS char* K_lds = lds + NA_OFF_K; LAS float* rpb_l = (LAS float*)(lds + NA_OFF_RPB);
    LAS float* ws = (LAS float*)(lds + NA_OFF_WS) + wid * 64; LAS float* li_l = ws; LAS float* al_l = ws + 32;
    float m_reg = -1e30f, l_reg = 0; f32x16 o[4] = {}; bf16x8 qr[8];
    const int typ = wid & 3, rp = wid >> 2, c15 = r32 & 15;
    const int g0 = (typ == 3) ? 0 : typ, g1 = (typ == 3) ? 3 : typ + 1;
    const int qc = (typ == 3) ? (c15 < 8 ? c15 : 48 + c15) : 8 + 16 * typ + c15;
    const int qrl = 2 * rp + (r32 >> 4), qrow = r0 + qrl;
    { const unsigned qo = (unsigned)(qrl * 64 + qc) * (unsigned)ldq + hi * 8;
#pragma unroll
      for (int d0 = 0; d0 < 8; ++d0) qr[d0] = *(const bf16x8*)(Qb + qo + d0 * 16); }
    const int sr = tid >> 4, sc = (tid & 15) * 8, vst0 = v_st(sr, sc), vst1 = v_st(32 + sr, sc);
    const int kst0 = KSWZ(KP, sr, sc * 2), kst1 = KSWZ(KP, 32 + sr, sc * 2);
    const unsigned ko = (unsigned)sr * (unsigned)ldk + sc;
    const int vbA = (int)(unsigned)(uintptr_t)V_lds + v_rd_base(lane) + g0 * 4096, vbB = (int)(unsigned)(uintptr_t)V_lds + v_rd_base(lane) + g1 * 4096;
    const int krow = 16 * (r32 < 16 ? g0 : g1) + c15;
    const LAS char* Kl = K_lds + krow * KP;
    const int kr_lo = clampi(r0 - 4, 0, 56), kr_hi = clampi(r0 + 3 - 4, 0, 56) + 8;
    const int s_lo = clampi(r0 + 2 * rp - 4, 0, 56), s_hi = clampi(r0 + 2 * rp + 1 - 4, 0, 56) + 8;
    const int srq = clampi(qrow - 4, 0, 56), scq = clampi(qc - 8, 0, 48);
    __syncthreads();
    if (tid < 465) rpb_l[tid] = rpb_h[tid] * 11.313708498984761f;
    bf16x8 va0, va1, ka0, ka1, vb0_, vb1_, kb0, kb1;
#define NA_LOAD(V0, V1, K0, K1, kr_) do { const bf16* Kt = Kseq + (size_t)((kr_) * 64) * ldk; const bf16* Vt = Vseq + (size_t)((kr_) * 64) * ldk; \
      V0 = *(const bf16x8*)(Vt + ko); V1 = *(const bf16x8*)(Vt + (size_t)32 * ldk + ko); K0 = *(const bf16x8*)(Kt + ko); K1 = *(const bf16x8*)(Kt + (size_t)32 * ldk + ko); } while (0)
#define NA_STEP(V0, V1, K0, K1, kr_) do { \
        __syncthreads();                                            \
        *(LAS bf16x8*)(V_lds + vst0) = V0; *(LAS bf16x8*)(V_lds + vst1) = V1; *(LAS bf16x8*)(K_lds + kst0) = K0; *(LAS bf16x8*)(K_lds + kst1) = K1; \
        __syncthreads(); \
        if ((kr_) + 2 < kr_hi) NA_LOAD(V0, V1, K0, K1, (kr_) + 2);     \
        if ((kr_) >= s_lo && (kr_) < s_hi) {                        \
            f32x16 p = {}; \
            _Pragma("unroll") for (int d0 = 0; d0 < 8; ++d0) { const int cb = (d0 * 16 + hi * 8) * 2; \
                const bf16x8 kf = *(const LAS bf16x8*)(Kl + (cb ^ (c15 << 4))); p = __builtin_amdgcn_mfma_f32_32x32x16_bf16(kf, qr[d0], p, 0, 0, 0); } \
            const bool rowin = ((kr_) >= srq) && ((kr_) < srq + 8); \
            const LAS float* bt = rpb_l + clampi((kr_) - qrow + 7, 0, 14) * 31 + (15 - qc); \
            _Pragma("unroll") for (int r = 0; r < 16; ++r) { const int kc = 16 * (r < 8 ? g0 : g1) + (r & 3) + 8 * ((r >> 2) & 1) + 4 * hi; \
                const bool in = rowin && (kc >= scq) && (kc < scq + 16); const float b = bt[in ? kc : qc]; p[r] = in ? p[r] + b : NEG; } \
              \
            float pmax = p[0]; _Pragma("unroll") for (int r = 1; r < 16; ++r) pmax = fmaxf(pmax, p[r]); \
            { auto rr = __builtin_amdgcn_permlane32_swap(__float_as_uint(pmax), __float_as_uint(pmax), false, false); pmax = fmaxf(__uint_as_float(rr[0]), __uint_as_float(rr[1])); } \
            float mn, al; \
            if (__builtin_expect(__all(pmax - m_reg <= THR / Cfg<128>::SCALE), 1)) { mn = m_reg; al = 1.f; } \
            else { mn = fmaxf(m_reg, pmax); al = __builtin_amdgcn_exp2f((m_reg - mn) * Cfg<128>::C); m_reg = mn; } \
            const float mnC = -mn * Cfg<128>::C; float ps = 0; \
            _Pragma("unroll") for (int r = 0; r < 16; ++r) { p[r] = __builtin_amdgcn_exp2f(fmaf(p[r], Cfg<128>::C, mnC)); ps += p[r]; } \
            { auto rr = __builtin_amdgcn_permlane32_swap(__float_as_uint(ps), __float_as_uint(ps), false, false); ps = __uint_as_float(rr[0]) + __uint_as_float(rr[1]); } \
            RESC(al); \
            l_reg = l_reg * al + ps; \
            bf16x8 pa0, pa1; \
            { unsigned a0 = cvt_pk_bf16(p[0], p[1]), a1 = cvt_pk_bf16(p[2], p[3]), b0 = cvt_pk_bf16(p[4], p[5]), b1 = cvt_pk_bf16(p[6], p[7]); \
              auto x0 = __builtin_amdgcn_permlane32_swap(a0, b0, false, false); auto x1 = __builtin_amdgcn_permlane32_swap(a1, b1, false, false); \
              u32x4 w = {x0[0], x1[0], x0[1], x1[1]}; pa0 = __builtin_bit_cast(bf16x8, w); } \
            { unsigned a0 = cvt_pk_bf16(p[8], p[9]), a1 = cvt_pk_bf16(p[10], p[11]), b0 = cvt_pk_bf16(p[12], p[13]), b1 = cvt_pk_bf16(p[14], p[15]); \
              auto x0 = __builtin_amdgcn_permlane32_swap(a0, b0, false, false); auto x1 = __builtin_amdgcn_permlane32_swap(a1, b1, false, false); \
              u32x4 w = {x0[0], x1[0], x0[1], x1[1]}; pa1 = __builtin_bit_cast(bf16x8, w); } \
            SBAR(); \
            na2_pv<0>(o[0], vbA, vbB, pa0, pa1); na2_pv<1>(o[1], vbA, vbB, pa0, pa1); na2_pv<2>(o[2], vbA, vbB, pa0, pa1); na2_pv<3>(o[3], vbA, vbB, pa0, pa1); \
        } } while (0)
    NA_LOAD(va0, va1, ka0, ka1, kr_lo);
    if (kr_lo + 1 < kr_hi) NA_LOAD(vb0_, vb1_, kb0, kb1, kr_lo + 1);
    for (int kr = kr_lo; kr < kr_hi; kr += 2) {
        NA_STEP(va0, va1, ka0, ka1, kr);
        if (kr + 1 < kr_hi) NA_STEP(vb0_, vb1_, kb0, kb1, kr + 1);
    }
#undef NA_LOAD
#undef NA_STEP
    __syncthreads();
    if (hi == 0) li_l[r32] = l_reg;
    asm volatile("s_waitcnt lgkmcnt(0)" ::: "memory");
    float rli[16];
#pragma unroll
    for (int r = 0; r < 16; ++r) rli[r] = __builtin_amdgcn_rcpf(li_l[crow(r, hi)]);
    LAS unsigned short* slab = (LAS unsigned short*)(lds + wid * 8192);
#pragma unroll
    for (int r = 0; r < 16; ++r) { const int orow = crow(r, hi);
#pragma unroll
        for (int d0 = 0; d0 < 4; ++d0) slab[orow * 128 + d0 * 32 + r32] = (unsigned short)(cvt_pk_bf16(o[d0][r] * rli[r], 0.f) & 0xffffu); }
    asm volatile("s_waitcnt lgkmcnt(0)" ::: "memory");
#pragma unroll
    for (int i = 0; i < 8; ++i) { const int id = i * 64 + lane, q = id >> 4, c16 = id & 15, q15 = q & 15;
        const int col = (typ == 3) ? (q15 < 8 ? q15 : 48 + q15) : 8 + 16 * typ + q15;
        const u32x4 w = *(const LAS u32x4*)((LAS char*)slab + q * 256 + c16 * 16);
        *(u32x4*)(Ob + (unsigned)((2 * rp + (q >> 4)) * 64 + col) * (unsigned)ldo + c16 * 8) = w; }
}
#undef RESC
}

constexpr size_t MiB = 1u << 20;
constexpr size_t WS_CTL = 0, CTL_ZERO_BYTES = 1 * MiB;
constexpr size_t WS_TAB_MLA = 5 * MiB;
constexpr size_t WS_TAB_1D = 6 * MiB;
constexpr size_t WS_MN = 8 * MiB;
constexpr size_t WS_MKV = 20 * MiB;
constexpr size_t WS_WB = 32 * MiB;
constexpr size_t WB_IN = 0, WB_QB = 24 * MiB, WB_KVB = 26 * MiB, WB_OUT = 28 * MiB, WB_XQ = 36 * MiB, WB_XKV = 38 * MiB, WB_XO = 42 * MiB, WB_UP = 44 * MiB, WB_DOWN = 76 * MiB;
constexpr size_t WS_H = 144 * MiB;
constexpr size_t WS_BIG = 336 * MiB;
constexpr size_t BIG_PROJ = 0, BIG_Q = 264 * MiB, BIG_KV = 408 * MiB;
constexpr size_t BIG_SPLIT = 96 * MiB;
constexpr size_t BIG_XQ = 0, BIG_XO = 48 * MiB;
constexpr size_t BIG_U = 0;
constexpr size_t BIG_XBA = 400 * MiB;
constexpr size_t WS_PS = WS_BIG + 600 * MiB;
constexpr size_t PS_BYTES = (size_t)T * 32 * 4, PSC_BYTES = (size_t)T * 8 * 4;
constexpr size_t WS_END = WS_PS + 3 * PS_BYTES + 2 * PSC_BYTES;
constexpr int CW_BAR = 4096;
constexpr int SKEW_TICKS = 0;

constexpr int RING_BYTES = 135168, MISC_OFF = RING_BYTES + 320, PTR_OFF = RING_BYTES + 1024, LDS_BYTES = 147456;
static_assert(pg8::RS_LDS_OFF == RING_BYTES + 2048 && pg8::RS_LDS_OFF + 2048 <= LDS_BYTES && PTR_OFF + 29 * 8 <= pg8::RS_LDS_OFF, "row-scale staging area");
static_assert(att::DV_TOTAL <= RING_BYTES && att::Cfg<192>::TOTAL <= RING_BYTES && att::NA_TOTAL <= RING_BYTES && pg8::STAGE_BYTES <= RING_BYTES, "LDS map");

#define XB_TMO      128
#define XB_XCNT(j)  (256  + 64 * (j))
#define XB_XSUB(j)  (1280 + 64 * (j))
#define XB_XGEN(j)  (2304 + 64 * (j))
#define XB_TOP      3328
#define XB_TOPGEN   3392
#define XCD_BAR_WORDS 3456
#define XB_SPIN_CAP (1u << 18)
__device__ __forceinline__ unsigned xb_ld(unsigned* p)              { return __hip_atomic_load(p, __ATOMIC_RELAXED, __HIP_MEMORY_SCOPE_AGENT); }
__device__ __forceinline__ unsigned xb_add(unsigned* p, unsigned v) { return __hip_atomic_fetch_add(p, v, __ATOMIC_RELAXED, __HIP_MEMORY_SCOPE_AGENT); }
__device__ __forceinline__ unsigned xb_xcc_id() { return (unsigned)__builtin_amdgcn_s_getreg((3 << 11) | 20) & 0xFu; }
#define XB_SPIN(cond, bar) do { unsigned _sp = 0; while (cond) { __builtin_amdgcn_s_sleep(1); \
    if ((++_sp & 255u) == 0u) { if (xb_ld(&(bar)[XB_TMO])) break; if (_sp > XB_SPIN_CAP) { atomicAdd(&(bar)[XB_TMO], 1u); break; } } } } while (0)
struct XcdBarrier { unsigned* bar; unsigned x; volatile LAS unsigned* st; };
__device__ __forceinline__ XcdBarrier xcd_barrier_post(unsigned* bar, volatile LAS unsigned* st, int wave) {
    XcdBarrier b; b.bar = bar; b.x = xb_xcc_id(); b.st = st;
    if (wave == 0 && lane_id_fresh() == 0) (void)xb_add(&bar[XB_XCNT(b.x)], 1u);
    return b;
}
__device__ __forceinline__ void xcd_barrier_complete(unsigned* bar, unsigned x, unsigned& nloc, unsigned& nx) {
    const unsigned G = gridDim.x * gridDim.y * gridDim.z;
    unsigned sum, cnt, mine, sp = 0u;
    for (;;) {
        sum = 0u; cnt = 0u; mine = 0u;
#pragma unroll
        for (unsigned j = 0; j < 16; ++j) { const unsigned c = xb_ld(&bar[XB_XCNT(j)]); sum += c; cnt += (c > 0u) ? 1u : 0u; mine = (j == x) ? c : mine; }
        if (sum == G) break;
        __builtin_amdgcn_s_sleep(1);
        if ((++sp & 255u) == 0u) { if (xb_ld(&bar[XB_TMO])) break; if (sp > XB_SPIN_CAP) { atomicAdd(&bar[XB_TMO], 1u); break; } }
    }
    nloc = mine > 0u ? mine : 1u; nx = cnt > 0u ? cnt : 1u;
}
__device__ __forceinline__ void xcd_barrier(const XcdBarrier& b, int wave) {
    asm volatile("s_waitcnt vmcnt(0)" ::: "memory");
    __syncthreads();
    if (wave == 0 && lane_id_fresh() == 0) {
        unsigned long long bar_i = (unsigned long long)(uintptr_t)b.bar; asm volatile("" : "+s"(bar_i));
        unsigned* bar = (unsigned*)(GAS unsigned*)(uintptr_t)bar_i;
        __builtin_amdgcn_s_waitcnt(0);
        unsigned nloc = b.st[0], nx = b.st[1];
        if (nloc == 0u) { xcd_barrier_complete(bar, b.x, nloc, nx); b.st[0] = nloc; b.st[1] = nx; }
        const unsigned old = xb_add(&bar[XB_XSUB(b.x)], 1u);
        const unsigned gen = old / nloc;
        if (old + 1u == (gen + 1u) * nloc) {
            __builtin_amdgcn_fence(__ATOMIC_RELEASE, "agent");
            asm volatile("s_waitcnt vmcnt(0)" ::: "memory");
            const unsigned og = xb_add(&bar[XB_TOP], 1u);
            const unsigned tg = og / nx;
            if (og + 1u == (tg + 1u) * nx) xb_add(&bar[XB_TOPGEN], 1u);
            else XB_SPIN(xb_ld(&bar[XB_TOPGEN]) == tg, bar);
            __builtin_amdgcn_fence(__ATOMIC_ACQUIRE, "agent");
            xb_add(&bar[XB_XGEN(b.x)], 1u);
            asm volatile("s_waitcnt vmcnt(0)" ::: "memory");
        } else {
            XB_SPIN(xb_ld(&bar[XB_XGEN(b.x)]) == gen, bar);
            __builtin_amdgcn_fence(__ATOMIC_ACQUIRE, "agent");
            asm volatile("s_waitcnt vmcnt(0)" ::: "memory");
        }
    }
    __syncthreads();
}

#define LDS_WAIT() asm volatile("s_waitcnt lgkmcnt(0)" ::: "memory")
constexpr int TR_PITCH = 65, TR_BYTES = 64 * TR_PITCH * 4;
static_assert(8 * TR_BYTES <= RING_BYTES, "transpose scratch");
__device__ __forceinline__ void transpose_item(const float* W, int K, int N, bf16* WT, const float* gain, LAS float* scr, int item, int lane) {
    const int nblk = N / 64, kb = item / nblk, nb = item % nblk, k0 = 64 * kb, n0 = 64 * nb;
    const int lr = lane >> 4, lc = (lane & 15) * 4;
#pragma unroll
    for (int h = 0; h < 2; ++h) {
        f32x4 v[8];
#pragma unroll
        for (int i = 0; i < 8; ++i) v[i] = *(const f32x4*)(W + (size_t)(k0 + 32 * h + 4 * i + lr) * N + n0 + lc);
#pragma unroll
        for (int i = 0; i < 8; ++i) { const int kk = 32 * h + 4 * i + lr; const float gk = gain ? gain[k0 + kk] : 1.f; LAS float* d = scr + kk * TR_PITCH + lc;
            d[0] = v[i].x * gk; d[1] = v[i].y * gk; d[2] = v[i].z * gk; d[3] = v[i].w * gk; }
    }
    LDS_WAIT(); asm volatile("" ::: "memory");
    const int c = lane & 7;
#pragma unroll
    for (int j = 0; j < 8; ++j) { const int n = (lane >> 3) + 8 * j; const LAS float* s = scr + (8 * c) * TR_PITCH + n;
        u32x4 o; o.x = cvt_pk_bf16(s[0 * TR_PITCH], s[1 * TR_PITCH]); o.y = cvt_pk_bf16(s[2 * TR_PITCH], s[3 * TR_PITCH]); o.z = cvt_pk_bf16(s[4 * TR_PITCH], s[5 * TR_PITCH]); o.w = cvt_pk_bf16(s[6 * TR_PITCH], s[7 * TR_PITCH]);
        *(u32x4*)(WT + (size_t)(n0 + n) * K + k0 + 8 * c) = o; }
    LDS_WAIT(); asm volatile("" ::: "memory");
}
__device__ __forceinline__ void convert_matrix(const float* W, int K, int N, bf16* WT, const float* gain, LAS float* scr, int gw, int NGW, int lane) {
    const int nitems = (K / 64) * (N / 64);
    for (int it = gw; it < nitems; it += NGW) transpose_item(W, K, N, WT, gain, scr, it, lane);
}
__device__ __forceinline__ void init_row_2048(const float* xrow, bf16* xh, float* ssp, int lane) {
    const f32x4* xr = (const f32x4*)xrow + lane;
    u32x2 w[8]; float s = 0.f;
#pragma unroll
    for (int j = 0; j < 8; ++j) { const f32x4 v = xr[64 * j]; w[j].x = cvt_pk_bf16(v.x, v.y); w[j].y = cvt_pk_bf16(v.z, v.w);
        const float y0 = bflo(w[j].x), y1 = bfhi(w[j].x), y2 = bflo(w[j].y), y3 = bfhi(w[j].y); s += (y0 * y0 + y1 * y1) + (y2 * y2 + y3 * y3); }
    s = wave_sum(s);
    u32x2* oh = (u32x2*)xh + lane;
#pragma unroll
    for (int j = 0; j < 8; ++j) oh[64 * j] = w[j];
    if (lane < 32) ssp[lane] = (lane == 0) ? s : 0.f;
}
__device__ __forceinline__ void init_rows2_2048(const float* xrow0, const float* xrow1, bf16* xh0, bf16* xh1, float* ssp0, float* ssp1, int lane) {
    f32x4 v0[8], v1[8];
#pragma unroll
    for (int j = 0; j < 8; ++j) { v0[j] = ((const f32x4*)xrow0 + lane)[64 * j]; v1[j] = ((const f32x4*)xrow1 + lane)[64 * j]; }
#pragma unroll
    for (int i = 0; i < 2; ++i) { u32x2 w[8]; float s = 0.f;
#pragma unroll
        for (int j = 0; j < 8; ++j) { const f32x4 v = i ? v1[j] : v0[j]; w[j].x = cvt_pk_bf16(v.x, v.y); w[j].y = cvt_pk_bf16(v.z, v.w);
            const float y0 = bflo(w[j].x), y1 = bfhi(w[j].x), y2 = bflo(w[j].y), y3 = bfhi(w[j].y); s += (y0 * y0 + y1 * y1) + (y2 * y2 + y3 * y3); }
        s = wave_sum(s);
        u32x2* oh = (u32x2*)(i ? xh1 : xh0) + lane;
#pragma unroll
        for (int j = 0; j < 8; ++j) oh[64 * j] = w[j];
        if (lane < 32) (i ? ssp1 : ssp0)[lane] = (lane == 0) ? s : 0.f; }
}
__device__ __forceinline__ void norm_row_2048(const float* xrow, const float* g, bf16* orow, float* copy, int lane) {
    const f32x4* xr = (const f32x4*)xrow + lane;
    f32x4 v[8]; float s = 0.f;
#pragma unroll
    for (int j = 0; j < 8; ++j) { v[j] = xr[64 * j]; s += (v[j].x * v[j].x + v[j].y * v[j].y) + (v[j].z * v[j].z + v[j].w * v[j].w); }
    const float rstd = 1.f / sqrtf(wave_sum(s) * (1.f / 2048.f) + EPS);
    if (copy) {
#pragma unroll
        for (int j = 0; j < 8; ++j) ((f32x4*)copy + lane)[64 * j] = v[j]; }
    u32x2* o8 = (u32x2*)orow + lane;
#pragma unroll
    for (int j = 0; j < 8; ++j) { const f32x4 gg = ((const f32x4*)g + lane)[64 * j]; u32x2 w; w.x = cvt_pk_bf16(v[j].x * rstd * gg.x, v[j].y * rstd * gg.y); w.y = cvt_pk_bf16(v[j].z * rstd * gg.z, v[j].w * rstd * gg.w); o8[64 * j] = w; }
}
__device__ __forceinline__ void final_norm_row(const bf16* xh, float* orow, const float* g, float ss, int lane) {
    const float rstd = 1.f / sqrtf(ss * (1.f / 2048.f) + EPS);
    const u32x2* ph = (const u32x2*)xh + lane; f32x4* po = (f32x4*)orow + lane;
#pragma unroll
    for (int j = 0; j < 8; ++j) { const u32x2 h = ph[64 * j]; const f32x4 gg = ((const f32x4*)g + lane)[64 * j];
        f32x4 o; o.x = bflo(h.x) * rstd * gg.x; o.y = bfhi(h.x) * rstd * gg.y; o.z = bflo(h.y) * rstd * gg.z; o.w = bfhi(h.y) * rstd * gg.w;
        po[64 * j] = o; }
}
template <int R>
__device__ __forceinline__ void final_norm_rows(const bf16* xh, float* out, const f32x4 (&gg)[8], const float* ssf, int m0, int mstep, int lane) {
    u32x2 h[R][8]; float ssv[R];
#pragma unroll
    for (int i = 0; i < R; ++i) { const size_t m = (size_t)(m0 + i * mstep); const u32x2* ph = (const u32x2*)(xh + m * DM) + lane;
        ssv[i] = lane < 32 ? ssf[m * 32 + lane] : 0.f;
#pragma unroll
        for (int j = 0; j < 8; ++j) h[i][j] = ph[64 * j]; }
#pragma unroll
    for (int i = 0; i < R; ++i) { const size_t m = (size_t)(m0 + i * mstep); f32x4* po = (f32x4*)(out + m * DM) + lane;
        const float rstd = 1.f / sqrtf(wave_sum(ssv[i]) * (1.f / 2048.f) + EPS);
#pragma unroll
        for (int j = 0; j < 8; ++j) { f32x4 o; o.x = bflo(h[i][j].x) * rstd * gg[j].x; o.y = bfhi(h[i][j].x) * rstd * gg[j].y; o.z = bflo(h[i][j].y) * rstd * gg[j].z; o.w = bfhi(h[i][j].y) * rstd * gg[j].w;
            po[64 * j] = o; } }
}
__device__ __forceinline__ void even_row_fix(bf16* row, int pos, const float* qn, const float* kvn, const float* gqn, const float* gkn, const float* tab_mla, int lane) {
    const float* cosm = tab_mla; const float* sinm = tab_mla + 4096 * 32;
#pragma unroll
    for (int part = 0; part < 2; ++part) {
        u32x4* p = (u32x4*)(row + part * 512) + lane; const u32x4 w = *p; const float* g = (part ? kvn : qn) + lane * 8;
        float x[8] = {bflo(w.x), bfhi(w.x), bflo(w.y), bfhi(w.y), bflo(w.z), bfhi(w.z), bflo(w.w), bfhi(w.w)};
        float s = 0.f;
#pragma unroll
        for (int e = 0; e < 8; ++e) s += x[e] * x[e];
        const float rstd = 1.f / sqrtf(wave_sum(s) * (1.f / 512.f) + EPS);
        const f32x4 g0 = *(const f32x4*)g, g1 = *(const f32x4*)(g + 4);
        u32x4 o; o.x = cvt_pk_bf16(x[0] * rstd * g0.x, x[1] * rstd * g0.y); o.y = cvt_pk_bf16(x[2] * rstd * g0.z, x[3] * rstd * g0.w);
        o.z = cvt_pk_bf16(x[4] * rstd * g1.x, x[5] * rstd * g1.y); o.w = cvt_pk_bf16(x[6] * rstd * g1.z, x[7] * rstd * g1.w);
        *p = o;
    }
    { bf16* p = row + 1024 + lane; const float x = bf2f(*p); const float y = other_half(x, lane < 32); const int f = lane & 31;
      const float c = cosm[pos * 32 + f], s = sinm[pos * 32 + f];
      const float r = (lane < 32) ? (x * c - y * s) : (x * c + y * s);
      *p = (bf16)(cvt_pk_bf16(r, 0.f) & 0xffffu); }
    const int prow = pos >> 6, pcol = pos & 63;
    const int e0 = 2 * lane, f0 = e0 & 31; const int tp = (e0 < 64) ? prow : pcol;
    const float c0 = cosm[tp * 32 + f0], s0 = sinm[tp * 32 + f0], c1 = cosm[tp * 32 + f0 + 1], s1 = sinm[tp * 32 + f0 + 1];
    const bool first = ((e0 & 32) == 0);
#pragma unroll 2
    for (int h = 0; h < 10; ++h) {
        unsigned* p = (unsigned*)(row + (h < 8 ? 1088 + h * 128 : 2112 + (h - 8) * 128)) + lane; const unsigned w = *p; const float* g = (h < 8 ? gqn : gkn) + e0;
        float x0 = bflo(w), x1 = bfhi(w);
        const float rstd = 1.f / sqrtf(wave_sum(x0 * x0 + x1 * x1) * (1.f / 128.f) + EPS);
        x0 = x0 * rstd * g[0]; x1 = x1 * rstd * g[1];
        const float y0 = swz_xor<16>(x0), y1 = swz_xor<16>(x1);
        const float r0 = first ? (x0 * c0 - y0 * s0) : (x0 * c0 + y0 * s0);
        const float r1 = first ? (x1 * c1 - y1 * s1) : (x1 * c1 + y1 * s1);
        *p = cvt_pk_bf16(r0, r1);
    }
}
__device__ __forceinline__ void even_row_fix_k(bf16* row, int pos, const float* gkn, const float* tab_mla, int lane) {
    const float* cosm = tab_mla; const float* sinm = tab_mla + 4096 * 32;
    { bf16* p = row + 1024 + lane; const float x = bf2f(*p); const float y = other_half(x, lane < 32); const int f = lane & 31;
      const float c = cosm[pos * 32 + f], s = sinm[pos * 32 + f];
      const float r = (lane < 32) ? (x * c - y * s) : (x * c + y * s);
      *p = (bf16)(cvt_pk_bf16(r, 0.f) & 0xffffu); }
    const int prow = pos >> 6, pcol = pos & 63;
    const int e0 = 2 * lane, f0 = e0 & 31; const int tp = (e0 < 64) ? prow : pcol;
    const float c0 = cosm[tp * 32 + f0], s0 = sinm[tp * 32 + f0], c1 = cosm[tp * 32 + f0 + 1], s1 = sinm[tp * 32 + f0 + 1];
    const bool first = ((e0 & 32) == 0);
#pragma unroll
    for (int h = 0; h < 2; ++h) {
        unsigned* p = (unsigned*)(row + 2112 + h * 128) + lane; const unsigned w = *p; const float* g = gkn + e0;
        float x0 = bflo(w), x1 = bfhi(w);
        const float rstd = 1.f / sqrtf(wave_sum(x0 * x0 + x1 * x1) * (1.f / 128.f) + EPS);
        x0 = x0 * rstd * g[0]; x1 = x1 * rstd * g[1];
        const float y0 = swz_xor<16>(x0), y1 = swz_xor<16>(x1);
        const float r0 = first ? (x0 * c0 - y0 * s0) : (x0 * c0 + y0 * s0);
        const float r1 = first ? (x1 * c1 - y1 * s1) : (x1 * c1 + y1 * s1);
        *p = cvt_pk_bf16(r0, r1);
    }
}
template <int R>
__device__ __forceinline__ void even_rows_fix_k(bf16* proj, int m0, int mstep, const float* gkn, const float* tab_mla, int lane) {
    const float* cosm = tab_mla; const float* sinm = tab_mla + 4096 * 32;
    const int f = lane & 31, e0 = 2 * lane, f0 = e0 & 31; const bool first = ((e0 & 32) == 0);
    const float g0 = gkn[e0], g1 = gkn[e0 + 1];
    unsigned short kx[R]; unsigned w0[R], w1[R]; float kc[R], ks[R], c0[R], s0[R], c1[R], s1[R];
#pragma unroll
    for (int i = 0; i < R; ++i) { const int m = m0 + i * mstep, pos = m & (SEQ - 1); bf16* row = proj + (size_t)m * AB_PAD;
        kx[i] = *(row + 1024 + lane); kc[i] = cosm[pos * 32 + f]; ks[i] = sinm[pos * 32 + f];
        const int tp = (e0 < 64) ? (pos >> 6) : (pos & 63);
        c0[i] = cosm[tp * 32 + f0]; s0[i] = sinm[tp * 32 + f0]; c1[i] = cosm[tp * 32 + f0 + 1]; s1[i] = sinm[tp * 32 + f0 + 1];
        w0[i] = *((const unsigned*)(row + 2112) + lane); w1[i] = *((const unsigned*)(row + 2112 + 128) + lane); }
#pragma unroll
    for (int i = 0; i < R; ++i) { const int m = m0 + i * mstep; bf16* row = proj + (size_t)m * AB_PAD;
        { const float x = bf2f(kx[i]); const float y = other_half(x, lane < 32);
          const float r = (lane < 32) ? (x * kc[i] - y * ks[i]) : (x * kc[i] + y * ks[i]);
          *(row + 1024 + lane) = (bf16)(cvt_pk_bf16(r, 0.f) & 0xffffu); }
#pragma unroll
        for (int h = 0; h < 2; ++h) { const unsigned w = h ? w1[i] : w0[i];
            float x0 = bflo(w), x1 = bfhi(w);
            const float rstd = 1.f / sqrtf(wave_sum(x0 * x0 + x1 * x1) * (1.f / 128.f) + EPS);
            x0 = x0 * rstd * g0; x1 = x1 * rstd * g1;
            const float y0 = swz_xor<16>(x0), y1 = swz_xor<16>(x1);
            const float r0 = first ? (x0 * c0[i] - y0 * s0[i]) : (x0 * c0[i] + y0 * s0[i]);
            const float r1 = first ? (x1 * c1[i] - y1 * s1[i]) : (x1 * c1[i] + y1 * s1[i]);
            *((unsigned*)(row + 2112 + h * 128) + lane) = cvt_pk_bf16(r0, r1); } }
}
__device__ __forceinline__ void mla_q_rope_row(bf16* row, int pos, const float* tab_mla, int lane) {
    const int h = lane >> 3, s4 = (lane & 7) * 4;
    u32x2* p1 = (u32x2*)(row + h * 192 + 128 + s4); u32x2* p2 = (u32x2*)(row + h * 192 + 160 + s4);
    const u32x2 w1 = *p1, w2 = *p2;
    const f32x4 c = *(const f32x4*)(tab_mla + pos * 32 + s4), s = *(const f32x4*)(tab_mla + 4096 * 32 + pos * 32 + s4);
    const float x1[4] = {bflo(w1.x), bfhi(w1.x), bflo(w1.y), bfhi(w1.y)}, x2[4] = {bflo(w2.x), bfhi(w2.x), bflo(w2.y), bfhi(w2.y)};
    float a[4], b[4];
#pragma unroll
    for (int e = 0; e < 4; ++e) { a[e] = x1[e] * c[e] - x2[e] * s[e]; b[e] = x2[e] * c[e] + x1[e] * s[e]; }
    u32x2 o1, o2; o1.x = cvt_pk_bf16(a[0], a[1]); o1.y = cvt_pk_bf16(a[2], a[3]); o2.x = cvt_pk_bf16(b[0], b[1]); o2.y = cvt_pk_bf16(b[2], b[3]);
    *p1 = o1; *p2 = o2;
}
__device__ __forceinline__ void rope1d_row(bf16* row, int pos, const float* tab_1d, int lane) {
    const int h = lane >> 3, s8 = (lane & 7) * 8;
    u32x4* p1 = (u32x4*)(row + h * 128 + s8); u32x4* p2 = (u32x4*)(row + h * 128 + 64 + s8);
    const u32x4 w1 = *p1, w2 = *p2;
    const float* ct = tab_1d + pos * 64 + s8; const float* st = tab_1d + 4096 * 64 + pos * 64 + s8;
    const f32x4 c0 = *(const f32x4*)ct, c1 = *(const f32x4*)(ct + 4), s0 = *(const f32x4*)st, s1 = *(const f32x4*)(st + 4);
    const float c[8] = {c0.x, c0.y, c0.z, c0.w, c1.x, c1.y, c1.z, c1.w}, s[8] = {s0.x, s0.y, s0.z, s0.w, s1.x, s1.y, s1.z, s1.w};
    const float x1[8] = {bflo(w1.x), bfhi(w1.x), bflo(w1.y), bfhi(w1.y), bflo(w1.z), bfhi(w1.z), bflo(w1.w), bfhi(w1.w)};
    const float x2[8] = {bflo(w2.x), bfhi(w2.x), bflo(w2.y), bfhi(w2.y), bflo(w2.z), bfhi(w2.z), bflo(w2.w), bfhi(w2.w)};
    float a[8], b[8];
#pragma unroll
    for (int e = 0; e < 8; ++e) { a[e] = x1[e] * c[e] - x2[e] * s[e]; b[e] = x2[e] * c[e] + x1[e] * s[e]; }
    u32x4 o1, o2; o1.x = cvt_pk_bf16(a[0], a[1]); o1.y = cvt_pk_bf16(a[2], a[3]); o1.z = cvt_pk_bf16(a[4], a[5]); o1.w = cvt_pk_bf16(a[6], a[7]);
    o2.x = cvt_pk_bf16(b[0], b[1]); o2.y = cvt_pk_bf16(b[2], b[3]); o2.z = cvt_pk_bf16(b[4], b[5]); o2.w = cvt_pk_bf16(b[6], b[7]);
    *p1 = o1; *p2 = o2;
}
__device__ __forceinline__ void rope1d_rows4(bf16* base, size_t ld, int m0, int mstep, const float* tab_1d, int lane) {
    const int h = lane >> 3, s8 = (lane & 7) * 8;
    u32x4 w1[4], w2[4]; f32x4 c0[4], c1[4], s0[4], s1[4];
#pragma unroll
    for (int i = 0; i < 4; ++i) { const int m = m0 + i * mstep, pos = m & (SEQ - 1); bf16* row = base + (size_t)m * ld;
        w1[i] = *(const u32x4*)(row + h * 128 + s8); w2[i] = *(const u32x4*)(row + h * 128 + 64 + s8);
        const float* ct = tab_1d + pos * 64 + s8; const float* st = tab_1d + 4096 * 64 + pos * 64 + s8;
        c0[i] = *(const f32x4*)ct; c1[i] = *(const f32x4*)(ct + 4); s0[i] = *(const f32x4*)st; s1[i] = *(const f32x4*)(st + 4); }
#pragma unroll
    for (int i = 0; i < 4; ++i) { const int m = m0 + i * mstep; bf16* row = base + (size_t)m * ld;
        const float c[8] = {c0[i].x, c0[i].y, c0[i].z, c0[i].w, c1[i].x, c1[i].y, c1[i].z, c1[i].w}, s[8] = {s0[i].x, s0[i].y, s0[i].z, s0[i].w, s1[i].x, s1[i].y, s1[i].z, s1[i].w};
        const float x1[8] = {bflo(w1[i].x), bfhi(w1[i].x), bflo(w1[i].y), bfhi(w1[i].y), bflo(w1[i].z), bfhi(w1[i].z), bflo(w1[i].w), bfhi(w1[i].w)};
        const float x2[8] = {bflo(w2[i].x), bfhi(w2[i].x), bflo(w2[i].y), bfhi(w2[i].y), bflo(w2[i].z), bfhi(w2[i].z), bflo(w2[i].w), bfhi(w2[i].w)};
        float a[8], b[8];
#pragma unroll
        for (int e = 0; e < 8; ++e) { a[e] = x1[e] * c[e] - x2[e] * s[e]; b[e] = x2[e] * c[e] + x1[e] * s[e]; }
        u32x4 o1, o2; o1.x = cvt_pk_bf16(a[0], a[1]); o1.y = cvt_pk_bf16(a[2], a[3]); o1.z = cvt_pk_bf16(a[4], a[5]); o1.w = cvt_pk_bf16(a[6], a[7]);
        o2.x = cvt_pk_bf16(b[0], b[1]); o2.y = cvt_pk_bf16(b[2], b[3]); o2.z = cvt_pk_bf16(b[4], b[5]); o2.w = cvt_pk_bf16(b[6], b[7]);
        *(u32x4*)(row + h * 128 + s8) = o1; *(u32x4*)(row + h * 128 + 64 + s8) = o2; }
}
__device__ __forceinline__ void diff_combine_row(const bf16* oc, bf16* out, float lam, float post, const float* subln, int lane) {
    const f32x4 g = *(const f32x4*)(subln + lane * 4);
#pragma unroll
    for (int h = 0; h < 4; ++h) {
        const u32x2 w0 = *((const u32x2*)(oc + h * 512) + lane), w1 = *((const u32x2*)(oc + h * 512 + 256) + lane);
        float d[4] = {bflo(w0.x) - lam * bflo(w1.x), bfhi(w0.x) - lam * bfhi(w1.x), bflo(w0.y) - lam * bflo(w1.y), bfhi(w0.y) - lam * bfhi(w1.y)};
        const float rstd = 1.f / sqrtf(wave_sum((d[0] * d[0] + d[1] * d[1]) + (d[2] * d[2] + d[3] * d[3])) * (1.f / 256.f) + EPS);
        u32x2 o; o.x = cvt_pk_bf16(d[0] * rstd * g.x * post, d[1] * rstd * g.y * post); o.y = cvt_pk_bf16(d[2] * rstd * g.z * post, d[3] * rstd * g.w * post);
        *((u32x2*)(out + h * 256) + lane) = o;
    }
}
template <int R>
__device__ __forceinline__ void diff_combine_rows(const bf16* ocb, bf16* outb, size_t ldo, int m0, int mstep, float lam, float post, const float* subln, int lane) {
    const f32x4 g = *(const f32x4*)(subln + lane * 4);
    u32x2 w0[R][4], w1[R][4];
#pragma unroll
    for (int i = 0; i < R; ++i) { const bf16* oc = ocb + (size_t)(m0 + i * mstep) * 2048;
#pragma unroll
        for (int h = 0; h < 4; ++h) { w0[i][h] = *((const u32x2*)(oc + h * 512) + lane); w1[i][h] = *((const u32x2*)(oc + h * 512 + 256) + lane); } }
#pragma unroll
    for (int i = 0; i < R; ++i) { bf16* out = outb + (size_t)(m0 + i * mstep) * ldo;
#pragma unroll
        for (int h = 0; h < 4; ++h) { const u32x2 a = w0[i][h], b = w1[i][h];
            float d[4] = {bflo(a.x) - lam * bflo(b.x), bfhi(a.x) - lam * bfhi(b.x), bflo(a.y) - lam * bflo(b.y), bfhi(a.y) - lam * bfhi(b.y)};
            const float rstd = 1.f / sqrtf(wave_sum((d[0] * d[0] + d[1] * d[1]) + (d[2] * d[2] + d[3] * d[3])) * (1.f / 256.f) + EPS);
            u32x2 o; o.x = cvt_pk_bf16(d[0] * rstd * g.x * post, d[1] * rstd * g.y * post); o.y = cvt_pk_bf16(d[2] * rstd * g.z * post, d[3] * rstd * g.w * post);
            *((u32x2*)(out + h * 256) + lane) = o; } }
}
__device__ __forceinline__ void sincos_d(double a, double& sn, double& cs) {
    const double k = __builtin_rint(a * 0.15915494309189533577);
    const double r = __builtin_fma(-k, 6.283185307179586476925, a) - k * 2.4492935982947064e-16 * 0.0;
    const double r2 = r * r;
    double s = -1.0 / 51090942171709440000.0;
    s = s * r2 + 1.0 / 121645100408832000.0; s = s * r2 - 1.0 / 355687428096000.0; s = s * r2 + 1.0 / 1307674368000.0; s = s * r2 - 1.0 / 6227020800.0;
    s = s * r2 + 1.0 / 39916800.0; s = s * r2 - 1.0 / 362880.0; s = s * r2 + 1.0 / 5040.0; s = s * r2 - 1.0 / 120.0; s = s * r2 + 1.0 / 6.0; s = s * r2 - 1.0;
    sn = -s * r;
    double c = 1.0 / 1124000727777607680000.0;
    c = c * r2 - 1.0 / 2432902008176640000.0; c = c * r2 + 1.0 / 6402373705728000.0; c = c * r2 - 1.0 / 20922789888000.0; c = c * r2 + 1.0 / 87178291200.0;
    c = c * r2 - 1.0 / 479001600.0; c = c * r2 + 1.0 / 3628800.0; c = c * r2 - 1.0 / 40320.0; c = c * r2 + 1.0 / 720.0; c = c * r2 - 1.0 / 24.0; c = c * r2 + 0.5; c = c * r2 - 1.0;
    cs = -c;
}

__device__ __forceinline__ void* ld_ptr(LAS unsigned long long* P, int i) {
    const unsigned long long v = P[i];
    const unsigned lo = __builtin_amdgcn_readfirstlane((unsigned)v), hi = __builtin_amdgcn_readfirstlane((unsigned)(v >> 32));
    return (void*)(GAS void*)(uintptr_t)(((unsigned long long)hi << 32) | lo);
}
struct Args { const float* in[27]; float* out; unsigned char* ws; int ph_lo, ph_hi; };
enum { I_XP = 0, I_XS, I_MP, I_MS, I_NORM_MIX, I_W_IN_AB, I_MLA_QN, I_W_QB, I_MLA_KVN, I_W_KVB, I_GQA_QN, I_GQA_KN, I_W_OUT_AB, I_W_IN_CD, I_RPB, I_DLAM, I_SUBLN, I_W_OUT_CD,
       I_NORM_XA, I_NORM_MEM, I_W_XQ, I_W_XKV, I_W_XO, I_NORM_MLP, I_W_UP, I_W_DOWN, I_FINAL };

__global__ void __launch_bounds__(512, 2) fwd(Args args) {
    extern __shared__ __attribute__((aligned(16))) unsigned char lds_raw[];
    LAS unsigned char* lds = (LAS unsigned char*)lds_raw;
    volatile LAS unsigned* MISC = (volatile LAS unsigned*)(lds + MISC_OFF);
    const int tid0 = threadIdx.x, wave = __builtin_amdgcn_readfirstlane(tid0 >> 6);
    const int G = gridDim.x; const int bx = blockIdx.x; const int vcu = (G % 8 == 0) ? (bx % 8) * (G / 8) + bx / 8 : bx;
    const int gw = vcu * 8 + wave, NGW = G * 8;
    for (int u = tid0; u < (LDS_BYTES - RING_BYTES) / 4; u += 512) ((LAS unsigned*)(lds + RING_BYTES))[u] = 0u;
    __syncthreads();
    LAS unsigned long long* PTRS = (LAS unsigned long long*)(lds + PTR_OFF);
    if (tid0 == 0) {
#pragma unroll
        for (int i = 0; i < 27; ++i) PTRS[i] = (unsigned long long)(uintptr_t)args.in[i];
        PTRS[27] = (unsigned long long)(uintptr_t)args.out; PTRS[28] = (unsigned long long)(uintptr_t)args.ws;
    }
    const int lo = args.ph_lo, hi = args.ph_hi; int ph = 0;
    __syncthreads();
#define INP(i) ((const float*)ld_ptr(PTRS, (i)))
#define WSP ((unsigned char*)ld_ptr(PTRS, 28))
#define XP ((float*)ld_ptr(PTRS, 27))
    XcdBarrier bar = xcd_barrier_post((unsigned*)(WSP + WS_CTL) + CW_BAR, MISC + 8, wave);
#ifndef PH_MASK
#define PH_MASK 0xffffffffu
#endif
#define PEN(k) (((PH_MASK) >> (k)) & 1u)
#ifndef PROBE_REP
#define PROBE_REP 0u
#endif
#define REPS(k) (1 + (int)(((PROBE_REP) >> (k)) & 1u))
#define PH_ON (ph >= lo && ph < hi)
#define PH_LANE const int lane = lane_id_fresh(), tid = wave * 64 + lane; (void)tid; (void)lane; int gw_s_ = gw; asm volatile("" : "+s"(gw_s_)); const int gw = gw_s_; (void)gw
#define PH_END do { if (ph >= lo && ph + 1 < hi) xcd_barrier(bar, wave); ++ph; } while (0)

#define X XP
#define H ((bf16*)(WSP + WS_H))
#define BIG (WSP + WS_BIG)
#define WB (WSP + WS_WB)
#define tab_mla ((float*)(WSP + WS_TAB_MLA))
#define tab_1d ((float*)(WSP + WS_TAB_1D))
#define MN ((bf16*)(WSP + WS_MN))
#define MKV ((bf16*)(WSP + WS_MKV))
#define HFIN H
#define PSQ(i) ((float*)(WSP + WS_PS + (size_t)(i) * PS_BYTES))
#define PSC(i) ((float*)(WSP + WS_PS + 3 * PS_BYTES + (size_t)(i) * PSC_BYTES))
#define XBH ((bf16*)XP)
#define XBA XBH
    LAS float* scr = (LAS float*)(lds + wave * TR_BYTES);

    if (PH_ON && PEN(0)) for (int rep_ = 0; rep_ < REPS(0); ++rep_) { PH_LANE;
        const int gt = vcu * 512 + tid, NT_ = G * 512;
        for (int i = gt; i < 4096 * 32; i += NT_) { const int pos = i >> 5, f = i & 31; double inv = 1.0; for (int k = 0; k < f; ++k) inv *= 0.7498942093324558273;
            const float ang = (float)pos * (float)inv; double sn, cs; sincos_d((double)ang, sn, cs); tab_mla[i] = (float)cs; tab_mla[4096 * 32 + i] = (float)sn; }
        for (int i = gt; i < 4096 * 64; i += NT_) { const int pos = i >> 6, f = i & 63; double inv = 1.0; for (int k = 0; k < f; ++k) inv *= 0.8659643233600653524;
            const float ang = (float)pos * (float)inv; double sn, cs; sincos_d((double)ang, sn, cs); tab_1d[i] = (float)cs; tab_1d[4096 * 64 + i] = (float)sn; }
        float* ss0 = PSQ(0);
        int m = gw;
        for (; m + NGW < T; m += 2 * NGW) { const int m1 = m + NGW;
            const float* src0 = (m < T_PROMPT) ? INP(I_XP) + (size_t)m * DM : INP(I_XS) + (size_t)(m - T_PROMPT) * DM;
            const float* src1 = (m1 < T_PROMPT) ? INP(I_XP) + (size_t)m1 * DM : INP(I_XS) + (size_t)(m1 - T_PROMPT) * DM;
            init_rows2_2048(src0, src1, XBH + (size_t)m * DM, XBH + (size_t)m1 * DM, ss0 + (size_t)m * 32, ss0 + (size_t)m1 * 32, lane); }
        for (; m < T; m += NGW) { const float* src = (m < T_PROMPT) ? INP(I_XP) + (size_t)m * DM : INP(I_XS) + (size_t)(m - T_PROMPT) * DM;
            init_row_2048(src, XBH + (size_t)m * DM, ss0 + (size_t)m * 32, lane); }
    }

    for (int layer = 0; layer < DEPTH; ++layer) {
        const int j = layer >> 1; const bool even = (layer & 1) == 0;
#define W_IN ((bf16*)(WB + WB_IN))
#define W_QB ((bf16*)(WB + WB_QB))
#define W_KVB ((bf16*)(WB + WB_KVB))
#define W_OUT ((bf16*)(WB + WB_OUT))
#define W_XQ ((bf16*)(WB + WB_XQ))
#define W_XKV ((bf16*)(WB + WB_XKV))
#define W_XO ((bf16*)(WB + WB_XO))
#define W_UP ((bf16*)(WB + WB_UP))
#define W_DOWN ((bf16*)(WB + WB_DOWN))

#define CONVERT_LATE do { __syncthreads(); { PH_LANE; \
            convert_matrix((even ? INP(I_W_OUT_AB) : INP(I_W_OUT_CD)) + (size_t)j * DM * DM, DM, DM, W_OUT, nullptr, scr, gw, NGW, lane); \
            convert_matrix(INP(I_W_XQ) + (size_t)layer * DM * 512, DM, 512, W_XQ, INP(I_NORM_XA) + layer * DM, scr, gw, NGW, lane); \
            convert_matrix(INP(I_W_XKV) + (size_t)layer * DM * 1024, DM, 1024, W_XKV, nullptr, scr, gw, NGW, lane); \
            convert_matrix(INP(I_W_XO) + (size_t)layer * 512 * DM, 512, DM, W_XO, nullptr, scr, gw, NGW, lane); \
            convert_matrix(INP(I_W_UP) + (size_t)layer * DM * DFF, DM, DFF, W_UP, INP(I_NORM_MLP) + layer * DM, scr, gw, NGW, lane); \
            convert_matrix(INP(I_W_DOWN) + (size_t)layer * DFF * DM, DFF, DM, W_DOWN, nullptr, scr, gw, NGW, lane); } __syncthreads(); } while (0)
#define CONV_SLOT (bx % ((NSEQ * 8 * 16 / G) < 6 ? ((NSEQ * 8 * 16 / G) < 1 ? 1 : (NSEQ * 8 * 16 / G)) : 6))
        if (PH_ON && PEN(1)) for (int rep_ = 0; rep_ < REPS(1); ++rep_) { PH_LANE;
            const float* gmix = INP(I_NORM_MIX) + layer * DM;
            if (even) {
                convert_matrix(INP(I_W_IN_AB) + (size_t)j * DM * AB_IN, DM, AB_IN, W_IN, gmix, scr, gw, NGW, lane);
                for (size_t i = (size_t)gw * 64 + lane; i < (size_t)(AB_PAD - AB_IN) * DM / 8; i += (size_t)NGW * 64) { u32x4 z = (u32x4){0u, 0u, 0u, 0u}; asm volatile("" : "+v"(z)); ((u32x4*)(W_IN + (size_t)AB_IN * DM))[i] = z; }
                convert_matrix(INP(I_W_QB) + (size_t)j * 512 * 1536, 512, 1536, W_QB, INP(I_MLA_QN) + j * 512, scr, gw, NGW, lane);
                convert_matrix(INP(I_W_KVB) + (size_t)j * 512 * 2048, 512, 2048, W_KVB, INP(I_MLA_KVN) + j * 512, scr, gw, NGW, lane);
            } else {
                convert_matrix(INP(I_W_IN_CD) + (size_t)j * DM * CD_IN, DM, CD_IN, W_IN, gmix, scr, gw, NGW, lane);
            }
            const float* gm = INP(I_NORM_MEM) + layer * DM;
            for (int r = gw; r < TM; r += NGW) { const float* src = (r < 8 * MEMLEN) ? INP(I_MP) + (size_t)r * DM : INP(I_MS) + (size_t)(r - 8 * MEMLEN) * DM;
                norm_row_2048(src, gm, MN + (size_t)r * DM, nullptr, lane); }
        }
        PH_END;

        if (even) {
            bf16* PROJ = (bf16*)(BIG + BIG_PROJ); bf16* Q = (bf16*)(BIG + BIG_Q); bf16* KV = (bf16*)(BIG + BIG_KV);
            if (PH_ON && PEN(2)) for (int rep_ = 0; rep_ < REPS(2); ++rep_) { PH_LANE;
                pg8::Gemm g{XBH, W_IN, T, AB_PAD, DM, DM, DM}; pg8::StaticOrder S; S.init(T, AB_PAD, G, bx, 3);
                pg8::EpiBf16<0, 32> E{PROJ, AB_PAD, 0, 0, PSQ(0), 1.f / 2048.f, PSC(0), PSC_BYTES / 4};
                pg8::gemm_phase(lds, g, S, E, wave);
            }
            PH_END;
            if (PH_ON && PEN(3)) for (int rep_ = 0; rep_ < REPS(3); ++rep_) { PH_LANE;
                const float* gkn = INP(I_GQA_KN) + j * 128;
                int m = gw;
                for (; m + 7 * NGW < T; m += 8 * NGW) even_rows_fix_k<8>(PROJ, m, NGW, gkn, tab_mla, lane);
                for (; m < T; m += NGW) even_row_fix_k(PROJ + (size_t)m * AB_PAD, m & (SEQ - 1), gkn, tab_mla, lane);
            }
            if (PH_ON && PEN(4)) for (int rep_ = 0; rep_ < REPS(4); ++rep_) { PH_LANE;
#pragma unroll 1
                for (int gi = 0; gi < 2; ++gi) {
                    pg8::Gemm g{PROJ + (gi ? 512 : 0), gi ? W_KVB : W_QB, T, gi ? 2048 : 1536, 512, AB_PAD, 512}; pg8::StaticOrder S; S.init(T, g.N, G, bx, 4);
                    pg8::EpiBf16<0, 8> E{gi ? KV : Q, g.N, 0, 0, PSC(gi), 1.f / 512.f, nullptr, 0};
                    pg8::gemm_phase(lds, g, S, E, wave);
                }
            }
            PH_END;
            if (PH_ON) {
                for (int rep_ = 0; rep_ < REPS(6); ++rep_)
                for (int u = vcu, it_ = 0; u < NSEQ * 8 * 16; u += G, ++it_) { const int qb = u & 15, h = (u >> 4) & 7, b = u >> 7; const size_t t0 = (size_t)b * SEQ;
                    att::dense_unit<192, 1, 1>(Q + (t0 + qb * 256) * 1536 + h * 192, 1536, KV + t0 * 2048 + h * 256, 2048, PROJ + t0 * AB_PAD + 1024, AB_PAD,
                                         KV + t0 * 2048 + h * 256 + 128, 2048, H + (t0 + qb * 256) * DM + h * 128, DM, SEQ, (LAS char*)lds, wave, qb * 256, tab_mla, nullptr);
                    if (rep_ == 0 && it_ == CONV_SLOT) CONVERT_LATE; }
                for (int rep_ = 0; rep_ < REPS(21); ++rep_)
                for (int u = vcu; u < NSEQ * 8 * 16; u += G) { const int qb = u & 15, h = (u >> 4) & 7, b = u >> 7; const size_t t0 = (size_t)b * SEQ; const int kvh = h >> 2;
                    att::dense_unit3<3>(PROJ + (t0 + qb * 256) * AB_PAD + 1088 + h * 128, AB_PAD, PROJ + t0 * AB_PAD + 2112 + kvh * 128, AB_PAD,
                                         PROJ + t0 * AB_PAD + 2368 + kvh * 128, AB_PAD, H + (t0 + qb * 256) * DM + 1024 + h * 128, DM, SEQ, (LAS char*)lds, wave, qb * 256, tab_mla, INP(I_GQA_QN) + j * 128); }
            }
            PH_END;
        } else {
            bf16* NQ = (bf16*)(BIG + 0 * BIG_SPLIT); bf16* NK = (bf16*)(BIG + 1 * BIG_SPLIT); bf16* NV = (bf16*)(BIG + 2 * BIG_SPLIT);
            bf16* DQ = (bf16*)(BIG + 3 * BIG_SPLIT); bf16* DK = (bf16*)(BIG + 4 * BIG_SPLIT); bf16* DV = (bf16*)(BIG + 5 * BIG_SPLIT); bf16* OC = NQ;
            if (PH_ON && PEN(7)) for (int rep_ = 0; rep_ < REPS(7); ++rep_) { PH_LANE;
                pg8::Gemm g{XBH, W_IN, T, CD_IN, DM, DM, DM}; pg8::StaticOrder S; S.init(T, CD_IN, G, bx, 4);
                pg8::EpiBf16<0, 32> E{NQ, 1024, 1024, BIG_SPLIT / 2, PSQ(0), 1.f / 2048.f, nullptr, 0};
                pg8::gemm_phase(lds, g, S, E, wave);
            }
            PH_END;
            if (PH_ON && PEN(9)) for (int rep_ = 0; rep_ < REPS(9); ++rep_) { PH_LANE;
                const float* rpb = INP(I_RPB) + (size_t)j * 8 * 465;
                const int nslot = (NSEQ * 8 * 16 / G) < 6 ? ((NSEQ * 8 * 16 / G) < 1 ? 1 : (NSEQ * 8 * 16 / G)) : 6;
                for (int u = vcu, it_ = 0; u < NSEQ * 8 * 16; u += G, ++it_) { const int qb = u & 15, h = (u >> 4) & 7, b = u >> 7; const size_t t0 = (size_t)b * SEQ;
                    att::na_unit2(NQ + (t0 + qb * 256) * 1024 + h * 128, 1024, NK + t0 * 1024 + h * 128, NV + t0 * 1024 + h * 128, 1024,
                                 H + (t0 + qb * 256) * DM + h * 128, DM, qb * 4, rpb + h * 465, (LAS char*)lds, wave);
                    if (rep_ == 0 && PEN(8) && it_ == bx % nslot) {
                        int m = gw;
                        for (; m + 3 * NGW < T; m += 4 * NGW) rope1d_rows4(DK, 1024, m, NGW, tab_1d, lane);
                        for (; m < T; m += NGW) rope1d_row(DK + (size_t)m * 1024, m & (SEQ - 1), tab_1d, lane);
                    } }
            }
            PH_END;
            if (PH_ON && PEN(10)) for (int rep_ = 0; rep_ < REPS(10); ++rep_) { PH_LANE;
                for (int u = vcu, it_ = 0; u < NSEQ * 8 * 16; u += G, ++it_) { const int qb = u & 15, hc = (u >> 4) & 7, b = u >> 7; const size_t t0 = (size_t)b * SEQ;
                    const int c = hc & 1, h = hc >> 1;
                    att::dense_unit_dv256(DQ + (t0 + qb * 256) * 1024 + (2 * h + c) * 128, 1024, DK + t0 * 1024 + (2 * h + c) * 128, 1024, DV + t0 * 1024 + h * 256, 1024,
                                          OC + (t0 + qb * 256) * 2048 + h * 512 + c * 256, 2048, SEQ, (LAS char*)lds, wave, qb * 256, tab_1d);
                    if (rep_ == 0 && it_ == CONV_SLOT) CONVERT_LATE; }
            }
            PH_END;
            if (PH_ON && PEN(11)) for (int rep_ = 0; rep_ < REPS(11); ++rep_) { PH_LANE;
                const float* lp = INP(I_DLAM) + j * 512;
                const float a0 = lp[lane] * lp[128 + lane] + lp[64 + lane] * lp[128 + 64 + lane], a1 = lp[256 + lane] * lp[384 + lane] + lp[256 + 64 + lane] * lp[384 + 64 + lane];
                const float lam_init = (layer == 1) ? 0.35550906759096934f : 0.5560582041556406f;
                const float lam = expf(wave_sum(a0)) - expf(wave_sum(a1)) + lam_init;
                const float* subln = INP(I_SUBLN) + j * 256;
                int m = gw;
                for (; m + 3 * NGW < T; m += 4 * NGW) diff_combine_rows<4>(OC, H + 1024, DM, m, NGW, lam, 1.f - lam_init, subln, lane);
                for (; m < T; m += NGW) diff_combine_row(OC + (size_t)m * 2048, H + (size_t)m * DM + 1024, lam, 1.f - lam_init, subln, lane);
            }
            PH_END;
        }
        if (PH_ON && PEN(12)) for (int rep_ = 0; rep_ < REPS(12); ++rep_) { PH_LANE;
            pg8::Gemm g{H, W_OUT, T, DM, DM, DM, DM}; pg8::StaticOrder S; S.init(T, DM, G, bx, 4);
            pg8::EpiResidX E{XBH, XBH, PSQ(1), DM, (rep_ == REPS(12) - 1) ? 1.f : 0.f};
            pg8::gemm_phase(lds, g, S, E, wave, ((bx >> 3) & 7) * SKEW_TICKS);
        }
        PH_END;
        {
            bf16* XQ = (bf16*)(BIG + BIG_XQ); bf16* XO = (bf16*)(BIG + BIG_XO);
            if (PH_ON && PEN(14)) for (int rep_ = 0; rep_ < REPS(14); ++rep_) { PH_LANE;
#pragma unroll 1
                for (int gi = 0; gi < 2; ++gi) {
                    pg8::Gemm g{gi ? MN : XBA, gi ? W_XKV : W_XQ, gi ? TM : T, gi ? 1024 : 512, DM, DM, DM}; pg8::StaticOrder S; S.init(g.M, g.N, G, gi ? (bx + (G >> 1)) % G : bx);
                    pg8::EpiBf16<0, 32> E{gi ? MKV : XQ, g.N, 0, 0, PSQ(1), 1.f / 2048.f, nullptr, 0, gi};
                    pg8::gemm_phase(lds, g, S, E, wave);
                }
            }
            PH_END;
            if (PH_ON && PEN(15)) for (int rep_ = 0; rep_ < REPS(15); ++rep_) { PH_LANE;
                for (int u = vcu; u < NSEQ * 4 * 16; u += G) { const int qb = u & 15, h = (u >> 4) & 3, b = u >> 6; const size_t t0 = (size_t)b * SEQ;
                    att::dense_unit3<0>(XQ + (t0 + qb * 256) * 512 + h * 128, 512, MKV + (size_t)b * MEMLEN * 1024 + h * 128, 1024,
                                         MKV + (size_t)b * MEMLEN * 1024 + 512 + h * 128, 1024, XO + (t0 + qb * 256) * 512 + h * 128, 512, MEMLEN, (LAS char*)lds, wave, 0, nullptr, nullptr); }
            }
            PH_END;
            if (PH_ON && PEN(16)) for (int rep_ = 0; rep_ < REPS(16); ++rep_) { PH_LANE;
                pg8::Gemm g{XO, W_XO, T, DM, 512, 512, 512}; pg8::StaticOrder S; S.init(T, DM, G, bx, 4);
                pg8::EpiResidX E{XBH, XBH, PSQ(2), DM, (rep_ == REPS(16) - 1) ? 1.f : 0.f};
                pg8::gemm_phase(lds, g, S, E, wave, ((bx >> 3) & 7) * SKEW_TICKS);
            }
            PH_END;
        }
        {
#pragma unroll 1
            for (int ch = -1; ch < N_MLP_CHUNKS; ++ch) {
                if (PH_ON && PEN(19)) for (int rep_ = 0; rep_ < REPS(19); ++rep_) { PH_LANE;
                    if (ch >= 0) {
                        pg8::Gemm g{(bf16*)(BIG + (size_t)(ch & 1) * U_BYTES), W_DOWN, MLP_CHUNK, DM, DFF, DFF, DFF}; pg8::StaticOrder S; S.init(MLP_CHUNK, DM, G, bx, 4);
                        const size_t co = (size_t)ch * MLP_CHUNK * DM; const bool lastl = (layer == DEPTH - 1);
                        pg8::EpiResidX E{XBH + co, (lastl ? HFIN : XBH) + co, PSQ(0) + (size_t)ch * MLP_CHUNK * 32, DM, (rep_ == REPS(19) - 1) ? 1.f : 0.f};
                        pg8::gemm_phase(lds, g, S, E, wave);
                    }
                    if (ch + 1 < N_MLP_CHUNKS) { const int cn = ch + 1;
                        pg8::Gemm g{XBA + (size_t)cn * MLP_CHUNK * DM, W_UP, MLP_CHUNK, DFF, DM, DM, DM}; pg8::StaticOrder S; S.init(MLP_CHUNK, DFF, G, bx, 8);
                        pg8::EpiBf16<2, 32> E{(bf16*)(BIG + (size_t)(cn & 1) * U_BYTES), DFF, 0, 0, PSQ(2) + (size_t)cn * MLP_CHUNK * 32, 1.f / 2048.f, nullptr, 0};
                        pg8::gemm_phase(lds, g, S, E, wave);
                    }
                }
                PH_END;
            }
        }
    }
    if (PH_ON && PEN(20)) for (int rep_ = 0; rep_ < REPS(20); ++rep_) { PH_LANE; const float* g = INP(I_FINAL); const float* ssf = PSQ(0);
        f32x4 gg[8];
#pragma unroll
        for (int jj = 0; jj < 8; ++jj) gg[jj] = ((const f32x4*)g + lane)[64 * jj];
        int m = gw;
        for (; m + 3 * NGW < T; m += 4 * NGW) final_norm_rows<4>(HFIN, X, gg, ssf, m, NGW, lane);
        for (; m < T; m += NGW) final_norm_row(HFIN + (size_t)m * DM, X + (size_t)m * DM, g, wave_sum(lane < 32 ? ssf[(size_t)m * 32 + lane] : 0.f), lane); }
#undef PH_ON
#undef PH_END
}

extern "C" void kernel_launch(void* const* d_in, const int* in_sizes, int n_in, void* d_out, int out_size, void* d_ws, size_t ws_size, hipStream_t stream) {
    static int grid = 0;
    if (grid == 0) {
        if (n_in != 27 || out_size != T * DM || ws_size < WS_END) { fprintf(stderr, "kernel_launch: shape mismatch: n_in %d out %d ws %zu (need %zu)\n", n_in, out_size, ws_size, (size_t)WS_END); grid = -1; return; }
        int dev = 0, cus = 0, per_cu = 0;
        if (hipGetDevice(&dev) != hipSuccess || hipDeviceGetAttribute(&cus, hipDeviceAttributeMultiprocessorCount, dev) != hipSuccess) { grid = -1; return; }
        if (hipFuncSetAttribute((const void*)fwd, hipFuncAttributeMaxDynamicSharedMemorySize, LDS_BYTES) != hipSuccess) { fprintf(stderr, "kernel_launch: hipFuncSetAttribute failed\n"); grid = -1; return; }
        if (hipOccupancyMaxActiveBlocksPerMultiprocessor(&per_cu, (const void*)fwd, 512, LDS_BYTES) != hipSuccess || per_cu < 1) { fprintf(stderr, "kernel_launch: occupancy query says %d\n", per_cu); }
        (void)hipGetLastError();
        grid = cus;
    }
    if (grid < 0) return;
    if (hipMemsetAsync((char*)d_ws + WS_CTL, 0, CTL_ZERO_BYTES, stream) != hipSuccess) return;
    Args a{};
    for (int i = 0; i < 27; ++i) a.in[i] = (const float*)d_in[i];
    a.out = (float*)d_out; a.ws = (unsigned char*)d_ws; a.ph_lo = 0; a.ph_hi = 1 << 30;
    hipLaunchKernelGGL(fwd, dim3(grid), dim3(512), LDS_BYTES, stream, a);
    const hipError_t le = hipPeekAtLastError();
    if (le != hipSuccess) fprintf(stderr, "kernel_launch: launch failed: %s\n", hipGetErrorName(le));
}
```

```cpp
#include <hip/hip_runtime.h>
#include <cstdio>
#include <cstdint>

#define LAS __attribute__((address_space(3)))
#define GAS __attribute__((address_space(1)))
typedef unsigned short bf16;
typedef short bf16x8 __attribute__((ext_vector_type(8)));
typedef short s16x4 __attribute__((ext_vector_type(4)));
typedef float f32x4 __attribute__((ext_vector_type(4)));
typedef float f32x2 __attribute__((ext_vector_type(2)));
typedef float f32x16 __attribute__((ext_vector_type(16)));
typedef unsigned u32x4 __attribute__((ext_vector_type(4)));
typedef unsigned u32x2 __attribute__((ext_vector_type(2)));

constexpr int DM = 2048, SEQ = 4096, NSEQ = 12, T = NSEQ * SEQ  , T_PROMPT = 8 * SEQ;
constexpr int DEPTH = 4, MEMLEN = 256, TM = NSEQ * MEMLEN  ;
constexpr int AB_IN = 2624, AB_PAD = 2816, CD_IN = 6144, DFF = 8192;
constexpr int MLP_CHUNK = 8192, N_MLP_CHUNKS = T / MLP_CHUNK;
constexpr size_t U_BYTES = (size_t)MLP_CHUNK * DFF * 2;
constexpr float EPS = 1e-6f;

__device__ __forceinline__ unsigned cvt_pk_bf16(float lo, float hi) { unsigned r; asm volatile("v_cvt_pk_bf16_f32 %0, %1, %2" : "=v"(r) : "v"(lo), "v"(hi)); return r; }
__device__ __forceinline__ float bf2f(unsigned short b) { return __builtin_bit_cast(float, ((unsigned)b) << 16); }
__device__ __forceinline__ float bflo(unsigned w) { return __builtin_bit_cast(float, w << 16); }
__device__ __forceinline__ float bfhi(unsigned w) { return __builtin_bit_cast(float, w & 0xffff0000u); }
__device__ __forceinline__ int lane_id_fresh() { int l; asm volatile("v_mbcnt_lo_u32_b32 %0, -1, 0\n\tv_mbcnt_hi_u32_b32 %0, -1, %0" : "=v"(l)); return l; }
template <int XOR> __device__ __forceinline__ float swz_xor(float v) { return __builtin_bit_cast(float, __builtin_amdgcn_ds_swizzle(__builtin_bit_cast(int, v), (XOR << 10) | 0x1f)); }
__device__ __forceinline__ float wave_sum(float v) {
    v += swz_xor<1>(v); v += swz_xor<2>(v); v += swz_xor<4>(v); v += swz_xor<8>(v); v += swz_xor<16>(v);
    auto rr = __builtin_amdgcn_permlane32_swap(__float_as_uint(v), __float_as_uint(v), false, false);
    return __uint_as_float(rr[0]) + __uint_as_float(rr[1]);
}
__device__ __forceinline__ float other_half(float v, bool lower) {
    auto rr = __builtin_amdgcn_permlane32_swap(__float_as_uint(v), __float_as_uint(v), false, false);
    return lower ? __uint_as_float(rr[1]) : __uint_as_float(rr[0]);
}

namespace pg8 {
constexpr int BM = 256, BK = 64, HALF = 128, HTB = HALF * BK * 2, STAGE_BYTES = 8 * HTB, NXCD = 8, WGM = 8;
__host__ __device__ __forceinline__ int lds_byte(int r, int c) { const int st = (r >> 4) * 2 + (c >> 5), rr = r & 15, cc = c & 31, ob = rr * 64 + cc * 2; return st * 1024 + (ob ^ (((ob >> 9) & 1) << 5)); }
__host__ __device__ __forceinline__ void stage_rc(int b, int& R, int& C) { const int st = b / 1024, sb = b % 1024, swz = sb ^ (((sb >> 9) & 1) << 5); R = (st >> 1) * 16 + swz / 64; C = (st & 1) * 32 + (swz % 64) / 2; }
__host__ __device__ __forceinline__ int perm32(int rho) { const int n = rho >> 4, i = rho & 15; return 8 * (i >> 2) + 4 * n + (i & 3); }

struct Unit { int pm, pn; };
struct Gemm { const bf16* A; const bf16* Bt; int M, N, K, lda, ldb; };

struct StaticOrder {
    int nM, nN, nwg, G, c, wgm;
    __device__ void init(int M, int N, int G_, int c_, int wgm_ = WGM) { nM = M / BM; nN = N / BM; nwg = nM * nN; G = G_; c = c_; wgm = wgm_; }
    __device__ bool next(int i, Unit& u) const {
        const long L = (long)i * G + c; if (L >= nwg) return false;
        int wgid = (int)L; { const int q = nwg / NXCD, r = nwg % NXCD, xcd = wgid % NXCD, off = wgid / NXCD; wgid = (xcd < r ? xcd * (q + 1) : r * (q + 1) + (xcd - r) * q) + off; }
        const int nig = wgm * nN, gid = wgid / nig, fm = gid * wgm, gsz = (nM - fm) < wgm ? (nM - fm) : wgm;
        u.pm = fm + ((wgid % nig) % gsz); u.pn = (wgid % nig) / gsz; return true;
    }
};

template <int W> __device__ __forceinline__ float row_ss(const float* ps, int row, int fq) {
    float s;
    if constexpr (W == 32) { const f32x4 a = *(const f32x4*)(ps + (size_t)row * 32 + fq * 8), b = *(const f32x4*)(ps + (size_t)row * 32 + fq * 8 + 4); s = ((a.x + a.y) + (a.z + a.w)) + ((b.x + b.y) + (b.z + b.w)); }
    else { const f32x2 a = *(const f32x2*)(ps + (size_t)row * 8 + fq * 2); s = a.x + a.y; }
    s += swz_xor<16>(s); s += other_half(s, fq < 2); return s;
}
__device__ __forceinline__ void store_row_sums(const float (&s8)[8], float* slot0, int slots_per_row, int row0, int fq) {
#pragma unroll
    for (int k = 0; k < 2; ++k) {
        const float v = fq == 0 ? s8[4 * k] : (fq == 1 ? s8[4 * k + 1] : (fq == 2 ? s8[4 * k + 2] : s8[4 * k + 3]));
        slot0[(size_t)(row0 + k * HALF + fq * 16) * slots_per_row] = v; }
}
constexpr int RS_LDS_OFF = 135168 + 2048;
template <int ACT  , int RSW> struct EpiBf16 {
    static constexpr bool PERM = true;
    bf16* O; int ldc; int split_cols; size_t split_stride; const float* rs_in; float rs_inv_dim; float* ss_out; size_t ss_stride; int rs_off;
    struct RsPf { f32x4 a[2], b[2]; f32x2 c[2]; };
    __device__ __forceinline__ void rs_issue(RsPf& p, int pm, int wr, int wc, int fr, int fq) const {
#pragma unroll
        for (int ai = 0; ai < 2; ++ai) { const size_t row = (size_t)pm * BM + wr * 64 + fr + ai * HALF + wc * 16;
            if constexpr (RSW == 32) { const float* q = rs_in + row * 32 + fq * 8;
                asm volatile("global_load_dwordx4 %0, %2, off\n\tglobal_load_dwordx4 %1, %2, off offset:16" : "=&v"(p.a[ai]), "=&v"(p.b[ai]) : "v"(q) : "memory"); }
            else { const float* q = rs_in + row * 8 + fq * 2;
                asm volatile("global_load_dwordx2 %0, %1, off" : "=&v"(p.c[ai]) : "v"(q) : "memory"); } }
    }
    template <int NYOUNGER>
    __device__ __forceinline__ void rs_finish(RsPf p, LAS unsigned char* lds, int parity, int wr, int wc, int fr, int fq) const {
        static_assert(NYOUNGER == 8 || NYOUNGER == 16, "count");
        if constexpr (RSW == 32) {
            if constexpr (NYOUNGER == 16) asm volatile("s_waitcnt vmcnt(16)" : "+v"(p.a[0]), "+v"(p.b[0]), "+v"(p.a[1]), "+v"(p.b[1]) :: "memory");
            else asm volatile("s_waitcnt vmcnt(8)" : "+v"(p.a[0]), "+v"(p.b[0]), "+v"(p.a[1]), "+v"(p.b[1]) :: "memory");
        } else {
            if constexpr (NYOUNGER == 16) asm volatile("s_waitcnt vmcnt(16)" : "+v"(p.c[0]), "+v"(p.c[1]) :: "memory");
            else asm volatile("s_waitcnt vmcnt(8)" : "+v"(p.c[0]), "+v"(p.c[1]) :: "memory");
        }
        LAS float* rsl = (LAS float*)(lds + RS_LDS_OFF) + parity * 256;
#pragma unroll
        for (int ai = 0; ai < 2; ++ai) { float s;
            if constexpr (RSW == 32) s = ((p.a[ai].x + p.a[ai].y) + (p.a[ai].z + p.a[ai].w)) + ((p.b[ai].x + p.b[ai].y) + (p.b[ai].z + p.b[ai].w)); else s = p.c[ai].x + p.c[ai].y;
            s += swz_xor<16>(s); s += other_half(s, fq < 2);
            const float rs = 1.f / sqrtf(s * rs_inv_dim + EPS);
            if (fq == 0) rsl[wr * 64 + fr + ai * HALF + wc * 16] = rs; }
        asm volatile("s_waitcnt lgkmcnt(0)" ::: "memory");
    }
    __device__ __forceinline__ void operator()(const f32x4 (&acc)[2][2][4][2], const Unit& u, int wr, int wc, int fr, int fq, LAS unsigned char* lds, int parity, const Unit& nx, bool has_next) const {
        RsPf pf; rs_issue(pf, has_next ? nx.pm : u.pm, wr, wc, fr, fq);
        const LAS float* rsl = (const LAS float*)(lds + RS_LDS_OFF) + parity * 256 + wr * 64 + fr;
        const int row0 = u.pm * BM + wr * 64 + fr; int colt = u.pn * BM; bf16* base = O;
        if (split_cols) { const int t = colt / split_cols; base += (size_t)t * split_stride; colt -= t * split_cols; }
        const int col0 = colt + wc * 32 + 8 * fq;
        const bool do_ss = (ss_out != nullptr) && (u.pn < 4);
        float* ssp = do_ss ? ss_out + (size_t)(u.pn >> 1) * ss_stride + (u.pn & 1) * 4 + wc : nullptr;
        float s8[8] = {0.f, 0.f, 0.f, 0.f, 0.f, 0.f, 0.f, 0.f};
#pragma unroll
        for (int ai = 0; ai < 2; ++ai)
#pragma unroll
            for (int m = 0; m < 4; ++m) { const int row = row0 + ai * HALF + m * 16; bf16* rowp = base + (size_t)row * ldc + col0;
                float rs = rsl[ai * HALF + m * 16]; rs = rs_off ? 1.f : rs;
                float ss = 0.f;
#pragma unroll
                for (int bj = 0; bj < 2; ++bj) { f32x4 v0 = acc[ai][bj][m][0] * rs, v1 = acc[ai][bj][m][1] * rs;
                    if (ACT == 2) {
#pragma unroll
                        for (int j = 0; j < 4; ++j) { const float a = fmaxf(v0[j], 0.f), b = fmaxf(v1[j], 0.f); v0[j] = a * a; v1[j] = b * b; } }
                    u32x4 w; w.x = cvt_pk_bf16(v0[0], v0[1]); w.y = cvt_pk_bf16(v0[2], v0[3]); w.z = cvt_pk_bf16(v1[0], v1[1]); w.w = cvt_pk_bf16(v1[2], v1[3]);
                    *(u32x4*)(rowp + bj * HALF) = w;
                    if (do_ss) { const float a0 = bflo(w.x), a1 = bfhi(w.x), a2 = bflo(w.y), a3 = bfhi(w.y), a4 = bflo(w.z), a5 = bfhi(w.z), a6 = bflo(w.w), a7 = bfhi(w.w);
                        ss += (a0 * a0 + a1 * a1) + (a2 * a2 + a3 * a3) + (a4 * a4 + a5 * a5) + (a6 * a6 + a7 * a7); } }
                if (do_ss) { ss += swz_xor<16>(ss); ss += other_half(ss, fq < 2); s8[ai * 4 + m] = ss; } }
        if (do_ss) store_row_sums(s8, ssp, 8, row0, fq);
        rs_finish<16>(pf, lds, parity ^ 1, wr, wc, fr, fq);
    }
};
struct EpiResidX {
    static constexpr bool PERM = true;
    const bf16* XBin; bf16* XBout; float* ps; int ldc; float scale;
    struct RsPf {};
    __device__ __forceinline__ void rs_issue(RsPf&, int, int, int, int, int) const {}
    template <int NYOUNGER> __device__ __forceinline__ void rs_finish(const RsPf&, LAS unsigned char*, int, int, int, int, int) const {}
    __device__ __forceinline__ void operator()(const f32x4 (&acc)[2][2][4][2], const Unit& u, int wr, int wc, int fr, int fq, LAS unsigned char*, int, const Unit&, bool) const {
        const int row0 = u.pm * BM + wr * 64 + fr, col0 = u.pn * BM + wc * 32 + 8 * fq;
        float* psp = ps + u.pn * 4 + wc;
        float s8[8];
        u32x4 ch[2][4][2];
#pragma unroll
        for (int ai = 0; ai < 2; ++ai)
#pragma unroll
            for (int m = 0; m < 4; ++m) { const bf16* q = XBin + (size_t)(row0 + ai * HALF + m * 16) * ldc + col0;
                asm volatile("global_load_dwordx4 %0, %2, off\n\tglobal_load_dwordx4 %1, %2, off offset:256" : "=&v"(ch[ai][m][0]), "=&v"(ch[ai][m][1]) : "v"(q) : "memory"); }
        static_assert(HALF * 2 == 256, "the second load's immediate offset");
#pragma unroll
        for (int ai = 0; ai < 2; ++ai)
#pragma unroll
            for (int m = 0; m < 4; ++m) { const int row = row0 + ai * HALF + m * 16; const size_t off = (size_t)row * ldc + col0;
                float ss = 0.f;
                asm volatile("s_waitcnt vmcnt(14)" : "+v"(ch[ai][m][0]), "+v"(ch[ai][m][1]) :: "memory");
#pragma unroll
                for (int bj = 0; bj < 2; ++bj) { const u32x4 h4 = ch[ai][m][bj]; const f32x4 a0 = acc[ai][bj][m][0] * scale, a1 = acc[ai][bj][m][1] * scale;
                    u32x4 wh; wh.x = cvt_pk_bf16(bflo(h4.x) + a0[0], bfhi(h4.x) + a0[1]); wh.y = cvt_pk_bf16(bflo(h4.y) + a0[2], bfhi(h4.y) + a0[3]);
                    wh.z = cvt_pk_bf16(bflo(h4.z) + a1[0], bfhi(h4.z) + a1[1]); wh.w = cvt_pk_bf16(bflo(h4.w) + a1[2], bfhi(h4.w) + a1[3]);
                    *(u32x4*)(XBout + off + bj * HALF) = wh;
                    const float y0 = bflo(wh.x), y1 = bfhi(wh.x), y2 = bflo(wh.y), y3 = bfhi(wh.y), y4 = bflo(wh.z), y5 = bfhi(wh.z), y6 = bflo(wh.w), y7 = bfhi(wh.w);
                    ss += (y0 * y0 + y1 * y1) + (y2 * y2 + y3 * y3) + (y4 * y4 + y5 * y5) + (y6 * y6 + y7 * y7); }
                ss += swz_xor<16>(ss); ss += other_half(ss, fq < 2); s8[ai * 4 + m] = ss; }
        store_row_sums(s8, psp, 32, row0, fq);
    }
};

template <class Epi>
__device__ __forceinline__ void gemm_phase(LAS unsigned char* lds, const Gemm g, const StaticOrder& S, const Epi& E, int wid, int skew_ticks = 0) {
    if (skew_ticks > 0) {
        const unsigned long long t0 = __builtin_amdgcn_s_memrealtime();
        while (__builtin_amdgcn_s_memrealtime() - t0 < (unsigned long long)skew_ticks) __builtin_amdgcn_s_sleep(8);
    }
    const int lane = lane_id_fresh(), tid = wid * 64 + lane, wr = wid >> 2, wc = wid & 3, fr = lane & 15, fq = lane >> 4;
    const int K = g.K, nt = K / BK;
    unsigned voffA[2], voffB[2];
#pragma unroll
    for (int i = 0; i < 2; ++i) { int R, C; stage_rc(tid * 16 + i * 8192, R, C); const int Rb = Epi::PERM ? ((R & ~31) + perm32(R & 31)) : R;
        voffA[i] = (unsigned)(R * g.lda + C) * 2u; voffB[i] = (unsigned)(Rb * g.ldb + C) * 2u; }
    const size_t kstep = (size_t)(BK * 2);
    const size_t hstepA = (size_t)HALF * g.lda * 2, hstepB = (size_t)HALF * g.ldb * 2;
    const size_t tstepA = 2 * hstepA, tstepB = 2 * hstepB;
    const unsigned ldsw = (unsigned)wid * 1024u;
    const int aoff = lds_byte(wr * 64 + fr, fq * 8), boff = lds_byte(wc * 32 + fr, fq * 8);
#define PG8_SA(b, h) (((b) * 2 + (h)) * HTB)
#define PG8_SB(b, h) ((4 + (b) * 2 + (h)) * HTB)
#define PG8_STAGE(bufoff, gbase, voff) do { _Pragma("unroll") for (int _i = 0; _i < 2; ++_i) \
        __builtin_amdgcn_global_load_lds((const unsigned*)((const char*)(gbase) + (voff)[_i]), (LAS unsigned*)(lds + (bufoff) + ldsw + _i * 8192), 16, 0, 0); } while (0)
#define PG8_LDA(dst, b, h) do { _Pragma("unroll") for (int m = 0; m < 4; ++m) _Pragma("unroll") for (int k = 0; k < 2; ++k) dst[m][k] = *(const LAS bf16x8*)(lds + PG8_SA(b, h) + aoff + m * 2048 + k * 1024); } while (0)
#define PG8_LDB(dst, b, h) do { _Pragma("unroll") for (int n = 0; n < 2; ++n) _Pragma("unroll") for (int k = 0; k < 2; ++k) dst[n][k] = *(const LAS bf16x8*)(lds + PG8_SB(b, h) + boff + n * 2048 + k * 1024); } while (0)
#define PG8_MMA(ai, bj, At, Bt) do { __builtin_amdgcn_s_setprio(1); _Pragma("unroll") for (int m = 0; m < 4; ++m) _Pragma("unroll") for (int n = 0; n < 2; ++n) _Pragma("unroll") for (int k = 0; k < 2; ++k) \
        acc[ai][bj][m][n] = __builtin_amdgcn_mfma_f32_16x16x32_bf16(Bt[n][k], At[m][k], acc[ai][bj][m][n], 0, 0, 0); __builtin_amdgcn_s_setprio(0); } while (0)
#define PG8_WAIT_V(n) asm volatile("s_waitcnt vmcnt(" #n ")" ::: "memory")
#define PG8_WAIT_L(n) asm volatile("s_waitcnt lgkmcnt(" #n ")" ::: "memory")
#define PG8_BAR __builtin_amdgcn_s_barrier()
#define PG8_SCHED __builtin_amdgcn_sched_barrier(0)
    Unit cur, nxt; int ui = 0;
    if (!S.next(0, cur)) return;
    f32x4 acc[2][2][4][2];
#pragma unroll
    for (int a = 0; a < 2; ++a)
#pragma unroll
        for (int b = 0; b < 2; ++b)
#pragma unroll
            for (int m = 0; m < 4; ++m)
#pragma unroll
                for (int n = 0; n < 2; ++n) acc[a][b][m][n] = (f32x4){0.f, 0.f, 0.f, 0.f};
    bf16x8 At[4][2], B0[2][2], B1[2][2];
    const char* cA = (const char*)g.A + (size_t)cur.pm * tstepA; const char* cB = (const char*)g.Bt + (size_t)cur.pn * tstepB;
    typename Epi::RsPf pf0; E.rs_issue(pf0, cur.pm, wr, wc, fr, fq);
    PG8_STAGE(PG8_SB(0, 0), cB, voffB); PG8_STAGE(PG8_SB(0, 1), cB + hstepB, voffB); PG8_STAGE(PG8_SA(0, 0), cA, voffA); PG8_STAGE(PG8_SA(0, 1), cA + hstepA, voffA);
    if (wr == 1) PG8_BAR;
    PG8_WAIT_V(2); PG8_BAR;
    E.template rs_finish<8>(pf0, lds, 0, wr, wc, fr, fq);
    PG8_STAGE(PG8_SB(1, 0), cB + kstep, voffB); PG8_STAGE(PG8_SA(1, 0), cA + kstep, voffA); PG8_STAGE(PG8_SB(1, 1), cB + hstepB + kstep, voffB);
    PG8_WAIT_V(6); PG8_BAR;
    for (;;) {
        const bool has_next = S.next(ui + 1, nxt);
        const char* nA = has_next ? (const char*)g.A + (size_t)nxt.pm * tstepA : cA; const char* nB = has_next ? (const char*)g.Bt + (size_t)nxt.pn * tstepB : cB;
        for (int t = 0; t < nt; t += 2) {
            const bool last = (t == nt - 2);
            const char* a1 = cA + (size_t)(t + 1) * kstep;
            const char* a2 = last ? nA : cA + (size_t)(t + 2) * kstep; const char* b2 = last ? nB : cB + (size_t)(t + 2) * kstep;
            const char* a3 = a2 + kstep; const char* b3 = b2 + kstep;
            PG8_LDB(B0, 0, 0); PG8_LDB(B1, 0, 1); PG8_SCHED; PG8_LDA(At, 0, 0); PG8_STAGE(PG8_SA(1, 1), a1 + hstepA, voffA);
            PG8_WAIT_V(8); PG8_WAIT_L(0); PG8_BAR; PG8_MMA(0, 0, At, B0); PG8_MMA(0, 1, At, B1); PG8_BAR; PG8_SCHED;
            PG8_LDA(At, 0, 1); PG8_STAGE(PG8_SB(0, 0), b2, voffB); PG8_STAGE(PG8_SB(0, 1), b2 + hstepB, voffB); PG8_STAGE(PG8_SA(0, 0), a2, voffA);
            PG8_WAIT_V(8); PG8_WAIT_L(0); PG8_BAR; PG8_MMA(1, 0, At, B0); PG8_MMA(1, 1, At, B1); PG8_BAR; PG8_SCHED;
            PG8_LDB(B0, 1, 0); PG8_LDB(B1, 1, 1); PG8_SCHED; PG8_LDA(At, 1, 0); PG8_STAGE(PG8_SA(0, 1), a2 + hstepA, voffA);
            PG8_WAIT_V(8); PG8_WAIT_L(0); PG8_BAR; PG8_MMA(0, 0, At, B0); PG8_MMA(0, 1, At, B1); PG8_BAR; PG8_SCHED;
            PG8_LDA(At, 1, 1); PG8_STAGE(PG8_SB(1, 0), b3, voffB); PG8_STAGE(PG8_SB(1, 1), b3 + hstepB, voffB); PG8_STAGE(PG8_SA(1, 0), a3, voffA);
            PG8_WAIT_V(8); PG8_WAIT_L(0); PG8_BAR; PG8_MMA(1, 0, At, B0); PG8_MMA(1, 1, At, B1); PG8_BAR; PG8_SCHED;
        }
        if (wr == 0) PG8_BAR;
        E(acc, cur, wr, wc, fr, fq, lds, ui & 1, nxt, has_next);
        if (!has_next) break;
#pragma unroll
        for (int a = 0; a < 2; ++a)
#pragma unroll
            for (int b = 0; b < 2; ++b)
#pragma unroll
                for (int m = 0; m < 4; ++m)
#pragma unroll
                    for (int n = 0; n < 2; ++n) acc[a][b][m][n] = (f32x4){0.f, 0.f, 0.f, 0.f};
        cur = nxt; cA = nA; cB = nB; ++ui;
        if (wr == 1) PG8_BAR;
    }
    PG8_WAIT_V(0);
    PG8_BAR;
#undef PG8_SA
#undef PG8_SB
#undef PG8_STAGE
#undef PG8_LDA
#undef PG8_LDB
#undef PG8_MMA
#undef PG8_WAIT_V
#undef PG8_WAIT_L
#undef PG8_BAR
#undef PG8_SCHED
}
}

namespace att {
#define SBAR() __builtin_amdgcn_sched_barrier(0)
constexpr int SHM_V = 64 * 128 * 2;
__device__ __forceinline__ int crow(int r, int hi) { return (r & 3) + 8 * (r >> 2) + 4 * hi; }
template <int DQK> struct Cfg {
    static constexpr int KP = DQK * 2, SHM_K = 64 * KP, OFF_K = 2 * SHM_V, OFF_WS = OFF_K + 2 * SHM_K, NPARK = (DQK == 192 ? 6 : 0), NREG = DQK / 16 - NPARK, OFF_QS = OFF_WS + 8 * 256, TOTAL = OFF_QS + 8 * 1024 * NPARK;
    static constexpr float SCALE = (DQK == 192) ? 0.07216878364870322f : 0.08838834764831845f;
    static constexpr float C = SCALE * 1.4426950408889634f;
};
constexpr float THR = 8.f;

template <int DQK>
__device__ __forceinline__ void partialSM(f32x16& p0, f32x16& p1, float& m_reg, float& mn, float& alpha) {
    constexpr float C = Cfg<DQK>::C, SCALE = Cfg<DQK>::SCALE;
    float pmax = p0[0];
#pragma unroll
    for (int r = 1; r < 16; ++r) pmax = fmaxf(pmax, p0[r]);
#pragma unroll
    for (int r = 0; r < 16; ++r) pmax = fmaxf(pmax, p1[r]);
    { auto rr = __builtin_amdgcn_permlane32_swap(__float_as_uint(pmax), __float_as_uint(pmax), false, false);
      pmax = fmaxf(__uint_as_float(rr[0]), __uint_as_float(rr[1])); }
    if (__builtin_expect(__all(pmax - m_reg <= THR / SCALE), 1)) { mn = m_reg; alpha = 1.f; }
    else { mn = fmaxf(m_reg, pmax); alpha = __builtin_amdgcn_exp2f((m_reg - mn) * C); m_reg = mn; }
    const float mnC = -mn * C;
#pragma unroll
    for (int r = 0; r < 16; ++r) p0[r] = fmaf(p0[r], C, mnC);
#pragma unroll
    for (int r = 0; r < 16; ++r) p1[r] = fmaf(p1[r], C, mnC);
#pragma unroll
    for (int r = 0; r < 16; ++r) p0[r] = __builtin_amdgcn_exp2f(p0[r]);
}
__device__ __forceinline__ void finishSM(f32x16& p0, f32x16& p1, float alpha, float& l_reg, bf16x8& pa0, bf16x8& pa1, bf16x8& pa2, bf16x8& pa3) {
#pragma unroll
    for (int r = 0; r < 16; ++r) p1[r] = __builtin_amdgcn_exp2f(p1[r]);
    float ps = 0;
#pragma unroll
    for (int r = 0; r < 16; ++r) ps += p0[r];
#pragma unroll
    for (int r = 0; r < 16; ++r) ps += p1[r];
    { auto rr = __builtin_amdgcn_permlane32_swap(__float_as_uint(ps), __float_as_uint(ps), false, false);
      ps = __uint_as_float(rr[0]) + __uint_as_float(rr[1]); }
    l_reg = l_reg * alpha + ps;
#define PK4(P, BASE, OUT) do { unsigned a0 = cvt_pk_bf16(P[BASE + 0], P[BASE + 1]), a1 = cvt_pk_bf16(P[BASE + 2], P[BASE + 3]);   \
    unsigned b0 = cvt_pk_bf16(P[BASE + 4], P[BASE + 5]), b1 = cvt_pk_bf16(P[BASE + 6], P[BASE + 7]);                              \
    auto r0 = __builtin_amdgcn_permlane32_swap(a0, b0, false, false); auto r1 = __builtin_amdgcn_permlane32_swap(a1, b1, false, false); \
    u32x4 w = {r0[0], r1[0], r0[1], r1[1]}; OUT = __builtin_bit_cast(bf16x8, w); } while (0)
    PK4(p0, 0, pa0); PK4(p0, 8, pa1); PK4(p1, 0, pa2); PK4(p1, 8, pa3);
#undef PK4
}
#define KSWZ(KP, row, colB) ((row) * (KP) + ((colB) ^ (((KP) == 256 ? ((row) & 15) : (((row) >> 1) & 7)) << 4)))
template <int DQK, int NREG = Cfg<DQK>::NREG>
__device__ __forceinline__ void qkt(f32x16& p0, f32x16& p1, const LAS char* Ks, const bf16x8* qr, const LAS char* Qs, int r32, int hi) {
    constexpr int KP = Cfg<DQK>::KP;
    p0 = f32x16{}; p1 = f32x16{};
#pragma unroll
    for (int d0 = 0; d0 < DQK / 16; ++d0) { const int cb = (d0 * 16 + hi * 8) * 2;
        const bf16x8 b0 = *(const LAS bf16x8*)(Ks + KSWZ(KP, r32, cb));
        const bf16x8 b1 = *(const LAS bf16x8*)(Ks + KSWZ(KP, 32 + r32, cb));
        bf16x8 q;
        if (d0 < NREG) q = qr[d0]; else q = *(const LAS bf16x8*)(Qs + (d0 - NREG) * 1024);
        p0 = __builtin_amdgcn_mfma_f32_32x32x16_bf16(b0, q, p0, 0, 0, 0);
        p1 = __builtin_amdgcn_mfma_f32_32x32x16_bf16(b1, q, p1, 0, 0, 0); }
}
__device__ __forceinline__ int v_st(int k, int c) { const int kk = (k & ~0xC) | ((k & 4) << 1) | ((k & 8) >> 1); return ((kk >> 3) * 4 + (c >> 5)) * 512 + ((kk & 7) * 32 + (c & 31)) * 2; }
__device__ __forceinline__ int v_rd_base(int lane) { return ((lane & 3) << 3) | (((lane >> 2) & 3) << 6) | (((lane >> 4) & 1) << 5) | (((lane >> 5) & 1) << 8); }
constexpr int v_rd_off(int d0, int ks, int half) { return d0 * 512 + ks * 4096 + half * 2048; }
template <int OFF> __device__ __forceinline__ s16x4 tr_read(int vb) {
    s16x4 r; asm volatile("ds_read_b64_tr_b16 %0, %1 offset:%2" : "=&v"(r) : "v"(vb), "i"(OFF) : "memory"); return r;
}
template <int D0> __device__ __forceinline__ void pv_one(f32x16& od, int vb, bf16x8 pa0, bf16x8 pa1, bf16x8 pa2, bf16x8 pa3) {
    const s16x4 l0 = tr_read<v_rd_off(D0, 0, 0)>(vb), h0 = tr_read<v_rd_off(D0, 0, 1)>(vb), l1 = tr_read<v_rd_off(D0, 1, 0)>(vb), h1 = tr_read<v_rd_off(D0, 1, 1)>(vb);
    const s16x4 l2 = tr_read<v_rd_off(D0, 2, 0)>(vb), h2 = tr_read<v_rd_off(D0, 2, 1)>(vb), l3 = tr_read<v_rd_off(D0, 3, 0)>(vb), h3 = tr_read<v_rd_off(D0, 3, 1)>(vb);
    asm volatile("s_waitcnt lgkmcnt(0)" ::: "memory"); SBAR();
#define PKV(L, H) (bf16x8){L[0], L[1], L[2], L[3], H[0], H[1], H[2], H[3]}
    od = __builtin_amdgcn_mfma_f32_32x32x16_bf16(pa0, PKV(l0, h0), od, 0, 0, 0);
    od = __builtin_amdgcn_mfma_f32_32x32x16_bf16(pa1, PKV(l1, h1), od, 0, 0, 0);
    od = __builtin_amdgcn_mfma_f32_32x32x16_bf16(pa2, PKV(l2, h2), od, 0, 0, 0);
    od = __builtin_amdgcn_mfma_f32_32x32x16_bf16(pa3, PKV(l3, h3), od, 0, 0, 0);
#undef PKV
}
__device__ __forceinline__ void pv_d0(f32x16* o, int vb, bf16x8 pa0, bf16x8 pa1, bf16x8 pa2, bf16x8 pa3) {
    pv_one<0>(o[0], vb, pa0, pa1, pa2, pa3); pv_one<1>(o[1], vb, pa0, pa1, pa2, pa3); pv_one<2>(o[2], vb, pa0, pa1, pa2, pa3); pv_one<3>(o[3], vb, pa0, pa1, pa2, pa3);
}
__device__ __forceinline__ void store_o(const f32x16* o, float l_reg, LAS float* li_l, LAS char* lds, bf16* Ob, int ldo, int wid, int lane, int r32, int hi) {
    if (hi == 0) li_l[r32] = l_reg;
    asm volatile("s_waitcnt lgkmcnt(0)" ::: "memory");
    float rli[16];
#pragma unroll
    for (int r = 0; r < 16; ++r) rli[r] = __builtin_amdgcn_rcpf(li_l[crow(r, hi)]);
    LAS unsigned short* slab = (LAS unsigned short*)(lds + wid * 8192);
#pragma unroll
    for (int r = 0; r < 16; ++r) { const int orow = crow(r, hi);
#pragma unroll
        for (int d0 = 0; d0 < 4; ++d0) slab[orow * 128 + d0 * 32 + r32] = (unsigned short)(cvt_pk_bf16(o[d0][r] * rli[r], 0.f) & 0xffffu); }
    asm volatile("s_waitcnt lgkmcnt(0)" ::: "memory");
#pragma unroll
    for (int i = 0; i < 8; ++i) { const int id = i * 64 + lane, row = id >> 4, c16 = id & 15;
        const u32x4 w = *(const LAS u32x4*)((LAS char*)slab + row * 256 + c16 * 16);
        *(u32x4*)(Ob + (unsigned)(wid * 32 + row) * (unsigned)ldo + c16 * 8) = w; }
}

__device__ __forceinline__ void unpack8(bf16x8 v, float (&x)[8]) {
#pragma unroll
    for (int e = 0; e < 8; ++e) x[e] = bf2f((unsigned short)v[e]);
}
__device__ __forceinline__ bf16x8 pack8(const float (&x)[8]) {
    u32x4 w; w.x = cvt_pk_bf16(x[0], x[1]); w.y = cvt_pk_bf16(x[2], x[3]); w.z = cvt_pk_bf16(x[4], x[5]); w.w = cvt_pk_bf16(x[6], x[7]); return __builtin_bit_cast(bf16x8, w);
}
__device__ __forceinline__ void rope_pair(bf16x8& f1, bf16x8& f2, const float* ct, const float* st, float mul, const float* g1, const float* g2) {
    float x1[8], x2[8], a[8], b[8]; unpack8(f1, x1); unpack8(f2, x2);
    const f32x4 c0 = *(const f32x4*)ct, c1 = *(const f32x4*)(ct + 4), s0 = *(const f32x4*)st, s1 = *(const f32x4*)(st + 4);
    const float c[8] = {c0.x, c0.y, c0.z, c0.w, c1.x, c1.y, c1.z, c1.w}, s[8] = {s0.x, s0.y, s0.z, s0.w, s1.x, s1.y, s1.z, s1.w};
    if (g1) {
        const f32x4 ga = *(const f32x4*)g1, gb = *(const f32x4*)(g1 + 4), gc = *(const f32x4*)g2, gd = *(const f32x4*)(g2 + 4);
        const float gg1[8] = {ga.x, ga.y, ga.z, ga.w, gb.x, gb.y, gb.z, gb.w}, gg2[8] = {gc.x, gc.y, gc.z, gc.w, gd.x, gd.y, gd.z, gd.w};
#pragma unroll
        for (int e = 0; e < 8; ++e) { x1[e] = x1[e] * mul * gg1[e]; x2[e] = x2[e] * mul * gg2[e]; }
    }
#pragma unroll
    for (int e = 0; e < 8; ++e) { a[e] = x1[e] * c[e] - x2[e] * s[e]; b[e] = x2[e] * c[e] + x1[e] * s[e]; }
    f1 = pack8(a); f2 = pack8(b);
}
template <int ND0, int QMODE>
__device__ __forceinline__ void load_q(bf16x8 (&qraw)[ND0], const bf16* __restrict__ Qb, int ldq, int wid, int r32, int hi, int qpos0, const float* __restrict__ tab, const float* __restrict__ qgain) {
    const unsigned qo = (unsigned)(wid * 32 + r32) * (unsigned)ldq + hi * 8;
#pragma unroll
    for (int d0 = 0; d0 < ND0; ++d0) qraw[d0] = *(const bf16x8*)(Qb + qo + d0 * 16);
    const int pos = qpos0 + wid * 32 + r32;
    if constexpr (QMODE == 1) {
        const float* ct = tab + pos * 32 + hi * 8; const float* st = ct + 4096 * 32;
        rope_pair(qraw[8], qraw[10], ct, st, 1.f, nullptr, nullptr); rope_pair(qraw[9], qraw[11], ct + 16, st + 16, 1.f, nullptr, nullptr);
    } else if constexpr (QMODE == 2) {
        const float* ct = tab + pos * 64 + hi * 8; const float* st = ct + 4096 * 64;
#pragma unroll
        for (int g = 0; g < 4; ++g) rope_pair(qraw[g], qraw[g + 4], ct + g * 16, st + g * 16, 1.f, nullptr, nullptr);
    } else if constexpr (QMODE == 3) {
        float ss = 0.f;
#pragma unroll
        for (int d0 = 0; d0 < 8; ++d0) { float x[8]; unpack8(qraw[d0], x);
#pragma unroll
            for (int e = 0; e < 8; ++e) ss += x[e] * x[e]; }
        ss += other_half(ss, hi == 0);
        const float rstd = 1.f / sqrtf(ss * (1.f / 128.f) + EPS);
        const float* ctr = tab + (pos >> 6) * 32 + hi * 8; const float* str = ctr + 4096 * 32; const float* ctc = tab + (pos & 63) * 32 + hi * 8; const float* stc = ctc + 4096 * 32;
        const float* gq = qgain + hi * 8;
#pragma unroll
        for (int g = 0; g < 2; ++g) { rope_pair(qraw[g], qraw[g + 2], ctr + g * 16, str + g * 16, rstd, gq + g * 16, gq + (g + 2) * 16);
                                      rope_pair(qraw[4 + g], qraw[6 + g], ctc + g * 16, stc + g * 16, rstd, gq + (4 + g) * 16, gq + (6 + g) * 16); }
    }
}
template <int DQK, int SDEPTH, int QMODE>
__device__ __forceinline__ void dense_unit(const bf16* __restrict__ Qb, int ldq, const bf16* __restrict__ Kh, int ldk, const bf16* __restrict__ K2h, int ldk2,
                                           const bf16* __restrict__ Vh, int ldv, bf16* __restrict__ Ob, int ldo, int seq, LAS char* lds, int wid,
                                           int qpos0, const float* __restrict__ tab, const float* __restrict__ qgain) {
    using CF = Cfg<DQK>; constexpr int KP = CF::KP, SHM_K = CF::SHM_K, ND0 = DQK / 16;
    const int lane = lane_id_fresh(), tid = wid * 64 + lane, r32 = lane & 31, hi = lane >> 5;
    LAS char* V_lds = lds; LAS char* K_lds = lds + CF::OFF_K;
    LAS float* ws = (LAS float*)(lds + CF::OFF_WS) + wid * 64; LAS float* li_l = ws; LAS float* al_l = ws + 32;
    float m_reg = -1e30f, l_reg = 0; f32x16 o[4] = {}; bf16x8 qr[CF::NREG];
    const LAS char* Qs = lds + CF::OFF_QS + wid * (1024 * CF::NPARK) + lane * 16;
    { bf16x8 qraw[ND0]; load_q<ND0, QMODE>(qraw, Qb, ldq, wid, r32, hi, qpos0, tab, qgain);
#pragma unroll
      for (int d0 = 0; d0 < CF::NREG; ++d0) qr[d0] = qraw[d0];
      if constexpr (CF::NPARK > 0) {
#pragma unroll
          for (int d0 = CF::NREG; d0 < ND0; ++d0) *(LAS bf16x8*)((LAS char*)Qs + (d0 - CF::NREG) * 1024) = qraw[d0]; } }
    const int sr = tid >> 4, sc = (tid & 15) * 8, vst0 = v_st(sr, sc), vst1 = v_st(32 + sr, sc);
    const int kst0 = KSWZ(KP, sr, sc * 2), kst1 = KSWZ(KP, 32 + sr, sc * 2);
    const int kr2 = tid >> 3, c2 = (tid & 7) * 8, kst2 = KSWZ(KP, kr2, (128 + c2) * 2);
    const unsigned vo = (unsigned)sr * (unsigned)ldv + sc, ko = (unsigned)sr * (unsigned)ldk + sc, k2o = (unsigned)kr2 * (unsigned)ldk2 + c2;
    const int vb0 = (int)(unsigned)(uintptr_t)V_lds + v_rd_base(lane);
    struct { bf16x8 vs0, vs1, ks0, ks1, k2; } sr_[SDEPTH];
#define SLOAD(i, k0) do { const bf16* Vt_ = Vh + (size_t)(k0) * ldv; const bf16* Kt_ = Kh + (size_t)(k0) * ldk; \
    sr_[i].vs0 = *(const bf16x8*)(Vt_ + vo); sr_[i].vs1 = *(const bf16x8*)(Vt_ + (size_t)32 * ldv + vo); \
    sr_[i].ks0 = *(const bf16x8*)(Kt_ + ko); sr_[i].ks1 = *(const bf16x8*)(Kt_ + (size_t)32 * ldk + ko); \
    if constexpr (DQK == 192) sr_[i].k2 = *(const bf16x8*)(K2h + (size_t)(k0) * ldk2 + k2o); } while (0)
#define SWRITE(b, i) do { *(LAS bf16x8*)(V_lds + (b) * SHM_V + vst0) = sr_[i].vs0; *(LAS bf16x8*)(V_lds + (b) * SHM_V + vst1) = sr_[i].vs1; \
    *(LAS bf16x8*)(K_lds + (b) * SHM_K + kst0) = sr_[i].ks0; *(LAS bf16x8*)(K_lds + (b) * SHM_K + kst1) = sr_[i].ks1; \
    if constexpr (DQK == 192) *(LAS bf16x8*)(K_lds + (b) * SHM_K + kst2) = sr_[i].k2; } while (0)
#define SWAIT() do { if constexpr (SDEPTH == 1) asm volatile("s_waitcnt vmcnt(0)" ::: "memory"); else if constexpr (DQK == 192) asm volatile("s_waitcnt vmcnt(5)" ::: "memory"); else asm volatile("s_waitcnt vmcnt(4)" ::: "memory"); } while (0)
#define RESC(a) do { if (__any((a) < 1.f)) { if (hi == 0) al_l[r32] = (a); asm volatile("s_waitcnt lgkmcnt(0)" ::: "memory"); \
    _Pragma("unroll") for (int d = 0; d < 4; ++d) _Pragma("unroll") for (int r = 0; r < 16; ++r) o[d][r] *= al_l[crow(r, hi)]; } } while (0)
    f32x16 pA0, pA1, pB0, pB1; float mnA, mnB, alA, alB; bf16x8 pa0, pa1, pa2, pa3; const int NT = seq / 64;
    constexpr int SE = 0, SO = SDEPTH - 1;
    __syncthreads();
    SLOAD(SE, 0); asm volatile("s_waitcnt vmcnt(0)" ::: "memory"); SWRITE(0, SE); __syncthreads();
    qkt<DQK>(pA0, pA1, K_lds, qr, Qs, r32, hi); partialSM<DQK>(pA0, pA1, m_reg, mnA, alA);
    SLOAD(SO, 64); if constexpr (SDEPTH == 2) { if (2 < NT) SLOAD(SE, 128); }
    SWAIT(); SWRITE(1, SO); __syncthreads();
    for (int j = 1; j + 1 < NT; j += 2) {
        SBAR(); qkt<DQK>(pB0, pB1, K_lds + SHM_K, qr, Qs, r32, hi);
        finishSM(pA0, pA1, alA, l_reg, pa0, pa1, pa2, pa3); SBAR();
        SLOAD(SO, (j + SDEPTH) * 64); SBAR();
        pv_d0(o, vb0, pa0, pa1, pa2, pa3); partialSM<DQK>(pB0, pB1, m_reg, mnB, alB);
        __syncthreads(); SWAIT(); SWRITE(0, SE);
        RESC(alB); __syncthreads();
        SBAR(); qkt<DQK>(pA0, pA1, K_lds, qr, Qs, r32, hi);
        finishSM(pB0, pB1, alB, l_reg, pa0, pa1, pa2, pa3); SBAR();
        if (SDEPTH == 1 || j + 3 < NT) SLOAD(SE, (j + 1 + SDEPTH) * 64); SBAR();
        pv_d0(o, vb0 + SHM_V, pa0, pa1, pa2, pa3); partialSM<DQK>(pA0, pA1, m_reg, mnA, alA);
        __syncthreads(); SWAIT(); SWRITE(1, SO);
        RESC(alA); __syncthreads();
    }
    SBAR(); qkt<DQK>(pB0, pB1, K_lds + SHM_K, qr, Qs, r32, hi);
    finishSM(pA0, pA1, alA, l_reg, pa0, pa1, pa2, pa3); SBAR();
    pv_d0(o, vb0, pa0, pa1, pa2, pa3); partialSM<DQK>(pB0, pB1, m_reg, mnB, alB);
    __syncthreads(); RESC(alB);
    finishSM(pB0, pB1, alB, l_reg, pa0, pa1, pa2, pa3); SBAR();
    pv_d0(o, vb0 + SHM_V, pa0, pa1, pa2, pa3);
    __syncthreads();
    store_o(o, l_reg, li_l, lds, Ob, ldo, wid, lane, r32, hi);
#undef SLOAD
#undef SWRITE
#undef SWAIT
}

constexpr int R3_SLOT = 32768, R3_OFF_WS = 3 * R3_SLOT, R3_TOTAL = R3_OFF_WS + 8 * 256;
template <int QMODE>
__device__ __forceinline__ void dense_unit3(const bf16* __restrict__ Qb, int ldq, const bf16* __restrict__ Kh, int ldk, const bf16* __restrict__ Vh, int ldv, bf16* __restrict__ Ob, int ldo, int seq,
                                            LAS char* lds, int wid, int qpos0, const float* __restrict__ tab, const float* __restrict__ qgain) {
    constexpr int KP = 256;
    const int lane = lane_id_fresh(), tid = wid * 64 + lane, r32 = lane & 31, hi = lane >> 5;
    LAS float* ws = (LAS float*)(lds + R3_OFF_WS) + wid * 64; LAS float* li_l = ws; LAS float* al_l = ws + 32;
    float m_reg = -1e30f, l_reg = 0; f32x16 o[4] = {}; bf16x8 qr[8];
    load_q<8, QMODE>(qr, Qb, ldq, wid, r32, hi, qpos0, tab, qgain);
    const int sr = tid >> 4, sc = (tid & 15) * 8, vst0 = v_st(sr, sc), vst1 = v_st(32 + sr, sc);
    const int kst0 = 16384 + KSWZ(KP, sr, sc * 2), kst1 = 16384 + KSWZ(KP, 32 + sr, sc * 2);
    const unsigned vo = (unsigned)sr * (unsigned)ldv + sc, ko = (unsigned)sr * (unsigned)ldk + sc;
    const int vbase = (int)(unsigned)(uintptr_t)lds + v_rd_base(lane);
    struct { bf16x8 vs0, vs1, ks0, ks1; } sr_[2];
#define SLOAD3(i, k0) do { const bf16* Vt_ = Vh + (size_t)(k0) * ldv; const bf16* Kt_ = Kh + (size_t)(k0) * ldk; \
    sr_[i].vs0 = *(const bf16x8*)(Vt_ + vo); sr_[i].vs1 = *(const bf16x8*)(Vt_ + (size_t)32 * ldv + vo); \
    sr_[i].ks0 = *(const bf16x8*)(Kt_ + ko); sr_[i].ks1 = *(const bf16x8*)(Kt_ + (size_t)32 * ldk + ko); } while (0)
#define SWRITE3(soff, i) do { *(LAS bf16x8*)(lds + (soff) + vst0) = sr_[i].vs0; *(LAS bf16x8*)(lds + (soff) + vst1) = sr_[i].vs1; \
    *(LAS bf16x8*)(lds + (soff) + kst0) = sr_[i].ks0; *(LAS bf16x8*)(lds + (soff) + kst1) = sr_[i].ks1; } while (0)
#define SWAIT3() asm volatile("s_waitcnt vmcnt(4)" ::: "memory")
#define RESC3(a) do { if (__any((a) < 1.f)) { if (hi == 0) al_l[r32] = (a); asm volatile("s_waitcnt lgkmcnt(0)" ::: "memory"); \
    _Pragma("unroll") for (int d = 0; d < 4; ++d) _Pragma("unroll") for (int r = 0; r < 16; ++r) o[d][r] *= al_l[crow(r, hi)]; } } while (0)
    f32x16 pA0, pA1, pB0, pB1; float mnA, mnB, alA, alB; bf16x8 pa0, pa1, pa2, pa3; const int NT = seq / 64;
    __syncthreads();
    SLOAD3(0, 0); SLOAD3(1, 64);
    SWAIT3(); SWRITE3(0, 0);
    if (2 < NT) SLOAD3(0, 128);
    __syncthreads();
    qkt<128>(pA0, pA1, lds + 16384, qr, nullptr, r32, hi); partialSM<128>(pA0, pA1, m_reg, mnA, alA);
    SWAIT3(); SWRITE3(R3_SLOT, 1);
    int sK = R3_SLOT, sV = 0, sW = 2 * R3_SLOT;
    for (int t = 1; t + 1 < NT; t += 2) {
        __syncthreads();
        SBAR(); qkt<128>(pB0, pB1, lds + sK + 16384, qr, nullptr, r32, hi);
        finishSM(pA0, pA1, alA, l_reg, pa0, pa1, pa2, pa3); SBAR();
        if (t + 2 < NT) SLOAD3(1, (t + 2) * 64); SBAR();
        pv_d0(o, vbase + sV, pa0, pa1, pa2, pa3); partialSM<128>(pB0, pB1, m_reg, mnB, alB);
        SWAIT3(); SWRITE3(sW, 0);
        RESC3(alB);
        { const int n = sV; sV = sK; sK = sW; sW = n; }
        __syncthreads();
        SBAR(); qkt<128>(pA0, pA1, lds + sK + 16384, qr, nullptr, r32, hi);
        finishSM(pB0, pB1, alB, l_reg, pa0, pa1, pa2, pa3); SBAR();
        if (t + 3 < NT) SLOAD3(0, (t + 3) * 64); SBAR();
        pv_d0(o, vbase + sV, pa0, pa1, pa2, pa3); partialSM<128>(pA0, pA1, m_reg, mnA, alA);
        SWAIT3(); if (t + 2 < NT) SWRITE3(sW, 1);
        RESC3(alA);
        { const int n = sV; sV = sK; sK = sW; sW = n; }
    }
    __syncthreads();
    SBAR(); qkt<128>(pB0, pB1, lds + sK + 16384, qr, nullptr, r32, hi);
    finishSM(pA0, pA1, alA, l_reg, pa0, pa1, pa2, pa3); SBAR();
    pv_d0(o, vbase + sV, pa0, pa1, pa2, pa3); partialSM<128>(pB0, pB1, m_reg, mnB, alB);
    RESC3(alB);
    finishSM(pB0, pB1, alB, l_reg, pa0, pa1, pa2, pa3); SBAR();
    pv_d0(o, vbase + sK, pa0, pa1, pa2, pa3);
    __syncthreads();
    store_o(o, l_reg, li_l, lds, Ob, ldo, wid, lane, r32, hi);
#undef SLOAD3
#undef SWRITE3
#undef SWAIT3
#undef RESC3
}

constexpr int DV_SLOT = 49152, DV_OFF_K = 32768, DV_OFF_WS = 131072, DV_TOTAL = DV_OFF_WS + 8 * 256;
struct DiffFuse { const bf16* O0b; bf16* Hb; int ldh; float lam, post; const float* subln; };
template <int FUSE>
__device__ __forceinline__ void dense_unit_dv256(const bf16* __restrict__ Qb, int ldq, const bf16* __restrict__ Kh, int ldk, const bf16* __restrict__ Vh, int ldv, bf16* __restrict__ Ob, int ldo, int seq,
                                                 LAS char* lds, int wid, int qpos0, const float* __restrict__ tab, const DiffFuse& df) {
    constexpr int KP = 256;
    const int lane = lane_id_fresh(), tid = wid * 64 + lane, r32 = lane & 31, hi = lane >> 5;
    LAS float* ws = (LAS float*)(lds + DV_OFF_WS) + wid * 64; LAS float* li_l = ws; LAS float* al_l = ws + 32;
    __syncthreads();
    float m_reg = -1e30f, l_reg = 0; f32x16 o[8] = {}; bf16x8 qr[4];
    const LAS char* Qs = lds + 2 * DV_SLOT + wid * 4096 + lane * 16;
    { bf16x8 qraw[8]; load_q<8, 2>(qraw, Qb, ldq, wid, r32, hi, qpos0, tab, nullptr);
#pragma unroll
      for (int d0 = 0; d0 < 4; ++d0) qr[d0] = qraw[d0];
#pragma unroll
      for (int d0 = 4; d0 < 8; ++d0) *(LAS bf16x8*)((LAS char*)Qs + (d0 - 4) * 1024) = qraw[d0]; }
    const int sr = tid >> 4, sc = (tid & 15) * 8, vst0 = v_st(sr, sc), vst1 = v_st(32 + sr, sc);
    const int kst0 = DV_OFF_K + KSWZ(KP, sr, sc * 2), kst1 = DV_OFF_K + KSWZ(KP, 32 + sr, sc * 2);
    const unsigned vo = (unsigned)sr * (unsigned)ldv + sc, ko = (unsigned)sr * (unsigned)ldk + sc;
    const int vbase = (int)(unsigned)(uintptr_t)lds + v_rd_base(lane);
    bf16x8 sv0, sv1, sv2, sv3, sk0, sk1;
#define DLOAD(k0) do { const bf16* Vt_ = Vh + (size_t)(k0) * ldv; const bf16* Kt_ = Kh + (size_t)(k0) * ldk; \
    sv0 = *(const bf16x8*)(Vt_ + vo); sv1 = *(const bf16x8*)(Vt_ + (size_t)32 * ldv + vo); sv2 = *(const bf16x8*)(Vt_ + vo + 128); sv3 = *(const bf16x8*)(Vt_ + (size_t)32 * ldv + vo + 128); \
    sk0 = *(const bf16x8*)(Kt_ + ko); sk1 = *(const bf16x8*)(Kt_ + (size_t)32 * ldk + ko); } while (0)
#define DWRITE(soff) do { *(LAS bf16x8*)(lds + (soff) + vst0) = sv0; *(LAS bf16x8*)(lds + (soff) + vst1) = sv1; *(LAS bf16x8*)(lds + (soff) + 16384 + vst0) = sv2; *(LAS bf16x8*)(lds + (soff) + 16384 + vst1) = sv3; \
    *(LAS bf16x8*)(lds + (soff) + kst0) = sk0; *(LAS bf16x8*)(lds + (soff) + kst1) = sk1; } while (0)
    const int NT = seq / 64;
    __syncthreads();
    DLOAD(0); asm volatile("s_waitcnt vmcnt(0)" ::: "memory"); DWRITE(0);
    __syncthreads();
    int sC = 0, sN = DV_SLOT;
    for (int t = 0; t < NT; ++t) {
        f32x16 p0, p1; float mn, al; bf16x8 pa0, pa1, pa2, pa3;
        SBAR(); qkt<128, 4>(p0, p1, lds + sC + DV_OFF_K, qr, Qs, r32, hi);
        partialSM<128>(p0, p1, m_reg, mn, al);
        if (__any(al < 1.f)) { if (hi == 0) al_l[r32] = al; asm volatile("s_waitcnt lgkmcnt(0)" ::: "memory");
#pragma unroll
            for (int d = 0; d < 8; ++d)
#pragma unroll
                for (int r = 0; r < 16; ++r) o[d][r] *= al_l[crow(r, hi)]; }
        finishSM(p0, p1, al, l_reg, pa0, pa1, pa2, pa3); SBAR();
        if (t + 1 < NT) DLOAD((t + 1) * 64);
        SBAR();
        pv_d0(o, vbase + sC, pa0, pa1, pa2, pa3);
        pv_d0(o + 4, vbase + sC + 16384, pa0, pa1, pa2, pa3);
        if (t + 1 < NT) { asm volatile("s_waitcnt vmcnt(0)" ::: "memory"); DWRITE(sN); }
        __syncthreads();
        { const int n = sC; sC = sN; sN = n; }
    }
    if (hi == 0) li_l[r32] = l_reg;
    asm volatile("s_waitcnt lgkmcnt(0)" ::: "memory");
    float rli[16];
#pragma unroll
    for (int r = 0; r < 16; ++r) rli[r] = __builtin_amdgcn_rcpf(li_l[crow(r, hi)]);
    LAS unsigned short* slab = (LAS unsigned short*)(lds + wid * 16384);
#pragma unroll
    for (int r = 0; r < 16; ++r) { const int orow = crow(r, hi);
#pragma unroll
        for (int d0 = 0; d0 < 8; ++d0) slab[orow * 256 + d0 * 32 + r32] = (unsigned short)(cvt_pk_bf16(o[d0][r] * rli[r], 0.f) & 0xffffu); }
    asm volatile("s_waitcnt lgkmcnt(0)" ::: "memory");
    if constexpr (FUSE == 0) {
#pragma unroll
        for (int i = 0; i < 16; ++i) { const int id = i * 64 + lane, row = id >> 5, c16 = id & 31;
            const u32x4 w = *(const LAS u32x4*)((LAS char*)slab + row * 512 + c16 * 16);
            *(u32x4*)(Ob + (unsigned)(wid * 32 + row) * (unsigned)ldo + c16 * 8) = w; }
    } else {
        const int c16 = lane & 31;
        const f32x4 g0 = *(const f32x4*)(df.subln + c16 * 8), g1 = *(const f32x4*)(df.subln + c16 * 8 + 4);
        const float gg[8] = {g0.x, g0.y, g0.z, g0.w, g1.x, g1.y, g1.z, g1.w};
        u32x4 w0[16];
#pragma unroll
        for (int i = 0; i < 16; ++i) { const int row = (i * 64 + lane) >> 5; w0[i] = *(const u32x4*)(df.O0b + (unsigned)(wid * 32 + row) * (unsigned)ldo + c16 * 8); }
#pragma unroll
        for (int i = 0; i < 16; ++i) { const int row = (i * 64 + lane) >> 5;
            const u32x4 w1 = *(const LAS u32x4*)((LAS char*)slab + row * 512 + c16 * 16);
            const u32x4 a = w0[i];
            float d[8] = {bflo(a.x) - df.lam * bflo(w1.x), bfhi(a.x) - df.lam * bfhi(w1.x), bflo(a.y) - df.lam * bflo(w1.y), bfhi(a.y) - df.lam * bfhi(w1.y),
                          bflo(a.z) - df.lam * bflo(w1.z), bfhi(a.z) - df.lam * bfhi(w1.z), bflo(a.w) - df.lam * bflo(w1.w), bfhi(a.w) - df.lam * bfhi(w1.w)};
            float ss = ((d[0] * d[0] + d[1] * d[1]) + (d[2] * d[2] + d[3] * d[3])) + ((d[4] * d[4] + d[5] * d[5]) + (d[6] * d[6] + d[7] * d[7]));
            ss += swz_xor<1>(ss); ss += swz_xor<2>(ss); ss += swz_xor<4>(ss); ss += swz_xor<8>(ss); ss += swz_xor<16>(ss);
            const float rs = df.post / sqrtf(ss * (1.f / 256.f) + EPS);
            u32x4 o4; o4.x = cvt_pk_bf16(d[0] * rs * gg[0], d[1] * rs * gg[1]); o4.y = cvt_pk_bf16(d[2] * rs * gg[2], d[3] * rs * gg[3]);
            o4.z = cvt_pk_bf16(d[4] * rs * gg[4], d[5] * rs * gg[5]); o4.w = cvt_pk_bf16(d[6] * rs * gg[6], d[7] * rs * gg[7]);
            *(u32x4*)(df.Hb + (unsigned)(wid * 32 + row) * (unsigned)df.ldh + c16 * 8) = o4; }
    }
#undef DLOAD
#undef DWRITE
}

constexpr int NA_OFF_K = SHM_V, NA_OFF_RPB = 65536, NA_OFF_WS = 65536 + 2048, NA_TOTAL = NA_OFF_WS + 8 * 256;
__device__ __forceinline__ int clampi(int v, int lo, int hi) { return v < lo ? lo : (v > hi ? hi : v); }
__device__ __forceinline__ void na_unit(const bf16* __restrict__ Qb, int ldq, const bf16* __restrict__ Kseq, const bf16* __restrict__ Vseq, int ldk,
                                        bf16* __restrict__ Ob, int ldo, int r0, const float* __restrict__ rpb_h, LAS char* lds, int wid) {
    constexpr int KP = 256;
    const int lane = lane_id_fresh(), tid = wid * 64 + lane, r32 = lane & 31, hi = lane >> 5;
    LAS char* V_lds = lds; LAS char* K_lds = lds + NA_OFF_K; LAS float* rpb_l = (LAS float*)(lds + NA_OFF_RPB);
    LAS float* ws = (LAS float*)(lds + NA_OFF_WS) + wid * 64; LAS float* li_l = ws; LAS float* al_l = ws + 32;
    float m_reg = -1e30f, l_reg = 0; f32x16 o[4] = {}; bf16x8 qr[8];
    { const unsigned qo = (unsigned)(wid * 32 + r32) * (unsigned)ldq + hi * 8;
#pragma unroll
      for (int d0 = 0; d0 < 8; ++d0) qr[d0] = *(const bf16x8*)(Qb + qo + d0 * 16); }
    const int sr = tid >> 4, sc = (tid & 15) * 8, vst0 = v_st(sr, sc), vst1 = v_st(32 + sr, sc);
    const int kst0 = KSWZ(KP, sr, sc * 2), kst1 = KSWZ(KP, 32 + sr, sc * 2);
    const unsigned ko = (unsigned)sr * (unsigned)ldk + sc;
    const int vb0 = (int)(unsigned)(uintptr_t)V_lds + v_rd_base(lane);
    const int kr_lo = clampi(r0 - 4, 0, 56), kr_hi = clampi(r0 + 3 - 4, 0, 56) + 8;
    const int qrw = r0 + (wid >> 1), srw = clampi(qrw - 4, 0, 56);
    const int qc = (wid & 1) * 32 + r32, scq = clampi(qc - 8, 0, 48);
    __syncthreads();
    if (tid < 465) rpb_l[tid] = rpb_h[tid] * 11.313708498984761f;
    bf16x8 va0, va1, ka0, ka1, vb0_, vb1_, kb0, kb1;
#define NA_LOAD(V0, V1, K0, K1, kr_) do { const bf16* Kt = Kseq + (size_t)((kr_) * 64) * ldk; const bf16* Vt = Vseq + (size_t)((kr_) * 64) * ldk; \
      V0 = *(const bf16x8*)(Vt + ko); V1 = *(const bf16x8*)(Vt + (size_t)32 * ldk + ko); K0 = *(const bf16x8*)(Kt + ko); K1 = *(const bf16x8*)(Kt + (size_t)32 * ldk + ko); } while (0)
#define NA_STEP(V0, V1, K0, K1, kr_) do { \
        __syncthreads();                                            \
        *(LAS bf16x8*)(V_lds + vst0) = V0; *(LAS bf16x8*)(V_lds + vst1) = V1; *(LAS bf16x8*)(K_lds + kst0) = K0; *(LAS bf16x8*)(K_lds + kst1) = K1; \
        __syncthreads(); \
        if ((kr_) + 2 < kr_hi) NA_LOAD(V0, V1, K0, K1, (kr_) + 2);     \
        if ((kr_) >= srw && (kr_) < srw + 8) {                      \
            f32x16 p0, p1; float mn, al; bf16x8 pa0, pa1, pa2, pa3; \
            qkt<128>(p0, p1, K_lds, qr, nullptr, r32, hi); \
            const LAS float* bt = rpb_l + ((kr_) - qrw + 7) * 31 + (15 - qc); \
            _Pragma("unroll") for (int r = 0; r < 16; ++r) { const int kc = crow(r, hi); const bool in = (kc >= scq) && (kc < scq + 16); const float b = bt[in ? kc : qc]; p0[r] = in ? p0[r] + b : -1e30f; } \
            _Pragma("unroll") for (int r = 0; r < 16; ++r) { const int kc = 32 + crow(r, hi); const bool in = (kc >= scq) && (kc < scq + 16); const float b = bt[in ? kc : qc]; p1[r] = in ? p1[r] + b : -1e30f; } \
            partialSM<128>(p0, p1, m_reg, mn, al); \
            RESC(al); \
            finishSM(p0, p1, al, l_reg, pa0, pa1, pa2, pa3); SBAR(); \
            pv_d0(o, vb0, pa0, pa1, pa2, pa3); \
        } } while (0)
    NA_LOAD(va0, va1, ka0, ka1, kr_lo);
    if (kr_lo + 1 < kr_hi) NA_LOAD(vb0_, vb1_, kb0, kb1, kr_lo + 1);
    for (int kr = kr_lo; kr < kr_hi; kr += 2) {
        NA_STEP(va0, va1, ka0, ka1, kr);
        if (kr + 1 < kr_hi) NA_STEP(vb0_, vb1_, kb0, kb1, kr + 1);
    }
#undef NA_LOAD
#undef NA_STEP
    __syncthreads();
    store_o(o, l_reg, li_l, lds, Ob, ldo, wid, lane, r32, hi);
}
template <int D0> __device__ __forceinline__ void na2_pv(f32x16& od, int vbA, int vbB, bf16x8 pa0, bf16x8 pa1) {
    const s16x4 l0 = tr_read<v_rd_off(D0, 0, 0)>(vbA), h0 = tr_read<v_rd_off(D0, 0, 1)>(vbA), l1 = tr_read<v_rd_off(D0, 0, 0)>(vbB), h1 = tr_read<v_rd_off(D0, 0, 1)>(vbB);
    asm volatile("s_waitcnt lgkmcnt(0)" ::: "memory"); SBAR();
    od = __builtin_amdgcn_mfma_f32_32x32x16_bf16(pa0, (bf16x8){l0[0], l0[1], l0[2], l0[3], h0[0], h0[1], h0[2], h0[3]}, od, 0, 0, 0);
    od = __builtin_amdgcn_mfma_f32_32x32x16_bf16(pa1, (bf16x8){l1[0], l1[1], l1[2], l1[3], h1[0], h1[1], h1[2], h1[3]}, od, 0, 0, 0);
}
__device__ __forceinline__ void na_unit2(const bf16* __restrict__ Qb, int ldq, const bf16* __restrict__ Kseq, const bf16* __restrict__ Vseq, int ldk,
                                         bf16* __restrict__ Ob, int ldo, int r0, const float* __restrict__ rpb_h, LAS char* lds, int wid) {
    constexpr int KP = 256; constexpr float NEG = -3.0e38f;
    const int lane = lane_id_fresh(), tid = wid * 64 + lane, r32 = lane & 31, hi = lane >> 5;
    LAS char* V_lds = lds; LAS char* K_lds = lds + NA_OFF_K; LAS float* rpb_l = (LAS float*)(lds + NA_OFF_RPB);
    LAS float* ws = (LAS float*)(lds + NA_OFF_WS) + wid * 64; LAS float* li_l = ws; LAS float* al_l = ws + 32;
    float m_reg = -1e30f, l_reg = 0; f32x16 o[4] = {}; bf16x8 qr[8];
    const int typ = wid & 3, rp = wid >> 2, c15 = r32 & 15;
    const int g0 = (typ == 3) ? 0 : typ, g1 = (typ == 3) ? 3 : typ + 1;
    const int qc = (typ == 3) ? (c15 < 8 ? c15 : 48 + c15) : 8 + 16 * typ + c15;
    const int qrl = 2 * rp + (r32 >> 4), qrow = r0 + qrl;
    { const unsigned qo = (unsigned)(qrl * 64 + qc) * (unsigned)ldq + hi * 8;
#pragma unroll
      for (int d0 = 0; d0 < 8; ++d0) qr[d0] = *(const bf16x8*)(Qb + qo + d0 * 16); }
    const int sr = tid >> 4, sc = (tid & 15) * 8, vst0 = v_st(sr, sc), vst1 = v_st(32 + sr, sc);
    const int kst0 = KSWZ(KP, sr, sc * 2), kst1 = KSWZ(KP, 32 + sr, sc * 2);
    const unsigned ko = (unsigned)sr * (unsigned)ldk + sc;
    const int vbA = (int)(unsigned)(uintptr_t)V_lds + v_rd_base(lane) + g0 * 4096, vbB = (int)(unsigned)(uintptr_t)V_lds + v_rd_base(lane) + g1 * 4096;
    const int krow = 16 * (r32 < 16 ? g0 : g1) + c15;
    const LAS char* Kl = K_lds + krow * KP;
    const int kr_lo = clampi(r0 - 4, 0, 56), kr_hi = clampi(r0 + 3 - 4, 0, 56) + 8;
    const int s_lo = clampi(r0 + 2 * rp - 4, 0, 56), s_hi = clampi(r0 + 2 * rp + 1 - 4, 0, 56) + 8;
    const int srq = clampi(qrow - 4, 0, 56), scq = clampi(qc - 8, 0, 48);
    __syncthreads();
    if (tid < 465) rpb_l[tid] = rpb_h[tid] * 11.313708498984761f;
    bf16x8 va0, va1, ka0, ka1, vb0_, vb1_, kb0, kb1;
#define NA_LOAD(V0, V1, K0, K1, kr_) do { const bf16* Kt = Kseq + (size_t)((kr_) * 64) * ldk; const bf16* Vt = Vseq + (size_t)((kr_) * 64) * ldk; \
      V0 = *(const bf16x8*)(Vt + ko); V1 = *(const bf16x8*)(Vt + (size_t)32 * ldk + ko); K0 = *(const bf16x8*)(Kt + ko); K1 = *(const bf16x8*)(Kt + (size_t)32 * ldk + ko); } while (0)
#define NA_STEP(V0, V1, K0, K1, kr_) do { \
        __syncthreads();                                            \
        *(LAS bf16x8*)(V_lds + vst0) = V0; *(LAS bf16x8*)(V_lds + vst1) = V1; *(LAS bf16x8*)(K_lds + kst0) = K0; *(LAS bf16x8*)(K_lds + kst1) = K1; \
        __syncthreads(); \
        if ((kr_) + 2 < kr_hi) NA_LOAD(V0, V1, K0, K1, (kr_) + 2);     \
        if ((kr_) >= s_lo && (kr_) < s_hi) {                        \
            f32x16 p = {}; \
            _Pragma("unroll") for (int d0 = 0; d0 < 8; ++d0) { const int cb = (d0 * 16 + hi * 8) * 2; \
                const bf16x8 kf = *(const LAS bf16x8*)(Kl + (cb ^ (c15 << 4))); p = __builtin_amdgcn_mfma_f32_32x32x16_bf16(kf, qr[d0], p, 0, 0, 0); } \
            const bool rowin = ((kr_) >= srq) && ((kr_) < srq + 8); \
            const LAS float* bt = rpb_l + clampi((kr_) - qrow + 7, 0, 14) * 31 + (15 - qc); \
            _Pragma("unroll") for (int r = 0; r < 16; ++r) { const int kc = 16 * (r < 8 ? g0 : g1) + (r & 3) + 8 * ((r >> 2) & 1) + 4 * hi; \
                const bool in = rowin && (kc >= scq) && (kc < scq + 16); const float b = bt[in ? kc : qc]; p[r] = in ? p[r] + b : NEG; } \
              \
            float pmax = p[0]; _Pragma("unroll") for (int r = 1; r < 16; ++r) pmax = fmaxf(pmax, p[r]); \
            { auto rr = __builtin_amdgcn_permlane32_swap(__float_as_uint(pmax), __float_as_uint(pmax), false, false); pmax = fmaxf(__uint_as_float(rr[0]), __uint_as_float(rr[1])); } \
            float mn, al; \
            if (__builtin_expect(__all(pmax - m_reg <= THR / Cfg<128>::SCALE), 1)) { mn = m_reg; al = 1.f; } \
            else { mn = fmaxf(m_reg, pmax); al = __builtin_amdgcn_exp2f((m_reg - mn) * Cfg<128>::C); m_reg = mn; } \
            const float mnC = -mn * Cfg<128>::C; float ps = 0; \
            _Pragma("unroll") for (int r = 0; r < 16; ++r) { p[r] = __builtin_amdgcn_exp2f(fmaf(p[r], Cfg<128>::C, mnC)); ps += p[r]; } \
            { auto rr = __builtin_amdgcn_permlane32_swap(__float_as_uint(ps), __float_as_uint(ps), false, false); ps = __uint_as_float(rr[0]) + __uint_as_float(rr[1]); } \
            RESC(al); \
            l_reg = l_reg * al + ps; \
            bf16x8 pa0, pa1; \
            { unsigned a0 = cvt_pk_bf16(p[0], p[1]), a1 = cvt_pk_bf16(p[2], p[3]), b0 = cvt_pk_bf16(p[4], p[5]), b1 = cvt_pk_bf16(p[6], p[7]); \
              auto x0 = __builtin_amdgcn_permlane32_swap(a0, b0, false, false); auto x1 = __builtin_amdgcn_permlane32_swap(a1, b1, false, false); \
              u32x4 w = {x0[0], x1[0], x0[1], x1[1]}; pa0 = __builtin_bit_cast(bf16x8, w); } \
            { unsigned a0 = cvt_pk_bf16(p[8], p[9]), a1 = cvt_pk_bf16(p[10], p[11]), b0 = cvt_pk_bf16(p[12], p[13]), b1 = cvt_pk_bf16(p[14], p[15]); \
              auto x0 = __builtin_amdgcn_permlane32_swap(a0, b0, false, false); auto x1 = __builtin_amdgcn_permlane32_swap(a1, b1, false, false); \
              u32x4 w = {x0[0], x1[0], x0[1], x1[1]}; pa1 = __builtin_bit_cast(bf16x8, w); } \
            SBAR(); \
            na2_pv<0>(o[0], vbA, vbB, pa0, pa1); na2_pv<1>(o[1], vbA, vbB, pa0, pa1); na2_pv<2>(o[2], vbA, vbB, pa0, pa1); na2_pv<3>(o[3], vbA, vbB, pa0, pa1); \
        } } while (0)
    NA_LOAD(va0, va1, ka0, ka1, kr_lo);
    if (kr_lo + 1 < kr_hi) NA_LOAD(vb0_, vb1_, kb0, kb1, kr_lo + 1);
    for (int kr = kr_lo; kr < kr_hi; kr += 2) {
        NA_STEP(va0, va1, ka0, ka1, kr);
        if (kr + 1 < kr_hi) NA_STEP(vb0_, vb1_, kb0, kb1, kr + 1);
    }
#undef NA_LOAD
#undef NA_STEP
    __syncthreads();
    if (hi == 0) li_l[r32] = l_reg;
    asm volatile("s_waitcnt lgkmcnt(0)" ::: "memory");
    float rli[16];
#pragma unroll
    for (int r = 0; r < 16; ++r) rli[r] = __builtin_amdgcn_rcpf(li_l[crow(r, hi)]);
    LAS unsigned short* slab = (LAS unsigned short*)(lds + wid * 8192);
#pragma unroll
    for (int r = 0; r < 16; ++r) { const int orow = crow(r, hi);
#pragma unroll
        for (int d0 = 0; d0 < 4; ++d0) slab[orow * 128 + d0 * 32 + r32] = (unsigned short)(cvt_pk_bf16(o[d0][r] * rli[r], 0.f) & 0xffffu); }
    asm volatile("s_waitcnt lgkmcnt(0)" ::: "memory");
#pragma unroll
    for (int i = 0; i < 8; ++i) { const int id = i * 64 + lane, q = id >> 4, c16 = id & 15, q15 = q & 15;
        const int col = (typ == 3) ? (q15 < 8 ? q15 : 48 + q15) : 8 + 16 * typ + q15;
        const u32x4 w = *(const LAS u32x4*)((LAS char*)slab + q * 256 + c16 * 16);
        *(u32x4*)(Ob + (unsigned)((2 * rp + (q >> 4)) * 64 + col) * (unsigned)ldo + c16 * 8) = w; }
}
#undef RESC
}

constexpr size_t MiB = 1u << 20;
constexpr size_t WS_CTL = 0, CTL_ZERO_BYTES = 1 * MiB;
constexpr size_t WS_TAB_MLA = 5 * MiB;
constexpr size_t WS_TAB_1D = 6 * MiB;
constexpr size_t WS_MN = 8 * MiB;
constexpr size_t WS_MKV = 20 * MiB;
constexpr size_t WS_WB = 32 * MiB;
constexpr size_t WB_IN = 0, WB_QB = 24 * MiB, WB_KVB = 26 * MiB, WB_OUT = 28 * MiB, WB_XQ = 36 * MiB, WB_XKV = 38 * MiB, WB_XO = 42 * MiB, WB_UP = 44 * MiB, WB_DOWN = 76 * MiB;
constexpr size_t WS_H = 144 * MiB;
constexpr size_t WS_BIG = 336 * MiB;
constexpr size_t BIG_PROJ = 0, BIG_Q = 264 * MiB, BIG_KV = 408 * MiB;
constexpr size_t BIG_SPLIT = 96 * MiB;
constexpr size_t BIG_XQ = 0, BIG_XO = 48 * MiB;
constexpr size_t BIG_U = 0;
constexpr size_t BIG_XBA = 400 * MiB;
constexpr size_t WS_PS = WS_BIG + 600 * MiB;
constexpr size_t PS_BYTES = (size_t)T * 32 * 4, PSC_BYTES = (size_t)T * 8 * 4;
constexpr size_t WS_END = WS_PS + 3 * PS_BYTES + 2 * PSC_BYTES;
constexpr int CW_BAR = 4096;
constexpr int SKEW_TICKS = 0;

constexpr int RING_BYTES = 135168, MISC_OFF = RING_BYTES + 320, PTR_OFF = RING_BYTES + 1024, LDS_BYTES = 147456;
static_assert(pg8::RS_LDS_OFF == RING_BYTES + 2048 && pg8::RS_LDS_OFF + 2048 <= LDS_BYTES && PTR_OFF + 29 * 8 <= pg8::RS_LDS_OFF, "row-scale staging area");
static_assert(att::DV_TOTAL <= RING_BYTES && att::Cfg<192>::TOTAL <= RING_BYTES && att::NA_TOTAL <= RING_BYTES && pg8::STAGE_BYTES <= RING_BYTES, "LDS map");

#define XB_TMO      128
#define XB_XCNT(j)  (256  + 64 * (j))
#define XB_XSUB(j)  (1280 + 64 * (j))
#define XB_XGEN(j)  (2304 + 64 * (j))
#define XB_TOP      3328
#define XB_TOPGEN   3392
#define XCD_BAR_WORDS 3456
#define XB_SPIN_CAP (1u << 18)
__device__ __forceinline__ unsigned xb_ld(unsigned* p)              { return __hip_atomic_load(p, __ATOMIC_RELAXED, __HIP_MEMORY_SCOPE_AGENT); }
__device__ __forceinline__ unsigned xb_add(unsigned* p, unsigned v) { return __hip_atomic_fetch_add(p, v, __ATOMIC_RELAXED, __HIP_MEMORY_SCOPE_AGENT); }
__device__ __forceinline__ unsigned xb_xcc_id() { return (unsigned)__builtin_amdgcn_s_getreg((3 << 11) | 20) & 0xFu; }
#define XB_SPIN(cond, bar) do { unsigned _sp = 0; while (cond) { __builtin_amdgcn_s_sleep(1); \
    if ((++_sp & 255u) == 0u) { if (xb_ld(&(bar)[XB_TMO])) break; if (_sp > XB_SPIN_CAP) { atomicAdd(&(bar)[XB_TMO], 1u); break; } } } } while (0)
struct XcdBarrier { unsigned* bar; unsigned x; volatile LAS unsigned* st; };
__device__ __forceinline__ XcdBarrier xcd_barrier_post(unsigned* bar, volatile LAS unsigned* st, int wave) {
    XcdBarrier b; b.bar = bar; b.x = xb_xcc_id(); b.st = st;
    if (wave == 0 && lane_id_fresh() == 0) (void)xb_add(&bar[XB_XCNT(b.x)], 1u);
    return b;
}
__device__ __forceinline__ void xcd_barrier_complete(unsigned* bar, unsigned x, unsigned& nloc, unsigned& nx) {
    const unsigned G = gridDim.x * gridDim.y * gridDim.z;
    unsigned sum, cnt, mine, sp = 0u;
    for (;;) {
        sum = 0u; cnt = 0u; mine = 0u;
#pragma unroll
        for (unsigned j = 0; j < 16; ++j) { const unsigned c = xb_ld(&bar[XB_XCNT(j)]); sum += c; cnt += (c > 0u) ? 1u : 0u; mine = (j == x) ? c : mine; }
        if (sum == G) break;
        __builtin_amdgcn_s_sleep(1);
        if ((++sp & 255u) == 0u) { if (xb_ld(&bar[XB_TMO])) break; if (sp > XB_SPIN_CAP) { atomicAdd(&bar[XB_TMO], 1u); break; } }
    }
    nloc = mine > 0u ? mine : 1u; nx = cnt > 0u ? cnt : 1u;
}
__device__ __forceinline__ void xcd_barrier(const XcdBarrier& b, int wave) {
    asm volatile("s_waitcnt vmcnt(0)" ::: "memory");
    __syncthreads();
    if (wave == 0 && lane_id_fresh() == 0) {
        unsigned long long bar_i = (unsigned long long)(uintptr_t)b.bar; asm volatile("" : "+s"(bar_i));
        unsigned* bar = (unsigned*)(GAS unsigned*)(uintptr_t)bar_i;
        __builtin_amdgcn_s_waitcnt(0);
        unsigned nloc = b.st[0], nx = b.st[1];
        if (nloc == 0u) { xcd_barrier_complete(bar, b.x, nloc, nx); b.st[0] = nloc; b.st[1] = nx; }
        const unsigned old = xb_add(&bar[XB_XSUB(b.x)], 1u);
        const unsigned gen = old / nloc;
        if (old + 1u == (gen + 1u) * nloc) {
            __builtin_amdgcn_fence(__ATOMIC_RELEASE, "agent");
            asm volatile("s_waitcnt vmcnt(0)" ::: "memory");
            const unsigned og = xb_add(&bar[XB_TOP], 1u);
            const unsigned tg = og / nx;
            if (og + 1u == (tg + 1u) * nx) xb_add(&bar[XB_TOPGEN], 1u);
            else XB_SPIN(xb_ld(&bar[XB_TOPGEN]) == tg, bar);
            __builtin_amdgcn_fence(__ATOMIC_ACQUIRE, "agent");
            xb_add(&bar[XB_XGEN(b.x)], 1u);
            asm volatile("s_waitcnt vmcnt(0)" ::: "memory");
        } else {
            XB_SPIN(xb_ld(&bar[XB_XGEN(b.x)]) == gen, bar);
            __builtin_amdgcn_fence(__ATOMIC_ACQUIRE, "agent");
            asm volatile("s_waitcnt vmcnt(0)" ::: "memory");
        }
    }
    __syncthreads();
}

#define LDS_WAIT() asm volatile("s_waitcnt lgkmcnt(0)" ::: "memory")
constexpr int TR_PITCH = 65, TR_BYTES = 64 * TR_PITCH * 4;
static_assert(8 * TR_BYTES <= RING_BYTES, "transpose scratch");
__device__ __forceinline__ void transpose_item(const float* W, int K, int N, bf16* WT, const float* gain, LAS float* scr, int item, int lane) {
    const int nblk = N / 64, kb = item / nblk, nb = item % nblk, k0 = 64 * kb, n0 = 64 * nb;
    const int lr = lane >> 4, lc = (lane & 15) * 4;
#pragma unroll
    for (int h = 0; h < 2; ++h) {
        f32x4 v[8];
#pragma unroll
        for (int i = 0; i < 8; ++i) v[i] = *(const f32x4*)(W + (size_t)(k0 + 32 * h + 4 * i + lr) * N + n0 + lc);
#pragma unroll
        for (int i = 0; i < 8; ++i) { const int kk = 32 * h + 4 * i + lr; const float gk = gain ? gain[k0 + kk] : 1.f; LAS float* d = scr + kk * TR_PITCH + lc;
            d[0] = v[i].x * gk; d[1] = v[i].y * gk; d[2] = v[i].z * gk; d[3] = v[i].w * gk; }
    }
    LDS_WAIT(); asm volatile("" ::: "memory");
    const int c = lane & 7;
#pragma unroll
    for (int j = 0; j < 8; ++j) { const int n = (lane >> 3) + 8 * j; const LAS float* s = scr + (8 * c) * TR_PITCH + n;
        u32x4 o; o.x = cvt_pk_bf16(s[0 * TR_PITCH], s[1 * TR_PITCH]); o.y = cvt_pk_bf16(s[2 * TR_PITCH], s[3 * TR_PITCH]); o.z = cvt_pk_bf16(s[4 * TR_PITCH], s[5 * TR_PITCH]); o.w = cvt_pk_bf16(s[6 * TR_PITCH], s[7 * TR_PITCH]);
        *(u32x4*)(WT + (size_t)(n0 + n) * K + k0 + 8 * c) = o; }
    LDS_WAIT(); asm volatile("" ::: "memory");
}
__device__ __forceinline__ void convert_matrix(const float* W, int K, int N, bf16* WT, const float* gain, LAS float* scr, int gw, int NGW, int lane) {
    const int nitems = (K / 64) * (N / 64);
    for (int it = gw; it < nitems; it += NGW) transpose_item(W, K, N, WT, gain, scr, it, lane);
}
__device__ __forceinline__ void init_row_2048(const float* xrow, bf16* xh, float* ssp, int lane) {
    const f32x4* xr = (const f32x4*)xrow + lane;
    u32x2 w[8]; float s = 0.f;
#pragma unroll
    for (int j = 0; j < 8; ++j) { const f32x4 v = xr[64 * j]; w[j].x = cvt_pk_bf16(v.x, v.y); w[j].y = cvt_pk_bf16(v.z, v.w);
        const float y0 = bflo(w[j].x), y1 = bfhi(w[j].x), y2 = bflo(w[j].y), y3 = bfhi(w[j].y); s += (y0 * y0 + y1 * y1) + (y2 * y2 + y3 * y3); }
    s = wave_sum(s);
    u32x2* oh = (u32x2*)xh + lane;
#pragma unroll
    for (int j = 0; j < 8; ++j) oh[64 * j] = w[j];
    if (lane < 32) ssp[lane] = (lane == 0) ? s : 0.f;
}
__device__ __forceinline__ void init_rows2_2048(const float* xrow0, const float* xrow1, bf16* xh0, bf16* xh1, float* ssp0, float* ssp1, int lane) {
    f32x4 v0[8], v1[8];
#pragma unroll
    for (int j = 0; j < 8; ++j) { v0[j] = ((const f32x4*)xrow0 + lane)[64 * j]; v1[j] = ((const f32x4*)xrow1 + lane)[64 * j]; }
#pragma unroll
    for (int i = 0; i < 2; ++i) { u32x2 w[8]; float s = 0.f;
#pragma unroll
        for (int j = 0; j < 8; ++j) { const f32x4 v = i ? v1[j] : v0[j]; w[j].x = cvt_pk_bf16(v.x, v.y); w[j].y = cvt_pk_bf16(v.z, v.w);
            const float y0 = bflo(w[j].x), y1 = bfhi(w[j].x), y2 = bflo(w[j].y), y3 = bfhi(w[j].y); s += (y0 * y0 + y1 * y1) + (y2 * y2 + y3 * y3); }
        s = wave_sum(s);
        u32x2* oh = (u32x2*)(i ? xh1 : xh0) + lane;
#pragma unroll
        for (int j = 0; j < 8; ++j) oh[64 * j] = w[j];
        if (lane < 32) (i ? ssp1 : ssp0)[lane] = (lane == 0) ? s : 0.f; }
}
__device__ __forceinline__ void norm_row_2048(const float* xrow, const float* g, bf16* orow, float* copy, int lane) {
    const f32x4* xr = (const f32x4*)xrow + lane;
    f32x4 v[8]; float s = 0.f;
#pragma unroll
    for (int j = 0; j < 8; ++j) { v[j] = xr[64 * j]; s += (v[j].x * v[j].x + v[j].y * v[j].y) + (v[j].z * v[j].z + v[j].w * v[j].w); }
    const float rstd = 1.f / sqrtf(wave_sum(s) * (1.f / 2048.f) + EPS);
    if (copy) {
#pragma unroll
        for (int j = 0; j < 8; ++j) ((f32x4*)copy + lane)[64 * j] = v[j]; }
    u32x2* o8 = (u32x2*)orow + lane;
#pragma unroll
    for (int j = 0; j < 8; ++j) { const f32x4 gg = ((const f32x4*)g + lane)[64 * j]; u32x2 w; w.x = cvt_pk_bf16(v[j].x * rstd * gg.x, v[j].y * rstd * gg.y); w.y = cvt_pk_bf16(v[j].z * rstd * gg.z, v[j].w * rstd * gg.w); o8[64 * j] = w; }
}
__device__ __forceinline__ void final_norm_row(const bf16* xh, float* orow, const float* g, float ss, int lane) {
    const float rstd = 1.f / sqrtf(ss * (1.f / 2048.f) + EPS);
    const u32x2* ph = (const u32x2*)xh + lane; f32x4* po = (f32x4*)orow + lane;
#pragma unroll
    for (int j = 0; j < 8; ++j) { const u32x2 h = ph[64 * j]; const f32x4 gg = ((const f32x4*)g + lane)[64 * j];
        f32x4 o; o.x = bflo(h.x) * rstd * gg.x; o.y = bfhi(h.x) * rstd * gg.y; o.z = bflo(h.y) * rstd * gg.z; o.w = bfhi(h.y) * rstd * gg.w;
        po[64 * j] = o; }
}
template <int R>
__device__ __forceinline__ void final_norm_rows(const bf16* xh, float* out, const f32x4 (&gg)[8], const float* ssf, int m0, int mstep, int lane) {
    u32x2 h[R][8]; float ssv[R];
#pragma unroll
    for (int i = 0; i < R; ++i) { const size_t m = (size_t)(m0 + i * mstep); const u32x2* ph = (const u32x2*)(xh + m * DM) + lane;
        ssv[i] = lane < 32 ? ssf[m * 32 + lane] : 0.f;
#pragma unroll
        for (int j = 0; j < 8; ++j) h[i][j] = ph[64 * j]; }
#pragma unroll
    for (int i = 0; i < R; ++i) { const size_t m = (size_t)(m0 + i * mstep); f32x4* po = (f32x4*)(out + m * DM) + lane;
        const float rstd = 1.f / sqrtf(wave_sum(ssv[i]) * (1.f / 2048.f) + EPS);
#pragma unroll
        for (int j = 0; j < 8; ++j) { f32x4 o; o.x = bflo(h[i][j].x) * rstd * gg[j].x; o.y = bfhi(h[i][j].x) * rstd * gg[j].y; o.z = bflo(h[i][j].y) * rstd * gg[j].z; o.w = bfhi(h[i][j].y) * rstd * gg[j].w;
            po[64 * j] = o; } }
}
__device__ __forceinline__ void even_row_fix(bf16* row, int pos, const float* qn, const float* kvn, const float* gqn, const float* gkn, const float* tab_mla, int lane) {
    const float* cosm = tab_mla; const float* sinm = tab_mla + 4096 * 32;
#pragma unroll
    for (int part = 0; part < 2; ++part) {
        u32x4* p = (u32x4*)(row + part * 512) + lane; const u32x4 w = *p; const float* g = (part ? kvn : qn) + lane * 8;
        float x[8] = {bflo(w.x), bfhi(w.x), bflo(w.y), bfhi(w.y), bflo(w.z), bfhi(w.z), bflo(w.w), bfhi(w.w)};
        float s = 0.f;
#pragma unroll
        for (int e = 0; e < 8; ++e) s += x[e] * x[e];
        const float rstd = 1.f / sqrtf(wave_sum(s) * (1.f / 512.f) + EPS);
        const f32x4 g0 = *(const f32x4*)g, g1 = *(const f32x4*)(g + 4);
        u32x4 o; o.x = cvt_pk_bf16(x[0] * rstd * g0.x, x[1] * rstd * g0.y); o.y = cvt_pk_bf16(x[2] * rstd * g0.z, x[3] * rstd * g0.w);
        o.z = cvt_pk_bf16(x[4] * rstd * g1.x, x[5] * rstd * g1.y); o.w = cvt_pk_bf16(x[6] * rstd * g1.z, x[7] * rstd * g1.w);
        *p = o;
    }
    { bf16* p = row + 1024 + lane; const float x = bf2f(*p); const float y = other_half(x, lane < 32); const int f = lane & 31;
      const float c = cosm[pos * 32 + f], s = sinm[pos * 32 + f];
      const float r = (lane < 32) ? (x * c - y * s) : (x * c + y * s);
      *p = (bf16)(cvt_pk_bf16(r, 0.f) & 0xffffu); }
    const int prow = pos >> 6, pcol = pos & 63;
    const int e0 = 2 * lane, f0 = e0 & 31; const int tp = (e0 < 64) ? prow : pcol;
    const float c0 = cosm[tp * 32 + f0], s0 = sinm[tp * 32 + f0], c1 = cosm[tp * 32 + f0 + 1], s1 = sinm[tp * 32 + f0 + 1];
    const bool first = ((e0 & 32) == 0);
#pragma unroll 2
    for (int h = 0; h < 10; ++h) {
        unsigned* p = (unsigned*)(row + (h < 8 ? 1088 + h * 128 : 2112 + (h - 8) * 128)) + lane; const unsigned w = *p; const float* g = (h < 8 ? gqn : gkn) + e0;
        float x0 = bflo(w), x1 = bfhi(w);
        const float rstd = 1.f / sqrtf(wave_sum(x0 * x0 + x1 * x1) * (1.f / 128.f) + EPS);
        x0 = x0 * rstd * g[0]; x1 = x1 * rstd * g[1];
        const float y0 = swz_xor<16>(x0), y1 = swz_xor<16>(x1);
        const float r0 = first ? (x0 * c0 - y0 * s0) : (x0 * c0 + y0 * s0);
        const float r1 = first ? (x1 * c1 - y1 * s1) : (x1 * c1 + y1 * s1);
        *p = cvt_pk_bf16(r0, r1);
    }
}
__device__ __forceinline__ void even_row_fix_k(bf16* row, int pos, const float* gkn, const float* tab_mla, int lane) {
    const float* cosm = tab_mla; const float* sinm = tab_mla + 4096 * 32;
    { bf16* p = row + 1024 + lane; const float x = bf2f(*p); const float y = other_half(x, lane < 32); const int f = lane & 31;
      const float c = cosm[pos * 32 + f], s = sinm[pos * 32 + f];
      const float r = (lane < 32) ? (x * c - y * s) : (x * c + y * s);
      *p = (bf16)(cvt_pk_bf16(r, 0.f) & 0xffffu); }
    const int prow = pos >> 6, pcol = pos & 63;
    const int e0 = 2 * lane, f0 = e0 & 31; const int tp = (e0 < 64) ? prow : pcol;
    const float c0 = cosm[tp * 32 + f0], s0 = sinm[tp * 32 + f0], c1 = cosm[tp * 32 + f0 + 1], s1 = sinm[tp * 32 + f0 + 1];
    const bool first = ((e0 & 32) == 0);
#pragma unroll
    for (int h = 0; h < 2; ++h) {
        unsigned* p = (unsigned*)(row + 2112 + h * 128) + lane; const unsigned w = *p; const float* g = gkn + e0;
        float x0 = bflo(w), x1 = bfhi(w);
        const float rstd = 1.f / sqrtf(wave_sum(x0 * x0 + x1 * x1) * (1.f / 128.f) + EPS);
        x0 = x0 * rstd * g[0]; x1 = x1 * rstd * g[1];
        const float y0 = swz_xor<16>(x0), y1 = swz_xor<16>(x1);
        const float r0 = first ? (x0 * c0 - y0 * s0) : (x0 * c0 + y0 * s0);
        const float r1 = first ? (x1 * c1 - y1 * s1) : (x1 * c1 + y1 * s1);
        *p = cvt_pk_bf16(r0, r1);
    }
}
template <int R>
__device__ __forceinline__ void even_rows_fix_k(bf16* proj, int m0, int mstep, const float* gkn, const float* tab_mla, int lane) {
    const float* cosm = tab_mla; const float* sinm = tab_mla + 4096 * 32;
    const int f = lane & 31, e0 = 2 * lane, f0 = e0 & 31; const bool first = ((e0 & 32) == 0);
    const float g0 = gkn[e0], g1 = gkn[e0 + 1];
    unsigned short kx[R]; unsigned w0[R], w1[R]; float kc[R], ks[R], c0[R], s0[R], c1[R], s1[R];
#pragma unroll
    for (int i = 0; i < R; ++i) { const int m = m0 + i * mstep, pos = m & (SEQ - 1); bf16* row = proj + (size_t)m * AB_PAD;
        kx[i] = *(row + 1024 + lane); kc[i] = cosm[pos * 32 + f]; ks[i] = sinm[pos * 32 + f];
        const int tp = (e0 < 64) ? (pos >> 6) : (pos & 63);
        c0[i] = cosm[tp * 32 + f0]; s0[i] = sinm[tp * 32 + f0]; c1[i] = cosm[tp * 32 + f0 + 1]; s1[i] = sinm[tp * 32 + f0 + 1];
        w0[i] = *((const unsigned*)(row + 2112) + lane); w1[i] = *((const unsigned*)(row + 2112 + 128) + lane); }
#pragma unroll
    for (int i = 0; i < R; ++i) { const int m = m0 + i * mstep; bf16* row = proj + (size_t)m * AB_PAD;
        { const float x = bf2f(kx[i]); const float y = other_half(x, lane < 32);
          const float r = (lane < 32) ? (x * kc[i] - y * ks[i]) : (x * kc[i] + y * ks[i]);
          *(row + 1024 + lane) = (bf16)(cvt_pk_bf16(r, 0.f) & 0xffffu); }
#pragma unroll
        for (int h = 0; h < 2; ++h) { const unsigned w = h ? w1[i] : w0[i];
            float x0 = bflo(w), x1 = bfhi(w);
            const float rstd = 1.f / sqrtf(wave_sum(x0 * x0 + x1 * x1) * (1.f / 128.f) + EPS);
            x0 = x0 * rstd * g0; x1 = x1 * rstd * g1;
            const float y0 = swz_xor<16>(x0), y1 = swz_xor<16>(x1);
            const float r0 = first ? (x0 * c0[i] - y0 * s0[i]) : (x0 * c0[i] + y0 * s0[i]);
            const float r1 = first ? (x1 * c1[i] - y1 * s1[i]) : (x1 * c1[i] + y1 * s1[i]);
            *((unsigned*)(row + 2112 + h * 128) + lane) = cvt_pk_bf16(r0, r1); } }
}
__device__ __forceinline__ void mla_q_rope_row(bf16* row, int pos, const float* tab_mla, int lane) {
    const int h = lane >> 3, s4 = (lane & 7) * 4;
    u32x2* p1 = (u32x2*)(row + h * 192 + 128 + s4); u32x2* p2 = (u32x2*)(row + h * 192 + 160 + s4);
    const u32x2 w1 = *p1, w2 = *p2;
    const f32x4 c = *(const f32x4*)(tab_mla + pos * 32 + s4), s = *(const f32x4*)(tab_mla + 4096 * 32 + pos * 32 + s4);
    const float x1[4] = {bflo(w1.x), bfhi(w1.x), bflo(w1.y), bfhi(w1.y)}, x2[4] = {bflo(w2.x), bfhi(w2.x), bflo(w2.y), bfhi(w2.y)};
    float a[4], b[4];
#pragma unroll
    for (int e = 0; e < 4; ++e) { a[e] = x1[e] * c[e] - x2[e] * s[e]; b[e] = x2[e] * c[e] + x1[e] * s[e]; }
    u32x2 o1, o2; o1.x = cvt_pk_bf16(a[0], a[1]); o1.y = cvt_pk_bf16(a[2], a[3]); o2.x = cvt_pk_bf16(b[0], b[1]); o2.y = cvt_pk_bf16(b[2], b[3]);
    *p1 = o1; *p2 = o2;
}
__device__ __forceinline__ void rope1d_row(bf16* row, int pos, const float* tab_1d, int lane) {
    const int h = lane >> 3, s8 = (lane & 7) * 8;
    u32x4* p1 = (u32x4*)(row + h * 128 + s8); u32x4* p2 = (u32x4*)(row + h * 128 + 64 + s8);
    const u32x4 w1 = *p1, w2 = *p2;
    const float* ct = tab_1d + pos * 64 + s8; const float* st = tab_1d + 4096 * 64 + pos * 64 + s8;
    const f32x4 c0 = *(const f32x4*)ct, c1 = *(const f32x4*)(ct + 4), s0 = *(const f32x4*)st, s1 = *(const f32x4*)(st + 4);
    const float c[8] = {c0.x, c0.y, c0.z, c0.w, c1.x, c1.y, c1.z, c1.w}, s[8] = {s0.x, s0.y, s0.z, s0.w, s1.x, s1.y, s1.z, s1.w};
    const float x1[8] = {bflo(w1.x), bfhi(w1.x), bflo(w1.y), bfhi(w1.y), bflo(w1.z), bfhi(w1.z), bflo(w1.w), bfhi(w1.w)};
    const float x2[8] = {bflo(w2.x), bfhi(w2.x), bflo(w2.y), bfhi(w2.y), bflo(w2.z), bfhi(w2.z), bflo(w2.w), bfhi(w2.w)};
    float a[8], b[8];
#pragma unroll
    for (int e = 0; e < 8; ++e) { a[e] = x1[e] * c[e] - x2[e] * s[e]; b[e] = x2[e] * c[e] + x1[e] * s[e]; }
    u32x4 o1, o2; o1.x = cvt_pk_bf16(a[0], a[1]); o1.y = cvt_pk_bf16(a[2], a[3]); o1.z = cvt_pk_bf16(a[4], a[5]); o1.w = cvt_pk_bf16(a[6], a[7]);
    o2.x = cvt_pk_bf16(b[0], b[1]); o2.y = cvt_pk_bf16(b[2], b[3]); o2.z = cvt_pk_bf16(b[4], b[5]); o2.w = cvt_pk_bf16(b[6], b[7]);
    *p1 = o1; *p2 = o2;
}
__device__ __forceinline__ void rope1d_rows4(bf16* base, size_t ld, int m0, int mstep, const float* tab_1d, int lane) {
    const int h = lane >> 3, s8 = (lane & 7) * 8;
    u32x4 w1[4], w2[4]; f32x4 c0[4], c1[4], s0[4], s1[4];
#pragma unroll
    for (int i = 0; i < 4; ++i) { const int m = m0 + i * mstep, pos = m & (SEQ - 1); bf16* row = base + (size_t)m * ld;
        w1[i] = *(const u32x4*)(row + h * 128 + s8); w2[i] = *(const u32x4*)(row + h * 128 + 64 + s8);
        const float* ct = tab_1d + pos * 64 + s8; const float* st = tab_1d + 4096 * 64 + pos * 64 + s8;
        c0[i] = *(const f32x4*)ct; c1[i] = *(const f32x4*)(ct + 4); s0[i] = *(const f32x4*)st; s1[i] = *(const f32x4*)(st + 4); }
#pragma unroll
    for (int i = 0; i < 4; ++i) { const int m = m0 + i * mstep; bf16* row = base + (size_t)m * ld;
        const float c[8] = {c0[i].x, c0[i].y, c0[i].z, c0[i].w, c1[i].x, c1[i].y, c1[i].z, c1[i].w}, s[8] = {s0[i].x, s0[i].y, s0[i].z, s0[i].w, s1[i].x, s1[i].y, s1[i].z, s1[i].w};
        const float x1[8] = {bflo(w1[i].x), bfhi(w1[i].x), bflo(w1[i].y), bfhi(w1[i].y), bflo(w1[i].z), bfhi(w1[i].z), bflo(w1[i].w), bfhi(w1[i].w)};
        const float x2[8] = {bflo(w2[i].x), bfhi(w2[i].x), bflo(w2[i].y), bfhi(w2[i].y), bflo(w2[i].z), bfhi(w2[i].z), bflo(w2[i].w), bfhi(w2[i].w)};
        float a[8], b[8];
#pragma unroll
        for (int e = 0; e < 8; ++e) { a[e] = x1[e] * c[e] - x2[e] * s[e]; b[e] = x2[e] * c[e] + x1[e] * s[e]; }
        u32x4 o1, o2; o1.x = cvt_pk_bf16(a[0], a[1]); o1.y = cvt_pk_bf16(a[2], a[3]); o1.z = cvt_pk_bf16(a[4], a[5]); o1.w = cvt_pk_bf16(a[6], a[7]);
        o2.x = cvt_pk_bf16(b[0], b[1]); o2.y = cvt_pk_bf16(b[2], b[3]); o2.z = cvt_pk_bf16(b[4], b[5]); o2.w = cvt_pk_bf16(b[6], b[7]);
        *(u32x4*)(row + h * 128 + s8) = o1; *(u32x4*)(row + h * 128 + 64 + s8) = o2; }
}
__device__ __forceinline__ void diff_combine_row(const bf16* oc, bf16* out, float lam, float post, const float* subln, int lane) {
    const f32x4 g = *(const f32x4*)(subln + lane * 4);
#pragma unroll
    for (int h = 0; h < 4; ++h) {
        const u32x2 w0 = *((const u32x2*)(oc + h * 512) + lane), w1 = *((const u32x2*)(oc + h * 512 + 256) + lane);
        float d[4] = {bflo(w0.x) - lam * bflo(w1.x), bfhi(w0.x) - lam * bfhi(w1.x), bflo(w0.y) - lam * bflo(w1.y), bfhi(w0.y) - lam * bfhi(w1.y)};
        const float rstd = 1.f / sqrtf(wave_sum((d[0] * d[0] + d[1] * d[1]) + (d[2] * d[2] + d[3] * d[3])) * (1.f / 256.f) + EPS);
        u32x2 o; o.x = cvt_pk_bf16(d[0] * rstd * g.x * post, d[1] * rstd * g.y * post); o.y = cvt_pk_bf16(d[2] * rstd * g.z * post, d[3] * rstd * g.w * post);
        *((u32x2*)(out + h * 256) + lane) = o;
    }
}
template <int R>
__device__ __forceinline__ void diff_combine_rows(const bf16* ocb, bf16* outb, size_t ldo, int m0, int mstep, float lam, float post, const float* subln, int lane) {
    const f32x4 g = *(const f32x4*)(subln + lane * 4);
    u32x2 w0[R][4], w1[R][4];
#pragma unroll
    for (int i = 0; i < R; ++i) { const bf16* oc = ocb + (size_t)(m0 + i * mstep) * 2048;
#pragma unroll
        for (int h = 0; h < 4; ++h) { w0[i][h] = *((const u32x2*)(oc + h * 512) + lane); w1[i][h] = *((const u32x2*)(oc + h * 512 + 256) + lane); } }
#pragma unroll
    for (int i = 0; i < R; ++i) { bf16* out = outb + (size_t)(m0 + i * mstep) * ldo;
#pragma unroll
        for (int h = 0; h < 4; ++h) { const u32x2 a = w0[i][h], b = w1[i][h];
            float d[4] = {bflo(a.x) - lam * bflo(b.x), bfhi(a.x) - lam * bfhi(b.x), bflo(a.y) - lam * bflo(b.y), bfhi(a.y) - lam * bfhi(b.y)};
            const float rstd = 1.f / sqrtf(wave_sum((d[0] * d[0] + d[1] * d[1]) + (d[2] * d[2] + d[3] * d[3])) * (1.f / 256.f) + EPS);
            u32x2 o; o.x = cvt_pk_bf16(d[0] * rstd * g.x * post, d[1] * rstd * g.y * post); o.y = cvt_pk_bf16(d[2] * rstd * g.z * post, d[3] * rstd * g.w * post);
            *((u32x2*)(out + h * 256) + lane) = o; } }
}
__device__ __forceinline__ void sincos_d(double a, double& sn, double& cs) {
    const double k = __builtin_rint(a * 0.15915494309189533577);
    const double r = __builtin_fma(-k, 6.283185307179586476925, a) - k * 2.4492935982947064e-16 * 0.0;
    const double r2 = r * r;
    double s = -1.0 / 51090942171709440000.0;
    s = s * r2 + 1.0 / 121645100408832000.0; s = s * r2 - 1.0 / 355687428096000.0; s = s * r2 + 1.0 / 1307674368000.0; s = s * r2 - 1.0 / 6227020800.0;
    s = s * r2 + 1.0 / 39916800.0; s = s * r2 - 1.0 / 362880.0; s = s * r2 + 1.0 / 5040.0; s = s * r2 - 1.0 / 120.0; s = s * r2 + 1.0 / 6.0; s = s * r2 - 1.0;
    sn = -s * r;
    double c = 1.0 / 1124000727777607680000.0;
    c = c * r2 - 1.0 / 2432902008176640000.0; c = c * r2 + 1.0 / 6402373705728000.0; c = c * r2 - 1.0 / 20922789888000.0; c = c * r2 + 1.0 / 87178291200.0;
    c = c * r2 - 1.0 / 479001600.0; c = c * r2 + 1.0 / 3628800.0; c = c * r2 - 1.0 / 40320.0; c = c * r2 + 1.0 / 720.0; c = c * r2 - 1.0 / 24.0; c = c * r2 + 0.5; c = c * r2 - 1.0;
    cs = -c;
}

__device__ __forceinline__ void* ld_ptr(LAS unsigned long long* P, int i) {
    const unsigned long long v = P[i];
    const unsigned lo = __builtin_amdgcn_readfirstlane((unsigned)v), hi = __builtin_amdgcn_readfirstlane((unsigned)(v >> 32));
    return (void*)(GAS void*)(uintptr_t)(((unsigned long long)hi << 32) | lo);
}
struct Args { const float* in[27]; float* out; unsigned char* ws; int ph_lo, ph_hi; };
enum { I_XP = 0, I_XS, I_MP, I_MS, I_NORM_MIX, I_W_IN_AB, I_MLA_QN, I_W_QB, I_MLA_KVN, I_W_KVB, I_GQA_QN, I_GQA_KN, I_W_OUT_AB, I_W_IN_CD, I_RPB, I_DLAM, I_SUBLN, I_W_OUT_CD,
       I_NORM_XA, I_NORM_MEM, I_W_XQ, I_W_XKV, I_W_XO, I_NORM_MLP, I_W_UP, I_W_DOWN, I_FINAL };

__global__ void __launch_bounds__(512, 2) fwd(Args args) {
    extern __shared__ __attribute__((aligned(16))) unsigned char lds_raw[];
    LAS unsigned char* lds = (LAS unsigned char*)lds_raw;
    volatile LAS unsigned* MISC = (volatile LAS unsigned*)(lds + MISC_OFF);
    const int tid0 = threadIdx.x, wave = __builtin_amdgcn_readfirstlane(tid0 >> 6);
    const int G = gridDim.x; const int bx = blockIdx.x; const int vcu = (G % 8 == 0) ? (bx % 8) * (G / 8) + bx / 8 : bx;
    const int gw = vcu * 8 + wave, NGW = G * 8;
    for (int u = tid0; u < (LDS_BYTES - RING_BYTES) / 4; u += 512) ((LAS unsigned*)(lds + RING_BYTES))[u] = 0u;
    __syncthreads();
    LAS unsigned long long* PTRS = (LAS unsigned long long*)(lds + PTR_OFF);
    if (tid0 == 0) {
#pragma unroll
        for (int i = 0; i < 27; ++i) PTRS[i] = (unsigned long long)(uintptr_t)args.in[i];
        PTRS[27] = (unsigned long long)(uintptr_t)args.out; PTRS[28] = (unsigned long long)(uintptr_t)args.ws;
    }
    const int lo = args.ph_lo, hi = args.ph_hi; int ph = 0;
    __syncthreads();
#define INP(i) ((const float*)ld_ptr(PTRS, (i)))
#define WSP ((unsigned char*)ld_ptr(PTRS, 28))
#define XP ((float*)ld_ptr(PTRS, 27))
    XcdBarrier bar = xcd_barrier_post((unsigned*)(WSP + WS_CTL) + CW_BAR, MISC + 8, wave);
#ifndef PH_MASK
#define PH_MASK 0xffffffffu
#endif
#define PEN(k) (((PH_MASK) >> (k)) & 1u)
#ifndef PROBE_REP
#define PROBE_REP 0u
#endif
#define REPS(k) (1 + (int)(((PROBE_REP) >> (k)) & 1u))
#define PH_ON (ph >= lo && ph < hi)
#define PH_LANE const int lane = lane_id_fresh(), tid = wave * 64 + lane; (void)tid; (void)lane; int gw_s_ = gw; asm volatile("" : "+s"(gw_s_)); const int gw = gw_s_; (void)gw
#define PH_END do { if (ph >= lo && ph + 1 < hi) xcd_barrier(bar, wave); ++ph; } while (0)

#define X XP
#define H ((bf16*)(WSP + WS_H))
#define BIG (WSP + WS_BIG)
#define WB (WSP + WS_WB)
#define tab_mla ((float*)(WSP + WS_TAB_MLA))
#define tab_1d ((float*)(WSP + WS_TAB_1D))
#define MN ((bf16*)(WSP + WS_MN))
#define MKV ((bf16*)(WSP + WS_MKV))
#define HFIN H
#define PSQ(i) ((float*)(WSP + WS_PS + (size_t)(i) * PS_BYTES))
#define PSC(i) ((float*)(WSP + WS_PS + 3 * PS_BYTES + (size_t)(i) * PSC_BYTES))
#define XBH ((bf16*)XP)
#define XBA XBH
    LAS float* scr = (LAS float*)(lds + wave * TR_BYTES);

    if (PH_ON && PEN(0)) for (int rep_ = 0; rep_ < REPS(0); ++rep_) { PH_LANE;
        const int gt = vcu * 512 + tid, NT_ = G * 512;
        for (int i = gt; i < 4096 * 32; i += NT_) { const int pos = i >> 5, f = i & 31; double inv = 1.0; for (int k = 0; k < f; ++k) inv *= 0.7498942093324558273;
            const float ang = (float)pos * (float)inv; double sn, cs; sincos_d((double)ang, sn, cs); tab_mla[i] = (float)cs; tab_mla[4096 * 32 + i] = (float)sn; }
        for (int i = gt; i < 4096 * 64; i += NT_) { const int pos = i >> 6, f = i & 63; double inv = 1.0; for (int k = 0; k < f; ++k) inv *= 0.8659643233600653524;
            const float ang = (float)pos * (float)inv; double sn, cs; sincos_d((double)ang, sn, cs); tab_1d[i] = (float)cs; tab_1d[4096 * 64 + i] = (float)sn; }
        float* ss0 = PSQ(0);
        int m = gw;
        for (; m + NGW < T; m += 2 * NGW) { const int m1 = m + NGW;
            const float* src0 = (m < T_PROMPT) ? INP(I_XP) + (size_t)m * DM : INP(I_XS) + (size_t)(m - T_PROMPT) * DM;
            const float* src1 = (m1 < T_PROMPT) ? INP(I_XP) + (size_t)m1 * DM : INP(I_XS) + (size_t)(m1 - T_PROMPT) * DM;
            init_rows2_2048(src0, src1, XBH + (size_t)m * DM, XBH + (size_t)m1 * DM, ss0 + (size_t)m * 32, ss0 + (size_t)m1 * 32, lane); }
        for (; m < T; m += NGW) { const float* src = (m < T_PROMPT) ? INP(I_XP) + (size_t)m * DM : INP(I_XS) + (size_t)(m - T_PROMPT) * DM;
            init_row_2048(src, XBH + (size_t)m * DM, ss0 + (size_t)m * 32, lane); }
    }

    for (int layer = 0; layer < DEPTH; ++layer) {
        const int j = layer >> 1; const bool even = (layer & 1) == 0;
#define W_IN ((bf16*)(WB + WB_IN))
#define W_QB ((bf16*)(WB + WB_QB))
#define W_KVB ((bf16*)(WB + WB_KVB))
#define W_OUT ((bf16*)(WB + WB_OUT))
#define W_XQ ((bf16*)(WB + WB_XQ))
#define W_XKV ((bf16*)(WB + WB_XKV))
#define W_XO ((bf16*)(WB + WB_XO))
#define W_UP ((bf16*)(WB + WB_UP))
#define W_DOWN ((bf16*)(WB + WB_DOWN))

#define CONVERT_LATE do { __syncthreads(); { PH_LANE; \
            convert_matrix((even ? INP(I_W_OUT_AB) : INP(I_W_OUT_CD)) + (size_t)j * DM * DM, DM, DM, W_OUT, nullptr, scr, gw, NGW, lane); \
            convert_matrix(INP(I_W_XQ) + (size_t)layer * DM * 512, DM, 512, W_XQ, INP(I_NORM_XA) + layer * DM, scr, gw, NGW, lane); \
            convert_matrix(INP(I_W_XKV) + (size_t)layer * DM * 1024, DM, 1024, W_XKV, nullptr, scr, gw, NGW, lane); \
            convert_matrix(INP(I_W_XO) + (size_t)layer * 512 * DM, 512, DM, W_XO, nullptr, scr, gw, NGW, lane); \
            convert_matrix(INP(I_W_UP) + (size_t)layer * DM * DFF, DM, DFF, W_UP, INP(I_NORM_MLP) + layer * DM, scr, gw, NGW, lane); \
            convert_matrix(INP(I_W_DOWN) + (size_t)layer * DFF * DM, DFF, DM, W_DOWN, nullptr, scr, gw, NGW, lane); } __syncthreads(); } while (0)
#define CONV_SLOT (bx % ((NSEQ * 8 * 16 / G) < 6 ? ((NSEQ * 8 * 16 / G) < 1 ? 1 : (NSEQ * 8 * 16 / G)) : 6))
        if (PH_ON && PEN(1)) for (int rep_ = 0; rep_ < REPS(1); ++rep_) { PH_LANE;
            const float* gmix = INP(I_NORM_MIX) + layer * DM;
            if (even) {
                convert_matrix(INP(I_W_IN_AB) + (size_t)j * DM * AB_IN, DM, AB_IN, W_IN, gmix, scr, gw, NGW, lane);
                for (size_t i = (size_t)gw * 64 + lane; i < (size_t)(AB_PAD - AB_IN) * DM / 8; i += (size_t)NGW * 64) { u32x4 z = (u32x4){0u, 0u, 0u, 0u}; asm volatile("" : "+v"(z)); ((u32x4*)(W_IN + (size_t)AB_IN * DM))[i] = z; }
                convert_matrix(INP(I_W_QB) + (size_t)j * 512 * 1536, 512, 1536, W_QB, INP(I_MLA_QN) + j * 512, scr, gw, NGW, lane);
                convert_matrix(INP(I_W_KVB) + (size_t)j * 512 * 2048, 512, 2048, W_KVB, INP(I_MLA_KVN) + j * 512, scr, gw, NGW, lane);
            } else {
                convert_matrix(INP(I_W_IN_CD) + (size_t)j * DM * CD_IN, DM, CD_IN, W_IN, gmix, scr, gw, NGW, lane);
            }
            const float* gm = INP(I_NORM_MEM) + layer * DM;
            for (int r = gw; r < TM; r += NGW) { const float* src = (r < 8 * MEMLEN) ? INP(I_MP) + (size_t)r * DM : INP(I_MS) + (size_t)(r - 8 * MEMLEN) * DM;
                norm_row_2048(src, gm, MN + (size_t)r * DM, nullptr, lane); }
        }
        PH_END;

        if (even) {
            bf16* PROJ = (bf16*)(BIG + BIG_PROJ); bf16* Q = (bf16*)(BIG + BIG_Q); bf16* KV = (bf16*)(BIG + BIG_KV);
            if (PH_ON && PEN(2)) for (int rep_ = 0; rep_ < REPS(2); ++rep_) { PH_LANE;
                pg8::Gemm g{XBH, W_IN, T, AB_PAD, DM, DM, DM}; pg8::StaticOrder S; S.init(T, AB_PAD, G, bx, 3);
                pg8::EpiBf16<0, 32> E{PROJ, AB_PAD, 0, 0, PSQ(0), 1.f / 2048.f, PSC(0), PSC_BYTES / 4};
                pg8::gemm_phase(lds, g, S, E, wave);
            }
            PH_END;
            if (PH_ON && PEN(3)) for (int rep_ = 0; rep_ < REPS(3); ++rep_) { PH_LANE;
                const float* gkn = INP(I_GQA_KN) + j * 128;
                int m = gw;
                for (; m + 7 * NGW < T; m += 8 * NGW) even_rows_fix_k<8>(PROJ, m, NGW, gkn, tab_mla, lane);
                for (; m < T; m += NGW) even_row_fix_k(PROJ + (size_t)m * AB_PAD, m & (SEQ - 1), gkn, tab_mla, lane);
            }
            if (PH_ON && PEN(4)) for (int rep_ = 0; rep_ < REPS(4); ++rep_) { PH_LANE;
#pragma unroll 1
                for (int gi = 0; gi < 2; ++gi) {
                    pg8::Gemm g{PROJ + (gi ? 512 : 0), gi ? W_KVB : W_QB, T, gi ? 2048 : 1536, 512, AB_PAD, 512}; pg8::StaticOrder S; S.init(T, g.N, G, bx, 4);
                    pg8::EpiBf16<0, 8> E{gi ? KV : Q, g.N, 0, 0, PSC(gi), 1.f / 512.f, nullptr, 0};
                    pg8::gemm_phase(lds, g, S, E, wave);
                }
            }
            PH_END;
            if (PH_ON) {
                for (int rep_ = 0; rep_ < REPS(6); ++rep_)
                for (int u = vcu, it_ = 0; u < NSEQ * 8 * 16; u += G, ++it_) { const int qb = u & 15, h = (u >> 4) & 7, b = u >> 7; const size_t t0 = (size_t)b * SEQ;
                    att::dense_unit<192, 1, 1>(Q + (t0 + qb * 256) * 1536 + h * 192, 1536, KV + t0 * 2048 + h * 256, 2048, PROJ + t0 * AB_PAD + 1024, AB_PAD,
                                         KV + t0 * 2048 + h * 256 + 128, 2048, H + (t0 + qb * 256) * DM + h * 128, DM, SEQ, (LAS char*)lds, wave, qb * 256, tab_mla, nullptr);
                    if (rep_ == 0 && it_ == CONV_SLOT) CONVERT_LATE; }
                for (int rep_ = 0; rep_ < REPS(21); ++rep_)
                for (int u = vcu; u < NSEQ * 8 * 16; u += G) { const int qb = u & 15, h = (u >> 4) & 7, b = u >> 7; const size_t t0 = (size_t)b * SEQ; const int kvh = h >> 2;
                    att::dense_unit3<3>(PROJ + (t0 + qb * 256) * AB_PAD + 1088 + h * 128, AB_PAD, PROJ + t0 * AB_PAD + 2112 + kvh * 128, AB_PAD,
                                         PROJ + t0 * AB_PAD + 2368 + kvh * 128, AB_PAD, H + (t0 + qb * 256) * DM + 1024 + h * 128, DM, SEQ, (LAS char*)lds, wave, qb * 256, tab_mla, INP(I_GQA_QN) + j * 128); }
            }
            PH_END;
        } else {
            bf16* NQ = (bf16*)(BIG + 0 * BIG_SPLIT); bf16* NK = (bf16*)(BIG + 1 * BIG_SPLIT); bf16* NV = (bf16*)(BIG + 2 * BIG_SPLIT);
            bf16* DQ = (bf16*)(BIG + 3 * BIG_SPLIT); bf16* DK = (bf16*)(BIG + 4 * BIG_SPLIT); bf16* DV = (bf16*)(BIG + 5 * BIG_SPLIT); bf16* OC = NQ;
            if (PH_ON && PEN(7)) for (int rep_ = 0; rep_ < REPS(7); ++rep_) { PH_LANE;
                pg8::Gemm g{XBH, W_IN, T, CD_IN, DM, DM, DM}; pg8::StaticOrder S; S.init(T, CD_IN, G, bx, 4);
                pg8::EpiBf16<0, 32> E{NQ, 1024, 1024, BIG_SPLIT / 2, PSQ(0), 1.f / 2048.f, nullptr, 0};
                pg8::gemm_phase(lds, g, S, E, wave);
            }
            PH_END;
            if (PH_ON && PEN(9)) for (int rep_ = 0; rep_ < REPS(9); ++rep_) { PH_LANE;
                const float* rpb = INP(I_RPB) + (size_t)j * 8 * 465;
                const int nslot = (NSEQ * 8 * 16 / G) < 6 ? ((NSEQ * 8 * 16 / G) < 1 ? 1 : (NSEQ * 8 * 16 / G)) : 6;
                for (int u = vcu, it_ = 0; u < NSEQ * 8 * 16; u += G, ++it_) { const int qb = u & 15, h = (u >> 4) & 7, b = u >> 7; const size_t t0 = (size_t)b * SEQ;
                    att::na_unit2(NQ + (t0 + qb * 256) * 1024 + h * 128, 1024, NK + t0 * 1024 + h * 128, NV + t0 * 1024 + h * 128, 1024,
                                 H + (t0 + qb * 256) * DM + h * 128, DM, qb * 4, rpb + h * 465, (LAS char*)lds, wave);
                    if (rep_ == 0 && PEN(8) && it_ == bx % nslot) {
                        int m = gw;
                        for (; m + 3 * NGW < T; m += 4 * NGW) rope1d_rows4(DK, 1024, m, NGW, tab_1d, lane);
                        for (; m < T; m += NGW) rope1d_row(DK + (size_t)m * 1024, m & (SEQ - 1), tab_1d, lane);
                    } }
            }
            PH_END;
            if (PH_ON && PEN(10)) for (int rep_ = 0; rep_ < REPS(10); ++rep_) { PH_LANE;
                const float* lp = INP(I_DLAM) + j * 512;
                const float a0 = lp[lane] * lp[128 + lane] + lp[64 + lane] * lp[128 + 64 + lane], a1 = lp[256 + lane] * lp[384 + lane] + lp[256 + 64 + lane] * lp[384 + 64 + lane];
                const float lam_init = (layer == 1) ? 0.35550906759096934f : 0.5560582041556406f;
                const float lam = expf(wave_sum(a0)) - expf(wave_sum(a1)) + lam_init;
                const float* subln = INP(I_SUBLN) + j * 256;
                const int npair = NSEQ * 4 * 16, nps = (npair / G) < 3 ? ((npair / G) < 1 ? 1 : (npair / G)) : 3;
                for (int p = vcu, it_ = 0; p < npair; p += G, ++it_) { const int qb = p & 15, h = (p >> 4) & 3, b = p >> 6; const size_t t0 = (size_t)b * SEQ;
                    bf16* oc0 = OC + (t0 + qb * 256) * 2048 + h * 512;
                    att::DiffFuse df{oc0, H + (t0 + qb * 256) * DM + 1024 + h * 256, DM, lam, 1.f - lam_init, subln};
                    att::dense_unit_dv256<0>(DQ + (t0 + qb * 256) * 1024 + (2 * h) * 128, 1024, DK + t0 * 1024 + (2 * h) * 128, 1024, DV + t0 * 1024 + h * 256, 1024,
                                             oc0, 2048, SEQ, (LAS char*)lds, wave, qb * 256, tab_1d, df);
                    att::dense_unit_dv256<1>(DQ + (t0 + qb * 256) * 1024 + (2 * h + 1) * 128, 1024, DK + t0 * 1024 + (2 * h + 1) * 128, 1024, DV + t0 * 1024 + h * 256, 1024,
                                             oc0, 2048, SEQ, (LAS char*)lds, wave, qb * 256, tab_1d, df);
                    if (rep_ == 0 && it_ == bx % nps) CONVERT_LATE; }
            }
            PH_END;
        }
        if (PH_ON && PEN(12)) for (int rep_ = 0; rep_ < REPS(12); ++rep_) { PH_LANE;
            pg8::Gemm g{H, W_OUT, T, DM, DM, DM, DM}; pg8::StaticOrder S; S.init(T, DM, G, bx, 4);
            pg8::EpiResidX E{XBH, XBH, PSQ(1), DM, (rep_ == REPS(12) - 1) ? 1.f : 0.f};
            pg8::gemm_phase(lds, g, S, E, wave, ((bx >> 3) & 7) * SKEW_TICKS);
        }
        PH_END;
        {
            bf16* XQ = (bf16*)(BIG + BIG_XQ); bf16* XO = (bf16*)(BIG + BIG_XO);
            if (PH_ON && PEN(14)) for (int rep_ = 0; rep_ < REPS(14); ++rep_) { PH_LANE;
#pragma unroll 1
                for (int gi = 0; gi < 2; ++gi) {
                    pg8::Gemm g{gi ? MN : XBA, gi ? W_XKV : W_XQ, gi ? TM : T, gi ? 1024 : 512, DM, DM, DM}; pg8::StaticOrder S; S.init(g.M, g.N, G, gi ? (bx + (G >> 1)) % G : bx);
                    pg8::EpiBf16<0, 32> E{gi ? MKV : XQ, g.N, 0, 0, PSQ(1), 1.f / 2048.f, nullptr, 0, gi};
                    pg8::gemm_phase(lds, g, S, E, wave);
                }
            }
            PH_END;
            if (PH_ON && PEN(15)) for (int rep_ = 0; rep_ < REPS(15); ++rep_) { PH_LANE;
                for (int u = vcu; u < NSEQ * 4 * 16; u += G) { const int qb = u & 15, h = (u >> 4) & 3, b = u >> 6; const size_t t0 = (size_t)b * SEQ;
                    att::dense_unit3<0>(XQ + (t0 + qb * 256) * 512 + h * 128, 512, MKV + (size_t)b * MEMLEN * 1024 + h * 128, 1024,
                                         MKV + (size_t)b * MEMLEN * 1024 + 512 + h * 128, 1024, XO + (t0 + qb * 256) * 512 + h * 128, 512, MEMLEN, (LAS char*)lds, wave, 0, nullptr, nullptr); }
            }
            PH_END;
            if (PH_ON && PEN(16)) for (int rep_ = 0; rep_ < REPS(16); ++rep_) { PH_LANE;
                pg8::Gemm g{XO, W_XO, T, DM, 512, 512, 512}; pg8::StaticOrder S; S.init(T, DM, G, bx, 4);
                pg8::EpiResidX E{XBH, XBH, PSQ(2), DM, (rep_ == REPS(16) - 1) ? 1.f : 0.f};
                pg8::gemm_phase(lds, g, S, E, wave, ((bx >> 3) & 7) * SKEW_TICKS);
            }
            PH_END;
        }
        {
#pragma unroll 1
            for (int ch = -1; ch < N_MLP_CHUNKS; ++ch) {
                if (PH_ON && PEN(19)) for (int rep_ = 0; rep_ < REPS(19); ++rep_) { PH_LANE;
                    if (ch >= 0) {
                        pg8::Gemm g{(bf16*)(BIG + (size_t)(ch & 1) * U_BYTES), W_DOWN, MLP_CHUNK, DM, DFF, DFF, DFF}; pg8::StaticOrder S; S.init(MLP_CHUNK, DM, G, bx, 4);
                        const size_t co = (size_t)ch * MLP_CHUNK * DM; const bool lastl = (layer == DEPTH - 1);
                        pg8::EpiResidX E{XBH + co, (lastl ? HFIN : XBH) + co, PSQ(0) + (size_t)ch * MLP_CHUNK * 32, DM, (rep_ == REPS(19) - 1) ? 1.f : 0.f};
                        pg8::gemm_phase(lds, g, S, E, wave);
                    }
                    if (ch + 1 < N_MLP_CHUNKS) { const int cn = ch + 1;
                        pg8::Gemm g{XBA + (size_t)cn * MLP_CHUNK * DM, W_UP, MLP_CHUNK, DFF, DM, DM, DM}; pg8::StaticOrder S; S.init(MLP_CHUNK, DFF, G, bx, 8);
                        pg8::EpiBf16<2, 32> E{(bf16*)(BIG + (size_t)(cn & 1) * U_BYTES), DFF, 0, 0, PSQ(2) + (size_t)cn * MLP_CHUNK * 32, 1.f / 2048.f, nullptr, 0};
                        pg8::gemm_phase(lds, g, S, E, wave);
                    }
                }
                PH_END;
            }
        }
    }
    if (PH_ON && PEN(20)) for (int rep_ = 0; rep_ < REPS(20); ++rep_) { PH_LANE; const float* g = INP(I_FINAL); const float* ssf = PSQ(0);
        f32x4 gg[8];
#pragma unroll
        for (int jj = 0; jj < 8; ++jj) gg[jj] = ((const f32x4*)g + lane)[64 * jj];
        int m = gw;
        for (; m + 3 * NGW < T; m += 4 * NGW) final_norm_rows<4>(HFIN, X, gg, ssf, m, NGW, lane);
        for (; m < T; m += NGW) final_norm_row(HFIN + (size_t)m * DM, X + (size_t)m * DM, g, wave_sum(lane < 32 ? ssf[(size_t)m * 32 + lane] : 0.f), lane); }
#undef PH_ON
#undef PH_END
}

extern "C" void kernel_launch(void* const* d_in, const int* in_sizes, int n_in, void* d_out, int out_size, void* d_ws, size_t ws_size, hipStream_t stream) {
    static int grid = 0;
    if (grid == 0) {
        if (n_in != 27 || out_size != T * DM || ws_size < WS_END) { fprintf(stderr, "kernel_launch: shape mismatch: n_in %d out %d ws %zu (need %zu)\n", n_in, out_size, ws_size, (size_t)WS_END); grid = -1; return; }
        int dev = 0, cus = 0, per_cu = 0;
        if (hipGetDevice(&dev) != hipSuccess || hipDeviceGetAttribute(&cus, hipDeviceAttributeMultiprocessorCount, dev) != hipSuccess) { grid = -1; return; }
        if (hipFuncSetAttribute((const void*)fwd, hipFuncAttributeMaxDynamicSharedMemorySize, LDS_BYTES) != hipSuccess) { fprintf(stderr, "kernel_launch: hipFuncSetAttribute failed\n"); grid = -1; return; }
        if (hipOccupancyMaxActiveBlocksPerMultiprocessor(&per_cu, (const void*)fwd, 512, LDS_BYTES) != hipSuccess || per_cu < 1) { fprintf(stderr, "kernel_launch: occupancy query says %d\n", per_cu); }
        (void)hipGetLastError();
        grid = cus;
    }
    if (grid < 0) return;
    if (hipMemsetAsync((char*)d_ws + WS_CTL, 0, CTL_ZERO_BYTES, stream) != hipSuccess) return;
    Args a{};
    for (int i = 0; i < 27; ++i) a.in[i] = (const float*)d_in[i];
    a.out = (float*)d_out; a.ws = (unsigned char*)d_ws; a.ph_lo = 0; a.ph_hi = 1 << 30;
    hipLaunchKernelGGL(fwd, dim3(grid), dim3(512), LDS_BYTES, stream, a);
    const hipError_t le = hipPeekAtLastError();
    if (le != hipSuccess) fprintf(stderr, "kernel_launch: launch failed: %s\n", hipGetErrorName(le));
}
```

```cpp
#include <hip/hip_runtime.h>
#include <cstdio>
#include <cstdint>

#define LAS __attribute__((address_space(3)))
#define GAS __attribute__((address_space(1)))
typedef unsigned short bf16;
typedef short bf16x8 __attribute__((ext_vector_type(8)));
typedef short s16x4 __attribute__((ext_vector_type(4)));
typedef float f32x4 __attribute__((ext_vector_type(4)));
typedef float f32x2 __attribute__((ext_vector_type(2)));
typedef float f32x16 __attribute__((ext_vector_type(16)));
typedef unsigned u32x4 __attribute__((ext_vector_type(4)));
typedef unsigned u32x2 __attribute__((ext_vector_type(2)));

constexpr int DM = 2048, SEQ = 4096, NSEQ = 12, T = NSEQ * SEQ  , T_PROMPT = 8 * SEQ;
constexpr int DEPTH = 4, MEMLEN = 256, TM = NSEQ * MEMLEN  ;
constexpr int AB_IN = 2624, AB_PAD = 2816, CD_IN = 6144, DFF = 8192;
constexpr int MLP_CHUNK = 8192, N_MLP_CHUNKS = T / MLP_CHUNK;
constexpr size_t U_BYTES = (size_t)MLP_CHUNK * DFF * 2;
constexpr float EPS = 1e-6f;

__device__ __forceinline__ unsigned cvt_pk_bf16(float lo, float hi) { unsigned r; asm volatile("v_cvt_pk_bf16_f32 %0, %1, %2" : "=v"(r) : "v"(lo), "v"(hi)); return r; }
__device__ __forceinline__ float bf2f(unsigned short b) { return __builtin_bit_cast(float, ((unsigned)b) << 16); }
__device__ __forceinline__ float bflo(unsigned w) { return __builtin_bit_cast(float, w << 16); }
__device__ __forceinline__ float bfhi(unsigned w) { return __builtin_bit_cast(float, w & 0xffff0000u); }
__device__ __forceinline__ int lane_id_fresh() { int l; asm volatile("v_mbcnt_lo_u32_b32 %0, -1, 0\n\tv_mbcnt_hi_u32_b32 %0, -1, %0" : "=v"(l)); return l; }
template <int XOR> __device__ __forceinline__ float swz_xor(float v) { return __builtin_bit_cast(float, __builtin_amdgcn_ds_swizzle(__builtin_bit_cast(int, v), (XOR << 10) | 0x1f)); }
__device__ __forceinline__ float wave_sum(float v) {
    v += swz_xor<1>(v); v += swz_xor<2>(v); v += swz_xor<4>(v); v += swz_xor<8>(v); v += swz_xor<16>(v);
    auto rr = __builtin_amdgcn_permlane32_swap(__float_as_uint(v), __float_as_uint(v), false, false);
    return __uint_as_float(rr[0]) + __uint_as_float(rr[1]);
}
__device__ __forceinline__ float other_half(float v, bool lower) {
    auto rr = __builtin_amdgcn_permlane32_swap(__float_as_uint(v), __float_as_uint(v), false, false);
    return lower ? __uint_as_float(rr[1]) : __uint_as_float(rr[0]);
}

namespace pg8 {
constexpr int BM = 256, BK = 64, HALF = 128, HTB = HALF * BK * 2, STAGE_BYTES = 8 * HTB, NXCD = 8, WGM = 8;
__host__ __device__ __forceinline__ int lds_byte(int r, int c) { const int st = (r >> 4) * 2 + (c >> 5), rr = r & 15, cc = c & 31, ob = rr * 64 + cc * 2; return st * 1024 + (ob ^ (((ob >> 9) & 1) << 5)); }
__host__ __device__ __forceinline__ void stage_rc(int b, int& R, int& C) { const int st = b / 1024, sb = b % 1024, swz = sb ^ (((sb >> 9) & 1) << 5); R = (st >> 1) * 16 + swz / 64; C = (st & 1) * 32 + (swz % 64) / 2; }
__host__ __device__ __forceinline__ int perm32(int rho) { const int n = rho >> 4, i = rho & 15; return 8 * (i >> 2) + 4 * n + (i & 3); }

struct Unit { int pm, pn; };
struct Gemm { const bf16* A; const bf16* Bt; int M, N, K, lda, ldb; };

struct StaticOrder {
    int nM, nN, nwg, G, c, wgm;
    __device__ void init(int M, int N, int G_, int c_, int wgm_ = WGM) { nM = M / BM; nN = N / BM; nwg = nM * nN; G = G_; c = c_; wgm = wgm_; }
    __device__ bool next(int i, Unit& u) const {
        const long L = (long)i * G + c; if (L >= nwg) return false;
        int wgid = (int)L; { const int q = nwg / NXCD, r = nwg % NXCD, xcd = wgid % NXCD, off = wgid / NXCD; wgid = (xcd < r ? xcd * (q + 1) : r * (q + 1) + (xcd - r) * q) + off; }
        const int nig = wgm * nN, gid = wgid / nig, fm = gid * wgm, gsz = (nM - fm) < wgm ? (nM - fm) : wgm;
        u.pm = fm + ((wgid % nig) % gsz); u.pn = (wgid % nig) / gsz; return true;
    }
};

template <int W> __device__ __forceinline__ float row_ss(const float* ps, int row, int fq) {
    float s;
    if constexpr (W == 32) { const f32x4 a = *(const f32x4*)(ps + (size_t)row * 32 + fq * 8), b = *(const f32x4*)(ps + (size_t)row * 32 + fq * 8 + 4); s = ((a.x + a.y) + (a.z + a.w)) + ((b.x + b.y) + (b.z + b.w)); }
    else { const f32x2 a = *(const f32x2*)(ps + (size_t)row * 8 + fq * 2); s = a.x + a.y; }
    s += swz_xor<16>(s); s += other_half(s, fq < 2); return s;
}
__device__ __forceinline__ void store_row_sums(const float (&s8)[8], float* slot0, int slots_per_row, int row0, int fq) {
#pragma unroll
    for (int k = 0; k < 2; ++k) {
        const float v = fq == 0 ? s8[4 * k] : (fq == 1 ? s8[4 * k + 1] : (fq == 2 ? s8[4 * k + 2] : s8[4 * k + 3]));
        slot0[(size_t)(row0 + k * HALF + fq * 16) * slots_per_row] = v; }
}
constexpr int RS_LDS_OFF = 135168 + 2048;
template <int ACT  , int RSW> struct EpiBf16 {
    static constexpr bool PERM = true;
    bf16* O; int ldc; int split_cols; size_t split_stride; const float* rs_in; float rs_inv_dim; float* ss_out; size_t ss_stride; int rs_off;
    struct RsPf { f32x4 a[2], b[2]; f32x2 c[2]; };
    __device__ __forceinline__ void rs_issue(RsPf& p, int pm, int wr, int wc, int fr, int fq) const {
#pragma unroll
        for (int ai = 0; ai < 2; ++ai) { const size_t row = (size_t)pm * BM + wr * 64 + fr + ai * HALF + wc * 16;
            if constexpr (RSW == 32) { const float* q = rs_in + row * 32 + fq * 8;
                asm volatile("global_load_dwordx4 %0, %2, off\n\tglobal_load_dwordx4 %1, %2, off offset:16" : "=&v"(p.a[ai]), "=&v"(p.b[ai]) : "v"(q) : "memory"); }
            else { const float* q = rs_in + row * 8 + fq * 2;
                asm volatile("global_load_dwordx2 %0, %1, off" : "=&v"(p.c[ai]) : "v"(q) : "memory"); } }
    }
    template <int NYOUNGER>
    __device__ __forceinline__ void rs_finish(RsPf p, LAS unsigned char* lds, int parity, int wr, int wc, int fr, int fq) const {
        static_assert(NYOUNGER == 8 || NYOUNGER == 16, "count");
        if constexpr (RSW == 32) {
            if constexpr (NYOUNGER == 16) asm volatile("s_waitcnt vmcnt(16)" : "+v"(p.a[0]), "+v"(p.b[0]), "+v"(p.a[1]), "+v"(p.b[1]) :: "memory");
            else asm volatile("s_waitcnt vmcnt(8)" : "+v"(p.a[0]), "+v"(p.b[0]), "+v"(p.a[1]), "+v"(p.b[1]) :: "memory");
        } else {
            if constexpr (NYOUNGER == 16) asm volatile("s_waitcnt vmcnt(16)" : "+v"(p.c[0]), "+v"(p.c[1]) :: "memory");
            else asm volatile("s_waitcnt vmcnt(8)" : "+v"(p.c[0]), "+v"(p.c[1]) :: "memory");
        }
        LAS float* rsl = (LAS float*)(lds + RS_LDS_OFF) + parity * 256;
#pragma unroll
        for (int ai = 0; ai < 2; ++ai) { float s;
            if constexpr (RSW == 32) s = ((p.a[ai].x + p.a[ai].y) + (p.a[ai].z + p.a[ai].w)) + ((p.b[ai].x + p.b[ai].y) + (p.b[ai].z + p.b[ai].w)); else s = p.c[ai].x + p.c[ai].y;
            s += swz_xor<16>(s); s += other_half(s, fq < 2);
            const float rs = 1.f / sqrtf(s * rs_inv_dim + EPS);
            if (fq == 0) rsl[wr * 64 + fr + ai * HALF + wc * 16] = rs; }
        asm volatile("s_waitcnt lgkmcnt(0)" ::: "memory");
    }
    __device__ __forceinline__ void operator()(const f32x4 (&acc)[2][2][4][2], const Unit& u, int wr, int wc, int fr, int fq, LAS unsigned char* lds, int parity, const Unit& nx, bool has_next) const {
        RsPf pf; rs_issue(pf, has_next ? nx.pm : u.pm, wr, wc, fr, fq);
        const LAS float* rsl = (const LAS float*)(lds + RS_LDS_OFF) + parity * 256 + wr * 64 + fr;
        const int row0 = u.pm * BM + wr * 64 + fr; int colt = u.pn * BM; bf16* base = O;
        if (split_cols) { const int t = colt / split_cols; base += (size_t)t * split_stride; colt -= t * split_cols; }
        const int col0 = colt + wc * 32 + 8 * fq;
        const bool do_ss = (ss_out != nullptr) && (u.pn < 4);
        float* ssp = do_ss ? ss_out + (size_t)(u.pn >> 1) * ss_stride + (u.pn & 1) * 4 + wc : nullptr;
        float s8[8] = {0.f, 0.f, 0.f, 0.f, 0.f, 0.f, 0.f, 0.f};
#pragma unroll
        for (int ai = 0; ai < 2; ++ai)
#pragma unroll
            for (int m = 0; m < 4; ++m) { const int row = row0 + ai * HALF + m * 16; bf16* rowp = base + (size_t)row * ldc + col0;
                float rs = rsl[ai * HALF + m * 16]; rs = rs_off ? 1.f : rs;
                float ss = 0.f;
#pragma unroll
                for (int bj = 0; bj < 2; ++bj) { f32x4 v0 = acc[ai][bj][m][0] * rs, v1 = acc[ai][bj][m][1] * rs;
                    if (ACT == 2) {
#pragma unroll
                        for (int j = 0; j < 4; ++j) { const float a = fmaxf(v0[j], 0.f), b = fmaxf(v1[j], 0.f); v0[j] = a * a; v1[j] = b * b; } }
                    u32x4 w; w.x = cvt_pk_bf16(v0[0], v0[1]); w.y = cvt_pk_bf16(v0[2], v0[3]); w.z = cvt_pk_bf16(v1[0], v1[1]); w.w = cvt_pk_bf16(v1[2], v1[3]);
                    *(u32x4*)(rowp + bj * HALF) = w;
                    if (do_ss) { const float a0 = bflo(w.x), a1 = bfhi(w.x), a2 = bflo(w.y), a3 = bfhi(w.y), a4 = bflo(w.z), a5 = bfhi(w.z), a6 = bflo(w.w), a7 = bfhi(w.w);
                        ss += (a0 * a0 + a1 * a1) + (a2 * a2 + a3 * a3) + (a4 * a4 + a5 * a5) + (a6 * a6 + a7 * a7); } }
                if (do_ss) { ss += swz_xor<16>(ss); ss += other_half(ss, fq < 2); s8[ai * 4 + m] = ss; } }
        if (do_ss) store_row_sums(s8, ssp, 8, row0, fq);
        rs_finish<16>(pf, lds, parity ^ 1, wr, wc, fr, fq);
    }
};
struct EpiResidX {
    static constexpr bool PERM = true;
    const bf16* XBin; bf16* XBout; float* ps; int ldc; float scale;
    struct RsPf {};
    __device__ __forceinline__ void rs_issue(RsPf&, int, int, int, int, int) const {}
    template <int NYOUNGER> __device__ __forceinline__ void rs_finish(const RsPf&, LAS unsigned char*, int, int, int, int, int) const {}
    __device__ __forceinline__ void operator()(const f32x4 (&acc)[2][2][4][2], const Unit& u, int wr, int wc, int fr, int fq, LAS unsigned char*, int, const Unit&, bool) const {
        const int row0 = u.pm * BM + wr * 64 + fr, col0 = u.pn * BM + wc * 32 + 8 * fq;
        float* psp = ps + u.pn * 4 + wc;
        float s8[8];
        u32x4 ch[2][4][2];
#pragma unroll
        for (int ai = 0; ai < 2; ++ai)
#pragma unroll
            for (int m = 0; m < 4; ++m) { const bf16* q = XBin + (size_t)(row0 + ai * HALF + m * 16) * ldc + col0;
                asm volatile("global_load_dwordx4 %0, %2, off\n\tglobal_load_dwordx4 %1, %2, off offset:256" : "=&v"(ch[ai][m][0]), "=&v"(ch[ai][m][1]) : "v"(q) : "memory"); }
        static_assert(HALF * 2 == 256, "the second load's immediate offset");
#pragma unroll
        for (int ai = 0; ai < 2; ++ai)
#pragma unroll
            for (int m = 0; m < 4; ++m) { const int row = row0 + ai * HALF + m * 16; const size_t off = (size_t)row * ldc + col0;
                float ss = 0.f;
                asm volatile("s_waitcnt vmcnt(14)" : "+v"(ch[ai][m][0]), "+v"(ch[ai][m][1]) :: "memory");
#pragma unroll
                for (int bj = 0; bj < 2; ++bj) { const u32x4 h4 = ch[ai][m][bj]; const f32x4 a0 = acc[ai][bj][m][0] * scale, a1 = acc[ai][bj][m][1] * scale;
                    u32x4 wh; wh.x = cvt_pk_bf16(bflo(h4.x) + a0[0], bfhi(h4.x) + a0[1]); wh.y = cvt_pk_bf16(bflo(h4.y) + a0[2], bfhi(h4.y) + a0[3]);
                    wh.z = cvt_pk_bf16(bflo(h4.z) + a1[0], bfhi(h4.z) + a1[1]); wh.w = cvt_pk_bf16(bflo(h4.w) + a1[2], bfhi(h4.w) + a1[3]);
                    *(u32x4*)(XBout + off + bj * HALF) = wh;
                    const float y0 = bflo(wh.x), y1 = bfhi(wh.x), y2 = bflo(wh.y), y3 = bfhi(wh.y), y4 = bflo(wh.z), y5 = bfhi(wh.z), y6 = bflo(wh.w), y7 = bfhi(wh.w);
                    ss += (y0 * y0 + y1 * y1) + (y2 * y2 + y3 * y3) + (y4 * y4 + y5 * y5) + (y6 * y6 + y7 * y7); }
                ss += swz_xor<16>(ss); ss += other_half(ss, fq < 2); s8[ai * 4 + m] = ss; }
        store_row_sums(s8, psp, 32, row0, fq);
    }
};

template <class Epi>
__device__ __forceinline__ void gemm_phase(LAS unsigned char* lds, const Gemm g, const StaticOrder& S, const Epi& E, int wid, int skew_ticks = 0) {
    if (skew_ticks > 0) {
        const unsigned long long t0 = __builtin_amdgcn_s_memrealtime();
        while (__builtin_amdgcn_s_memrealtime() - t0 < (unsigned long long)skew_ticks) __builtin_amdgcn_s_sleep(8);
    }
    const int lane = lane_id_fresh(), tid = wid * 64 + lane, wr = wid >> 2, wc = wid & 3, fr = lane & 15, fq = lane >> 4;
    const int K = g.K, nt = K / BK;
    unsigned voffA[2], voffB[2];
#pragma unroll
    for (int i = 0; i < 2; ++i) { int R, C; stage_rc(tid * 16 + i * 8192, R, C); const int Rb = Epi::PERM ? ((R & ~31) + perm32(R & 31)) : R;
        voffA[i] = (unsigned)(R * g.lda + C) * 2u; voffB[i] = (unsigned)(Rb * g.ldb + C) * 2u; }
    const size_t kstep = (size_t)(BK * 2);
    const size_t hstepA = (size_t)HALF * g.lda * 2, hstepB = (size_t)HALF * g.ldb * 2;
    const size_t tstepA = 2 * hstepA, tstepB = 2 * hstepB;
    const unsigned ldsw = (unsigned)wid * 1024u;
    const int aoff = lds_byte(wr * 64 + fr, fq * 8), boff = lds_byte(wc * 32 + fr, fq * 8);
#define PG8_SA(b, h) (((b) * 2 + (h)) * HTB)
#define PG8_SB(b, h) ((4 + (b) * 2 + (h)) * HTB)
#define PG8_STAGE(bufoff, gbase, voff) do { _Pragma("unroll") for (int _i = 0; _i < 2; ++_i) \
        __builtin_amdgcn_global_load_lds((const unsigned*)((const char*)(gbase) + (voff)[_i]), (LAS unsigned*)(lds + (bufoff) + ldsw + _i * 8192), 16, 0, 0); } while (0)
#define PG8_LDA(dst, b, h) do { _Pragma("unroll") for (int m = 0; m < 4; ++m) _Pragma("unroll") for (int k = 0; k < 2; ++k) dst[m][k] = *(const LAS bf16x8*)(lds + PG8_SA(b, h) + aoff + m * 2048 + k * 1024); } while (0)
#define PG8_LDB(dst, b, h) do { _Pragma("unroll") for (int n = 0; n < 2; ++n) _Pragma("unroll") for (int k = 0; k < 2; ++k) dst[n][k] = *(const LAS bf16x8*)(lds + PG8_SB(b, h) + boff + n * 2048 + k * 1024); } while (0)
#define PG8_MMA(ai, bj, At, Bt) do { __builtin_amdgcn_s_setprio(1); _Pragma("unroll") for (int m = 0; m < 4; ++m) _Pragma("unroll") for (int n = 0; n < 2; ++n) _Pragma("unroll") for (int k = 0; k < 2; ++k) \
        acc[ai][bj][m][n] = __builtin_amdgcn_mfma_f32_16x16x32_bf16(Bt[n][k], At[m][k], acc[ai][bj][m][n], 0, 0, 0); __builtin_amdgcn_s_setprio(0); } while (0)
#define PG8_WAIT_V(n) asm volatile("s_waitcnt vmcnt(" #n ")" ::: "memory")
#define PG8_WAIT_L(n) asm volatile("s_waitcnt lgkmcnt(" #n ")" ::: "memory")
#define PG8_BAR __builtin_amdgcn_s_barrier()
#define PG8_SCHED __builtin_amdgcn_sched_barrier(0)
    Unit cur, nxt; int ui = 0;
    if (!S.next(0, cur)) return;
    f32x4 acc[2][2][4][2];
#pragma unroll
    for (int a = 0; a < 2; ++a)
#pragma unroll
        for (int b = 0; b < 2; ++b)
#pragma unroll
            for (int m = 0; m < 4; ++m)
#pragma unroll
                for (int n = 0; n < 2; ++n) acc[a][b][m][n] = (f32x4){0.f, 0.f, 0.f, 0.f};
    bf16x8 At[4][2], B0[2][2], B1[2][2];
    const char* cA = (const char*)g.A + (size_t)cur.pm * tstepA; const char* cB = (const char*)g.Bt + (size_t)cur.pn * tstepB;
    typename Epi::RsPf pf0; E.rs_issue(pf0, cur.pm, wr, wc, fr, fq);
    PG8_STAGE(PG8_SB(0, 0), cB, voffB); PG8_STAGE(PG8_SB(0, 1), cB + hstepB, voffB); PG8_STAGE(PG8_SA(0, 0), cA, voffA); PG8_STAGE(PG8_SA(0, 1), cA + hstepA, voffA);
    if (wr == 1) PG8_BAR;
    PG8_WAIT_V(2); PG8_BAR;
    E.template rs_finish<8>(pf0, lds, 0, wr, wc, fr, fq);
    PG8_STAGE(PG8_SB(1, 0), cB + kstep, voffB); PG8_STAGE(PG8_SA(1, 0), cA + kstep, voffA); PG8_STAGE(PG8_SB(1, 1), cB + hstepB + kstep, voffB);
    PG8_WAIT_V(6); PG8_BAR;
    for (;;) {
        const bool has_next = S.next(ui + 1, nxt);
        const char* nA = has_next ? (const char*)g.A + (size_t)nxt.pm * tstepA : cA; const char* nB = has_next ? (const char*)g.Bt + (size_t)nxt.pn * tstepB : cB;
        for (int t = 0; t < nt; t += 2) {
            const bool last = (t == nt - 2);
            const char* a1 = cA + (size_t)(t + 1) * kstep;
            const char* a2 = last ? nA : cA + (size_t)(t + 2) * kstep; const char* b2 = last ? nB : cB + (size_t)(t + 2) * kstep;
            const char* a3 = a2 + kstep; const char* b3 = b2 + kstep;
            PG8_LDB(B0, 0, 0); PG8_LDB(B1, 0, 1); PG8_SCHED; PG8_LDA(At, 0, 0); PG8_STAGE(PG8_SA(1, 1), a1 + hstepA, voffA);
            PG8_WAIT_V(8); PG8_WAIT_L(0); PG8_BAR; PG8_MMA(0, 0, At, B0); PG8_MMA(0, 1, At, B1); PG8_BAR; PG8_SCHED;
            PG8_LDA(At, 0, 1); PG8_STAGE(PG8_SB(0, 0), b2, voffB); PG8_STAGE(PG8_SB(0, 1), b2 + hstepB, voffB); PG8_STAGE(PG8_SA(0, 0), a2, voffA);
            PG8_WAIT_V(8); PG8_WAIT_L(0); PG8_BAR; PG8_MMA(1, 0, At, B0); PG8_MMA(1, 1, At, B1); PG8_BAR; PG8_SCHED;
            PG8_LDB(B0, 1, 0); PG8_LDB(B1, 1, 1); PG8_SCHED; PG8_LDA(At, 1, 0); PG8_STAGE(PG8_SA(0, 1), a2 + hstepA, voffA);
            PG8_WAIT_V(8); PG8_WAIT_L(0); PG8_BAR; PG8_MMA(0, 0, At, B0); PG8_MMA(0, 1, At, B1); PG8_BAR; PG8_SCHED;
            PG8_LDA(At, 1, 1); PG8_STAGE(PG8_SB(1, 0), b3, voffB); PG8_STAGE(PG8_SB(1, 1), b3 + hstepB, voffB); PG8_STAGE(PG8_SA(1, 0), a3, voffA);
            PG8_WAIT_V(8); PG8_WAIT_L(0); PG8_BAR; PG8_MMA(1, 0, At, B0); PG8_MMA(1, 1, At, B1); PG8_BAR; PG8_SCHED;
        }
        if (wr == 0) PG8_BAR;
        E(acc, cur, wr, wc, fr, fq, lds, ui & 1, nxt, has_next);
        if (!has_next) break;
#pragma unroll
        for (int a = 0; a < 2; ++a)
#pragma unroll
            for (int b = 0; b < 2; ++b)
#pragma unroll
                for (int m = 0; m < 4; ++m)
#pragma unroll
                    for (int n = 0; n < 2; ++n) acc[a][b][m][n] = (f32x4){0.f, 0.f, 0.f, 0.f};
        cur = nxt; cA = nA; cB = nB; ++ui;
        if (wr == 1) PG8_BAR;
    }
    PG8_WAIT_V(0);
    PG8_BAR;
#undef PG8_SA
#undef PG8_SB
#undef PG8_STAGE
#undef PG8_LDA
#undef PG8_LDB
#undef PG8_MMA
#undef PG8_WAIT_V
#undef PG8_WAIT_L
#undef PG8_BAR
#undef PG8_SCHED
}
}

namespace att {
#define SBAR() __builtin_amdgcn_sched_barrier(0)
constexpr int SHM_V = 64 * 128 * 2;
__device__ __forceinline__ int crow(int r, int hi) { return (r & 3) + 8 * (r >> 2) + 4 * hi; }
template <int DQK> struct Cfg {
    static constexpr int KP = DQK * 2, SHM_K = 64 * KP, OFF_K = 2 * SHM_V, OFF_WS = OFF_K + 2 * SHM_K, NPARK = (DQK == 192 ? 6 : 0), NREG = DQK / 16 - NPARK, OFF_QS = OFF_WS + 8 * 256, TOTAL = OFF_QS + 8 * 1024 * NPARK;
    static constexpr float SCALE = (DQK == 192) ? 0.07216878364870322f : 0.08838834764831845f;
    static constexpr float C = SCALE * 1.4426950408889634f;
};
constexpr float THR = 8.f;

template <int DQK>
__device__ __forceinline__ void partialSM(f32x16& p0, f32x16& p1, float& m_reg, float& mn, float& alpha) {
    constexpr float C = Cfg<DQK>::C, SCALE = Cfg<DQK>::SCALE;
    float pmax = p0[0];
#pragma unroll
    for (int r = 1; r < 16; ++r) pmax = fmaxf(pmax, p0[r]);
#pragma unroll
    for (int r = 0; r < 16; ++r) pmax = fmaxf(pmax, p1[r]);
    { auto rr = __builtin_amdgcn_permlane32_swap(__float_as_uint(pmax), __float_as_uint(pmax), false, false);
      pmax = fmaxf(__uint_as_float(rr[0]), __uint_as_float(rr[1])); }
    if (__builtin_expect(__all(pmax - m_reg <= THR / SCALE), 1)) { mn = m_reg; alpha = 1.f; }
    else { mn = fmaxf(m_reg, pmax); alpha = __builtin_amdgcn_exp2f((m_reg - mn) * C); m_reg = mn; }
    const float mnC = -mn * C;
#pragma unroll
    for (int r = 0; r < 16; ++r) p0[r] = fmaf(p0[r], C, mnC);
#pragma unroll
    for (int r = 0; r < 16; ++r) p1[r] = fmaf(p1[r], C, mnC);
#pragma unroll
    for (int r = 0; r < 16; ++r) p0[r] = __builtin_amdgcn_exp2f(p0[r]);
}
__device__ __forceinline__ void finishSM(f32x16& p0, f32x16& p1, float alpha, float& l_reg, bf16x8& pa0, bf16x8& pa1, bf16x8& pa2, bf16x8& pa3) {
#pragma unroll
    for (int r = 0; r < 16; ++r) p1[r] = __builtin_amdgcn_exp2f(p1[r]);
    float ps = 0;
#pragma unroll
    for (int r = 0; r < 16; ++r) ps += p0[r];
#pragma unroll
    for (int r = 0; r < 16; ++r) ps += p1[r];
    { auto rr = __builtin_amdgcn_permlane32_swap(__float_as_uint(ps), __float_as_uint(ps), false, false);
      ps = __uint_as_float(rr[0]) + __uint_as_float(rr[1]); }
    l_reg = l_reg * alpha + ps;
#define PK4(P, BASE, OUT) do { unsigned a0 = cvt_pk_bf16(P[BASE + 0], P[BASE + 1]), a1 = cvt_pk_bf16(P[BASE + 2], P[BASE + 3]);   \
    unsigned b0 = cvt_pk_bf16(P[BASE + 4], P[BASE + 5]), b1 = cvt_pk_bf16(P[BASE + 6], P[BASE + 7]);                              \
    auto r0 = __builtin_amdgcn_permlane32_swap(a0, b0, false, false); auto r1 = __builtin_amdgcn_permlane32_swap(a1, b1, false, false); \
    u32x4 w = {r0[0], r1[0], r0[1], r1[1]}; OUT = __builtin_bit_cast(bf16x8, w); } while (0)
    PK4(p0, 0, pa0); PK4(p0, 8, pa1); PK4(p1, 0, pa2); PK4(p1, 8, pa3);
#undef PK4
}
#define KSWZ(KP, row, colB) ((row) * (KP) + ((colB) ^ (((KP) == 256 ? ((row) & 15) : (((row) >> 1) & 7)) << 4)))
template <int DQK, int NREG = Cfg<DQK>::NREG>
__device__ __forceinline__ void qkt(f32x16& p0, f32x16& p1, const LAS char* Ks, const bf16x8* qr, const LAS char* Qs, int r32, int hi) {
    constexpr int KP = Cfg<DQK>::KP;
    p0 = f32x16{}; p1 = f32x16{};
#pragma unroll
    for (int d0 = 0; d0 < DQK / 16; ++d0) { const int cb = (d0 * 16 + hi * 8) * 2;
        const bf16x8 b0 = *(const LAS bf16x8*)(Ks + KSWZ(KP, r32, cb));
        const bf16x8 b1 = *(const LAS bf16x8*)(Ks + KSWZ(KP, 32 + r32, cb));
        bf16x8 q;
        if (d0 < NREG) q = qr[d0]; else q = *(const LAS bf16x8*)(Qs + (d0 - NREG) * 1024);
        p0 = __builtin_amdgcn_mfma_f32_32x32x16_bf16(b0, q, p0, 0, 0, 0);
        p1 = __builtin_amdgcn_mfma_f32_32x32x16_bf16(b1, q, p1, 0, 0, 0); }
}
__device__ __forceinline__ int v_st(int k, int c) { const int kk = (k & ~0xC) | ((k & 4) << 1) | ((k & 8) >> 1); return ((kk >> 3) * 4 + (c >> 5)) * 512 + ((kk & 7) * 32 + (c & 31)) * 2; }
__device__ __forceinline__ int v_rd_base(int lane) { return ((lane & 3) << 3) | (((lane >> 2) & 3) << 6) | (((lane >> 4) & 1) << 5) | (((lane >> 5) & 1) << 8); }
constexpr int v_rd_off(int d0, int ks, int half) { return d0 * 512 + ks * 4096 + half * 2048; }
template <int OFF> __device__ __forceinline__ s16x4 tr_read(int vb) {
    s16x4 r; asm volatile("ds_read_b64_tr_b16 %0, %1 offset:%2" : "=&v"(r) : "v"(vb), "i"(OFF) : "memory"); return r;
}
template <int D0> __device__ __forceinline__ void pv_one(f32x16& od, int vb, bf16x8 pa0, bf16x8 pa1, bf16x8 pa2, bf16x8 pa3) {
    const s16x4 l0 = tr_read<v_rd_off(D0, 0, 0)>(vb), h0 = tr_read<v_rd_off(D0, 0, 1)>(vb), l1 = tr_read<v_rd_off(D0, 1, 0)>(vb), h1 = tr_read<v_rd_off(D0, 1, 1)>(vb);
    const s16x4 l2 = tr_read<v_rd_off(D0, 2, 0)>(vb), h2 = tr_read<v_rd_off(D0, 2, 1)>(vb), l3 = tr_read<v_rd_off(D0, 3, 0)>(vb), h3 = tr_read<v_rd_off(D0, 3, 1)>(vb);
    asm volatile("s_waitcnt lgkmcnt(0)" ::: "memory"); SBAR();
#define PKV(L, H) (bf16x8){L[0], L[1], L[2], L[3], H[0], H[1], H[2], H[3]}
    od = __builtin_amdgcn_mfma_f32_32x32x16_bf16(pa0, PKV(l0, h0), od, 0, 0, 0);
    od = __builtin_amdgcn_mfma_f32_32x32x16_bf16(pa1, PKV(l1, h1), od, 0, 0, 0);
    od = __builtin_amdgcn_mfma_f32_32x32x16_bf16(pa2, PKV(l2, h2), od, 0, 0, 0);
    od = __builtin_amdgcn_mfma_f32_32x32x16_bf16(pa3, PKV(l3, h3), od, 0, 0, 0);
#undef PKV
}
__device__ __forceinline__ void pv_d0(f32x16* o, int vb, bf16x8 pa0, bf16x8 pa1, bf16x8 pa2, bf16x8 pa3) {
    pv_one<0>(o[0], vb, pa0, pa1, pa2, pa3); pv_one<1>(o[1], vb, pa0, pa1, pa2, pa3); pv_one<2>(o[2], vb, pa0, pa1, pa2, pa3); pv_one<3>(o[3], vb, pa0, pa1, pa2, pa3);
}
__device__ __forceinline__ void store_o(const f32x16* o, float l_reg, LAS float* li_l, LAS char* lds, bf16* Ob, int ldo, int wid, int lane, int r32, int hi) {
    if (hi == 0) li_l[r32] = l_reg;
    asm volatile("s_waitcnt lgkmcnt(0)" ::: "memory");
    float rli[16];
#pragma unroll
    for (int r = 0; r < 16; ++r) rli[r] = __builtin_amdgcn_rcpf(li_l[crow(r, hi)]);
    LAS unsigned short* slab = (LAS unsigned short*)(lds + wid * 8192);
#pragma unroll
    for (int r = 0; r < 16; ++r) { const int orow = crow(r, hi);
#pragma unroll
        for (int d0 = 0; d0 < 4; ++d0) slab[orow * 128 + d0 * 32 + r32] = (unsigned short)(cvt_pk_bf16(o[d0][r] * rli[r], 0.f) & 0xffffu); }
    asm volatile("s_waitcnt lgkmcnt(0)" ::: "memory");
#pragma unroll
    for (int i = 0; i < 8; ++i) { const int id = i * 64 + lane, row = id >> 4, c16 = id & 15;
        const u32x4 w = *(const LAS u32x4*)((LAS char*)slab + row * 256 + c16 * 16);
        *(u32x4*)(Ob + (unsigned)(wid * 32 + row) * (unsigned)ldo + c16 * 8) = w; }
}

__device__ __forceinline__ void unpack8(bf16x8 v, float (&x)[8]) {
#pragma unroll
    for (int e = 0; e < 8; ++e) x[e] = bf2f((unsigned short)v[e]);
}
__device__ __forceinline__ bf16x8 pack8(const float (&x)[8]) {
    u32x4 w; w.x = cvt_pk_bf16(x[0], x[1]); w.y = cvt_pk_bf16(x[2], x[3]); w.z = cvt_pk_bf16(x[4], x[5]); w.w = cvt_pk_bf16(x[6], x[7]); return __builtin_bit_cast(bf16x8, w);
}
__device__ __forceinline__ void rope_pair(bf16x8& f1, bf16x8& f2, const float* ct, const float* st, float mul, const float* g1, const float* g2) {
    float x1[8], x2[8], a[8], b[8]; unpack8(f1, x1); unpack8(f2, x2);
    const f32x4 c0 = *(const f32x4*)ct, c1 = *(const f32x4*)(ct + 4), s0 = *(const f32x4*)st, s1 = *(const f32x4*)(st + 4);
    const float c[8] = {c0.x, c0.y, c0.z, c0.w, c1.x, c1.y, c1.z, c1.w}, s[8] = {s0.x, s0.y, s0.z, s0.w, s1.x, s1.y, s1.z, s1.w};
    if (g1) {
        const f32x4 ga = *(const f32x4*)g1, gb = *(const f32x4*)(g1 + 4), gc = *(const f32x4*)g2, gd = *(const f32x4*)(g2 + 4);
        const float gg1[8] = {ga.x, ga.y, ga.z, ga.w, gb.x, gb.y, gb.z, gb.w}, gg2[8] = {gc.x, gc.y, gc.z, gc.w, gd.x, gd.y, gd.z, gd.w};
#pragma unroll
        for (int e = 0; e < 8; ++e) { x1[e] = x1[e] * mul * gg1[e]; x2[e] = x2[e] * mul * gg2[e]; }
    }
#pragma unroll
    for (int e = 0; e < 8; ++e) { a[e] = x1[e] * c[e] - x2[e] * s[e]; b[e] = x2[e] * c[e] + x1[e] * s[e]; }
    f1 = pack8(a); f2 = pack8(b);
}
template <int ND0, int QMODE>
__device__ __forceinline__ void load_q(bf16x8 (&qraw)[ND0], const bf16* __restrict__ Qb, int ldq, int wid, int r32, int hi, int qpos0, const float* __restrict__ tab, const float* __restrict__ qgain) {
    const unsigned qo = (unsigned)(wid * 32 + r32) * (unsigned)ldq + hi * 8;
#pragma unroll
    for (int d0 = 0; d0 < ND0; ++d0) qraw[d0] = *(const bf16x8*)(Qb + qo + d0 * 16);
    const int pos = qpos0 + wid * 32 + r32;
    if constexpr (QMODE == 1) {
        const float* ct = tab + pos * 32 + hi * 8; const float* st = ct + 4096 * 32;
        rope_pair(qraw[8], qraw[10], ct, st, 1.f, nullptr, nullptr); rope_pair(qraw[9], qraw[11], ct + 16, st + 16, 1.f, nullptr, nullptr);
    } else if constexpr (QMODE == 2) {
        const float* ct = tab + pos * 64 + hi * 8; const float* st = ct + 4096 * 64;
#pragma unroll
        for (int g = 0; g < 4; ++g) rope_pair(qraw[g], qraw[g + 4], ct + g * 16, st + g * 16, 1.f, nullptr, nullptr);
    } else if constexpr (QMODE == 3) {
        float ss = 0.f;
#pragma unroll
        for (int d0 = 0; d0 < 8; ++d0) { float x[8]; unpack8(qraw[d0], x);
#pragma unroll
            for (int e = 0; e < 8; ++e) ss += x[e] * x[e]; }
        ss += other_half(ss, hi == 0);
        const float rstd = 1.f / sqrtf(ss * (1.f / 128.f) + EPS);
        const float* ctr = tab + (pos >> 6) * 32 + hi * 8; const float* str = ctr + 4096 * 32; const float* ctc = tab + (pos & 63) * 32 + hi * 8; const float* stc = ctc + 4096 * 32;
        const float* gq = qgain + hi * 8;
#pragma unroll
        for (int g = 0; g < 2; ++g) { rope_pair(qraw[g], qraw[g + 2], ctr + g * 16, str + g * 16, rstd, gq + g * 16, gq + (g + 2) * 16);
                                      rope_pair(qraw[4 + g], qraw[6 + g], ctc + g * 16, stc + g * 16, rstd, gq + (4 + g) * 16, gq + (6 + g) * 16); }
    }
}
template <int DQK, int SDEPTH, int QMODE>
__device__ __forceinline__ void dense_unit(const bf16* __restrict__ Qb, int ldq, const bf16* __restrict__ Kh, int ldk, const bf16* __restrict__ K2h, int ldk2,
                                           const bf16* __restrict__ Vh, int ldv, bf16* __restrict__ Ob, int ldo, int seq, LAS char* lds, int wid,
                                           int qpos0, const float* __restrict__ tab, const float* __restrict__ qgain) {
    using CF = Cfg<DQK>; constexpr int KP = CF::KP, SHM_K = CF::SHM_K, ND0 = DQK / 16;
    const int lane = lane_id_fresh(), tid = wid * 64 + lane, r32 = lane & 31, hi = lane >> 5;
    LAS char* V_lds = lds; LAS char* K_lds = lds + CF::OFF_K;
    LAS float* ws = (LAS float*)(lds + CF::OFF_WS) + wid * 64; LAS float* li_l = ws; LAS float* al_l = ws + 32;
    float m_reg = -1e30f, l_reg = 0; f32x16 o[4] = {}; bf16x8 qr[CF::NREG];
    const LAS char* Qs = lds + CF::OFF_QS + wid * (1024 * CF::NPARK) + lane * 16;
    { bf16x8 qraw[ND0]; load_q<ND0, QMODE>(qraw, Qb, ldq, wid, r32, hi, qpos0, tab, qgain);
#pragma unroll
      for (int d0 = 0; d0 < CF::NREG; ++d0) qr[d0] = qraw[d0];
      if constexpr (CF::NPARK > 0) {
#pragma unroll
          for (int d0 = CF::NREG; d0 < ND0; ++d0) *(LAS bf16x8*)((LAS char*)Qs + (d0 - CF::NREG) * 1024) = qraw[d0]; } }
    const int sr = tid >> 4, sc = (tid & 15) * 8, vst0 = v_st(sr, sc), vst1 = v_st(32 + sr, sc);
    const int kst0 = KSWZ(KP, sr, sc * 2), kst1 = KSWZ(KP, 32 + sr, sc * 2);
    const int kr2 = tid >> 3, c2 = (tid & 7) * 8, kst2 = KSWZ(KP, kr2, (128 + c2) * 2);
    const unsigned vo = (unsigned)sr * (unsigned)ldv + sc, ko = (unsigned)sr * (unsigned)ldk + sc, k2o = (unsigned)kr2 * (unsigned)ldk2 + c2;
    const int vb0 = (int)(unsigned)(uintptr_t)V_lds + v_rd_base(lane);
    struct { bf16x8 vs0, vs1, ks0, ks1, k2; } sr_[SDEPTH];
#define SLOAD(i, k0) do { const bf16* Vt_ = Vh + (size_t)(k0) * ldv; const bf16* Kt_ = Kh + (size_t)(k0) * ldk; \
    sr_[i].vs0 = *(const bf16x8*)(Vt_ + vo); sr_[i].vs1 = *(const bf16x8*)(Vt_ + (size_t)32 * ldv + vo); \
    sr_[i].ks0 = *(const bf16x8*)(Kt_ + ko); sr_[i].ks1 = *(const bf16x8*)(Kt_ + (size_t)32 * ldk + ko); \
    if constexpr (DQK == 192) sr_[i].k2 = *(const bf16x8*)(K2h + (size_t)(k0) * ldk2 + k2o); } while (0)
#define SWRITE(b, i) do { *(LAS bf16x8*)(V_lds + (b) * SHM_V + vst0) = sr_[i].vs0; *(LAS bf16x8*)(V_lds + (b) * SHM_V + vst1) = sr_[i].vs1; \
    *(LAS bf16x8*)(K_lds + (b) * SHM_K + kst0) = sr_[i].ks0; *(LAS bf16x8*)(K_lds + (b) * SHM_K + kst1) = sr_[i].ks1; \
    if constexpr (DQK == 192) *(LAS bf16x8*)(K_lds + (b) * SHM_K + kst2) = sr_[i].k2; } while (0)
#define SWAIT() do { if constexpr (SDEPTH == 1) asm volatile("s_waitcnt vmcnt(0)" ::: "memory"); else if constexpr (DQK == 192) asm volatile("s_waitcnt vmcnt(5)" ::: "memory"); else asm volatile("s_waitcnt vmcnt(4)" ::: "memory"); } while (0)
#define RESC(a) do { if (__any((a) < 1.f)) { if (hi == 0) al_l[r32] = (a); asm volatile("s_waitcnt lgkmcnt(0)" ::: "memory"); \
    _Pragma("unroll") for (int d = 0; d < 4; ++d) _Pragma("unroll") for (int r = 0; r < 16; ++r) o[d][r] *= al_l[crow(r, hi)]; } } while (0)
    f32x16 pA0, pA1, pB0, pB1; float mnA, mnB, alA, alB; bf16x8 pa0, pa1, pa2, pa3; const int NT = seq / 64;
    constexpr int SE = 0, SO = SDEPTH - 1;
    __syncthreads();
    SLOAD(SE, 0); asm volatile("s_waitcnt vmcnt(0)" ::: "memory"); SWRITE(0, SE); __syncthreads();
    qkt<DQK>(pA0, pA1, K_lds, qr, Qs, r32, hi); partialSM<DQK>(pA0, pA1, m_reg, mnA, alA);
    SLOAD(SO, 64); if constexpr (SDEPTH == 2) { if (2 < NT) SLOAD(SE, 128); }
    SWAIT(); SWRITE(1, SO); __syncthreads();
    for (int j = 1; j + 1 < NT; j += 2) {
        SBAR(); qkt<DQK>(pB0, pB1, K_lds + SHM_K, qr, Qs, r32, hi);
        finishSM(pA0, pA1, alA, l_reg, pa0, pa1, pa2, pa3); SBAR();
        SLOAD(SO, (j + SDEPTH) * 64); SBAR();
        pv_d0(o, vb0, pa0, pa1, pa2, pa3); partialSM<DQK>(pB0, pB1, m_reg, mnB, alB);
        __syncthreads(); SWAIT(); SWRITE(0, SE);
        RESC(alB); __syncthreads();
        SBAR(); qkt<DQK>(pA0, pA1, K_lds, qr, Qs, r32, hi);
        finishSM(pB0, pB1, alB, l_reg, pa0, pa1, pa2, pa3); SBAR();
        if (SDEPTH == 1 || j + 3 < NT) SLOAD(SE, (j + 1 + SDEPTH) * 64); SBAR();
        pv_d0(o, vb0 + SHM_V, pa0, pa1, pa2, pa3); partialSM<DQK>(pA0, pA1, m_reg, mnA, alA);
        __syncthreads(); SWAIT(); SWRITE(1, SO);
        RESC(alA); __syncthreads();
    }
    SBAR(); qkt<DQK>(pB0, pB1, K_lds + SHM_K, qr, Qs, r32, hi);
    finishSM(pA0, pA1, alA, l_reg, pa0, pa1, pa2, pa3); SBAR();
    pv_d0(o, vb0, pa0, pa1, pa2, pa3); partialSM<DQK>(pB0, pB1, m_reg, mnB, alB);
    __syncthreads(); RESC(alB);
    finishSM(pB0, pB1, alB, l_reg, pa0, pa1, pa2, pa3); SBAR();
    pv_d0(o, vb0 + SHM_V, pa0, pa1, pa2, pa3);
    __syncthreads();
    store_o(o, l_reg, li_l, lds, Ob, ldo, wid, lane, r32, hi);
#undef SLOAD
#undef SWRITE
#undef SWAIT
}

constexpr int R3_SLOT = 32768, R3_OFF_WS = 3 * R3_SLOT, R3_TOTAL = R3_OFF_WS + 8 * 256;
template <int QMODE>
__device__ __forceinline__ void dense_unit3(const bf16* __restrict__ Qb, int ldq, const bf16* __restrict__ Kh, int ldk, const bf16* __restrict__ Vh, int ldv, bf16* __restrict__ Ob, int ldo, int seq,
                                            LAS char* lds, int wid, int qpos0, const float* __restrict__ tab, const float* __restrict__ qgain) {
    constexpr int KP = 256;
    const int lane = lane_id_fresh(), tid = wid * 64 + lane, r32 = lane & 31, hi = lane >> 5;
    LAS float* ws = (LAS float*)(lds + R3_OFF_WS) + wid * 64; LAS float* li_l = ws; LAS float* al_l = ws + 32;
    float m_reg = -1e30f, l_reg = 0; f32x16 o[4] = {}; bf16x8 qr[8];
    load_q<8, QMODE>(qr, Qb, ldq, wid, r32, hi, qpos0, tab, qgain);
    const int sr = tid >> 4, sc = (tid & 15) * 8, vst0 = v_st(sr, sc), vst1 = v_st(32 + sr, sc);
    const int kst0 = 16384 + KSWZ(KP, sr, sc * 2), kst1 = 16384 + KSWZ(KP, 32 + sr, sc * 2);
    const unsigned vo = (unsigned)sr * (unsigned)ldv + sc, ko = (unsigned)sr * (unsigned)ldk + sc;
    const int vbase = (int)(unsigned)(uintptr_t)lds + v_rd_base(lane);
    struct { bf16x8 vs0, vs1, ks0, ks1; } sr_[2];
#define SLOAD3(i, k0) do { const bf16* Vt_ = Vh + (size_t)(k0) * ldv; const bf16* Kt_ = Kh + (size_t)(k0) * ldk; \
    sr_[i].vs0 = *(const bf16x8*)(Vt_ + vo); sr_[i].vs1 = *(const bf16x8*)(Vt_ + (size_t)32 * ldv + vo); \
    sr_[i].ks0 = *(const bf16x8*)(Kt_ + ko); sr_[i].ks1 = *(const bf16x8*)(Kt_ + (size_t)32 * ldk + ko); } while (0)
#define SWRITE3(soff, i) do { *(LAS bf16x8*)(lds + (soff) + vst0) = sr_[i].vs0; *(LAS bf16x8*)(lds + (soff) + vst1) = sr_[i].vs1; \
    *(LAS bf16x8*)(lds + (soff) + kst0) = sr_[i].ks0; *(LAS bf16x8*)(lds + (soff) + kst1) = sr_[i].ks1; } while (0)
#define SWAIT3() asm volatile("s_waitcnt vmcnt(4)" ::: "memory")
#define RESC3(a) do { if (__any((a) < 1.f)) { if (hi == 0) al_l[r32] = (a); asm volatile("s_waitcnt lgkmcnt(0)" ::: "memory"); \
    _Pragma("unroll") for (int d = 0; d < 4; ++d) _Pragma("unroll") for (int r = 0; r < 16; ++r) o[d][r] *= al_l[crow(r, hi)]; } } while (0)
    f32x16 pA0, pA1, pB0, pB1; float mnA, mnB, alA, alB; bf16x8 pa0, pa1, pa2, pa3; const int NT = seq / 64;
    __syncthreads();
    SLOAD3(0, 0); SLOAD3(1, 64);
    SWAIT3(); SWRITE3(0, 0);
    if (2 < NT) SLOAD3(0, 128);
    __syncthreads();
    qkt<128>(pA0, pA1, lds + 16384, qr, nullptr, r32, hi); partialSM<128>(pA0, pA1, m_reg, mnA, alA);
    SWAIT3(); SWRITE3(R3_SLOT, 1);
    int sK = R3_SLOT, sV = 0, sW = 2 * R3_SLOT;
    for (int t = 1; t + 1 < NT; t += 2) {
        __syncthreads();
        SBAR(); qkt<128>(pB0, pB1, lds + sK + 16384, qr, nullptr, r32, hi);
        finishSM(pA0, pA1, alA, l_reg, pa0, pa1, pa2, pa3); SBAR();
        if (t + 2 < NT) SLOAD3(1, (t + 2) * 64); SBAR();
        pv_d0(o, vbase + sV, pa0, pa1, pa2, pa3); partialSM<128>(pB0, pB1, m_reg, mnB, alB);
        SWAIT3(); SWRITE3(sW, 0);
        RESC3(alB);
        { const int n = sV; sV = sK; sK = sW; sW = n; }
        __syncthreads();
        SBAR(); qkt<128>(pA0, pA1, lds + sK + 16384, qr, nullptr, r32, hi);
        finishSM(pB0, pB1, alB, l_reg, pa0, pa1, pa2, pa3); SBAR();
        if (t + 3 < NT) SLOAD3(0, (t + 3) * 64); SBAR();
        pv_d0(o, vbase + sV, pa0, pa1, pa2, pa3); partialSM<128>(pA0, pA1, m_reg, mnA, alA);
        SWAIT3(); if (t + 2 < NT) SWRITE3(sW, 1);
        RESC3(alA);
        { const int n = sV; sV = sK; sK = sW; sW = n; }
    }
    __syncthreads();
    SBAR(); qkt<128>(pB0, pB1, lds + sK + 16384, qr, nullptr, r32, hi);
    finishSM(pA0, pA1, alA, l_reg, pa0, pa1, pa2, pa3); SBAR();
    pv_d0(o, vbase + sV, pa0, pa1, pa2, pa3); partialSM<128>(pB0, pB1, m_reg, mnB, alB);
    RESC3(alB);
    finishSM(pB0, pB1, alB, l_reg, pa0, pa1, pa2, pa3); SBAR();
    pv_d0(o, vbase + sK, pa0, pa1, pa2, pa3);
    __syncthreads();
    store_o(o, l_reg, li_l, lds, Ob, ldo, wid, lane, r32, hi);
#undef SLOAD3
#undef SWRITE3
#undef SWAIT3
#undef RESC3
}

constexpr int DV_SLOT = 49152, DV_OFF_K = 32768, DV_OFF_WS = 131072, DV_TOTAL = DV_OFF_WS + 8 * 256;
struct DiffFuse { const bf16* O0b; bf16* Hb; int ldh; float lam, post; const float* subln; };
template <int FUSE>
__device__ __forceinline__ void dense_unit_dv256(const bf16* __restrict__ Qb, int ldq, const bf16* __restrict__ Kh, int ldk, const bf16* __restrict__ Vh, int ldv, bf16* __restrict__ Ob, int ldo, int seq,
                                                 LAS char* lds, int wid, int qpos0, const float* __restrict__ tab, const DiffFuse& df) {
    constexpr int KP = 256;
    const int lane = lane_id_fresh(), tid = wid * 64 + lane, r32 = lane & 31, hi = lane >> 5;
    LAS float* ws = (LAS float*)(lds + DV_OFF_WS) + wid * 64; LAS float* li_l = ws; LAS float* al_l = ws + 32;
    __syncthreads();
    float m_reg = -1e30f, l_reg = 0; f32x16 o[8] = {}; bf16x8 qr[4];
    const LAS char* Qs = lds + 2 * DV_SLOT + wid * 4096 + lane * 16;
    { bf16x8 qraw[8]; load_q<8, 2>(qraw, Qb, ldq, wid, r32, hi, qpos0, tab, nullptr);
#pragma unroll
      for (int d0 = 0; d0 < 4; ++d0) qr[d0] = qraw[d0];
#pragma unroll
      for (int d0 = 4; d0 < 8; ++d0) *(LAS bf16x8*)((LAS char*)Qs + (d0 - 4) * 1024) = qraw[d0]; }
    const int sr = tid >> 4, sc = (tid & 15) * 8, vst0 = v_st(sr, sc), vst1 = v_st(32 + sr, sc);
    const int kst0 = DV_OFF_K + KSWZ(KP, sr, sc * 2), kst1 = DV_OFF_K + KSWZ(KP, 32 + sr, sc * 2);
    const unsigned vo = (unsigned)sr * (unsigned)ldv + sc, ko = (unsigned)sr * (unsigned)ldk + sc;
    const int vbase = (int)(unsigned)(uintptr_t)lds + v_rd_base(lane);
    bf16x8 sv0, sv1, sv2, sv3, sk0, sk1;
#define DLOAD(k0) do { const bf16* Vt_ = Vh + (size_t)(k0) * ldv; const bf16* Kt_ = Kh + (size_t)(k0) * ldk; \
    sv0 = *(const bf16x8*)(Vt_ + vo); sv1 = *(const bf16x8*)(Vt_ + (size_t)32 * ldv + vo); sv2 = *(const bf16x8*)(Vt_ + vo + 128); sv3 = *(const bf16x8*)(Vt_ + (size_t)32 * ldv + vo + 128); \
    sk0 = *(const bf16x8*)(Kt_ + ko); sk1 = *(const bf16x8*)(Kt_ + (size_t)32 * ldk + ko); } while (0)
#define DWRITE(soff) do { *(LAS bf16x8*)(lds + (soff) + vst0) = sv0; *(LAS bf16x8*)(lds + (soff) + vst1) = sv1; *(LAS bf16x8*)(lds + (soff) + 16384 + vst0) = sv2; *(LAS bf16x8*)(lds + (soff) + 16384 + vst1) = sv3; \
    *(LAS bf16x8*)(lds + (soff) + kst0) = sk0; *(LAS bf16x8*)(lds + (soff) + kst1) = sk1; } while (0)
    const int NT = seq / 64;
    __syncthreads();
    DLOAD(0); asm volatile("s_waitcnt vmcnt(0)" ::: "memory"); DWRITE(0);
    __syncthreads();
    int sC = 0, sN = DV_SLOT;
    for (int t = 0; t < NT; ++t) {
        f32x16 p0, p1; float mn, al; bf16x8 pa0, pa1, pa2, pa3;
        SBAR(); qkt<128, 4>(p0, p1, lds + sC + DV_OFF_K, qr, Qs, r32, hi);
        partialSM<128>(p0, p1, m_reg, mn, al);
        if (__any(al < 1.f)) { if (hi == 0) al_l[r32] = al; asm volatile("s_waitcnt lgkmcnt(0)" ::: "memory");
#pragma unroll
            for (int d = 0; d < 8; ++d)
#pragma unroll
                for (int r = 0; r < 16; ++r) o[d][r] *= al_l[crow(r, hi)]; }
        finishSM(p0, p1, al, l_reg, pa0, pa1, pa2, pa3); SBAR();
        if (t + 1 < NT) DLOAD((t + 1) * 64);
        SBAR();
        pv_d0(o, vbase + sC, pa0, pa1, pa2, pa3);
        pv_d0(o + 4, vbase + sC + 16384, pa0, pa1, pa2, pa3);
        if (t + 1 < NT) { asm volatile("s_waitcnt vmcnt(0)" ::: "memory"); DWRITE(sN); }
        __syncthreads();
        { const int n = sC; sC = sN; sN = n; }
    }
    u32x4 w0[FUSE ? 16 : 1];
    if constexpr (FUSE == 1) {
#pragma unroll
        for (int i = 0; i < 16; ++i) { const int row = (i * 64 + lane) >> 5; w0[i] = *(const u32x4*)(df.O0b + (unsigned)(wid * 32 + row) * (unsigned)ldo + (lane & 31) * 8); } }
    if (hi == 0) li_l[r32] = l_reg;
    asm volatile("s_waitcnt lgkmcnt(0)" ::: "memory");
    float rli[16];
#pragma unroll
    for (int r = 0; r < 16; ++r) rli[r] = __builtin_amdgcn_rcpf(li_l[crow(r, hi)]);
    LAS unsigned short* slab = (LAS unsigned short*)(lds + wid * 16384);
#pragma unroll
    for (int r = 0; r < 16; ++r) { const int orow = crow(r, hi);
#pragma unroll
        for (int d0 = 0; d0 < 8; ++d0) slab[orow * 256 + d0 * 32 + r32] = (unsigned short)(cvt_pk_bf16(o[d0][r] * rli[r], 0.f) & 0xffffu); }
    asm volatile("s_waitcnt lgkmcnt(0)" ::: "memory");
    if constexpr (FUSE == 0) {
#pragma unroll
        for (int i = 0; i < 16; ++i) { const int id = i * 64 + lane, row = id >> 5, c16 = id & 31;
            const u32x4 w = *(const LAS u32x4*)((LAS char*)slab + row * 512 + c16 * 16);
            *(u32x4*)(Ob + (unsigned)(wid * 32 + row) * (unsigned)ldo + c16 * 8) = w; }
    } else {
        const int c16 = lane & 31;
        const f32x4 g0 = *(const f32x4*)(df.subln + c16 * 8), g1 = *(const f32x4*)(df.subln + c16 * 8 + 4);
        const float gg[8] = {g0.x, g0.y, g0.z, g0.w, g1.x, g1.y, g1.z, g1.w};
#pragma unroll
        for (int i = 0; i < 16; ++i) { const int row = (i * 64 + lane) >> 5;
            const u32x4 w1 = *(const LAS u32x4*)((LAS char*)slab + row * 512 + c16 * 16);
            const u32x4 a = w0[i];
            float d[8] = {bflo(a.x) - df.lam * bflo(w1.x), bfhi(a.x) - df.lam * bfhi(w1.x), bflo(a.y) - df.lam * bflo(w1.y), bfhi(a.y) - df.lam * bfhi(w1.y),
                          bflo(a.z) - df.lam * bflo(w1.z), bfhi(a.z) - df.lam * bfhi(w1.z), bflo(a.w) - df.lam * bflo(w1.w), bfhi(a.w) - df.lam * bfhi(w1.w)};
            float ss = ((d[0] * d[0] + d[1] * d[1]) + (d[2] * d[2] + d[3] * d[3])) + ((d[4] * d[4] + d[5] * d[5]) + (d[6] * d[6] + d[7] * d[7]));
            ss += swz_xor<1>(ss); ss += swz_xor<2>(ss); ss += swz_xor<4>(ss); ss += swz_xor<8>(ss); ss += swz_xor<16>(ss);
            const float rs = df.post / sqrtf(ss * (1.f / 256.f) + EPS);
            u32x4 o4; o4.x = cvt_pk_bf16(d[0] * rs * gg[0], d[1] * rs * gg[1]); o4.y = cvt_pk_bf16(d[2] * rs * gg[2], d[3] * rs * gg[3]);
            o4.z = cvt_pk_bf16(d[4] * rs * gg[4], d[5] * rs * gg[5]); o4.w = cvt_pk_bf16(d[6] * rs * gg[6], d[7] * rs * gg[7]);
            *(u32x4*)(df.Hb + (unsigned)(wid * 32 + row) * (unsigned)df.ldh + c16 * 8) = o4; }
    }
#undef DLOAD
#undef DWRITE
}

constexpr int NA_OFF_K = SHM_V, NA_OFF_RPB = 65536, NA_OFF_WS = 65536 + 2048, NA_TOTAL = NA_OFF_WS + 8 * 256;
__device__ __forceinline__ int clampi(int v, int lo, int hi) { return v < lo ? lo : (v > hi ? hi : v); }
__device__ __forceinline__ void na_unit(const bf16* __restrict__ Qb, int ldq, const bf16* __restrict__ Kseq, const bf16* __restrict__ Vseq, int ldk,
                                        bf16* __restrict__ Ob, int ldo, int r0, const float* __restrict__ rpb_h, LAS char* lds, int wid) {
    constexpr int KP = 256;
    const int lane = lane_id_fresh(), tid = wid * 64 + lane, r32 = lane & 31, hi = lane >> 5;
    LAS char* V_lds = lds; LAS char* K_lds = lds + NA_OFF_K; LAS float* rpb_l = (LAS float*)(lds + NA_OFF_RPB);
    LAS float* ws = (LAS float*)(lds + NA_OFF_WS) + wid * 64; LAS float* li_l = ws; LAS float* al_l = ws + 32;
    float m_reg = -1e30f, l_reg = 0; f32x16 o[4] = {}; bf16x8 qr[8];
    { const unsigned qo = (unsigned)(wid * 32 + r32) * (unsigned)ldq + hi * 8;
#pragma unroll
      for (int d0 = 0; d0 < 8; ++d0) qr[d0] = *(const bf16x8*)(Qb + qo + d0 * 16); }
    const int sr = tid >> 4, sc = (tid & 15) * 8, vst0 = v_st(sr, sc), vst1 = v_st(32 + sr, sc);
    const int kst0 = KSWZ(KP, sr, sc * 2), kst1 = KSWZ(KP, 32 + sr, sc * 2);
    const unsigned ko = (unsigned)sr * (unsigned)ldk + sc;
    const int vb0 = (int)(unsigned)(uintptr_t)V_lds + v_rd_base(lane);
    const int kr_lo = clampi(r0 - 4, 0, 56), kr_hi = clampi(r0 + 3 - 4, 0, 56) + 8;
    const int qrw = r0 + (wid >> 1), srw = clampi(qrw - 4, 0, 56);
    const int qc = (wid & 1) * 32 + r32, scq = clampi(qc - 8, 0, 48);
    __syncthreads();
    if (tid < 465) rpb_l[tid] = rpb_h[tid] * 11.313708498984761f;
    bf16x8 va0, va1, ka0, ka1, vb0_, vb1_, kb0, kb1;
#define NA_LOAD(V0, V1, K0, K1, kr_) do { const bf16* Kt = Kseq + (size_t)((kr_) * 64) * ldk; const bf16* Vt = Vseq + (size_t)((kr_) * 64) * ldk; \
      V0 = *(const bf16x8*)(Vt + ko); V1 = *(const bf16x8*)(Vt + (size_t)32 * ldk + ko); K0 = *(const bf16x8*)(Kt + ko); K1 = *(const bf16x8*)(Kt + (size_t)32 * ldk + ko); } while (0)
#define NA_STEP(V0, V1, K0, K1, kr_) do { \
        __syncthreads();                                            \
        *(LAS bf16x8*)(V_lds + vst0) = V0; *(LAS bf16x8*)(V_lds + vst1) = V1; *(LAS bf16x8*)(K_lds + kst0) = K0; *(LAS bf16x8*)(K_lds + kst1) = K1; \
        __syncthreads(); \
        if ((kr_) + 2 < kr_hi) NA_LOAD(V0, V1, K0, K1, (kr_) + 2);     \
        if ((kr_) >= srw && (kr_) < srw + 8) {                      \
            f32x16 p0, p1; float mn, al; bf16x8 pa0, pa1, pa2, pa3; \
            qkt<128>(p0, p1, K_lds, qr, nullptr, r32, hi); \
            const LAS float* bt = rpb_l + ((kr_) - qrw + 7) * 31 + (15 - qc); \
            _Pragma("unroll") for (int r = 0; r < 16; ++r) { const int kc = crow(r, hi); const bool in = (kc >= scq) && (kc < scq + 16); const float b = bt[in ? kc : qc]; p0[r] = in ? p0[r] + b : -1e30f; } \
            _Pragma("unroll") for (int r = 0; r < 16; ++r) { const int kc = 32 + crow(r, hi); const bool in = (kc >= scq) && (kc < scq + 16); const float b = bt[in ? kc : qc]; p1[r] = in ? p1[r] + b : -1e30f; } \
            partialSM<128>(p0, p1, m_reg, mn, al); \
            RESC(al); \
            finishSM(p0, p1, al, l_reg, pa0, pa1, pa2, pa3); SBAR(); \
            pv_d0(o, vb0, pa0, pa1, pa2, pa3); \
        } } while (0)
    NA_LOAD(va0, va1, ka0, ka1, kr_lo);
    if (kr_lo + 1 < kr_hi) NA_LOAD(vb0_, vb1_, kb0, kb1, kr_lo + 1);
    for (int kr = kr_lo; kr < kr_hi; kr += 2) {
        NA_STEP(va0, va1, ka0, ka1, kr);
        if (kr + 1 < kr_hi) NA_STEP(vb0_, vb1_, kb0, kb1, kr + 1);
    }
#undef NA_LOAD
#undef NA_STEP
    __syncthreads();
    store_o(o, l_reg, li_l, lds, Ob, ldo, wid, lane, r32, hi);
}
template <int D0> __device__ __forceinline__ void na2_pv(f32x16& od, int vbA, int vbB, bf16x8 pa0, bf16x8 pa1) {
    const s16x4 l0 = tr_read<v_rd_off(D0, 0, 0)>(vbA), h0 = tr_read<v_rd_off(D0, 0, 1)>(vbA), l1 = tr_read<v_rd_off(D0, 0, 0)>(vbB), h1 = tr_read<v_rd_off(D0, 0, 1)>(vbB);
    asm volatile("s_waitcnt lgkmcnt(0)" ::: "memory"); SBAR();
    od = __builtin_amdgcn_mfma_f32_32x32x16_bf16(pa0, (bf16x8){l0[0], l0[1], l0[2], l0[3], h0[0], h0[1], h0[2], h0[3]}, od, 0, 0, 0);
    od = __builtin_amdgcn_mfma_f32_32x32x16_bf16(pa1, (bf16x8){l1[0], l1[1], l1[2], l1[3], h1[0], h1[1], h1[2], h1[3]}, od, 0, 0, 0);
}
__device__ __forceinline__ void na_unit2(const bf16* __restrict__ Qb, int ldq, const bf16* __restrict__ Kseq, const bf16* __restrict__ Vseq, int ldk,
                                         bf16* __restrict__ Ob, int ldo, int r0, const float* __restrict__ rpb_h, LAS char* lds, int wid) {
    constexpr int KP = 256; constexpr float NEG = -3.0e38f;
    const int lane = lane_id_fresh(), tid = wid * 64 + lane, r32 = lane & 31, hi = lane >> 5;
    LAS char* V_lds = lds; LAS char* K_lds = lds + NA_OFF_K; LAS float* rpb_l = (LAS float*)(lds + NA_OFF_RPB);
    LAS float* ws = (LAS float*)(lds + NA_OFF_WS) + wid * 64; LAS float* li_l = ws; LAS float* al_l = ws + 32;
    float m_reg = -1e30f, l_reg = 0; f32x16 o[4] = {}; bf16x8 qr[8];
    const int typ = wid & 3, rp = wid >> 2, c15 = r32 & 15;
    const int g0 = (typ == 3) ? 0 : typ, g1 = (typ == 3) ? 3 : typ + 1;
    const int qc = (typ == 3) ? (c15 < 8 ? c15 : 48 + c15) : 8 + 16 * typ + c15;
    const int qrl = 2 * rp + (r32 >> 4), qrow = r0 + qrl;
    { const unsigned qo = (unsigned)(qrl * 64 + qc) * (unsigned)ldq + hi * 8;
#pragma unroll
      for (int d0 = 0; d0 < 8; ++d0) qr[d0] = *(const bf16x8*)(Qb + qo + d0 * 16); }
    const int sr = tid >> 4, sc = (tid & 15) * 8, vst0 = v_st(sr, sc), vst1 = v_st(32 + sr, sc);
    const int kst0 = KSWZ(KP, sr, sc * 2), kst1 = KSWZ(KP, 32 + sr, sc * 2);
    const unsigned ko = (unsigned)sr * (unsigned)ldk + sc;
    const int vbA = (int)(unsigned)(uintptr_t)V_lds + v_rd_base(lane) + g0 * 4096, vbB = (int)(unsigned)(uintptr_t)V_lds + v_rd_base(lane) + g1 * 4096;
    const int krow = 16 * (r32 < 16 ? g0 : g1) + c15;
    const LAS char* Kl = K_lds + krow * KP;
    const int kr_lo = clampi(r0 - 4, 0, 56), kr_hi = clampi(r0 + 3 - 4, 0, 56) + 8;
    const int s_lo = clampi(r0 + 2 * rp - 4, 0, 56), s_hi = clampi(r0 + 2 * rp + 1 - 4, 0, 56) + 8;
    const int srq = clampi(qrow - 4, 0, 56), scq = clampi(qc - 8, 0, 48);
    __syncthreads();
    if (tid < 465) rpb_l[tid] = rpb_h[tid] * 11.313708498984761f;
    bf16x8 va0, va1, ka0, ka1, vb0_, vb1_, kb0, kb1;
#define NA_LOAD(V0, V1, K0, K1, kr_) do { const bf16* Kt = Kseq + (size_t)((kr_) * 64) * ldk; const bf16* Vt = Vseq + (size_t)((kr_) * 64) * ldk; \
      V0 = *(const bf16x8*)(Vt + ko); V1 = *(const bf16x8*)(Vt + (size_t)32 * ldk + ko); K0 = *(const bf16x8*)(Kt + ko); K1 = *(const bf16x8*)(Kt + (size_t)32 * ldk + ko); } while (0)
#define NA_STEP(V0, V1, K0, K1, kr_) do { \
        __syncthreads();                                            \
        *(LAS bf16x8*)(V_lds + vst0) = V0; *(LAS bf16x8*)(V_lds + vst1) = V1; *(LAS bf16x8*)(K_lds + kst0) = K0; *(LAS bf16x8*)(K_lds + kst1) = K1; \
        __syncthreads(); \
        if ((kr_) + 2 < kr_hi) NA_LOAD(V0, V1, K0, K1, (kr_) + 2);     \
        if ((kr_) >= s_lo && (kr_) < s_hi) {                        \
            f32x16 p = {}; \
            _Pragma("unroll") for (int d0 = 0; d0 < 8; ++d0) { const int cb = (d0 * 16 + hi * 8) * 2; \
                const bf16x8 kf = *(const LAS bf16x8*)(Kl + (cb ^ (c15 << 4))); p = __builtin_amdgcn_mfma_f32_32x32x16_bf16(kf, qr[d0], p, 0, 0, 0); } \
            const bool rowin = ((kr_) >= srq) && ((kr_) < srq + 8); \
            const LAS float* bt = rpb_l + clampi((kr_) - qrow + 7, 0, 14) * 31 + (15 - qc); \
            _Pragma("unroll") for (int r = 0; r < 16; ++r) { const int kc = 16 * (r < 8 ? g0 : g1) + (r & 3) + 8 * ((r >> 2) & 1) + 4 * hi; \
                const bool in = rowin && (kc >= scq) && (kc < scq + 16); const float b = bt[in ? kc : qc]; p[r] = in ? p[r] + b : NEG; } \
              \
            float pmax = p[0]; _Pragma("unroll") for (int r = 1; r < 16; ++r) pmax = fmaxf(pmax, p[r]); \
            { auto rr = __builtin_amdgcn_permlane32_swap(__float_as_uint(pmax), __float_as_uint(pmax), false, false); pmax = fmaxf(__uint_as_float(rr[0]), __uint_as_float(rr[1])); } \
            float mn, al; \
            if (__builtin_expect(__all(pmax - m_reg <= THR / Cfg<128>::SCALE), 1)) { mn = m_reg; al = 1.f; } \
            else { mn = fmaxf(m_reg, pmax); al = __builtin_amdgcn_exp2f((m_reg - mn) * Cfg<128>::C); m_reg = mn; } \
            const float mnC = -mn * Cfg<128>::C; float ps = 0; \
            _Pragma("unroll") for (int r = 0; r < 16; ++r) { p[r] = __builtin_amdgcn_exp2f(fmaf(p[r], Cfg<128>::C, mnC)); ps += p[r]; } \
            { auto rr = __builtin_amdgcn_permlane32_swap(__float_as_uint(ps), __float_as_uint(ps), false, false); ps = __uint_as_float(rr[0]) + __uint_as_float(rr[1]); } \
            RESC(al); \
            l_reg = l_reg * al + ps; \
            bf16x8 pa0, pa1; \
            { unsigned a0 = cvt_pk_bf16(p[0], p[1]), a1 = cvt_pk_bf16(p[2], p[3]), b0 = cvt_pk_bf16(p[4], p[5]), b1 = cvt_pk_bf16(p[6], p[7]); \
              auto x0 = __builtin_amdgcn_permlane32_swap(a0, b0, false, false); auto x1 = __builtin_amdgcn_permlane32_swap(a1, b1, false, false); \
              u32x4 w = {x0[0], x1[0], x0[1], x1[1]}; pa0 = __builtin_bit_cast(bf16x8, w); } \
            { unsigned a0 = cvt_pk_bf16(p[8], p[9]), a1 = cvt_pk_bf16(p[10], p[11]), b0 = cvt_pk_bf16(p[12], p[13]), b1 = cvt_pk_bf16(p[14], p[15]); \
              auto x0 = __builtin_amdgcn_permlane32_swap(a0, b0, false, false); auto x1 = __builtin_amdgcn_permlane32_swap(a1, b1, false, false); \
              u32x4 w = {x0[0], x1[0], x0[1], x1[1]}; pa1 = __builtin_bit_cast(bf16x8, w); } \
            SBAR(); \
            na2_pv<0>(o[0], vbA, vbB, pa0, pa1); na2_pv<1>(o[1], vbA, vbB, pa0, pa1); na2_pv<2>(o[2], vbA, vbB, pa0, pa1); na2_pv<3>(o[3], vbA, vbB, pa0, pa1); \
        } } while (0)
    NA_LOAD(va0, va1, ka0, ka1, kr_lo);
    if (kr_lo + 1 < kr_hi) NA_LOAD(vb0_, vb1_, kb0, kb1, kr_lo + 1);
    for (int kr = kr_lo; kr < kr_hi; kr += 2) {
        NA_STEP(va0, va1, ka0, ka1, kr);
        if (kr + 1 < kr_hi) NA_STEP(vb0_, vb1_, kb0, kb1, kr + 1);
    }
#undef NA_LOAD
#undef NA_STEP
    __syncthreads();
    if (hi == 0) li_l[r32] = l_reg;
    asm volatile("s_waitcnt lgkmcnt(0)" ::: "memory");
    float rli[16];
#pragma unroll
    for (int r = 0; r < 16; ++r) rli[r] = __builtin_amdgcn_rcpf(li_l[crow(r, hi)]);
    LAS unsigned short* slab = (LAS unsigned short*)(lds + wid * 8192);
#pragma unroll
    for (int r = 0; r < 16; ++r) { const int orow = crow(r, hi);
#pragma unroll
        for (int d0 = 0; d0 < 4; ++d0) slab[orow * 128 + d0 * 32 + r32] = (unsigned short)(cvt_pk_bf16(o[d0][r] * rli[r], 0.f) & 0xffffu); }
    asm volatile("s_waitcnt lgkmcnt(0)" ::: "memory");
#pragma unroll
    for (int i = 0; i < 8; ++i) { const int id = i * 64 + lane, q = id >> 4, c16 = id & 15, q15 = q & 15;
        const int col = (typ == 3) ? (q15 < 8 ? q15 : 48 + q15) : 8 + 16 * typ + q15;
        const u32x4 w = *(const LAS u32x4*)((LAS char*)slab + q * 256 + c16 * 16);
        *(u32x4*)(Ob + (unsigned)((2 * rp + (q >> 4)) * 64 + col) * (unsigned)ldo + c16 * 8) = w; }
}
#undef RESC
}

constexpr size_t MiB = 1u << 20;
constexpr size_t WS_CTL = 0, CTL_ZERO_BYTES = 1 * MiB;
constexpr size_t WS_TAB_MLA = 5 * MiB;
constexpr size_t WS_TAB_1D = 6 * MiB;
constexpr size_t WS_MN = 8 * MiB;
constexpr size_t WS_MKV = 20 * MiB;
constexpr size_t WS_WB = 32 * MiB;
constexpr size_t WB_IN = 0, WB_QB = 24 * MiB, WB_KVB = 26 * MiB, WB_OUT = 28 * MiB, WB_XQ = 36 * MiB, WB_XKV = 38 * MiB, WB_XO = 42 * MiB, WB_UP = 44 * MiB, WB_DOWN = 76 * MiB;
constexpr size_t WS_H = 144 * MiB;
constexpr size_t WS_BIG = 336 * MiB;
constexpr size_t BIG_PROJ = 0, BIG_Q = 264 * MiB, BIG_KV = 408 * MiB;
constexpr size_t BIG_SPLIT = 96 * MiB;
constexpr size_t BIG_XQ = 0, BIG_XO = 48 * MiB;
constexpr size_t BIG_U = 0;
constexpr size_t BIG_XBA = 400 * MiB;
constexpr size_t WS_PS = WS_BIG + 600 * MiB;
constexpr size_t PS_BYTES = (size_t)T * 32 * 4, PSC_BYTES = (size_t)T * 8 * 4;
constexpr size_t WS_END = WS_PS + 3 * PS_BYTES + 2 * PSC_BYTES;
constexpr int CW_BAR = 4096;
constexpr int SKEW_TICKS = 0;

constexpr int RING_BYTES = 135168, MISC_OFF = RING_BYTES + 320, PTR_OFF = RING_BYTES + 1024, LDS_BYTES = 147456;
static_assert(pg8::RS_LDS_OFF == RING_BYTES + 2048 && pg8::RS_LDS_OFF + 2048 <= LDS_BYTES && PTR_OFF + 29 * 8 <= pg8::RS_LDS_OFF, "row-scale staging area");
static_assert(att::DV_TOTAL <= RING_BYTES && att::Cfg<192>::TOTAL <= RING_BYTES && att::NA_TOTAL <= RING_BYTES && pg8::STAGE_BYTES <= RING_BYTES, "LDS map");

#define XB_TMO      128
#define XB_XCNT(j)  (256  + 64 * (j))
#define XB_XSUB(j)  (1280 + 64 * (j))
#define XB_XGEN(j)  (2304 + 64 * (j))
#define XB_TOP      3328
#define XB_TOPGEN   3392
#define XCD_BAR_WORDS 3456
#define XB_SPIN_CAP (1u << 18)
__device__ __forceinline__ unsigned xb_ld(unsigned* p)              { return __hip_atomic_load(p, __ATOMIC_RELAXED, __HIP_MEMORY_SCOPE_AGENT); }
__device__ __forceinline__ unsigned xb_add(unsigned* p, unsigned v) { return __hip_atomic_fetch_add(p, v, __ATOMIC_RELAXED, __HIP_MEMORY_SCOPE_AGENT); }
__device__ __forceinline__ unsigned xb_xcc_id() { return (unsigned)__builtin_amdgcn_s_getreg((3 << 11) | 20) & 0xFu; }
#define XB_SPIN(cond, bar) do { unsigned _sp = 0; while (cond) { __builtin_amdgcn_s_sleep(1); \
    if ((++_sp & 255u) == 0u) { if (xb_ld(&(bar)[XB_TMO])) break; if (_sp > XB_SPIN_CAP) { atomicAdd(&(bar)[XB_TMO], 1u); break; } } } } while (0)
struct XcdBarrier { unsigned* bar; unsigned x; volatile LAS unsigned* st; };
__device__ __forceinline__ XcdBarrier xcd_barrier_post(unsigned* bar, volatile LAS unsigned* st, int wave) {
    XcdBarrier b; b.bar = bar; b.x = xb_xcc_id(); b.st = st;
    if (wave == 0 && lane_id_fresh() == 0) (void)xb_add(&bar[XB_XCNT(b.x)], 1u);
    return b;
}
__device__ __forceinline__ void xcd_barrier_complete(unsigned* bar, unsigned x, unsigned& nloc, unsigned& nx) {
    const unsigned G = gridDim.x * gridDim.y * gridDim.z;
    unsigned sum, cnt, mine, sp = 0u;
    for (;;) {
        sum = 0u; cnt = 0u; mine = 0u;
#pragma unroll
        for (unsigned j = 0; j < 16; ++j) { const unsigned c = xb_ld(&bar[XB_XCNT(j)]); sum += c; cnt += (c > 0u) ? 1u : 0u; mine = (j == x) ? c : mine; }
        if (sum == G) break;
        __builtin_amdgcn_s_sleep(1);
        if ((++sp & 255u) == 0u) { if (xb_ld(&bar[XB_TMO])) break; if (sp > XB_SPIN_CAP) { atomicAdd(&bar[XB_TMO], 1u); break; } }
    }
    nloc = mine > 0u ? mine : 1u; nx = cnt > 0u ? cnt : 1u;
}
__device__ __forceinline__ void xcd_barrier(const XcdBarrier& b, int wave) {
    asm volatile("s_waitcnt vmcnt(0)" ::: "memory");
    __syncthreads();
    if (wave == 0 && lane_id_fresh() == 0) {
        unsigned long long bar_i = (unsigned long long)(uintptr_t)b.bar; asm volatile("" : "+s"(bar_i));
        unsigned* bar = (unsigned*)(GAS unsigned*)(uintptr_t)bar_i;
        __builtin_amdgcn_s_waitcnt(0);
        unsigned nloc = b.st[0], nx = b.st[1];
        if (nloc == 0u) { xcd_barrier_complete(bar, b.x, nloc, nx); b.st[0] = nloc; b.st[1] = nx; }
        const unsigned old = xb_add(&bar[XB_XSUB(b.x)], 1u);
        const unsigned gen = old / nloc;
        if (old + 1u == (gen + 1u) * nloc) {
            __builtin_amdgcn_fence(__ATOMIC_RELEASE, "agent");
            asm volatile("s_waitcnt vmcnt(0)" ::: "memory");
            const unsigned og = xb_add(&bar[XB_TOP], 1u);
            const unsigned tg = og / nx;
            if (og + 1u == (tg + 1u) * nx) xb_add(&bar[XB_TOPGEN], 1u);
            else XB_SPIN(xb_ld(&bar[XB_TOPGEN]) == tg, bar);
            __builtin_amdgcn_fence(__ATOMIC_ACQUIRE, "agent");
            xb_add(&bar[XB_XGEN(b.x)], 1u);
            asm volatile("s_waitcnt vmcnt(0)" ::: "memory");
        } else {
            XB_SPIN(xb_ld(&bar[XB_XGEN(b.x)]) == gen, bar);
            __builtin_amdgcn_fence(__ATOMIC_ACQUIRE, "agent");
            asm volatile("s_waitcnt vmcnt(0)" ::: "memory");
        }
    }
    __syncthreads();
}

#define LDS_WAIT() asm volatile("s_waitcnt lgkmcnt(0)" ::: "memory")
constexpr int TR_PITCH = 65, TR_BYTES = 64 * TR_PITCH * 4;
static_assert(8 * TR_BYTES <= RING_BYTES, "transpose scratch");
__device__ __forceinline__ void transpose_item(const float* W, int K, int N, bf16* WT, const float* gain, LAS float* scr, int item, int lane) {
    const int nblk = N / 64, kb = item / nblk, nb = item % nblk, k0 = 64 * kb, n0 = 64 * nb;
    const int lr = lane >> 4, lc = (lane & 15) * 4;
#pragma unroll
    for (int h = 0; h < 2; ++h) {
        f32x4 v[8];
#pragma unroll
        for (int i = 0; i < 8; ++i) v[i] = *(const f32x4*)(W + (size_t)(k0 + 32 * h + 4 * i + lr) * N + n0 + lc);
#pragma unroll
        for (int i = 0; i < 8; ++i) { const int kk = 32 * h + 4 * i + lr; const float gk = gain ? gain[k0 + kk] : 1.f; LAS float* d = scr + kk * TR_PITCH + lc;
            d[0] = v[i].x * gk; d[1] = v[i].y * gk; d[2] = v[i].z * gk; d[3] = v[i].w * gk; }
    }
    LDS_WAIT(); asm volatile("" ::: "memory");
    const int c = lane & 7;
#pragma unroll
    for (int j = 0; j < 8; ++j) { const int n = (lane >> 3) + 8 * j; const LAS float* s = scr + (8 * c) * TR_PITCH + n;
        u32x4 o; o.x = cvt_pk_bf16(s[0 * TR_PITCH], s[1 * TR_PITCH]); o.y = cvt_pk_bf16(s[2 * TR_PITCH], s[3 * TR_PITCH]); o.z = cvt_pk_bf16(s[4 * TR_PITCH], s[5 * TR_PITCH]); o.w = cvt_pk_bf16(s[6 * TR_PITCH], s[7 * TR_PITCH]);
        *(u32x4*)(WT + (size_t)(n0 + n) * K + k0 + 8 * c) = o; }
    LDS_WAIT(); asm volatile("" ::: "memory");
}
__device__ __forceinline__ void convert_matrix(const float* W, int K, int N, bf16* WT, const float* gain, LAS float* scr, int gw, int NGW, int lane) {
    const int nitems = (K / 64) * (N / 64);
    for (int it = gw; it < nitems; it += NGW) transpose_item(W, K, N, WT, gain, scr, it, lane);
}
__device__ __forceinline__ void init_row_2048(const float* xrow, bf16* xh, float* ssp, int lane) {
    const f32x4* xr = (const f32x4*)xrow + lane;
    u32x2 w[8]; float s = 0.f;
#pragma unroll
    for (int j = 0; j < 8; ++j) { const f32x4 v = xr[64 * j]; w[j].x = cvt_pk_bf16(v.x, v.y); w[j].y = cvt_pk_bf16(v.z, v.w);
        const float y0 = bflo(w[j].x), y1 = bfhi(w[j].x), y2 = bflo(w[j].y), y3 = bfhi(w[j].y); s += (y0 * y0 + y1 * y1) + (y2 * y2 + y3 * y3); }
    s = wave_sum(s);
    u32x2* oh = (u32x2*)xh + lane;
#pragma unroll
    for (int j = 0; j < 8; ++j) oh[64 * j] = w[j];
    if (lane < 32) ssp[lane] = (lane == 0) ? s : 0.f;
}
__device__ __forceinline__ void init_rows2_2048(const float* xrow0, const float* xrow1, bf16* xh0, bf16* xh1, float* ssp0, float* ssp1, int lane) {
    f32x4 v0[8], v1[8];
#pragma unroll
    for (int j = 0; j < 8; ++j) { v0[j] = ((const f32x4*)xrow0 + lane)[64 * j]; v1[j] = ((const f32x4*)xrow1 + lane)[64 * j]; }
#pragma unroll
    for (int i = 0; i < 2; ++i) { u32x2 w[8]; float s = 0.f;
#pragma unroll
        for (int j = 0; j < 8; ++j) { const f32x4 v = i ? v1[j] : v0[j]; w[j].x = cvt_pk_bf16(v.x, v.y); w[j].y = cvt_pk_bf16(v.z, v.w);
            const float y0 = bflo(w[j].x), y1 = bfhi(w[j].x), y2 = bflo(w[j].y), y3 = bfhi(w[j].y); s += (y0 * y0 + y1 * y1) + (y2 * y2 + y3 * y3); }
        s = wave_sum(s);
        u32x2* oh = (u32x2*)(i ? xh1 : xh0) + lane;
#pragma unroll
        for (int j = 0; j < 8; ++j) oh[64 * j] = w[j];
        if (lane < 32) (i ? ssp1 : ssp0)[lane] = (lane == 0) ? s : 0.f; }
}
__device__ __forceinline__ void norm_row_2048(const float* xrow, const float* g, bf16* orow, float* copy, int lane) {
    const f32x4* xr = (const f32x4*)xrow + lane;
    f32x4 v[8]; float s = 0.f;
#pragma unroll
    for (int j = 0; j < 8; ++j) { v[j] = xr[64 * j]; s += (v[j].x * v[j].x + v[j].y * v[j].y) + (v[j].z * v[j].z + v[j].w * v[j].w); }
    const float rstd = 1.f / sqrtf(wave_sum(s) * (1.f / 2048.f) + EPS);
    if (copy) {
#pragma unroll
        for (int j = 0; j < 8; ++j) ((f32x4*)copy + lane)[64 * j] = v[j]; }
    u32x2* o8 = (u32x2*)orow + lane;
#pragma unroll
    for (int j = 0; j < 8; ++j) { const f32x4 gg = ((const f32x4*)g + lane)[64 * j]; u32x2 w; w.x = cvt_pk_bf16(v[j].x * rstd * gg.x, v[j].y * rstd * gg.y); w.y = cvt_pk_bf16(v[j].z * rstd * gg.z, v[j].w * rstd * gg.w); o8[64 * j] = w; }
}
__device__ __forceinline__ void final_norm_row(const bf16* xh, float* orow, const float* g, float ss, int lane) {
    const float rstd = 1.f / sqrtf(ss * (1.f / 2048.f) + EPS);
    const u32x2* ph = (const u32x2*)xh + lane; f32x4* po = (f32x4*)orow + lane;
#pragma unroll
    for (int j = 0; j < 8; ++j) { const u32x2 h = ph[64 * j]; const f32x4 gg = ((const f32x4*)g + lane)[64 * j];
        f32x4 o; o.x = bflo(h.x) * rstd * gg.x; o.y = bfhi(h.x) * rstd * gg.y; o.z = bflo(h.y) * rstd * gg.z; o.w = bfhi(h.y) * rstd * gg.w;
        po[64 * j] = o; }
}
template <int R>
__device__ __forceinline__ void final_norm_rows(const bf16* xh, float* out, const f32x4 (&gg)[8], const float* ssf, int m0, int mstep, int lane) {
    u32x2 h[R][8]; float ssv[R];
#pragma unroll
    for (int i = 0; i < R; ++i) { const size_t m = (size_t)(m0 + i * mstep); const u32x2* ph = (const u32x2*)(xh + m * DM) + lane;
        ssv[i] = lane < 32 ? ssf[m * 32 + lane] : 0.f;
#pragma unroll
        for (int j = 0; j < 8; ++j) h[i][j] = ph[64 * j]; }
#pragma unroll
    for (int i = 0; i < R; ++i) { const size_t m = (size_t)(m0 + i * mstep); f32x4* po = (f32x4*)(out + m * DM) + lane;
        const float rstd = 1.f / sqrtf(wave_sum(ssv[i]) * (1.f / 2048.f) + EPS);
#pragma unroll
        for (int j = 0; j < 8; ++j) { f32x4 o; o.x = bflo(h[i][j].x) * rstd * gg[j].x; o.y = bfhi(h[i][j].x) * rstd * gg[j].y; o.z = bflo(h[i][j].y) * rstd * gg[j].z; o.w = bfhi(h[i][j].y) * rstd * gg[j].w;
            po[64 * j] = o; } }
}
__device__ __forceinline__ void even_row_fix(bf16* row, int pos, const float* qn, const float* kvn, const float* gqn, const float* gkn, const float* tab_mla, int lane) {
    const float* cosm = tab_mla; const float* sinm = tab_mla + 4096 * 32;
#pragma unroll
    for (int part = 0; part < 2; ++part) {
        u32x4* p = (u32x4*)(row + part * 512) + lane; const u32x4 w = *p; const float* g = (part ? kvn : qn) + lane * 8;
        float x[8] = {bflo(w.x), bfhi(w.x), bflo(w.y), bfhi(w.y), bflo(w.z), bfhi(w.z), bflo(w.w), bfhi(w.w)};
        float s = 0.f;
#pragma unroll
        for (int e = 0; e < 8; ++e) s += x[e] * x[e];
        const float rstd = 1.f / sqrtf(wave_sum(s) * (1.f / 512.f) + EPS);
        const f32x4 g0 = *(const f32x4*)g, g1 = *(const f32x4*)(g + 4);
        u32x4 o; o.x = cvt_pk_bf16(x[0] * rstd * g0.x, x[1] * rstd * g0.y); o.y = cvt_pk_bf16(x[2] * rstd * g0.z, x[3] * rstd * g0.w);
        o.z = cvt_pk_bf16(x[4] * rstd * g1.x, x[5] * rstd * g1.y); o.w = cvt_pk_bf16(x[6] * rstd * g1.z, x[7] * rstd * g1.w);
        *p = o;
    }
    { bf16* p = row + 1024 + lane; const float x = bf2f(*p); const float y = other_half(x, lane < 32); const int f = lane & 31;
      const float c = cosm[pos * 32 + f], s = sinm[pos * 32 + f];
      const float r = (lane < 32) ? (x * c - y * s) : (x * c + y * s);
      *p = (bf16)(cvt_pk_bf16(r, 0.f) & 0xffffu); }
    const int prow = pos >> 6, pcol = pos & 63;
    const int e0 = 2 * lane, f0 = e0 & 31; const int tp = (e0 < 64) ? prow : pcol;
    const float c0 = cosm[tp * 32 + f0], s0 = sinm[tp * 32 + f0], c1 = cosm[tp * 32 + f0 + 1], s1 = sinm[tp * 32 + f0 + 1];
    const bool first = ((e0 & 32) == 0);
#pragma unroll 2
    for (int h = 0; h < 10; ++h) {
        unsigned* p = (unsigned*)(row + (h < 8 ? 1088 + h * 128 : 2112 + (h - 8) * 128)) + lane; const unsigned w = *p; const float* g = (h < 8 ? gqn : gkn) + e0;
        float x0 = bflo(w), x1 = bfhi(w);
        const float rstd = 1.f / sqrtf(wave_sum(x0 * x0 + x1 * x1) * (1.f / 128.f) + EPS);
        x0 = x0 * rstd * g[0]; x1 = x1 * rstd * g[1];
        const float y0 = swz_xor<16>(x0), y1 = swz_xor<16>(x1);
        const float r0 = first ? (x0 * c0 - y0 * s0) : (x0 * c0 + y0 * s0);
        const float r1 = first ? (x1 * c1 - y1 * s1) : (x1 * c1 + y1 * s1);
        *p = cvt_pk_bf16(r0, r1);
    }
}
__device__ __forceinline__ void even_row_fix_k(bf16* row, int pos, const float* gkn, const float* tab_mla, int lane) {
    const float* cosm = tab_mla; const float* sinm = tab_mla + 4096 * 32;
    { bf16* p = row + 1024 + lane; const float x = bf2f(*p); const float y = other_half(x, lane < 32); const int f = lane & 31;
      const float c = cosm[pos * 32 + f], s = sinm[pos * 32 + f];
      const float r = (lane < 32) ? (x * c - y * s) : (x * c + y * s);
      *p = (bf16)(cvt_pk_bf16(r, 0.f) & 0xffffu); }
    const int prow = pos >> 6, pcol = pos & 63;
    const int e0 = 2 * lane, f0 = e0 & 31; const int tp = (e0 < 64) ? prow : pcol;
    const float c0 = cosm[tp * 32 + f0], s0 = sinm[tp * 32 + f0], c1 = cosm[tp * 32 + f0 + 1], s1 = sinm[tp * 32 + f0 + 1];
    const bool first = ((e0 & 32) == 0);
#pragma unroll
    for (int h = 0; h < 2; ++h) {
        unsigned* p = (unsigned*)(row + 2112 + h * 128) + lane; const unsigned w = *p; const float* g = gkn + e0;
        float x0 = bflo(w), x1 = bfhi(w);
        const float rstd = 1.f / sqrtf(wave_sum(x0 * x0 + x1 * x1) * (1.f / 128.f) + EPS);
        x0 = x0 * rstd * g[0]; x1 = x1 * rstd * g[1];
        const float y0 = swz_xor<16>(x0), y1 = swz_xor<16>(x1);
        const float r0 = first ? (x0 * c0 - y0 * s0) : (x0 * c0 + y0 * s0);
        const float r1 = first ? (x1 * c1 - y1 * s1) : (x1 * c1 + y1 * s1);
        *p = cvt_pk_bf16(r0, r1);
    }
}
template <int R>
__device__ __forceinline__ void even_rows_fix_k(bf16* proj, int m0, int mstep, const float* gkn, const float* tab_mla, int lane) {
    const float* cosm = tab_mla; const float* sinm = tab_mla + 4096 * 32;
    const int f = lane & 31, e0 = 2 * lane, f0 = e0 & 31; const bool first = ((e0 & 32) == 0);
    const float g0 = gkn[e0], g1 = gkn[e0 + 1];
    unsigned short kx[R]; unsigned w0[R], w1[R]; float kc[R], ks[R], c0[R], s0[R], c1[R], s1[R];
#pragma unroll
    for (int i = 0; i < R; ++i) { const int m = m0 + i * mstep, pos = m & (SEQ - 1); bf16* row = proj + (size_t)m * AB_PAD;
        kx[i] = *(row + 1024 + lane); kc[i] = cosm[pos * 32 + f]; ks[i] = sinm[pos * 32 + f];
        const int tp = (e0 < 64) ? (pos >> 6) : (pos & 63);
        c0[i] = cosm[tp * 32 + f0]; s0[i] = sinm[tp * 32 + f0]; c1[i] = cosm[tp * 32 + f0 + 1]; s1[i] = sinm[tp * 32 + f0 + 1];
        w0[i] = *((const unsigned*)(row + 2112) + lane); w1[i] = *((const unsigned*)(row + 2112 + 128) + lane); }
#pragma unroll
    for (int i = 0; i < R; ++i) { const int m = m0 + i * mstep; bf16* row = proj + (size_t)m * AB_PAD;
        { const float x = bf2f(kx[i]); const float y = other_half(x, lane < 32);
          const float r = (lane < 32) ? (x * kc[i] - y * ks[i]) : (x * kc[i] + y * ks[i]);
          *(row + 1024 + lane) = (bf16)(cvt_pk_bf16(r, 0.f) & 0xffffu); }
#pragma unroll
        for (int h = 0; h < 2; ++h) { const unsigned w = h ? w1[i] : w0[i];
            float x0 = bflo(w), x1 = bfhi(w);
            const float rstd = 1.f / sqrtf(wave_sum(x0 * x0 + x1 * x1) * (1.f / 128.f) + EPS);
            x0 = x0 * rstd * g0; x1 = x1 * rstd * g1;
            const float y0 = swz_xor<16>(x0), y1 = swz_xor<16>(x1);
            const float r0 = first ? (x0 * c0[i] - y0 * s0[i]) : (x0 * c0[i] + y0 * s0[i]);
            const float r1 = first ? (x1 * c1[i] - y1 * s1[i]) : (x1 * c1[i] + y1 * s1[i]);
            *((unsigned*)(row + 2112 + h * 128) + lane) = cvt_pk_bf16(r0, r1); } }
}
__device__ __forceinline__ void mla_q_rope_row(bf16* row, int pos, const float* tab_mla, int lane) {
    const int h = lane >> 3, s4 = (lane & 7) * 4;
    u32x2* p1 = (u32x2*)(row + h * 192 + 128 + s4); u32x2* p2 = (u32x2*)(row + h * 192 + 160 + s4);
    const u32x2 w1 = *p1, w2 = *p2;
    const f32x4 c = *(const f32x4*)(tab_mla + pos * 32 + s4), s = *(const f32x4*)(tab_mla + 4096 * 32 + pos * 32 + s4);
    const float x1[4] = {bflo(w1.x), bfhi(w1.x), bflo(w1.y), bfhi(w1.y)}, x2[4] = {bflo(w2.x), bfhi(w2.x), bflo(w2.y), bfhi(w2.y)};
    float a[4], b[4];
#pragma unroll
    for (int e = 0; e < 4; ++e) { a[e] = x1[e] * c[e] - x2[e] * s[e]; b[e] = x2[e] * c[e] + x1[e] * s[e]; }
    u32x2 o1, o2; o1.x = cvt_pk_bf16(a[0], a[1]); o1.y = cvt_pk_bf16(a[2], a[3]); o2.x = cvt_pk_bf16(b[0], b[1]); o2.y = cvt_pk_bf16(b[2], b[3]);
    *p1 = o1; *p2 = o2;
}
__device__ __forceinline__ void rope1d_row(bf16* row, int pos, const float* tab_1d, int lane) {
    const int h = lane >> 3, s8 = (lane & 7) * 8;
    u32x4* p1 = (u32x4*)(row + h * 128 + s8); u32x4* p2 = (u32x4*)(row + h * 128 + 64 + s8);
    const u32x4 w1 = *p1, w2 = *p2;
    const float* ct = tab_1d + pos * 64 + s8; const float* st = tab_1d + 4096 * 64 + pos * 64 + s8;
    const f32x4 c0 = *(const f32x4*)ct, c1 = *(const f32x4*)(ct + 4), s0 = *(const f32x4*)st, s1 = *(const f32x4*)(st + 4);
    const float c[8] = {c0.x, c0.y, c0.z, c0.w, c1.x, c1.y, c1.z, c1.w}, s[8] = {s0.x, s0.y, s0.z, s0.w, s1.x, s1.y, s1.z, s1.w};
    const float x1[8] = {bflo(w1.x), bfhi(w1.x), bflo(w1.y), bfhi(w1.y), bflo(w1.z), bfhi(w1.z), bflo(w1.w), bfhi(w1.w)};
    const float x2[8] = {bflo(w2.x), bfhi(w2.x), bflo(w2.y), bfhi(w2.y), bflo(w2.z), bfhi(w2.z), bflo(w2.w), bfhi(w2.w)};
    float a[8], b[8];
#pragma unroll
    for (int e = 0; e < 8; ++e) { a[e] = x1[e] * c[e] - x2[e] * s[e]; b[e] = x2[e] * c[e] + x1[e] * s[e]; }
    u32x4 o1, o2; o1.x = cvt_pk_bf16(a[0], a[1]); o1.y = cvt_pk_bf16(a[2], a[3]); o1.z = cvt_pk_bf16(a[4], a[5]); o1.w = cvt_pk_bf16(a[6], a[7]);
    o2.x = cvt_pk_bf16(b[0], b[1]); o2.y = cvt_pk_bf16(b[2], b[3]); o2.z = cvt_pk_bf16(b[4], b[5]); o2.w = cvt_pk_bf16(b[6], b[7]);
    *p1 = o1; *p2 = o2;
}
__device__ __forceinline__ void rope1d_rows4(bf16* base, size_t ld, int m0, int mstep, const float* tab_1d, int lane) {
    const int h = lane >> 3, s8 = (lane & 7) * 8;
    u32x4 w1[4], w2[4]; f32x4 c0[4], c1[4], s0[4], s1[4];
#pragma unroll
    for (int i = 0; i < 4; ++i) { const int m = m0 + i * mstep, pos = m & (SEQ - 1); bf16* row = base + (size_t)m * ld;
        w1[i] = *(const u32x4*)(row + h * 128 + s8); w2[i] = *(const u32x4*)(row + h * 128 + 64 + s8);
        const float* ct = tab_1d + pos * 64 + s8; const float* st = tab_1d + 4096 * 64 + pos * 64 + s8;
        c0[i] = *(const f32x4*)ct; c1[i] = *(const f32x4*)(ct + 4); s0[i] = *(const f32x4*)st; s1[i] = *(const f32x4*)(st + 4); }
#pragma unroll
    for (int i = 0; i < 4; ++i) { const int m = m0 + i * mstep; bf16* row = base + (size_t)m * ld;
        const float c[8] = {c0[i].x, c0[i].y, c0[i].z, c0[i].w, c1[i].x, c1[i].y, c1[i].z, c1[i].w}, s[8] = {s0[i].x, s0[i].y, s0[i].z, s0[i].w, s1[i].x, s1[i].y, s1[i].z, s1[i].w};
        const float x1[8] = {bflo(w1[i].x), bfhi(w1[i].x), bflo(w1[i].y), bfhi(w1[i].y), bflo(w1[i].z), bfhi(w1[i].z), bflo(w1[i].w), bfhi(w1[i].w)};
        const float x2[8] = {bflo(w2[i].x), bfhi(w2[i].x), bflo(w2[i].y), bfhi(w2[i].y), bflo(w2[i].z), bfhi(w2[i].z), bflo(w2[i].w), bfhi(w2[i].w)};
        float a[8], b[8];
#pragma unroll
        for (int e = 0; e < 8; ++e) { a[e] = x1[e] * c[e] - x2[e] * s[e]; b[e] = x2[e] * c[e] + x1[e] * s[e]; }
        u32x4 o1, o2; o1.x = cvt_pk_bf16(a[0], a[1]); o1.y = cvt_pk_bf16(a[2], a[3]); o1.z = cvt_pk_bf16(a[4], a[5]); o1.w = cvt_pk_bf16(a[6], a[7]);
        o2.x = cvt_pk_bf16(b[0], b[1]); o2.y = cvt_pk_bf16(b[2], b[3]); o2.z = cvt_pk_bf16(b[4], b[5]); o2.w = cvt_pk_bf16(b[6], b[7]);
        *(u32x4*)(row + h * 128 + s8) = o1; *(u32x4*)(row + h * 128 + 64 + s8) = o2; }
}
__device__ __forceinline__ void diff_combine_row(const bf16* oc, bf16* out, float lam, float post, const float* subln, int lane) {
    const f32x4 g = *(const f32x4*)(subln + lane * 4);
#pragma unroll
    for (int h = 0; h < 4; ++h) {
        const u32x2 w0 = *((const u32x2*)(oc + h * 512) + lane), w1 = *((const u32x2*)(oc + h * 512 + 256) + lane);
        float d[4] = {bflo(w0.x) - lam * bflo(w1.x), bfhi(w0.x) - lam * bfhi(w1.x), bflo(w0.y) - lam * bflo(w1.y), bfhi(w0.y) - lam * bfhi(w1.y)};
        const float rstd = 1.f / sqrtf(wave_sum((d[0] * d[0] + d[1] * d[1]) + (d[2] * d[2] + d[3] * d[3])) * (1.f / 256.f) + EPS);
        u32x2 o; o.x = cvt_pk_bf16(d[0] * rstd * g.x * post, d[1] * rstd * g.y * post); o.y = cvt_pk_bf16(d[2] * rstd * g.z * post, d[3] * rstd * g.w * post);
        *((u32x2*)(out + h * 256) + lane) = o;
    }
}
template <int R>
__device__ __forceinline__ void diff_combine_rows(const bf16* ocb, bf16* outb, size_t ldo, int m0, int mstep, float lam, float post, const float* subln, int lane) {
    const f32x4 g = *(const f32x4*)(subln + lane * 4);
    u32x2 w0[R][4], w1[R][4];
#pragma unroll
    for (int i = 0; i < R; ++i) { const bf16* oc = ocb + (size_t)(m0 + i * mstep) * 2048;
#pragma unroll
        for (int h = 0; h < 4; ++h) { w0[i][h] = *((const u32x2*)(oc + h * 512) + lane); w1[i][h] = *((const u32x2*)(oc + h * 512 + 256) + lane); } }
#pragma unroll
    for (int i = 0; i < R; ++i) { bf16* out = outb + (size_t)(m0 + i * mstep) * ldo;
#pragma unroll
        for (int h = 0; h < 4; ++h) { const u32x2 a = w0[i][h], b = w1[i][h];
            float d[4] = {bflo(a.x) - lam * bflo(b.x), bfhi(a.x) - lam * bfhi(b.x), bflo(a.y) - lam * bflo(b.y), bfhi(a.y) - lam * bfhi(b.y)};
            const float rstd = 1.f / sqrtf(wave_sum((d[0] * d[0] + d[1] * d[1]) + (d[2] * d[2] + d[3] * d[3])) * (1.f / 256.f) + EPS);
            u32x2 o; o.x = cvt_pk_bf16(d[0] * rstd * g.x * post, d[1] * rstd * g.y * post); o.y = cvt_pk_bf16(d[2] * rstd * g.z * post, d[3] * rstd * g.w * post);
            *((u32x2*)(out + h * 256) + lane) = o; } }
}
__device__ __forceinline__ void sincos_d(double a, double& sn, double& cs) {
    const double k = __builtin_rint(a * 0.15915494309189533577);
    const double r = __builtin_fma(-k, 6.283185307179586476925, a) - k * 2.4492935982947064e-16 * 0.0;
    const double r2 = r * r;
    double s = -1.0 / 51090942171709440000.0;
    s = s * r2 + 1.0 / 121645100408832000.0; s = s * r2 - 1.0 / 355687428096000.0; s = s * r2 + 1.0 / 1307674368000.0; s = s * r2 - 1.0 / 6227020800.0;
    s = s * r2 + 1.0 / 39916800.0; s = s * r2 - 1.0 / 362880.0; s = s * r2 + 1.0 / 5040.0; s = s * r2 - 1.0 / 120.0; s = s * r2 + 1.0 / 6.0; s = s * r2 - 1.0;
    sn = -s * r;
    double c = 1.0 / 1124000727777607680000.0;
    c = c * r2 - 1.0 / 2432902008176640000.0; c = c * r2 + 1.0 / 6402373705728000.0; c = c * r2 - 1.0 / 20922789888000.0; c = c * r2 + 1.0 / 87178291200.0;
    c = c * r2 - 1.0 / 479001600.0; c = c * r2 + 1.0 / 3628800.0; c = c * r2 - 1.0 / 40320.0; c = c * r2 + 1.0 / 720.0; c = c * r2 - 1.0 / 24.0; c = c * r2 + 0.5; c = c * r2 - 1.0;
    cs = -c;
}

__device__ __forceinline__ void* ld_ptr(LAS unsigned long long* P, int i) {
    const unsigned long long v = P[i];
    const unsigned lo = __builtin_amdgcn_readfirstlane((unsigned)v), hi = __builtin_amdgcn_readfirstlane((unsigned)(v >> 32));
    return (void*)(GAS void*)(uintptr_t)(((unsigned long long)hi << 32) | lo);
}
struct Args { const float* in[27]; float* out; unsigned char* ws; int ph_lo, ph_hi; };
enum { I_XP = 0, I_XS, I_MP, I_MS, I_NORM_MIX, I_W_IN_AB, I_MLA_QN, I_W_QB, I_MLA_KVN, I_W_KVB, I_GQA_QN, I_GQA_KN, I_W_OUT_AB, I_W_IN_CD, I_RPB, I_DLAM, I_SUBLN, I_W_OUT_CD,
       I_NORM_XA, I_NORM_MEM, I_W_XQ, I_W_XKV, I_W_XO, I_NORM_MLP, I_W_UP, I_W_DOWN, I_FINAL };

__global__ void __launch_bounds__(512, 2) fwd(Args args) {
    extern __shared__ __attribute__((aligned(16))) unsigned char lds_raw[];
    LAS unsigned char* lds = (LAS unsigned char*)lds_raw;
    volatile LAS unsigned* MISC = (volatile LAS unsigned*)(lds + MISC_OFF);
    const int tid0 = threadIdx.x, wave = __builtin_amdgcn_readfirstlane(tid0 >> 6);
    const int G = gridDim.x; const int bx = blockIdx.x; const int vcu = (G % 8 == 0) ? (bx % 8) * (G / 8) + bx / 8 : bx;
    const int gw = vcu * 8 + wave, NGW = G * 8;
    for (int u = tid0; u < (LDS_BYTES - RING_BYTES) / 4; u += 512) ((LAS unsigned*)(lds + RING_BYTES))[u] = 0u;
    __syncthreads();
    LAS unsigned long long* PTRS = (LAS unsigned long long*)(lds + PTR_OFF);
    if (tid0 == 0) {
#pragma unroll
        for (int i = 0; i < 27; ++i) PTRS[i] = (unsigned long long)(uintptr_t)args.in[i];
        PTRS[27] = (unsigned long long)(uintptr_t)args.out; PTRS[28] = (unsigned long long)(uintptr_t)args.ws;
    }
    const int lo = args.ph_lo, hi = args.ph_hi; int ph = 0;
    __syncthreads();
#define INP(i) ((const float*)ld_ptr(PTRS, (i)))
#define WSP ((unsigned char*)ld_ptr(PTRS, 28))
#define XP ((float*)ld_ptr(PTRS, 27))
    XcdBarrier bar = xcd_barrier_post((unsigned*)(WSP + WS_CTL) + CW_BAR, MISC + 8, wave);
#ifndef PH_MASK
#define PH_MASK 0xffffffffu
#endif
#define PEN(k) (((PH_MASK) >> (k)) & 1u)
#ifndef PROBE_REP
#define PROBE_REP 0u
#endif
#define REPS(k) (1 + (int)(((PROBE_REP) >> (k)) & 1u))
#define PH_ON (ph >= lo && ph < hi)
#define PH_LANE const int lane = lane_id_fresh(), tid = wave * 64 + lane; (void)tid; (void)lane; int gw_s_ = gw; asm volatile("" : "+s"(gw_s_)); const int gw = gw_s_; (void)gw
#define PH_END do { if (ph >= lo && ph + 1 < hi) xcd_barrier(bar, wave); ++ph; } while (0)

#define X XP
#define H ((bf16*)(WSP + WS_H))
#define BIG (WSP + WS_BIG)
#define WB (WSP + WS_WB)
#define tab_mla ((float*)(WSP + WS_TAB_MLA))
#define tab_1d ((float*)(WSP + WS_TAB_1D))
#define MN ((bf16*)(WSP + WS_MN))
#define MKV ((bf16*)(WSP + WS_MKV))
#define HFIN H
#define PSQ(i) ((float*)(WSP + WS_PS + (size_t)(i) * PS_BYTES))
#define PSC(i) ((float*)(WSP + WS_PS + 3 * PS_BYTES + (size_t)(i) * PSC_BYTES))
#define XBH ((bf16*)XP)
#define XBA XBH
    LAS float* scr = (LAS float*)(lds + wave * TR_BYTES);

    if (PH_ON && PEN(0)) for (int rep_ = 0; rep_ < REPS(0); ++rep_) { PH_LANE;
        const int gt = vcu * 512 + tid, NT_ = G * 512;
        for (int i = gt; i < 4096 * 32; i += NT_) { const int pos = i >> 5, f = i & 31; double inv = 1.0; for (int k = 0; k < f; ++k) inv *= 0.7498942093324558273;
            const float ang = (float)pos * (float)inv; double sn, cs; sincos_d((double)ang, sn, cs); tab_mla[i] = (float)cs; tab_mla[4096 * 32 + i] = (float)sn; }
        for (int i = gt; i < 4096 * 64; i += NT_) { const int pos = i >> 6, f = i & 63; double inv = 1.0; for (int k = 0; k < f; ++k) inv *= 0.8659643233600653524;
            const float ang = (float)pos * (float)inv; double sn, cs; sincos_d((double)ang, sn, cs); tab_1d[i] = (float)cs; tab_1d[4096 * 64 + i] = (float)sn; }
        float* ss0 = PSQ(0);
        int m = gw;
        for (; m + NGW < T; m += 2 * NGW) { const int m1 = m + NGW;
            const float* src0 = (m < T_PROMPT) ? INP(I_XP) + (size_t)m * DM : INP(I_XS) + (size_t)(m - T_PROMPT) * DM;
            const float* src1 = (m1 < T_PROMPT) ? INP(I_XP) + (size_t)m1 * DM : INP(I_XS) + (size_t)(m1 - T_PROMPT) * DM;
            init_rows2_2048(src0, src1, XBH + (size_t)m * DM, XBH + (size_t)m1 * DM, ss0 + (size_t)m * 32, ss0 + (size_t)m1 * 32, lane); }
        for (; m < T; m += NGW) { const float* src = (m < T_PROMPT) ? INP(I_XP) + (size_t)m * DM : INP(I_XS) + (size_t)(m - T_PROMPT) * DM;
            init_row_2048(src, XBH + (size_t)m * DM, ss0 + (size_t)m * 32, lane); }
    }

    for (int layer = 0; layer < DEPTH; ++layer) {
        const int j = layer >> 1; const bool even = (layer & 1) == 0;
#define W_IN ((bf16*)(WB + WB_IN))
#define W_QB ((bf16*)(WB + WB_QB))
#define W_KVB ((bf16*)(WB + WB_KVB))
#define W_OUT ((bf16*)(WB + WB_OUT))
#define W_XQ ((bf16*)(WB + WB_XQ))
#define W_XKV ((bf16*)(WB + WB_XKV))
#define W_XO ((bf16*)(WB + WB_XO))
#define W_UP ((bf16*)(WB + WB_UP))
#define W_DOWN ((bf16*)(WB + WB_DOWN))

#define CONVERT_LATE do { __syncthreads(); { PH_LANE; \
            convert_matrix((even ? INP(I_W_OUT_AB) : INP(I_W_OUT_CD)) + (size_t)j * DM * DM, DM, DM, W_OUT, nullptr, scr, gw, NGW, lane); \
            convert_matrix(INP(I_W_XQ) + (size_t)layer * DM * 512, DM, 512, W_XQ, INP(I_NORM_XA) + layer * DM, scr, gw, NGW, lane); \
            convert_matrix(INP(I_W_XKV) + (size_t)layer * DM * 1024, DM, 1024, W_XKV, nullptr, scr, gw, NGW, lane); \
            convert_matrix(INP(I_W_XO) + (size_t)layer * 512 * DM, 512, DM, W_XO, nullptr, scr, gw, NGW, lane); \
            convert_matrix(INP(I_W_UP) + (size_t)layer * DM * DFF, DM, DFF, W_UP, INP(I_NORM_MLP) + layer * DM, scr, gw, NGW, lane); \
            convert_matrix(INP(I_W_DOWN) + (size_t)layer * DFF * DM, DFF, DM, W_DOWN, nullptr, scr, gw, NGW, lane); } __syncthreads(); } while (0)
#define CONV_SLOT (bx % ((NSEQ * 8 * 16 / G) < 6 ? ((NSEQ * 8 * 16 / G) < 1 ? 1 : (NSEQ * 8 * 16 / G)) : 6))
        if (PH_ON && PEN(1)) for (int rep_ = 0; rep_ < REPS(1); ++rep_) { PH_LANE;
            const float* gmix = INP(I_NORM_MIX) + layer * DM;
            if (even) {
                convert_matrix(INP(I_W_IN_AB) + (size_t)j * DM * AB_IN, DM, AB_IN, W_IN, gmix, scr, gw, NGW, lane);
                for (size_t i = (size_t)gw * 64 + lane; i < (size_t)(AB_PAD - AB_IN) * DM / 8; i += (size_t)NGW * 64) { u32x4 z = (u32x4){0u, 0u, 0u, 0u}; asm volatile("" : "+v"(z)); ((u32x4*)(W_IN + (size_t)AB_IN * DM))[i] = z; }
                convert_matrix(INP(I_W_QB) + (size_t)j * 512 * 1536, 512, 1536, W_QB, INP(I_MLA_QN) + j * 512, scr, gw, NGW, lane);
                convert_matrix(INP(I_W_KVB) + (size_t)j * 512 * 2048, 512, 2048, W_KVB, INP(I_MLA_KVN) + j * 512, scr, gw, NGW, lane);
            } else {
                convert_matrix(INP(I_W_IN_CD) + (size_t)j * DM * CD_IN, DM, CD_IN, W_IN, gmix, scr, gw, NGW, lane);
            }
            const float* gm = INP(I_NORM_MEM) + layer * DM;
            for (int r = gw; r < TM; r += NGW) { const float* src = (r < 8 * MEMLEN) ? INP(I_MP) + (size_t)r * DM : INP(I_MS) + (size_t)(r - 8 * MEMLEN) * DM;
                norm_row_2048(src, gm, MN + (size_t)r * DM, nullptr, lane); }
        }
        PH_END;

        if (even) {
            bf16* PROJ = (bf16*)(BIG + BIG_PROJ); bf16* Q = (bf16*)(BIG + BIG_Q); bf16* KV = (bf16*)(BIG + BIG_KV);
            if (PH_ON && PEN(2)) for (int rep_ = 0; rep_ < REPS(2); ++rep_) { PH_LANE;
                pg8::Gemm g{XBH, W_IN, T, AB_PAD, DM, DM, DM}; pg8::StaticOrder S; S.init(T, AB_PAD, G, bx, 3);
                pg8::EpiBf16<0, 32> E{PROJ, AB_PAD, 0, 0, PSQ(0), 1.f / 2048.f, PSC(0), PSC_BYTES / 4};
                pg8::gemm_phase(lds, g, S, E, wave);
            }
            PH_END;
            if (PH_ON && PEN(3)) for (int rep_ = 0; rep_ < REPS(3); ++rep_) { PH_LANE;
                const float* gkn = INP(I_GQA_KN) + j * 128;
                int m = gw;
                for (; m + 7 * NGW < T; m += 8 * NGW) even_rows_fix_k<8>(PROJ, m, NGW, gkn, tab_mla, lane);
                for (; m < T; m += NGW) even_row_fix_k(PROJ + (size_t)m * AB_PAD, m & (SEQ - 1), gkn, tab_mla, lane);
            }
            if (PH_ON && PEN(4)) for (int rep_ = 0; rep_ < REPS(4); ++rep_) { PH_LANE;
#pragma unroll 1
                for (int gi = 0; gi < 2; ++gi) {
                    pg8::Gemm g{PROJ + (gi ? 512 : 0), gi ? W_KVB : W_QB, T, gi ? 2048 : 1536, 512, AB_PAD, 512}; pg8::StaticOrder S; S.init(T, g.N, G, bx, 4);
                    pg8::EpiBf16<0, 8> E{gi ? KV : Q, g.N, 0, 0, PSC(gi), 1.f / 512.f, nullptr, 0};
                    pg8::gemm_phase(lds, g, S, E, wave);
                }
            }
            PH_END;
            if (PH_ON) {
                for (int rep_ = 0; rep_ < REPS(6); ++rep_)
                for (int u = vcu, it_ = 0; u < NSEQ * 8 * 16; u += G, ++it_) { const int qb = u & 15, h = (u >> 4) & 7, b = u >> 7; const size_t t0 = (size_t)b * SEQ;
                    att::dense_unit<192, 1, 1>(Q + (t0 + qb * 256) * 1536 + h * 192, 1536, KV + t0 * 2048 + h * 256, 2048, PROJ + t0 * AB_PAD + 1024, AB_PAD,
                                         KV + t0 * 2048 + h * 256 + 128, 2048, H + (t0 + qb * 256) * DM + h * 128, DM, SEQ, (LAS char*)lds, wave, qb * 256, tab_mla, nullptr);
                    if (rep_ == 0 && it_ == CONV_SLOT) CONVERT_LATE; }
                for (int rep_ = 0; rep_ < REPS(21); ++rep_)
                for (int u = vcu; u < NSEQ * 8 * 16; u += G) { const int qb = u & 15, h = (u >> 4) & 7, b = u >> 7; const size_t t0 = (size_t)b * SEQ; const int kvh = h >> 2;
                    att::dense_unit3<3>(PROJ + (t0 + qb * 256) * AB_PAD + 1088 + h * 128, AB_PAD, PROJ + t0 * AB_PAD + 2112 + kvh * 128, AB_PAD,
                                         PROJ + t0 * AB_PAD + 2368 + kvh * 128, AB_PAD, H + (t0 + qb * 256) * DM + 1024 + h * 128, DM, SEQ, (LAS char*)lds, wave, qb * 256, tab_mla, INP(I_GQA_QN) + j * 128); }
            }
            PH_END;
        } else {
            bf16* NQ = (bf16*)(BIG + 0 * BIG_SPLIT); bf16* NK = (bf16*)(BIG + 1 * BIG_SPLIT); bf16* NV = (bf16*)(BIG + 2 * BIG_SPLIT);
            bf16* DQ = (bf16*)(BIG + 3 * BIG_SPLIT); bf16* DK = (bf16*)(BIG + 4 * BIG_SPLIT); bf16* DV = (bf16*)(BIG + 5 * BIG_SPLIT); bf16* OC = NQ;
            if (PH_ON && PEN(7)) for (int rep_ = 0; rep_ < REPS(7); ++rep_) { PH_LANE;
                pg8::Gemm g{XBH, W_IN, T, CD_IN, DM, DM, DM}; pg8::StaticOrder S; S.init(T, CD_IN, G, bx, 4);
                pg8::EpiBf16<0, 32> E{NQ, 1024, 1024, BIG_SPLIT / 2, PSQ(0), 1.f / 2048.f, nullptr, 0};
                pg8::gemm_phase(lds, g, S, E, wave);
            }
            PH_END;
            if (PH_ON && PEN(9)) for (int rep_ = 0; rep_ < REPS(9); ++rep_) { PH_LANE;
                const float* rpb = INP(I_RPB) + (size_t)j * 8 * 465;
                const int nslot = (NSEQ * 8 * 16 / G) < 6 ? ((NSEQ * 8 * 16 / G) < 1 ? 1 : (NSEQ * 8 * 16 / G)) : 6;
                for (int u = vcu, it_ = 0; u < NSEQ * 8 * 16; u += G, ++it_) { const int qb = u & 15, h = (u >> 4) & 7, b = u >> 7; const size_t t0 = (size_t)b * SEQ;
                    att::na_unit2(NQ + (t0 + qb * 256) * 1024 + h * 128, 1024, NK + t0 * 1024 + h * 128, NV + t0 * 1024 + h * 128, 1024,
                                 H + (t0 + qb * 256) * DM + h * 128, DM, qb * 4, rpb + h * 465, (LAS char*)lds, wave);
                    if (rep_ == 0 && PEN(8) && it_ == bx % nslot) {
                        int m = gw;
                        for (; m + 3 * NGW < T; m += 4 * NGW) rope1d_rows4(DK, 1024, m, NGW, tab_1d, lane);
                        for (; m < T; m += NGW) rope1d_row(DK + (size_t)m * 1024, m & (SEQ - 1), tab_1d, lane);
                    } }
            }
            PH_END;
            if (PH_ON && PEN(10)) for (int rep_ = 0; rep_ < REPS(10); ++rep_) { PH_LANE;
                const float* lp = INP(I_DLAM) + j * 512;
                const float a0 = lp[lane] * lp[128 + lane] + lp[64 + lane] * lp[128 + 64 + lane], a1 = lp[256 + lane] * lp[384 + lane] + lp[256 + 64 + lane] * lp[384 + 64 + lane];
                const float lam_init = (layer == 1) ? 0.35550906759096934f : 0.5560582041556406f;
                const float lam = expf(wave_sum(a0)) - expf(wave_sum(a1)) + lam_init;
                const float* subln = INP(I_SUBLN) + j * 256;
                const int npair = NSEQ * 4 * 16, nps = (npair / G) < 3 ? ((npair / G) < 1 ? 1 : (npair / G)) : 3;
                for (int p = vcu, it_ = 0; p < npair; p += G, ++it_) { const int qb = p & 15, h = (p >> 4) & 3, b = p >> 6; const size_t t0 = (size_t)b * SEQ;
                    bf16* oc0 = OC + (t0 + qb * 256) * 2048 + h * 512;
                    att::DiffFuse df{oc0, H + (t0 + qb * 256) * DM + 1024 + h * 256, DM, lam, 1.f - lam_init, subln};
                    att::dense_unit_dv256<0>(DQ + (t0 + qb * 256) * 1024 + (2 * h) * 128, 1024, DK + t0 * 1024 + (2 * h) * 128, 1024, DV + t0 * 1024 + h * 256, 1024,
                                             oc0, 2048, SEQ, (LAS char*)lds, wave, qb * 256, tab_1d, df);
                    att::dense_unit_dv256<1>(DQ + (t0 + qb * 256) * 1024 + (2 * h + 1) * 128, 1024, DK + t0 * 1024 + (2 * h + 1) * 128, 1024, DV + t0 * 1024 + h * 256, 1024,
                                             oc0, 2048, SEQ, (LAS char*)lds, wave, qb * 256, tab_1d, df);
                    if (rep_ == 0 && it_ == bx % nps) CONVERT_LATE; }
            }
            PH_END;
        }
        if (PH_ON && PEN(12)) for (int rep_ = 0; rep_ < REPS(12); ++rep_) { PH_LANE;
            pg8::Gemm g{H, W_OUT, T, DM, DM, DM, DM}; pg8::StaticOrder S; S.init(T, DM, G, bx, 4);
            pg8::EpiResidX E{XBH, XBH, PSQ(1), DM, (rep_ == REPS(12) - 1) ? 1.f : 0.f};
            pg8::gemm_phase(lds, g, S, E, wave, ((bx >> 3) & 7) * SKEW_TICKS);
        }
        PH_END;
        {
            bf16* XQ = (bf16*)(BIG + BIG_XQ); bf16* XO = (bf16*)(BIG + BIG_XO);
            if (PH_ON && PEN(14)) for (int rep_ = 0; rep_ < REPS(14); ++rep_) { PH_LANE;
#pragma unroll 1
                for (int gi = 0; gi < 2; ++gi) {
                    pg8::Gemm g{gi ? MN : XBA, gi ? W_XKV : W_XQ, gi ? TM : T, gi ? 1024 : 512, DM, DM, DM}; pg8::StaticOrder S; S.init(g.M, g.N, G, gi ? (bx + (G >> 1)) % G : bx);
                    pg8::EpiBf16<0, 32> E{gi ? MKV : XQ, g.N, 0, 0, PSQ(1), 1.f / 2048.f, nullptr, 0, gi};
                    pg8::gemm_phase(lds, g, S, E, wave);
                }
            }
            PH_END;
            if (PH_ON && PEN(15)) for (int rep_ = 0; rep_ < REPS(15); ++rep_) { PH_LANE;
                for (int u = vcu; u < NSEQ * 4 * 16; u += G) { const int qb = u & 15, h = (u >> 4) & 3, b = u >> 6; const size_t t0 = (size_t)b * SEQ;
                    att::dense_unit3<0>(XQ + (t0 + qb * 256) * 512 + h * 128, 512, MKV + (size_t)b * MEMLEN * 1024 + h * 128, 1024,
                                         MKV + (size_t)b * MEMLEN * 1024 + 512 + h * 128, 1024, XO + (t0 + qb * 256) * 512 + h * 128, 512, MEMLEN, (LAS char*)lds, wave, 0, nullptr, nullptr); }
            }
            PH_END;
            if (PH_ON && PEN(16)) for (int rep_ = 0; rep_ < REPS(16); ++rep_) { PH_LANE;
                pg8::Gemm g{XO, W_XO, T, DM, 512, 512, 512}; pg8::StaticOrder S; S.init(T, DM, G, bx, 4);
                pg8::EpiResidX E{XBH, XBH, PSQ(2), DM, (rep_ == REPS(16) - 1) ? 1.f : 0.f};
                pg8::gemm_phase(lds, g, S, E, wave, ((bx >> 3) & 7) * SKEW_TICKS);
            }
            PH_END;
        }
        {
#pragma unroll 1
            for (int ch = -1; ch < N_MLP_CHUNKS; ++ch) {
                if (PH_ON && PEN(19)) for (int rep_ = 0; rep_ < REPS(19); ++rep_) { PH_LANE;
                    if (ch >= 0) {
                        pg8::Gemm g{(bf16*)(BIG + (size_t)(ch & 1) * U_BYTES), W_DOWN, MLP_CHUNK, DM, DFF, DFF, DFF}; pg8::StaticOrder S; S.init(MLP_CHUNK, DM, G, bx, 4);
                        const size_t co = (size_t)ch * MLP_CHUNK * DM; const bool lastl = (layer == DEPTH - 1);
                        pg8::EpiResidX E{XBH + co, (lastl ? HFIN : XBH) + co, PSQ(0) + (size_t)ch * MLP_CHUNK * 32, DM, (rep_ == REPS(19) - 1) ? 1.f : 0.f};
                        pg8::gemm_phase(lds, g, S, E, wave);
                    }
                    if (ch + 1 < N_MLP_CHUNKS) { const int cn = ch + 1;
                        pg8::Gemm g{XBA + (size_t)cn * MLP_CHUNK * DM, W_UP, MLP_CHUNK, DFF, DM, DM, DM}; pg8::StaticOrder S; S.init(MLP_CHUNK, DFF, G, bx, 8);
                        pg8::EpiBf16<2, 32> E{(bf16*)(BIG + (size_t)(cn & 1) * U_BYTES), DFF, 0, 0, PSQ(2) + (size_t)cn * MLP_CHUNK * 32, 1.f / 2048.f, nullptr, 0};
                        pg8::gemm_phase(lds, g, S, E, wave);
                    }
                }
                PH_END;
            }
        }
    }
    if (PH_ON && PEN(20)) for (int rep_ = 0; rep_ < REPS(20); ++rep_) { PH_LANE; const float* g = INP(I_FINAL); const float* ssf = PSQ(0);
        f32x4 gg[8];
#pragma unroll
        for (int jj = 0; jj < 8; ++jj) gg[jj] = ((const f32x4*)g + lane)[64 * jj];
        int m = gw;
        for (; m + 3 * NGW < T; m += 4 * NGW) final_norm_rows<4>(HFIN, X, gg, ssf, m, NGW, lane);
        for (; m < T; m += NGW) final_norm_row(HFIN + (size_t)m * DM, X + (size_t)m * DM, g, wave_sum(lane < 32 ? ssf[(size_t)m * 32 + lane] : 0.f), lane); }
#undef PH_ON
#undef PH_END
}

extern "C" void kernel_launch(void* const* d_in, const int* in_sizes, int n_in, void* d_out, int out_size, void* d_ws, size_t ws_size, hipStream_t stream) {
    static int grid = 0;
    if (grid == 0) {
        if (n_in != 27 || out_size != T * DM || ws_size < WS_END) { fprintf(stderr, "kernel_launch: shape mismatch: n_in %d out %d ws %zu (need %zu)\n", n_in, out_size, ws_size, (size_t)WS_END); grid = -1; return; }
        int dev = 0, cus = 0, per_cu = 0;
        if (hipGetDevice(&dev) != hipSuccess || hipDeviceGetAttribute(&cus, hipDeviceAttributeMultiprocessorCount, dev) != hipSuccess) { grid = -1; return; }
        if (hipFuncSetAttribute((const void*)fwd, hipFuncAttributeMaxDynamicSharedMemorySize, LDS_BYTES) != hipSuccess) { fprintf(stderr, "kernel_launch: hipFuncSetAttribute failed\n"); grid = -1; return; }
        if (hipOccupancyMaxActiveBlocksPerMultiprocessor(&per_cu, (const void*)fwd, 512, LDS_BYTES) != hipSuccess || per_cu < 1) { fprintf(stderr, "kernel_launch: occupancy query says %d\n", per_cu); }
        (void)hipGetLastError();
        grid = cus;
    }
    if (grid < 0) return;
    if (hipMemsetAsync((char*)d_ws + WS_CTL, 0, CTL_ZERO_BYTES, stream) != hipSuccess) return;
    Args a{};
    for (int i = 0; i < 27; ++i) a.in[i] = (const float*)d_in[i];
    a.out = (float*)d_out; a.ws = (unsigned char*)d_ws; a.ph_lo = 0; a.ph_hi = 1 << 30;
    hipLaunchKernelGGL(fwd, dim3(grid), dim3(512), LDS_BYTES, stream, a);
    const hipError_t le = hipPeekAtLastError();
    if (le != hipSuccess) fprintf(stderr, "kernel_launch: launch failed: %s\n", hipGetErrorName(le));
}
```

```cpp
#include <hip/hip_runtime.h>
#include <cstdio>
#include <cstdint>

#define LAS __attribute__((address_space(3)))
#define GAS __attribute__((address_space(1)))
typedef unsigned short bf16;
typedef short bf16x8 __attribute__((ext_vector_type(8)));
typedef short s16x4 __attribute__((ext_vector_type(4)));
typedef float f32x4 __attribute__((ext_vector_type(4)));
typedef float f32x2 __attribute__((ext_vector_type(2)));
typedef float f32x16 __attribute__((ext_vector_type(16)));
typedef unsigned u32x4 __attribute__((ext_vector_type(4)));
typedef unsigned u32x2 __attribute__((ext_vector_type(2)));

constexpr int DM = 2048, SEQ = 4096, NSEQ = 12, T = NSEQ * SEQ  , T_PROMPT = 8 * SEQ;
constexpr int DEPTH = 4, MEMLEN = 256, TM = NSEQ * MEMLEN  ;
constexpr int AB_IN = 2624, AB_PAD = 2816, CD_IN = 6144, DFF = 8192;
constexpr int MLP_CHUNK = 8192, N_MLP_CHUNKS = T / MLP_CHUNK;
constexpr size_t U_BYTES = (size_t)MLP_CHUNK * DFF * 2;
constexpr float EPS = 1e-6f;

__device__ __forceinline__ unsigned cvt_pk_bf16(float lo, float hi) { unsigned r; asm volatile("v_cvt_pk_bf16_f32 %0, %1, %2" : "=v"(r) : "v"(lo), "v"(hi)); return r; }
__device__ __forceinline__ float bf2f(unsigned short b) { return __builtin_bit_cast(float, ((unsigned)b) << 16); }
__device__ __forceinline__ float bflo(unsigned w) { return __builtin_bit_cast(float, w << 16); }
__device__ __forceinline__ float bfhi(unsigned w) { return __builtin_bit_cast(float, w & 0xffff0000u); }
__device__ __forceinline__ int lane_id_fresh() { int l; asm volatile("v_mbcnt_lo_u32_b32 %0, -1, 0\n\tv_mbcnt_hi_u32_b32 %0, -1, %0" : "=v"(l)); return l; }
template <int XOR> __device__ __forceinline__ float swz_xor(float v) { return __builtin_bit_cast(float, __builtin_amdgcn_ds_swizzle(__builtin_bit_cast(int, v), (XOR << 10) | 0x1f)); }
__device__ __forceinline__ float wave_sum(float v) {
    v += swz_xor<1>(v); v += swz_xor<2>(v); v += swz_xor<4>(v); v += swz_xor<8>(v); v += swz_xor<16>(v);
    auto rr = __builtin_amdgcn_permlane32_swap(__float_as_uint(v), __float_as_uint(v), false, false);
    return __uint_as_float(rr[0]) + __uint_as_float(rr[1]);
}
__device__ __forceinline__ float other_half(float v, bool lower) {
    auto rr = __builtin_amdgcn_permlane32_swap(__float_as_uint(v), __float_as_uint(v), false, false);
    return lower ? __uint_as_float(rr[1]) : __uint_as_float(rr[0]);
}

namespace pg8 {
constexpr int BM = 256, BK = 64, HALF = 128, HTB = HALF * BK * 2, STAGE_BYTES = 8 * HTB, NXCD = 8, WGM = 8;
__host__ __device__ __forceinline__ int lds_byte(int r, int c) { const int st = (r >> 4) * 2 + (c >> 5), rr = r & 15, cc = c & 31, ob = rr * 64 + cc * 2; return st * 1024 + (ob ^ (((ob >> 9) & 1) << 5)); }
__host__ __device__ __forceinline__ void stage_rc(int b, int& R, int& C) { const int st = b / 1024, sb = b % 1024, swz = sb ^ (((sb >> 9) & 1) << 5); R = (st >> 1) * 16 + swz / 64; C = (st & 1) * 32 + (swz % 64) / 2; }
__host__ __device__ __forceinline__ int perm32(int rho) { const int n = rho >> 4, i = rho & 15; return 8 * (i >> 2) + 4 * n + (i & 3); }

struct Unit { int pm, pn; };
struct Gemm { const bf16* A; const bf16* Bt; int M, N, K, lda, ldb; };

struct StaticOrder {
    int nM, nN, nwg, G, c, wgm;
    __device__ void init(int M, int N, int G_, int c_, int wgm_ = WGM) { nM = M / BM; nN = N / BM; nwg = nM * nN; G = G_; c = c_; wgm = wgm_; }
    __device__ bool next(int i, Unit& u) const {
        const long L = (long)i * G + c; if (L >= nwg) return false;
        int wgid = (int)L; { const int q = nwg / NXCD, r = nwg % NXCD, xcd = wgid % NXCD, off = wgid / NXCD; wgid = (xcd < r ? xcd * (q + 1) : r * (q + 1) + (xcd - r) * q) + off; }
        const int nig = wgm * nN, gid = wgid / nig, fm = gid * wgm, gsz = (nM - fm) < wgm ? (nM - fm) : wgm;
        u.pm = fm + ((wgid % nig) % gsz); u.pn = (wgid % nig) / gsz; return true;
    }
};

template <int W> __device__ __forceinline__ float row_ss(const float* ps, int row, int fq) {
    float s;
    if constexpr (W == 32) { const f32x4 a = *(const f32x4*)(ps + (size_t)row * 32 + fq * 8), b = *(const f32x4*)(ps + (size_t)row * 32 + fq * 8 + 4); s = ((a.x + a.y) + (a.z + a.w)) + ((b.x + b.y) + (b.z + b.w)); }
    else { const f32x2 a = *(const f32x2*)(ps + (size_t)row * 8 + fq * 2); s = a.x + a.y; }
    s += swz_xor<16>(s); s += other_half(s, fq < 2); return s;
}
__device__ __forceinline__ void store_row_sums(const float (&s8)[8], float* slot0, int slots_per_row, int row0, int fq) {
#pragma unroll
    for (int k = 0; k < 2; ++k) {
        const float v = fq == 0 ? s8[4 * k] : (fq == 1 ? s8[4 * k + 1] : (fq == 2 ? s8[4 * k + 2] : s8[4 * k + 3]));
        slot0[(size_t)(row0 + k * HALF + fq * 16) * slots_per_row] = v; }
}
constexpr int RS_LDS_OFF = 135168 + 2048;
template <int ACT  , int RSW> struct EpiBf16 {
    static constexpr bool PERM = true;
    bf16* O; int ldc; int split_cols; size_t split_stride; const float* rs_in; float rs_inv_dim; float* ss_out; size_t ss_stride; int rs_off;
    struct RsPf { f32x4 a[2], b[2]; f32x2 c[2]; };
    __device__ __forceinline__ void rs_issue(RsPf& p, int pm, int wr, int wc, int fr, int fq) const {
#pragma unroll
        for (int ai = 0; ai < 2; ++ai) { const size_t row = (size_t)pm * BM + wr * 64 + fr + ai * HALF + wc * 16;
            if constexpr (RSW == 32) { const float* q = rs_in + row * 32 + fq * 8;
                asm volatile("global_load_dwordx4 %0, %2, off\n\tglobal_load_dwordx4 %1, %2, off offset:16" : "=&v"(p.a[ai]), "=&v"(p.b[ai]) : "v"(q) : "memory"); }
            else { const float* q = rs_in + row * 8 + fq * 2;
                asm volatile("global_load_dwordx2 %0, %1, off" : "=&v"(p.c[ai]) : "v"(q) : "memory"); } }
    }
    template <int NYOUNGER>
    __device__ __forceinline__ void rs_finish(RsPf p, LAS unsigned char* lds, int parity, int wr, int wc, int fr, int fq) const {
        static_assert(NYOUNGER == 8 || NYOUNGER == 16, "count");
        if constexpr (RSW == 32) {
            if constexpr (NYOUNGER == 16) asm volatile("s_waitcnt vmcnt(16)" : "+v"(p.a[0]), "+v"(p.b[0]), "+v"(p.a[1]), "+v"(p.b[1]) :: "memory");
            else asm volatile("s_waitcnt vmcnt(8)" : "+v"(p.a[0]), "+v"(p.b[0]), "+v"(p.a[1]), "+v"(p.b[1]) :: "memory");
        } else {
            if constexpr (NYOUNGER == 16) asm volatile("s_waitcnt vmcnt(16)" : "+v"(p.c[0]), "+v"(p.c[1]) :: "memory");
            else asm volatile("s_waitcnt vmcnt(8)" : "+v"(p.c[0]), "+v"(p.c[1]) :: "memory");
        }
        LAS float* rsl = (LAS float*)(lds + RS_LDS_OFF) + parity * 256;
#pragma unroll
        for (int ai = 0; ai < 2; ++ai) { float s;
            if constexpr (RSW == 32) s = ((p.a[ai].x + p.a[ai].y) + (p.a[ai].z + p.a[ai].w)) + ((p.b[ai].x + p.b[ai].y) + (p.b[ai].z + p.b[ai].w)); else s = p.c[ai].x + p.c[ai].y;
            s += swz_xor<16>(s); s += other_half(s, fq < 2);
            const float rs = 1.f / sqrtf(s * rs_inv_dim + EPS);
            if (fq == 0) rsl[wr * 64 + fr + ai * HALF + wc * 16] = rs; }
        asm volatile("s_waitcnt lgkmcnt(0)" ::: "memory");
    }
    __device__ __forceinline__ void operator()(const f32x4 (&acc)[2][2][4][2], const Unit& u, int wr, int wc, int fr, int fq, LAS unsigned char* lds, int parity, const Unit& nx, bool has_next) const {
        RsPf pf; rs_issue(pf, has_next ? nx.pm : u.pm, wr, wc, fr, fq);
        const LAS float* rsl = (const LAS float*)(lds + RS_LDS_OFF) + parity * 256 + wr * 64 + fr;
        const int row0 = u.pm * BM + wr * 64 + fr; int colt = u.pn * BM; bf16* base = O;
        if (split_cols) { const int t = colt / split_cols; base += (size_t)t * split_stride; colt -= t * split_cols; }
        const int col0 = colt + wc * 32 + 8 * fq;
        const bool do_ss = (ss_out != nullptr) && (u.pn < 4);
        float* ssp = do_ss ? ss_out + (size_t)(u.pn >> 1) * ss_stride + (u.pn & 1) * 4 + wc : nullptr;
        float s8[8] = {0.f, 0.f, 0.f, 0.f, 0.f, 0.f, 0.f, 0.f};
#pragma unroll
        for (int ai = 0; ai < 2; ++ai)
#pragma unroll
            for (int m = 0; m < 4; ++m) { const int row = row0 + ai * HALF + m * 16; bf16* rowp = base + (size_t)row * ldc + col0;
                float rs = rsl[ai * HALF + m * 16]; rs = rs_off ? 1.f : rs;
                float ss = 0.f;
#pragma unroll
                for (int bj = 0; bj < 2; ++bj) { f32x4 v0 = acc[ai][bj][m][0] * rs, v1 = acc[ai][bj][m][1] * rs;
                    if (ACT == 2) {
#pragma unroll
                        for (int j = 0; j < 4; ++j) { const float a = fmaxf(v0[j], 0.f), b = fmaxf(v1[j], 0.f); v0[j] = a * a; v1[j] = b * b; } }
                    u32x4 w; w.x = cvt_pk_bf16(v0[0], v0[1]); w.y = cvt_pk_bf16(v0[2], v0[3]); w.z = cvt_pk_bf16(v1[0], v1[1]); w.w = cvt_pk_bf16(v1[2], v1[3]);
                    *(u32x4*)(rowp + bj * HALF) = w;
                    if (do_ss) { const float a0 = bflo(w.x), a1 = bfhi(w.x), a2 = bflo(w.y), a3 = bfhi(w.y), a4 = bflo(w.z), a5 = bfhi(w.z), a6 = bflo(w.w), a7 = bfhi(w.w);
                        ss += (a0 * a0 + a1 * a1) + (a2 * a2 + a3 * a3) + (a4 * a4 + a5 * a5) + (a6 * a6 + a7 * a7); } }
                if (do_ss) { ss += swz_xor<16>(ss); ss += other_half(ss, fq < 2); s8[ai * 4 + m] = ss; } }
        if (do_ss) store_row_sums(s8, ssp, 8, row0, fq);
        rs_finish<16>(pf, lds, parity ^ 1, wr, wc, fr, fq);
    }
};
struct EpiResidX {
    static constexpr bool PERM = true;
    const bf16* XBin; bf16* XBout; float* ps; int ldc; float scale;
    struct RsPf {};
    __device__ __forceinline__ void rs_issue(RsPf&, int, int, int, int, int) const {}
    template <int NYOUNGER> __device__ __forceinline__ void rs_finish(const RsPf&, LAS unsigned char*, int, int, int, int, int) const {}
    __device__ __forceinline__ void operator()(const f32x4 (&acc)[2][2][4][2], const Unit& u, int wr, int wc, int fr, int fq, LAS unsigned char*, int, const Unit&, bool) const {
        const int row0 = u.pm * BM + wr * 64 + fr, col0 = u.pn * BM + wc * 32 + 8 * fq;
        float* psp = ps + u.pn * 4 + wc;
        float s8[8];
        u32x4 ch[2][4][2];
#pragma unroll
        for (int ai = 0; ai < 2; ++ai)
#pragma unroll
            for (int m = 0; m < 4; ++m) { const bf16* q = XBin + (size_t)(row0 + ai * HALF + m * 16) * ldc + col0;
                asm volatile("global_load_dwordx4 %0, %2, off\n\tglobal_load_dwordx4 %1, %2, off offset:256" : "=&v"(ch[ai][m][0]), "=&v"(ch[ai][m][1]) : "v"(q) : "memory"); }
        static_assert(HALF * 2 == 256, "the second load's immediate offset");
#pragma unroll
        for (int ai = 0; ai < 2; ++ai)
#pragma unroll
            for (int m = 0; m < 4; ++m) { const int row = row0 + ai * HALF + m * 16; const size_t off = (size_t)row * ldc + col0;
                float ss = 0.f;
                asm volatile("s_waitcnt vmcnt(14)" : "+v"(ch[ai][m][0]), "+v"(ch[ai][m][1]) :: "memory");
#pragma unroll
                for (int bj = 0; bj < 2; ++bj) { const u32x4 h4 = ch[ai][m][bj]; const f32x4 a0 = acc[ai][bj][m][0] * scale, a1 = acc[ai][bj][m][1] * scale;
                    u32x4 wh; wh.x = cvt_pk_bf16(bflo(h4.x) + a0[0], bfhi(h4.x) + a0[1]); wh.y = cvt_pk_bf16(bflo(h4.y) + a0[2], bfhi(h4.y) + a0[3]);
                    wh.z = cvt_pk_bf16(bflo(h4.z) + a1[0], bfhi(h4.z) + a1[1]); wh.w = cvt_pk_bf16(bflo(h4.w) + a1[2], bfhi(h4.w) + a1[3]);
                    *(u32x4*)(XBout + off + bj * HALF) = wh;
                    const float y0 = bflo(wh.x), y1 = bfhi(wh.x), y2 = bflo(wh.y), y3 = bfhi(wh.y), y4 = bflo(wh.z), y5 = bfhi(wh.z), y6 = bflo(wh.w), y7 = bfhi(wh.w);
                    ss += (y0 * y0 + y1 * y1) + (y2 * y2 + y3 * y3) + (y4 * y4 + y5 * y5) + (y6 * y6 + y7 * y7); }
                ss += swz_xor<16>(ss); ss += other_half(ss, fq < 2); s8[ai * 4 + m] = ss; }
        store_row_sums(s8, psp, 32, row0, fq);
    }
};

template <class Epi>
__device__ __forceinline__ void gemm_phase(LAS unsigned char* lds, const Gemm g, const StaticOrder& S, const Epi& E, int wid, int skew_ticks = 0) {
    if (skew_ticks > 0) {
        const unsigned long long t0 = __builtin_amdgcn_s_memrealtime();
        while (__builtin_amdgcn_s_memrealtime() - t0 < (unsigned long long)skew_ticks) __builtin_amdgcn_s_sleep(8);
    }
    const int lane = lane_id_fresh(), tid = wid * 64 + lane, wr = wid >> 2, wc = wid & 3, fr = lane & 15, fq = lane >> 4;
    const int K = g.K, nt = K / BK;
    unsigned voffA[2], voffB[2];
#pragma unroll
    for (int i = 0; i < 2; ++i) { int R, C; stage_rc(tid * 16 + i * 8192, R, C); const int Rb = Epi::PERM ? ((R & ~31) + perm32(R & 31)) : R;
        voffA[i] = (unsigned)(R * g.lda + C) * 2u; voffB[i] = (unsigned)(Rb * g.ldb + C) * 2u; }
    const size_t kstep = (size_t)(BK * 2);
    const size_t hstepA = (size_t)HALF * g.lda * 2, hstepB = (size_t)HALF * g.ldb * 2;
    const size_t tstepA = 2 * hstepA, tstepB = 2 * hstepB;
    const unsigned ldsw = (unsigned)wid * 1024u;
    const int aoff = lds_byte(wr * 64 + fr, fq * 8), boff = lds_byte(wc * 32 + fr, fq * 8);
#define PG8_SA(b, h) (((b) * 2 + (h)) * HTB)
#define PG8_SB(b, h) ((4 + (b) * 2 + (h)) * HTB)
#define PG8_STAGE(bufoff, gbase, voff) do { _Pragma("unroll") for (int _i = 0; _i < 2; ++_i) \
        __builtin_amdgcn_global_load_lds((const unsigned*)((const char*)(gbase) + (voff)[_i]), (LAS unsigned*)(lds + (bufoff) + ldsw + _i * 8192), 16, 0, 0); } while (0)
#define PG8_LDA(dst, b, h) do { _Pragma("unroll") for (int m = 0; m < 4; ++m) _Pragma("unroll") for (int k = 0; k < 2; ++k) dst[m][k] = *(const LAS bf16x8*)(lds + PG8_SA(b, h) + aoff + m * 2048 + k * 1024); } while (0)
#define PG8_LDB(dst, b, h) do { _Pragma("unroll") for (int n = 0; n < 2; ++n) _Pragma("unroll") for (int k = 0; k < 2; ++k) dst[n][k] = *(const LAS bf16x8*)(lds + PG8_SB(b, h) + boff + n * 2048 + k * 1024); } while (0)
#define PG8_MMA(ai, bj, At, Bt) do { __builtin_amdgcn_s_setprio(1); _Pragma("unroll") for (int m = 0; m < 4; ++m) _Pragma("unroll") for (int n = 0; n < 2; ++n) _Pragma("unroll") for (int k = 0; k < 2; ++k) \
        acc[ai][bj][m][n] = __builtin_amdgcn_mfma_f32_16x16x32_bf16(Bt[n][k], At[m][k], acc[ai][bj][m][n], 0, 0, 0); __builtin_amdgcn_s_setprio(0); } while (0)
#define PG8_WAIT_V(n) asm volatile("s_waitcnt vmcnt(" #n ")" ::: "memory")
#define PG8_WAIT_L(n) asm volatile("s_waitcnt lgkmcnt(" #n ")" ::: "memory")
#define PG8_BAR __builtin_amdgcn_s_barrier()
#define PG8_SCHED __builtin_amdgcn_sched_barrier(0)
    Unit cur, nxt; int ui = 0;
    if (!S.next(0, cur)) return;
    f32x4 acc[2][2][4][2];
#pragma unroll
    for (int a = 0; a < 2; ++a)
#pragma unroll
        for (int b = 0; b < 2; ++b)
#pragma unroll
            for (int m = 0; m < 4; ++m)
#pragma unroll
                for (int n = 0; n < 2; ++n) acc[a][b][m][n] = (f32x4){0.f, 0.f, 0.f, 0.f};
    bf16x8 At[4][2], B0[2][2], B1[2][2];
    const char* cA = (const char*)g.A + (size_t)cur.pm * tstepA; const char* cB = (const char*)g.Bt + (size_t)cur.pn * tstepB;
    typename Epi::RsPf pf0; E.rs_issue(pf0, cur.pm, wr, wc, fr, fq);
    PG8_STAGE(PG8_SB(0, 0), cB, voffB); PG8_STAGE(PG8_SB(0, 1), cB + hstepB, voffB); PG8_STAGE(PG8_SA(0, 0), cA, voffA); PG8_STAGE(PG8_SA(0, 1), cA + hstepA, voffA);
    if (wr == 1) PG8_BAR;
    PG8_WAIT_V(2); PG8_BAR;
    E.template rs_finish<8>(pf0, lds, 0, wr, wc, fr, fq);
    PG8_STAGE(PG8_SB(1, 0), cB + kstep, voffB); PG8_STAGE(PG8_SA(1, 0), cA + kstep, voffA); PG8_STAGE(PG8_SB(1, 1), cB + hstepB + kstep, voffB);
    PG8_WAIT_V(6); PG8_BAR;
    for (;;) {
        const bool has_next = S.next(ui + 1, nxt);
        const char* nA = has_next ? (const char*)g.A + (size_t)nxt.pm * tstepA : cA; const char* nB = has_next ? (const char*)g.Bt + (size_t)nxt.pn * tstepB : cB;
        for (int t = 0; t < nt; t += 2) {
            const bool last = (t == nt - 2);
            const char* a1 = cA + (size_t)(t + 1) * kstep;
            const char* a2 = last ? nA : cA + (size_t)(t + 2) * kstep; const char* b2 = last ? nB : cB + (size_t)(t + 2) * kstep;
            const char* a3 = a2 + kstep; const char* b3 = b2 + kstep;
            PG8_LDB(B0, 0, 0); PG8_LDB(B1, 0, 1); PG8_SCHED; PG8_LDA(At, 0, 0); PG8_STAGE(PG8_SA(1, 1), a1 + hstepA, voffA);
            PG8_WAIT_V(8); PG8_WAIT_L(0); PG8_BAR; PG8_MMA(0, 0, At, B0); PG8_MMA(0, 1, At, B1); PG8_BAR; PG8_SCHED;
            PG8_LDA(At, 0, 1); PG8_STAGE(PG8_SB(0, 0), b2, voffB); PG8_STAGE(PG8_SB(0, 1), b2 + hstepB, voffB); PG8_STAGE(PG8_SA(0, 0), a2, voffA);
            PG8_WAIT_V(8); PG8_WAIT_L(0); PG8_BAR; PG8_MMA(1, 0, At, B0); PG8_MMA(1, 1, At, B1); PG8_BAR; PG8_SCHED;
            PG8_LDB(B0, 1, 0); PG8_LDB(B1, 1, 1); PG8_SCHED; PG8_LDA(At, 1, 0); PG8_STAGE(PG8_SA(0, 1), a2 + hstepA, voffA);
            PG8_WAIT_V(8); PG8_WAIT_L(0); PG8_BAR; PG8_MMA(0, 0, At, B0); PG8_MMA(0, 1, At, B1); PG8_BAR; PG8_SCHED;
            PG8_LDA(At, 1, 1); PG8_STAGE(PG8_SB(1, 0), b3, voffB); PG8_STAGE(PG8_SB(1, 1), b3 + hstepB, voffB); PG8_STAGE(PG8_SA(1, 0), a3, voffA);
            PG8_WAIT_V(8); PG8_WAIT_L(0); PG8_BAR; PG8_MMA(1, 0, At, B0); PG8_MMA(1, 1, At, B1); PG8_BAR; PG8_SCHED;
        }
        if (wr == 0) PG8_BAR;
        E(acc, cur, wr, wc, fr, fq, lds, ui & 1, nxt, has_next);
        if (!has_next) break;
#pragma unroll
        for (int a = 0; a < 2; ++a)
#pragma unroll
            for (int b = 0; b < 2; ++b)
#pragma unroll
                for (int m = 0; m < 4; ++m)
#pragma unroll
                    for (int n = 0; n < 2; ++n) acc[a][b][m][n] = (f32x4){0.f, 0.f, 0.f, 0.f};
        cur = nxt; cA = nA; cB = nB; ++ui;
        if (wr == 1) PG8_BAR;
    }
    PG8_WAIT_V(0);
    PG8_BAR;
#undef PG8_SA
#undef PG8_SB
#undef PG8_STAGE
#undef PG8_LDA
#undef PG8_LDB
#undef PG8_MMA
#undef PG8_WAIT_V
#undef PG8_WAIT_L
#undef PG8_BAR
#undef PG8_SCHED
}
}

namespace att {
#define SBAR() __builtin_amdgcn_sched_barrier(0)
constexpr int SHM_V = 64 * 128 * 2;
__device__ __forceinline__ int crow(int r, int hi) { return (r & 3) + 8 * (r >> 2) + 4 * hi; }
template <int DQK> struct Cfg {
    static constexpr int KP = DQK * 2, SHM_K = 64 * KP, OFF_K = 2 * SHM_V, OFF_WS = OFF_K + 2 * SHM_K, NPARK = (DQK == 192 ? 6 : 0), NREG = DQK / 16 - NPARK, OFF_QS = OFF_WS + 8 * 256, TOTAL = OFF_QS + 8 * 1024 * NPARK;
    static constexpr float SCALE = (DQK == 192) ? 0.07216878364870322f : 0.08838834764831845f;
    static constexpr float C = SCALE * 1.4426950408889634f;
};
constexpr float THR = 8.f;

template <int DQK>
__device__ __forceinline__ void partialSM(f32x16& p0, f32x16& p1, float& m_reg, float& mn, float& alpha) {
    constexpr float C = Cfg<DQK>::C, SCALE = Cfg<DQK>::SCALE;
    float pmax = p0[0];
#pragma unroll
    for (int r = 1; r < 16; ++r) pmax = fmaxf(pmax, p0[r]);
#pragma unroll
    for (int r = 0; r < 16; ++r) pmax = fmaxf(pmax, p1[r]);
    { auto rr = __builtin_amdgcn_permlane32_swap(__float_as_uint(pmax), __float_as_uint(pmax), false, false);
      pmax = fmaxf(__uint_as_float(rr[0]), __uint_as_float(rr[1])); }
    if (__builtin_expect(__all(pmax - m_reg <= THR / SCALE), 1)) { mn = m_reg; alpha = 1.f; }
    else { mn = fmaxf(m_reg, pmax); alpha = __builtin_amdgcn_exp2f((m_reg - mn) * C); m_reg = mn; }
    const float mnC = -mn * C;
#pragma unroll
    for (int r = 0; r < 16; ++r) p0[r] = fmaf(p0[r], C, mnC);
#pragma unroll
    for (int r = 0; r < 16; ++r) p1[r] = fmaf(p1[r], C, mnC);
#pragma unroll
    for (int r = 0; r < 16; ++r) p0[r] = __builtin_amdgcn_exp2f(p0[r]);
}
__device__ __forceinline__ void finishSM(f32x16& p0, f32x16& p1, float alpha, float& l_reg, bf16x8& pa0, bf16x8& pa1, bf16x8& pa2, bf16x8& pa3) {
#pragma unroll
    for (int r = 0; r < 16; ++r) p1[r] = __builtin_amdgcn_exp2f(p1[r]);
    float ps = 0;
#pragma unroll
    for (int r = 0; r < 16; ++r) ps += p0[r];
#pragma unroll
    for (int r = 0; r < 16; ++r) ps += p1[r];
    { auto rr = __builtin_amdgcn_permlane32_swap(__float_as_uint(ps), __float_as_uint(ps), false, false);
      ps = __uint_as_float(rr[0]) + __uint_as_float(rr[1]); }
    l_reg = l_reg * alpha + ps;
#define PK4(P, BASE, OUT) do { unsigned a0 = cvt_pk_bf16(P[BASE + 0], P[BASE + 1]), a1 = cvt_pk_bf16(P[BASE + 2], P[BASE + 3]);   \
    unsigned b0 = cvt_pk_bf16(P[BASE + 4], P[BASE + 5]), b1 = cvt_pk_bf16(P[BASE + 6], P[BASE + 7]);                              \
    auto r0 = __builtin_amdgcn_permlane32_swap(a0, b0, false, false); auto r1 = __builtin_amdgcn_permlane32_swap(a1, b1, false, false); \
    u32x4 w = {r0[0], r1[0], r0[1], r1[1]}; OUT = __builtin_bit_cast(bf16x8, w); } while (0)
    PK4(p0, 0, pa0); PK4(p0, 8, pa1); PK4(p1, 0, pa2); PK4(p1, 8, pa3);
#undef PK4
}
#define KSWZ(KP, row, colB) ((row) * (KP) + ((colB) ^ (((KP) == 256 ? ((row) & 15) : (((row) >> 1) & 7)) << 4)))
template <int DQK, int NREG = Cfg<DQK>::NREG>
__device__ __forceinline__ void qkt(f32x16& p0, f32x16& p1, const LAS char* Ks, const bf16x8* qr, const LAS char* Qs, int r32, int hi) {
    constexpr int KP = Cfg<DQK>::KP;
    p0 = f32x16{}; p1 = f32x16{};
#pragma unroll
    for (int d0 = 0; d0 < DQK / 16; ++d0) { const int cb = (d0 * 16 + hi * 8) * 2;
        const bf16x8 b0 = *(const LAS bf16x8*)(Ks + KSWZ(KP, r32, cb));
        const bf16x8 b1 = *(const LAS bf16x8*)(Ks + KSWZ(KP, 32 + r32, cb));
        bf16x8 q;
        if (d0 < NREG) q = qr[d0]; else q = *(const LAS bf16x8*)(Qs + (d0 - NREG) * 1024);
        p0 = __builtin_amdgcn_mfma_f32_32x32x16_bf16(b0, q, p0, 0, 0, 0);
        p1 = __builtin_amdgcn_mfma_f32_32x32x16_bf16(b1, q, p1, 0, 0, 0); }
}
__device__ __forceinline__ int v_st(int k, int c) { const int kk = (k & ~0xC) | ((k & 4) << 1) | ((k & 8) >> 1); return ((kk >> 3) * 4 + (c >> 5)) * 512 + ((kk & 7) * 32 + (c & 31)) * 2; }
__device__ __forceinline__ int v_rd_base(int lane) { return ((lane & 3) << 3) | (((lane >> 2) & 3) << 6) | (((lane >> 4) & 1) << 5) | (((lane >> 5) & 1) << 8); }
constexpr int v_rd_off(int d0, int ks, int half) { return d0 * 512 + ks * 4096 + half * 2048; }
template <int OFF> __device__ __forceinline__ s16x4 tr_read(int vb) {
    s16x4 r; asm volatile("ds_read_b64_tr_b16 %0, %1 offset:%2" : "=&v"(r) : "v"(vb), "i"(OFF) : "memory"); return r;
}
template <int D0> __device__ __forceinline__ void pv_one(f32x16& od, int vb, bf16x8 pa0, bf16x8 pa1, bf16x8 pa2, bf16x8 pa3) {
    const s16x4 l0 = tr_read<v_rd_off(D0, 0, 0)>(vb), h0 = tr_read<v_rd_off(D0, 0, 1)>(vb), l1 = tr_read<v_rd_off(D0, 1, 0)>(vb), h1 = tr_read<v_rd_off(D0, 1, 1)>(vb);
    const s16x4 l2 = tr_read<v_rd_off(D0, 2, 0)>(vb), h2 = tr_read<v_rd_off(D0, 2, 1)>(vb), l3 = tr_read<v_rd_off(D0, 3, 0)>(vb), h3 = tr_read<v_rd_off(D0, 3, 1)>(vb);
    asm volatile("s_waitcnt lgkmcnt(0)" ::: "memory"); SBAR();
#define PKV(L, H) (bf16x8){L[0], L[1], L[2], L[3], H[0], H[1], H[2], H[3]}
    od = __builtin_amdgcn_mfma_f32_32x32x16_bf16(pa0, PKV(l0, h0), od, 0, 0, 0);
    od = __builtin_amdgcn_mfma_f32_32x32x16_bf16(pa1, PKV(l1, h1), od, 0, 0, 0);
    od = __builtin_amdgcn_mfma_f32_32x32x16_bf16(pa2, PKV(l2, h2), od, 0, 0, 0);
    od = __builtin_amdgcn_mfma_f32_32x32x16_bf16(pa3, PKV(l3, h3), od, 0, 0, 0);
#undef PKV
}
__device__ __forceinline__ void pv_d0(f32x16* o, int vb, bf16x8 pa0, bf16x8 pa1, bf16x8 pa2, bf16x8 pa3) {
    pv_one<0>(o[0], vb, pa0, pa1, pa2, pa3); pv_one<1>(o[1], vb, pa0, pa1, pa2, pa3); pv_one<2>(o[2], vb, pa0, pa1, pa2, pa3); pv_one<3>(o[3], vb, pa0, pa1, pa2, pa3);
}
__device__ __forceinline__ void store_o(const f32x16* o, float l_reg, LAS float* li_l, LAS char* lds, bf16* Ob, int ldo, int wid, int lane, int r32, int hi) {
    if (hi == 0) li_l[r32] = l_reg;
    asm volatile("s_waitcnt lgkmcnt(0)" ::: "memory");
    float rli[16];
#pragma unroll
    for (int r = 0; r < 16; ++r) rli[r] = __builtin_amdgcn_rcpf(li_l[crow(r, hi)]);
    LAS unsigned short* slab = (LAS unsigned short*)(lds + wid * 8192);
#pragma unroll
    for (int r = 0; r < 16; ++r) { const int orow = crow(r, hi);
#pragma unroll
        for (int d0 = 0; d0 < 4; ++d0) slab[orow * 128 + d0 * 32 + r32] = (unsigned short)(cvt_pk_bf16(o[d0][r] * rli[r], 0.f) & 0xffffu); }
    asm volatile("s_waitcnt lgkmcnt(0)" ::: "memory");
#pragma unroll
    for (int i = 0; i < 8; ++i) { const int id = i * 64 + lane, row = id >> 4, c16 = id & 15;
        const u32x4 w = *(const LAS u32x4*)((LAS char*)slab + row * 256 + c16 * 16);
        *(u32x4*)(Ob + (unsigned)(wid * 32 + row) * (unsigned)ldo + c16 * 8) = w; }
}

__device__ __forceinline__ void unpack8(bf16x8 v, float (&x)[8]) {
#pragma unroll
    for (int e = 0; e < 8; ++e) x[e] = bf2f((unsigned short)v[e]);
}
__device__ __forceinline__ bf16x8 pack8(const float (&x)[8]) {
    u32x4 w; w.x = cvt_pk_bf16(x[0], x[1]); w.y = cvt_pk_bf16(x[2], x[3]); w.z = cvt_pk_bf16(x[4], x[5]); w.w = cvt_pk_bf16(x[6], x[7]); return __builtin_bit_cast(bf16x8, w);
}
__device__ __forceinline__ void rope_pair(bf16x8& f1, bf16x8& f2, const float* ct, const float* st, float mul, const float* g1, const float* g2) {
    float x1[8], x2[8], a[8], b[8]; unpack8(f1, x1); unpack8(f2, x2);
    const f32x4 c0 = *(const f32x4*)ct, c1 = *(const f32x4*)(ct + 4), s0 = *(const f32x4*)st, s1 = *(const f32x4*)(st + 4);
    const float c[8] = {c0.x, c0.y, c0.z, c0.w, c1.x, c1.y, c1.z, c1.w}, s[8] = {s0.x, s0.y, s0.z, s0.w, s1.x, s1.y, s1.z, s1.w};
    if (g1) {
        const f32x4 ga = *(const f32x4*)g1, gb = *(const f32x4*)(g1 + 4), gc = *(const f32x4*)g2, gd = *(const f32x4*)(g2 + 4);
        const float gg1[8] = {ga.x, ga.y, ga.z, ga.w, gb.x, gb.y, gb.z, gb.w}, gg2[8] = {gc.x, gc.y, gc.z, gc.w, gd.x, gd.y, gd.z, gd.w};
#pragma unroll
        for (int e = 0; e < 8; ++e) { x1[e] = x1[e] * mul * gg1[e]; x2[e] = x2[e] * mul * gg2[e]; }
    }
#pragma unroll
    for (int e = 0; e < 8; ++e) { a[e] = x1[e] * c[e] - x2[e] * s[e]; b[e] = x2[e] * c[e] + x1[e] * s[e]; }
    f1 = pack8(a); f2 = pack8(b);
}
template <int ND0, int QMODE>
__device__ __forceinline__ void load_q(bf16x8 (&qraw)[ND0], const bf16* __restrict__ Qb, int ldq, int wid, int r32, int hi, int qpos0, const float* __restrict__ tab, const float* __restrict__ qgain) {
    const unsigned qo = (unsigned)(wid * 32 + r32) * (unsigned)ldq + hi * 8;
#pragma unroll
    for (int d0 = 0; d0 < ND0; ++d0) qraw[d0] = *(const bf16x8*)(Qb + qo + d0 * 16);
    const int pos = qpos0 + wid * 32 + r32;
    if constexpr (QMODE == 1) {
        const float* ct = tab + pos * 32 + hi * 8; const float* st = ct + 4096 * 32;
        rope_pair(qraw[8], qraw[10], ct, st, 1.f, nullptr, nullptr); rope_pair(qraw[9], qraw[11], ct + 16, st + 16, 1.f, nullptr, nullptr);
    } else if constexpr (QMODE == 2) {
        const float* ct = tab + pos * 64 + hi * 8; const float* st = ct + 4096 * 64;
#pragma unroll
        for (int g = 0; g < 4; ++g) rope_pair(qraw[g], qraw[g + 4], ct + g * 16, st + g * 16, 1.f, nullptr, nullptr);
    } else if constexpr (QMODE == 3) {
        float ss = 0.f;
#pragma unroll
        for (int d0 = 0; d0 < 8; ++d0) { float x[8]; unpack8(qraw[d0], x);
#pragma unroll
            for (int e = 0; e < 8; ++e) ss += x[e] * x[e]; }
        ss += other_half(ss, hi == 0);
        const float rstd = 1.f / sqrtf(ss * (1.f / 128.f) + EPS);
        const float* ctr = tab + (pos >> 6) * 32 + hi * 8; const float* str = ctr + 4096 * 32; const float* ctc = tab + (pos & 63) * 32 + hi * 8; const float* stc = ctc + 4096 * 32;
        const float* gq = qgain + hi * 8;
#pragma unroll
        for (int g = 0; g < 2; ++g) { rope_pair(qraw[g], qraw[g + 2], ctr + g * 16, str + g * 16, rstd, gq + g * 16, gq + (g + 2) * 16);
                                      rope_pair(qraw[4 + g], qraw[6 + g], ctc + g * 16, stc + g * 16, rstd, gq + (4 + g) * 16, gq + (6 + g) * 16); }
    }
}
template <int DQK, int SDEPTH, int QMODE>
__device__ __forceinline__ void dense_unit(const bf16* __restrict__ Qb, int ldq, const bf16* __restrict__ Kh, int ldk, const bf16* __restrict__ K2h, int ldk2,
                                           const bf16* __restrict__ Vh, int ldv, bf16* __restrict__ Ob, int ldo, int seq, LAS char* lds, int wid,
                                           int qpos0, const float* __restrict__ tab, const float* __restrict__ qgain) {
    using CF = Cfg<DQK>; constexpr int KP = CF::KP, SHM_K = CF::SHM_K, ND0 = DQK / 16;
    const int lane = lane_id_fresh(), tid = wid * 64 + lane, r32 = lane & 31, hi = lane >> 5;
    LAS char* V_lds = lds; LAS char* K_lds = lds + CF::OFF_K;
    LAS float* ws = (LAS float*)(lds + CF::OFF_WS) + wid * 64; LAS float* li_l = ws; LAS float* al_l = ws + 32;
    float m_reg = -1e30f, l_reg = 0; f32x16 o[4] = {}; bf16x8 qr[CF::NREG];
    const LAS char* Qs = lds + CF::OFF_QS + wid * (1024 * CF::NPARK) + lane * 16;
    { bf16x8 qraw[ND0]; load_q<ND0, QMODE>(qraw, Qb, ldq, wid, r32, hi, qpos0, tab, qgain);
#pragma unroll
      for (int d0 = 0; d0 < CF::NREG; ++d0) qr[d0] = qraw[d0];
      if constexpr (CF::NPARK > 0) {
#pragma unroll
          for (int d0 = CF::NREG; d0 < ND0; ++d0) *(LAS bf16x8*)((LAS char*)Qs + (d0 - CF::NREG) * 1024) = qraw[d0]; } }
    const int sr = tid >> 4, sc = (tid & 15) * 8, vst0 = v_st(sr, sc), vst1 = v_st(32 + sr, sc);
    const int kst0 = KSWZ(KP, sr, sc * 2), kst1 = KSWZ(KP, 32 + sr, sc * 2);
    const int kr2 = tid >> 3, c2 = (tid & 7) * 8, kst2 = KSWZ(KP, kr2, (128 + c2) * 2);
    const unsigned vo = (unsigned)sr * (unsigned)ldv + sc, ko = (unsigned)sr * (unsigned)ldk + sc, k2o = (unsigned)kr2 * (unsigned)ldk2 + c2;
    const int vb0 = (int)(unsigned)(uintptr_t)V_lds + v_rd_base(lane);
    struct { bf16x8 vs0, vs1, ks0, ks1, k2; } sr_[SDEPTH];
#define SLOAD(i, k0) do { const bf16* Vt_ = Vh + (size_t)(k0) * ldv; const bf16* Kt_ = Kh + (size_t)(k0) * ldk; \
    sr_[i].vs0 = *(const bf16x8*)(Vt_ + vo); sr_[i].vs1 = *(const bf16x8*)(Vt_ + (size_t)32 * ldv + vo); \
    sr_[i].ks0 = *(const bf16x8*)(Kt_ + ko); sr_[i].ks1 = *(const bf16x8*)(Kt_ + (size_t)32 * ldk + ko); \
    if constexpr (DQK == 192) sr_[i].k2 = *(const bf16x8*)(K2h + (size_t)(k0) * ldk2 + k2o); } while (0)
#define SWRITE(b, i) do { *(LAS bf16x8*)(V_lds + (b) * SHM_V + vst0) = sr_[i].vs0; *(LAS bf16x8*)(V_lds + (b) * SHM_V + vst1) = sr_[i].vs1; \
    *(LAS bf16x8*)(K_lds + (b) * SHM_K + kst0) = sr_[i].ks0; *(LAS bf16x8*)(K_lds + (b) * SHM_K + kst1) = sr_[i].ks1; \
    if constexpr (DQK == 192) *(LAS bf16x8*)(K_lds + (b) * SHM_K + kst2) = sr_[i].k2; } while (0)
#define SWAIT() do { if constexpr (SDEPTH == 1) asm volatile("s_waitcnt vmcnt(0)" ::: "memory"); else if constexpr (DQK == 192) asm volatile("s_waitcnt vmcnt(5)" ::: "memory"); else asm volatile("s_waitcnt vmcnt(4)" ::: "memory"); } while (0)
#define RESC(a) do { if (__any((a) < 1.f)) { if (hi == 0) al_l[r32] = (a); asm volatile("s_waitcnt lgkmcnt(0)" ::: "memory"); \
    _Pragma("unroll") for (int d = 0; d < 4; ++d) _Pragma("unroll") for (int r = 0; r < 16; ++r) o[d][r] *= al_l[crow(r, hi)]; } } while (0)
    f32x16 pA0, pA1, pB0, pB1; float mnA, mnB, alA, alB; bf16x8 pa0, pa1, pa2, pa3; const int NT = seq / 64;
    constexpr int SE = 0, SO = SDEPTH - 1;
    __syncthreads();
    SLOAD(SE, 0); asm volatile("s_waitcnt vmcnt(0)" ::: "memory"); SWRITE(0, SE); __syncthreads();
    qkt<DQK>(pA0, pA1, K_lds, qr, Qs, r32, hi); partialSM<DQK>(pA0, pA1, m_reg, mnA, alA);
    SLOAD(SO, 64); if constexpr (SDEPTH == 2) { if (2 < NT) SLOAD(SE, 128); }
    SWAIT(); SWRITE(1, SO); __syncthreads();
    for (int j = 1; j + 1 < NT; j += 2) {
        SBAR(); qkt<DQK>(pB0, pB1, K_lds + SHM_K, qr, Qs, r32, hi);
        finishSM(pA0, pA1, alA, l_reg, pa0, pa1, pa2, pa3); SBAR();
        SLOAD(SO, (j + SDEPTH) * 64); SBAR();
        pv_d0(o, vb0, pa0, pa1, pa2, pa3); partialSM<DQK>(pB0, pB1, m_reg, mnB, alB);
        __syncthreads(); SWAIT(); SWRITE(0, SE);
        RESC(alB); __syncthreads();
        SBAR(); qkt<DQK>(pA0, pA1, K_lds, qr, Qs, r32, hi);
        finishSM(pB0, pB1, alB, l_reg, pa0, pa1, pa2, pa3); SBAR();
        if (SDEPTH == 1 || j + 3 < NT) SLOAD(SE, (j + 1 + SDEPTH) * 64); SBAR();
        pv_d0(o, vb0 + SHM_V, pa0, pa1, pa2, pa3); partialSM<DQK>(pA0, pA1, m_reg, mnA, alA);
        __syncthreads(); SWAIT(); SWRITE(1, SO);
        RESC(alA); __syncthreads();
    }
    SBAR(); qkt<DQK>(pB0, pB1, K_lds + SHM_K, qr, Qs, r32, hi);
    finishSM(pA0, pA1, alA, l_reg, pa0, pa1, pa2, pa3); SBAR();
    pv_d0(o, vb0, pa0, pa1, pa2, pa3); partialSM<DQK>(pB0, pB1, m_reg, mnB, alB);
    __syncthreads(); RESC(alB);
    finishSM(pB0, pB1, alB, l_reg, pa0, pa1, pa2, pa3); SBAR();
    pv_d0(o, vb0 + SHM_V, pa0, pa1, pa2, pa3);
    __syncthreads();
    store_o(o, l_reg, li_l, lds, Ob, ldo, wid, lane, r32, hi);
#undef SLOAD
#undef SWRITE
#undef SWAIT
}

constexpr int R3_SLOT = 32768, R3_OFF_WS = 3 * R3_SLOT, R3_TOTAL = R3_OFF_WS + 8 * 256;
template <int QMODE>
__device__ __forceinline__ void dense_unit3(const bf16* __restrict__ Qb, int ldq, const bf16* __restrict__ Kh, int ldk, const bf16* __restrict__ Vh, int ldv, bf16* __restrict__ Ob, int ldo, int seq,
                                            LAS char* lds, int wid, int qpos0, const float* __restrict__ tab, const float* __restrict__ qgain) {
    constexpr int KP = 256;
    const int lane = lane_id_fresh(), tid = wid * 64 + lane, r32 = lane & 31, hi = lane >> 5;
    LAS float* ws = (LAS float*)(lds + R3_OFF_WS) + wid * 64; LAS float* li_l = ws; LAS float* al_l = ws + 32;
    float m_reg = -1e30f, l_reg = 0; f32x16 o[4] = {}; bf16x8 qr[8];
    load_q<8, QMODE>(qr, Qb, ldq, wid, r32, hi, qpos0, tab, qgain);
    const int sr = tid >> 4, sc = (tid & 15) * 8, vst0 = v_st(sr, sc), vst1 = v_st(32 + sr, sc);
    const int kst0 = 16384 + KSWZ(KP, sr, sc * 2), kst1 = 16384 + KSWZ(KP, 32 + sr, sc * 2);
    const unsigned vo = (unsigned)sr * (unsigned)ldv + sc, ko = (unsigned)sr * (unsigned)ldk + sc;
    const int vbase = (int)(unsigned)(uintptr_t)lds + v_rd_base(lane);
    struct { bf16x8 vs0, vs1, ks0, ks1; } sr_[2];
#define SLOAD3(i, k0) do { const bf16* Vt_ = Vh + (size_t)(k0) * ldv; const bf16* Kt_ = Kh + (size_t)(k0) * ldk; \
    sr_[i].vs0 = *(const bf16x8*)(Vt_ + vo); sr_[i].vs1 = *(const bf16x8*)(Vt_ + (size_t)32 * ldv + vo); \
    sr_[i].ks0 = *(const bf16x8*)(Kt_ + ko); sr_[i].ks1 = *(const bf16x8*)(Kt_ + (size_t)32 * ldk + ko); } while (0)
#define SWRITE3(soff, i) do { *(LAS bf16x8*)(lds + (soff) + vst0) = sr_[i].vs0; *(LAS bf16x8*)(lds + (soff) + vst1) = sr_[i].vs1; \
    *(LAS bf16x8*)(lds + (soff) + kst0) = sr_[i].ks0; *(LAS bf16x8*)(lds + (soff) + kst1) = sr_[i].ks1; } while (0)
#define SWAIT3() asm volatile("s_waitcnt vmcnt(4)" ::: "memory")
#define RESC3(a) do { if (__any((a) < 1.f)) { if (hi == 0) al_l[r32] = (a); asm volatile("s_waitcnt lgkmcnt(0)" ::: "memory"); \
    _Pragma("unroll") for (int d = 0; d < 4; ++d) _Pragma("unroll") for (int r = 0; r < 16; ++r) o[d][r] *= al_l[crow(r, hi)]; } } while (0)
    f32x16 pA0, pA1, pB0, pB1; float mnA, mnB, alA, alB; bf16x8 pa0, pa1, pa2, pa3; const int NT = seq / 64;
    __syncthreads();
    SLOAD3(0, 0); SLOAD3(1, 64);
    SWAIT3(); SWRITE3(0, 0);
    if (2 < NT) SLOAD3(0, 128);
    __syncthreads();
    qkt<128>(pA0, pA1, lds + 16384, qr, nullptr, r32, hi); partialSM<128>(pA0, pA1, m_reg, mnA, alA);
    SWAIT3(); SWRITE3(R3_SLOT, 1);
    int sK = R3_SLOT, sV = 0, sW = 2 * R3_SLOT;
    for (int t = 1; t + 1 < NT; t += 2) {
        __syncthreads();
        SBAR(); qkt<128>(pB0, pB1, lds + sK + 16384, qr, nullptr, r32, hi);
        finishSM(pA0, pA1, alA, l_reg, pa0, pa1, pa2, pa3); SBAR();
        if (t + 2 < NT) SLOAD3(1, (t + 2) * 64); SBAR();
        pv_d0(o, vbase + sV, pa0, pa1, pa2, pa3); partialSM<128>(pB0, pB1, m_reg, mnB, alB);
        SWAIT3(); SWRITE3(sW, 0);
        RESC3(alB);
        { const int n = sV; sV = sK; sK = sW; sW = n; }
        __syncthreads();
        SBAR(); qkt<128>(pA0, pA1, lds + sK + 16384, qr, nullptr, r32, hi);
        finishSM(pB0, pB1, alB, l_reg, pa0, pa1, pa2, pa3); SBAR();
        if (t + 3 < NT) SLOAD3(0, (t + 3) * 64); SBAR();
        pv_d0(o, vbase + sV, pa0, pa1, pa2, pa3); partialSM<128>(pA0, pA1, m_reg, mnA, alA);
        SWAIT3(); if (t + 2 < NT) SWRITE3(sW, 1);
        RESC3(alA);
        { const int n = sV; sV = sK; sK = sW; sW = n; }
    }
    __syncthreads();
    SBAR(); qkt<128>(pB0, pB1, lds + sK + 16384, qr, nullptr, r32, hi);
    finishSM(pA0, pA1, alA, l_reg, pa0, pa1, pa2, pa3); SBAR();
    pv_d0(o, vbase + sV, pa0, pa1, pa2, pa3); partialSM<128>(pB0, pB1, m_reg, mnB, alB);
    RESC3(alB);
    finishSM(pB0, pB1, alB, l_reg, pa0, pa1, pa2, pa3); SBAR();
    pv_d0(o, vbase + sK, pa0, pa1, pa2, pa3);
    __syncthreads();
    store_o(o, l_reg, li_l, lds, Ob, ldo, wid, lane, r32, hi);
#undef SLOAD3
#undef SWRITE3
#undef SWAIT3
#undef RESC3
}

constexpr int DV_SLOT = 49152, DV_OFF_K = 32768, DV_OFF_WS = 131072, DV_TOTAL = DV_OFF_WS + 8 * 256;
struct DiffFuse { const bf16* O0b; bf16* Hb; int ldh; float lam, post; const float* subln; };
template <int FUSE>
__device__ __forceinline__ void dense_unit_dv256(const bf16* __restrict__ Qb, int ldq, const bf16* __restrict__ Kh, int ldk, const bf16* __restrict__ Vh, int ldv, bf16* __restrict__ Ob, int ldo, int seq,
                                                 LAS char* lds, int wid, int qpos0, const float* __restrict__ tab, const DiffFuse& df) {
    constexpr int KP = 256;
    const int lane = lane_id_fresh(), tid = wid * 64 + lane, r32 = lane & 31, hi = lane >> 5;
    LAS float* ws = (LAS float*)(lds + DV_OFF_WS) + wid * 64; LAS float* li_l = ws; LAS float* al_l = ws + 32;
    __syncthreads();
    float m_reg = -1e30f, l_reg = 0; f32x16 o[8] = {}; bf16x8 qr[4];
    const LAS char* Qs = lds + 2 * DV_SLOT + wid * 4096 + lane * 16;
    { bf16x8 qraw[8]; load_q<8, 2>(qraw, Qb, ldq, wid, r32, hi, qpos0, tab, nullptr);
#pragma unroll
      for (int d0 = 0; d0 < 4; ++d0) qr[d0] = qraw[d0];
#pragma unroll
      for (int d0 = 4; d0 < 8; ++d0) *(LAS bf16x8*)((LAS char*)Qs + (d0 - 4) * 1024) = qraw[d0]; }
    const int sr = tid >> 4, sc = (tid & 15) * 8, vst0 = v_st(sr, sc), vst1 = v_st(32 + sr, sc);
    const int kst0 = DV_OFF_K + KSWZ(KP, sr, sc * 2), kst1 = DV_OFF_K + KSWZ(KP, 32 + sr, sc * 2);
    const unsigned vo = (unsigned)sr * (unsigned)ldv + sc, ko = (unsigned)sr * (unsigned)ldk + sc;
    const int vbase = (int)(unsigned)(uintptr_t)lds + v_rd_base(lane);
    bf16x8 sv0, sv1, sv2, sv3, sk0, sk1;
#define DLOAD(k0) do { const bf16* Vt_ = Vh + (size_t)(k0) * ldv; const bf16* Kt_ = Kh + (size_t)(k0) * ldk; \
    sv0 = *(const bf16x8*)(Vt_ + vo); sv1 = *(const bf16x8*)(Vt_ + (size_t)32 * ldv + vo); sv2 = *(const bf16x8*)(Vt_ + vo + 128); sv3 = *(const bf16x8*)(Vt_ + (size_t)32 * ldv + vo + 128); \
    sk0 = *(const bf16x8*)(Kt_ + ko); sk1 = *(const bf16x8*)(Kt_ + (size_t)32 * ldk + ko); } while (0)
#define DWRITE(soff) do { *(LAS bf16x8*)(lds + (soff) + vst0) = sv0; *(LAS bf16x8*)(lds + (soff) + vst1) = sv1; *(LAS bf16x8*)(lds + (soff) + 16384 + vst0) = sv2; *(LAS bf16x8*)(lds + (soff) + 16384 + vst1) = sv3; \
    *(LAS bf16x8*)(lds + (soff) + kst0) = sk0; *(LAS bf16x8*)(lds + (soff) + kst1) = sk1; } while (0)
    const int NT = seq / 64;
    __syncthreads();
    DLOAD(0); asm volatile("s_waitcnt vmcnt(0)" ::: "memory"); DWRITE(0);
    __syncthreads();
    int sC = 0, sN = DV_SLOT;
    for (int t = 0; t < NT; ++t) {
        f32x16 p0, p1; float mn, al; bf16x8 pa0, pa1, pa2, pa3;
        SBAR(); qkt<128, 4>(p0, p1, lds + sC + DV_OFF_K, qr, Qs, r32, hi);
        partialSM<128>(p0, p1, m_reg, mn, al);
        if (__any(al < 1.f)) { if (hi == 0) al_l[r32] = al; asm volatile("s_waitcnt lgkmcnt(0)" ::: "memory");
#pragma unroll
            for (int d = 0; d < 8; ++d)
#pragma unroll
                for (int r = 0; r < 16; ++r) o[d][r] *= al_l[crow(r, hi)]; }
        finishSM(p0, p1, al, l_reg, pa0, pa1, pa2, pa3); SBAR();
        if (t + 1 < NT) DLOAD((t + 1) * 64);
        SBAR();
        pv_d0(o, vbase + sC, pa0, pa1, pa2, pa3);
        pv_d0(o + 4, vbase + sC + 16384, pa0, pa1, pa2, pa3);
        if (t + 1 < NT) { asm volatile("s_waitcnt vmcnt(0)" ::: "memory"); DWRITE(sN); }
        __syncthreads();
        { const int n = sC; sC = sN; sN = n; }
    }
    u32x4 w0[FUSE ? 16 : 1];
    if constexpr (FUSE == 1) {
#pragma unroll
        for (int i = 0; i < 16; ++i) { const int row = (i * 64 + lane) >> 5; w0[i] = *(const u32x4*)(df.O0b + (unsigned)(wid * 32 + row) * (unsigned)ldo + (lane & 31) * 8); } }
    if (hi == 0) li_l[r32] = l_reg;
    asm volatile("s_waitcnt lgkmcnt(0)" ::: "memory");
    float rli[16];
#pragma unroll
    for (int r = 0; r < 16; ++r) rli[r] = __builtin_amdgcn_rcpf(li_l[crow(r, hi)]);
    LAS unsigned short* slab = (LAS unsigned short*)(lds + wid * 16384);
#pragma unroll
    for (int r = 0; r < 16; ++r) { const int orow = crow(r, hi);
#pragma unroll
        for (int d0 = 0; d0 < 8; ++d0) slab[orow * 256 + d0 * 32 + r32] = (unsigned short)(cvt_pk_bf16(o[d0][r] * rli[r], 0.f) & 0xffffu); }
    asm volatile("s_waitcnt lgkmcnt(0)" ::: "memory");
    if constexpr (FUSE == 0) {
#pragma unroll
        for (int i = 0; i < 16; ++i) { const int id = i * 64 + lane, row = id >> 5, c16 = id & 31;
            const u32x4 w = *(const LAS u32x4*)((LAS char*)slab + row * 512 + c16 * 16);
            *(u32x4*)(Ob + (unsigned)(wid * 32 + row) * (unsigned)ldo + c16 * 8) = w; }
    } else {
        const int c16 = lane & 31;
        const f32x4 g0 = *(const f32x4*)(df.subln + c16 * 8), g1 = *(const f32x4*)(df.subln + c16 * 8 + 4);
        const float gg[8] = {g0.x, g0.y, g0.z, g0.w, g1.x, g1.y, g1.z, g1.w};
#pragma unroll
        for (int i = 0; i < 16; ++i) { const int row = (i * 64 + lane) >> 5;
            const u32x4 w1 = *(const LAS u32x4*)((LAS char*)slab + row * 512 + c16 * 16);
            const u32x4 a = w0[i];
            float d[8] = {bflo(a.x) - df.lam * bflo(w1.x), bfhi(a.x) - df.lam * bfhi(w1.x), bflo(a.y) - df.lam * bflo(w1.y), bfhi(a.y) - df.lam * bfhi(w1.y),
                          bflo(a.z) - df.lam * bflo(w1.z), bfhi(a.z) - df.lam * bfhi(w1.z), bflo(a.w) - df.lam * bflo(w1.w), bfhi(a.w) - df.lam * bfhi(w1.w)};
            float ss = ((d[0] * d[0] + d[1] * d[1]) + (d[2] * d[2] + d[3] * d[3])) + ((d[4] * d[4] + d[5] * d[5]) + (d[6] * d[6] + d[7] * d[7]));
            ss += swz_xor<1>(ss); ss += swz_xor<2>(ss); ss += swz_xor<4>(ss); ss += swz_xor<8>(ss); ss += swz_xor<16>(ss);
            const float rs = df.post / sqrtf(ss * (1.f / 256.f) + EPS);
            u32x4 o4; o4.x = cvt_pk_bf16(d[0] * rs * gg[0], d[1] * rs * gg[1]); o4.y = cvt_pk_bf16(d[2] * rs * gg[2], d[3] * rs * gg[3]);
            o4.z = cvt_pk_bf16(d[4] * rs * gg[4], d[5] * rs * gg[5]); o4.w = cvt_pk_bf16(d[6] * rs * gg[6], d[7] * rs * gg[7]);
            *(u32x4*)(df.Hb + (unsigned)(wid * 32 + row) * (unsigned)df.ldh + c16 * 8) = o4; }
    }
#undef DLOAD
#undef DWRITE
}

constexpr int NA_OFF_K = SHM_V, NA_OFF_RPB = 65536, NA_OFF_WS = 65536 + 2048, NA_TOTAL = NA_OFF_WS + 8 * 256;
__device__ __forceinline__ int clampi(int v, int lo, int hi) { return v < lo ? lo : (v > hi ? hi : v); }
__device__ __forceinline__ void na_unit(const bf16* __restrict__ Qb, int ldq, const bf16* __restrict__ Kseq, const bf16* __restrict__ Vseq, int ldk,
                                        bf16* __restrict__ Ob, int ldo, int r0, const float* __restrict__ rpb_h, LAS char* lds, int wid) {
    constexpr int KP = 256;
    const int lane = lane_id_fresh(), tid = wid * 64 + lane, r32 = lane & 31, hi = lane >> 5;
    LAS char* V_lds = lds; LAS char* K_lds = lds + NA_OFF_K; LAS float* rpb_l = (LAS float*)(lds + NA_OFF_RPB);
    LAS float* ws = (LAS float*)(lds + NA_OFF_WS) + wid * 64; LAS float* li_l = ws; LAS float* al_l = ws + 32;
    float m_reg = -1e30f, l_reg = 0; f32x16 o[4] = {}; bf16x8 qr[8];
    { const unsigned qo = (unsigned)(wid * 32 + r32) * (unsigned)ldq + hi * 8;
#pragma unroll
      for (int d0 = 0; d0 < 8; ++d0) qr[d0] = *(const bf16x8*)(Qb + qo + d0 * 16); }
    const int sr = tid >> 4, sc = (tid & 15) * 8, vst0 = v_st(sr, sc), vst1 = v_st(32 + sr, sc);
    const int kst0 = KSWZ(KP, sr, sc * 2), kst1 = KSWZ(KP, 32 + sr, sc * 2);
    const unsigned ko = (unsigned)sr * (unsigned)ldk + sc;
    const int vb0 = (int)(unsigned)(uintptr_t)V_lds + v_rd_base(lane);
    const int kr_lo = clampi(r0 - 4, 0, 56), kr_hi = clampi(r0 + 3 - 4, 0, 56) + 8;
    const int qrw = r0 + (wid >> 1), srw = clampi(qrw - 4, 0, 56);
    const int qc = (wid & 1) * 32 + r32, scq = clampi(qc - 8, 0, 48);
    __syncthreads();
    if (tid < 465) rpb_l[tid] = rpb_h[tid] * 11.313708498984761f;
    bf16x8 va0, va1, ka0, ka1, vb0_, vb1_, kb0, kb1;
#define NA_LOAD(V0, V1, K0, K1, kr_) do { const bf16* Kt = Kseq + (size_t)((kr_) * 64) * ldk; const bf16* Vt = Vseq + (size_t)((kr_) * 64) * ldk; \
      V0 = *(const bf16x8*)(Vt + ko); V1 = *(const bf16x8*)(Vt + (size_t)32 * ldk + ko); K0 = *(const bf16x8*)(Kt + ko); K1 = *(const bf16x8*)(Kt + (size_t)32 * ldk + ko); } while (0)
#define NA_STEP(V0, V1, K0, K1, kr_) do { \
        __syncthreads();                                            \
        *(LAS bf16x8*)(V_lds + vst0) = V0; *(LAS bf16x8*)(V_lds + vst1) = V1; *(LAS bf16x8*)(K_lds + kst0) = K0; *(LAS bf16x8*)(K_lds + kst1) = K1; \
        __syncthreads(); \
        if ((kr_) + 2 < kr_hi) NA_LOAD(V0, V1, K0, K1, (kr_) + 2);     \
        if ((kr_) >= srw && (kr_) < srw + 8) {                      \
            f32x16 p0, p1; float mn, al; bf16x8 pa0, pa1, pa2, pa3; \
            qkt<128>(p0, p1, K_lds, qr, nullptr, r32, hi); \
            const LAS float* bt = rpb_l + ((kr_) - qrw + 7) * 31 + (15 - qc); \
            _Pragma("unroll") for (int r = 0; r < 16; ++r) { const int kc = crow(r, hi); const bool in = (kc >= scq) && (kc < scq + 16); const float b = bt[in ? kc : qc]; p0[r] = in ? p0[r] + b : -1e30f; } \
            _Pragma("unroll") for (int r = 0; r < 16; ++r) { const int kc = 32 + crow(r, hi); const bool in = (kc >= scq) && (kc < scq + 16); const float b = bt[in ? kc : qc]; p1[r] = in ? p1[r] + b : -1e30f; } \
            partialSM<128>(p0, p1, m_reg, mn, al); \
            RESC(al); \
            finishSM(p0, p1, al, l_reg, pa0, pa1, pa2, pa3); SBAR(); \
            pv_d0(o, vb0, pa0, pa1, pa2, pa3); \
        } } while (0)
    NA_LOAD(va0, va1, ka0, ka1, kr_lo);
    if (kr_lo + 1 < kr_hi) NA_LOAD(vb0_, vb1_, kb0, kb1, kr_lo + 1);
    for (int kr = kr_lo; kr < kr_hi; kr += 2) {
        NA_STEP(va0, va1, ka0, ka1, kr);
        if (kr + 1 < kr_hi) NA_STEP(vb0_, vb1_, kb0, kb1, kr + 1);
    }
#undef NA_LOAD
#undef NA_STEP
    __syncthreads();
    store_o(o, l_reg, li_l, lds, Ob, ldo, wid, lane, r32, hi);
}
template <int D0> __device__ __forceinline__ void na2_pv(f32x16& od, int vbA, int vbB, bf16x8 pa0, bf16x8 pa1) {
    const s16x4 l0 = tr_read<v_rd_off(D0, 0, 0)>(vbA), h0 = tr_read<v_rd_off(D0, 0, 1)>(vbA), l1 = tr_read<v_rd_off(D0, 0, 0)>(vbB), h1 = tr_read<v_rd_off(D0, 0, 1)>(vbB);
    asm volatile("s_waitcnt lgkmcnt(0)" ::: "memory"); SBAR();
    od = __builtin_amdgcn_mfma_f32_32x32x16_bf16(pa0, (bf16x8){l0[0], l0[1], l0[2], l0[3], h0[0], h0[1], h0[2], h0[3]}, od, 0, 0, 0);
    od = __builtin_amdgcn_mfma_f32_32x32x16_bf16(pa1, (bf16x8){l1[0], l1[1], l1[2], l1[3], h1[0], h1[1], h1[2], h1[3]}, od, 0, 0, 0);
}
__device__ __forceinline__ void na_unit2(const bf16* __restrict__ Qb, int ldq, const bf16* __restrict__ Kseq, const bf16* __restrict__ Vseq, int ldk,
                                         bf16* __restrict__ Ob, int ldo, int r0, const float* __restrict__ rpb_h, LAS char* lds, int wid) {
    constexpr int KP = 256; constexpr float NEG = -3.0e38f;
    const int lane = lane_id_fresh(), tid = wid * 64 + lane, r32 = lane & 31, hi = lane >> 5;
    LAS char* V_lds = lds; LAS char* K_lds = lds + NA_OFF_K; LAS float* rpb_l = (LAS float*)(lds + NA_OFF_RPB);
    LAS float* ws = (LAS float*)(lds + NA_OFF_WS) + wid * 64; LAS float* li_l = ws; LAS float* al_l = ws + 32;
    float m_reg = -1e30f, l_reg = 0; f32x16 o[4] = {}; bf16x8 qr[8];
    const int typ = wid & 3, rp = wid >> 2, c15 = r32 & 15;
    const int g0 = (typ == 3) ? 0 : typ, g1 = (typ == 3) ? 3 : typ + 1;
    const int qc = (typ == 3) ? (c15 < 8 ? c15 : 48 + c15) : 8 + 16 * typ + c15;
    const int qrl = 2 * rp + (r32 >> 4), qrow = r0 + qrl;
    { const unsigned qo = (unsigned)(qrl * 64 + qc) * (unsigned)ldq + hi * 8;
#pragma unroll
      for (int d0 = 0; d0 < 8; ++d0) qr[d0] = *(const bf16x8*)(Qb + qo + d0 * 16); }
    const int sr = tid >> 4, sc = (tid & 15) * 8, vst0 = v_st(sr, sc), vst1 = v_st(32 + sr, sc);
    const int kst0 = KSWZ(KP, sr, sc * 2), kst1 = KSWZ(KP, 32 + sr, sc * 2);
    const unsigned ko = (unsigned)sr * (unsigned)ldk + sc;
    const int vbA = (int)(unsigned)(uintptr_t)V_lds + v_rd_base(lane) + g0 * 4096, vbB = (int)(unsigned)(uintptr_t)V_lds + v_rd_base(lane) + g1 * 4096;
    const int krow = 16 * (r32 < 16 ? g0 : g1) + c15;
    const LAS char* Kl = K_lds + krow * KP;
    const int kr_lo = clampi(r0 - 4, 0, 56), kr_hi = clampi(r0 + 3 - 4, 0, 56) + 8;
    const int s_lo = clampi(r0 + 2 * rp - 4, 0, 56), s_hi = clampi(r0 + 2 * rp + 1 - 4, 0, 56) + 8;
    const int srq = clampi(qrow - 4, 0, 56), scq = clampi(qc - 8, 0, 48);
    __syncthreads();
    if (tid < 465) rpb_l[tid] = rpb_h[tid] * 11.313708498984761f;
    bf16x8 va0, va1, ka0, ka1, vb0_, vb1_, kb0, kb1;
#define NA_LOAD(V0, V1, K0, K1, kr_) do { const bf16* Kt = Kseq + (size_t)((kr_) * 64) * ldk; const bf16* Vt = Vseq + (size_t)((kr_) * 64) * ldk; \
      V0 = *(const bf16x8*)(Vt + ko); V1 = *(const bf16x8*)(Vt + (size_t)32 * ldk + ko); K0 = *(const bf16x8*)(Kt + ko); K1 = *(const bf16x8*)(Kt + (size_t)32 * ldk + ko); } while (0)
#define NA_STEP(V0, V1, K0, K1, kr_) do { \
        __syncthreads();                                            \
        *(LAS bf16x8*)(V_lds + vst0) = V0; *(LAS bf16x8*)(V_lds + vst1) = V1; *(LAS bf16x8*)(K_lds + kst0) = K0; *(LAS bf16x8*)(K_lds + kst1) = K1; \
        __syncthreads(); \
        if ((kr_) + 2 < kr_hi) NA_LOAD(V0, V1, K0, K1, (kr_) + 2);     \
        if ((kr_) >= s_lo && (kr_) < s_hi) {                        \
            f32x16 p = {}; \
            _Pragma("unroll") for (int d0 = 0; d0 < 8; ++d0) { const int cb = (d0 * 16 + hi * 8) * 2; \
                const bf16x8 kf = *(const LAS bf16x8*)(Kl + (cb ^ (c15 << 4))); p = __builtin_amdgcn_mfma_f32_32x32x16_bf16(kf, qr[d0], p, 0, 0, 0); } \
            const bool rowin = ((kr_) >= srq) && ((kr_) < srq + 8); \
            const LAS float* bt = rpb_l + clampi((kr_) - qrow + 7, 0, 14) * 31 + (15 - qc); \
            _Pragma("unroll") for (int r = 0; r < 16; ++r) { const int kc = 16 * (r < 8 ? g0 : g1) + (r & 3) + 8 * ((r >> 2) & 1) + 4 * hi; \
                const bool in = rowin && (kc >= scq) && (kc < scq + 16); const float b = bt[in ? kc : qc]; p[r] = in ? p[r] + b : NEG; } \
              \
            float pmax = p[0]; _Pragma("unroll") for (int r = 1; r < 16; ++r) pmax = fmaxf(pmax, p[r]); \
            { auto rr = __builtin_amdgcn_permlane32_swap(__float_as_uint(pmax), __float_as_uint(pmax), false, false); pmax = fmaxf(__uint_as_float(rr[0]), __uint_as_float(rr[1])); } \
            float mn, al; \
            if (__builtin_expect(__all(pmax - m_reg <= THR / Cfg<128>::SCALE), 1)) { mn = m_reg; al = 1.f; } \
            else { mn = fmaxf(m_reg, pmax); al = __builtin_amdgcn_exp2f((m_reg - mn) * Cfg<128>::C); m_reg = mn; } \
            const float mnC = -mn * Cfg<128>::C; float ps = 0; \
            _Pragma("unroll") for (int r = 0; r < 16; ++r) { p[r] = __builtin_amdgcn_exp2f(fmaf(p[r], Cfg<128>::C, mnC)); ps += p[r]; } \
            { auto rr = __builtin_amdgcn_permlane32_swap(__float_as_uint(ps), __float_as_uint(ps), false, false); ps = __uint_as_float(rr[0]) + __uint_as_float(rr[1]); } \
            RESC(al); \
            l_reg = l_reg * al + ps; \
            bf16x8 pa0, pa1; \
            { unsigned a0 = cvt_pk_bf16(p[0], p[1]), a1 = cvt_pk_bf16(p[2], p[3]), b0 = cvt_pk_bf16(p[4], p[5]), b1 = cvt_pk_bf16(p[6], p[7]); \
              auto x0 = __builtin_amdgcn_permlane32_swap(a0, b0, false, false); auto x1 = __builtin_amdgcn_permlane32_swap(a1, b1, false, false); \
              u32x4 w = {x0[0], x1[0], x0[1], x1[1]}; pa0 = __builtin_bit_cast(bf16x8, w); } \
            { unsigned a0 = cvt_pk_bf16(p[8], p[9]), a1 = cvt_pk_bf16(p[10], p[11]), b0 = cvt_pk_bf16(p[12], p[13]), b1 = cvt_pk_bf16(p[14], p[15]); \
              auto x0 = __builtin_amdgcn_permlane32_swap(a0, b0, false, false); auto x1 = __builtin_amdgcn_permlane32_swap(a1, b1, false, false); \
              u32x4 w = {x0[0], x1[0], x0[1], x1[1]}; pa1 = __builtin_bit_cast(bf16x8, w); } \
            SBAR(); \
            na2_pv<0>(o[0], vbA, vbB, pa0, pa1); na2_pv<1>(o[1], vbA, vbB, pa0, pa1); na2_pv<2>(o[2], vbA, vbB, pa0, pa1); na2_pv<3>(o[3], vbA, vbB, pa0, pa1); \
        } } while (0)
    NA_LOAD(va0, va1, ka0, ka1, kr_lo);
    if (kr_lo + 1 < kr_hi) NA_LOAD(vb0_, vb1_, kb0, kb1, kr_lo + 1);
    for (int kr = kr_lo; kr < kr_hi; kr += 2) {
        NA_STEP(va0, va1, ka0, ka1, kr);
        if (kr + 1 < kr_hi) NA_STEP(vb0_, vb1_, kb0, kb1, kr + 1);
    }
#undef NA_LOAD
#undef NA_STEP
    __syncthreads();
    if (hi == 0) li_l[r32] = l_reg;
    asm volatile("s_waitcnt lgkmcnt(0)" ::: "memory");
    float rli[16];
#pragma unroll
    for (int r = 0; r < 16; ++r) rli[r] = __builtin_amdgcn_rcpf(li_l[crow(r, hi)]);
    LAS unsigned short* slab = (LAS unsigned short*)(lds + wid * 8192);
#pragma unroll
    for (int r = 0; r < 16; ++r) { const int orow = crow(r, hi);
#pragma unroll
        for (int d0 = 0; d0 < 4; ++d0) slab[orow * 128 + d0 * 32 + r32] = (unsigned short)(cvt_pk_bf16(o[d0][r] * rli[r], 0.f) & 0xffffu); }
    asm volatile("s_waitcnt lgkmcnt(0)" ::: "memory");
#pragma unroll
    for (int i = 0; i < 8; ++i) { const int id = i * 64 + lane, q = id >> 4, c16 = id & 15, q15 = q & 15;
        const int col = (typ == 3) ? (q15 < 8 ? q15 : 48 + q15) : 8 + 16 * typ + q15;
        const u32x4 w = *(const LAS u32x4*)((LAS char*)slab + q * 256 + c16 * 16);
        *(u32x4*)(Ob + (unsigned)((2 * rp + (q >> 4)) * 64 + col) * (unsigned)ldo + c16 * 8) = w; }
}
#undef RESC
}

constexpr size_t MiB = 1u << 20;
constexpr size_t WS_CTL = 0, CTL_ZERO_BYTES = 64 * 1024;
constexpr size_t WS_TAB_MLA = 5 * MiB;
constexpr size_t WS_TAB_1D = 6 * MiB;
constexpr size_t WS_MN = 8 * MiB;
constexpr size_t WS_MKV = 20 * MiB;
constexpr size_t WS_WB = 32 * MiB;
constexpr size_t WB_IN = 0, WB_QB = 24 * MiB, WB_KVB = 26 * MiB, WB_OUT = 28 * MiB, WB_XQ = 36 * MiB, WB_XKV = 38 * MiB, WB_XO = 42 * MiB, WB_UP = 44 * MiB, WB_DOWN = 76 * MiB;
constexpr size_t WS_H = 144 * MiB;
constexpr size_t WS_BIG = 336 * MiB;
constexpr size_t BIG_PROJ = 0, BIG_Q = 264 * MiB, BIG_KV = 408 * MiB;
constexpr size_t BIG_SPLIT = 96 * MiB;
constexpr size_t BIG_XQ = 0, BIG_XO = 48 * MiB;
constexpr size_t BIG_U = 0;
constexpr size_t BIG_XBA = 400 * MiB;
constexpr size_t WS_PS = WS_BIG + 600 * MiB;
constexpr size_t PS_BYTES = (size_t)T * 32 * 4, PSC_BYTES = (size_t)T * 8 * 4;
constexpr size_t WS_END = WS_PS + 3 * PS_BYTES + 2 * PSC_BYTES;
constexpr int CW_BAR = 4096;
static_assert((size_t)(CW_BAR + 3456) * 4 <= CTL_ZERO_BYTES, "barrier words inside the zeroed region");
constexpr int SKEW_TICKS = 0;

constexpr int RING_BYTES = 135168, MISC_OFF = RING_BYTES + 320, PTR_OFF = RING_BYTES + 1024, LDS_BYTES = 147456;
static_assert(pg8::RS_LDS_OFF == RING_BYTES + 2048 && pg8::RS_LDS_OFF + 2048 <= LDS_BYTES && PTR_OFF + 29 * 8 <= pg8::RS_LDS_OFF, "row-scale staging area");
static_assert(att::DV_TOTAL <= RING_BYTES && att::Cfg<192>::TOTAL <= RING_BYTES && att::NA_TOTAL <= RING_BYTES && pg8::STAGE_BYTES <= RING_BYTES, "LDS map");

#define XB_TMO      128
#define XB_XCNT(j)  (256  + 64 * (j))
#define XB_XSUB(j)  (1280 + 64 * (j))
#define XB_XGEN(j)  (2304 + 64 * (j))
#define XB_TOP      3328
#define XB_TOPGEN   3392
#define XCD_BAR_WORDS 3456
#define XB_SPIN_CAP (1u << 18)
__device__ __forceinline__ unsigned xb_ld(unsigned* p)              { return __hip_atomic_load(p, __ATOMIC_RELAXED, __HIP_MEMORY_SCOPE_AGENT); }
__device__ __forceinline__ unsigned xb_add(unsigned* p, unsigned v) { return __hip_atomic_fetch_add(p, v, __ATOMIC_RELAXED, __HIP_MEMORY_SCOPE_AGENT); }
__device__ __forceinline__ unsigned xb_xcc_id() { return (unsigned)__builtin_amdgcn_s_getreg((3 << 11) | 20) & 0xFu; }
#define XB_SPIN(cond, bar) do { unsigned _sp = 0; while (cond) { __builtin_amdgcn_s_sleep(1); \
    if ((++_sp & 255u) == 0u) { if (xb_ld(&(bar)[XB_TMO])) break; if (_sp > XB_SPIN_CAP) { atomicAdd(&(bar)[XB_TMO], 1u); break; } } } } while (0)
struct XcdBarrier { unsigned* bar; unsigned x; volatile LAS unsigned* st; };
__device__ __forceinline__ XcdBarrier xcd_barrier_post(unsigned* bar, volatile LAS unsigned* st, int wave) {
    XcdBarrier b; b.bar = bar; b.x = xb_xcc_id(); b.st = st;
    if (wave == 0 && lane_id_fresh() == 0) (void)xb_add(&bar[XB_XCNT(b.x)], 1u);
    return b;
}
__device__ __forceinline__ void xcd_barrier_complete(unsigned* bar, unsigned x, unsigned& nloc, unsigned& nx) {
    const unsigned G = gridDim.x * gridDim.y * gridDim.z;
    unsigned sum, cnt, mine, sp = 0u;
    for (;;) {
        sum = 0u; cnt = 0u; mine = 0u;
#pragma unroll
        for (unsigned j = 0; j < 16; ++j) { const unsigned c = xb_ld(&bar[XB_XCNT(j)]); sum += c; cnt += (c > 0u) ? 1u : 0u; mine = (j == x) ? c : mine; }
        if (sum == G) break;
        __builtin_amdgcn_s_sleep(1);
        if ((++sp & 255u) == 0u) { if (xb_ld(&bar[XB_TMO])) break; if (sp > XB_SPIN_CAP) { atomicAdd(&bar[XB_TMO], 1u); break; } }
    }
    nloc = mine > 0u ? mine : 1u; nx = cnt > 0u ? cnt : 1u;
}
__device__ __forceinline__ void xcd_barrier(const XcdBarrier& b, int wave) {
    asm volatile("s_waitcnt vmcnt(0)" ::: "memory");
    __syncthreads();
    if (wave == 0 && lane_id_fresh() == 0) {
        unsigned long long bar_i = (unsigned long long)(uintptr_t)b.bar; asm volatile("" : "+s"(bar_i));
        unsigned* bar = (unsigned*)(GAS unsigned*)(uintptr_t)bar_i;
        __builtin_amdgcn_s_waitcnt(0);
        unsigned nloc = b.st[0], nx = b.st[1];
        if (nloc == 0u) { xcd_barrier_complete(bar, b.x, nloc, nx); b.st[0] = nloc; b.st[1] = nx; }
        const unsigned old = xb_add(&bar[XB_XSUB(b.x)], 1u);
        const unsigned gen = old / nloc;
        if (old + 1u == (gen + 1u) * nloc) {
            __builtin_amdgcn_fence(__ATOMIC_RELEASE, "agent");
            asm volatile("s_waitcnt vmcnt(0)" ::: "memory");
            const unsigned og = xb_add(&bar[XB_TOP], 1u);
            const unsigned tg = og / nx;
            if (og + 1u == (tg + 1u) * nx) xb_add(&bar[XB_TOPGEN], 1u);
            else XB_SPIN(xb_ld(&bar[XB_TOPGEN]) == tg, bar);
            __builtin_amdgcn_fence(__ATOMIC_ACQUIRE, "agent");
            xb_add(&bar[XB_XGEN(b.x)], 1u);
            asm volatile("s_waitcnt vmcnt(0)" ::: "memory");
        } else {
            XB_SPIN(xb_ld(&bar[XB_XGEN(b.x)]) == gen, bar);
            __builtin_amdgcn_fence(__ATOMIC_ACQUIRE, "agent");
            asm volatile("s_waitcnt vmcnt(0)" ::: "memory");
        }
    }
    __syncthreads();
}

#define LDS_WAIT() asm volatile("s_waitcnt lgkmcnt(0)" ::: "memory")
constexpr int TR_PITCH = 65, TR_BYTES = 64 * TR_PITCH * 4;
static_assert(8 * TR_BYTES <= RING_BYTES, "transpose scratch");
__device__ __forceinline__ void transpose_item(const float* W, int K, int N, bf16* WT, const float* gain, LAS float* scr, int item, int lane) {
    const int nblk = N / 64, kb = item / nblk, nb = item % nblk, k0 = 64 * kb, n0 = 64 * nb;
    const int lr = lane >> 4, lc = (lane & 15) * 4;
#pragma unroll
    for (int h = 0; h < 2; ++h) {
        f32x4 v[8];
#pragma unroll
        for (int i = 0; i < 8; ++i) v[i] = *(const f32x4*)(W + (size_t)(k0 + 32 * h + 4 * i + lr) * N + n0 + lc);
#pragma unroll
        for (int i = 0; i < 8; ++i) { const int kk = 32 * h + 4 * i + lr; const float gk = gain ? gain[k0 + kk] : 1.f; LAS float* d = scr + kk * TR_PITCH + lc;
            d[0] = v[i].x * gk; d[1] = v[i].y * gk; d[2] = v[i].z * gk; d[3] = v[i].w * gk; }
    }
    LDS_WAIT(); asm volatile("" ::: "memory");
    const int c = lane & 7;
#pragma unroll
    for (int j = 0; j < 8; ++j) { const int n = (lane >> 3) + 8 * j; const LAS float* s = scr + (8 * c) * TR_PITCH + n;
        u32x4 o; o.x = cvt_pk_bf16(s[0 * TR_PITCH], s[1 * TR_PITCH]); o.y = cvt_pk_bf16(s[2 * TR_PITCH], s[3 * TR_PITCH]); o.z = cvt_pk_bf16(s[4 * TR_PITCH], s[5 * TR_PITCH]); o.w = cvt_pk_bf16(s[6 * TR_PITCH], s[7 * TR_PITCH]);
        *(u32x4*)(WT + (size_t)(n0 + n) * K + k0 + 8 * c) = o; }
    LDS_WAIT(); asm volatile("" ::: "memory");
}
__device__ __forceinline__ void convert_matrix(const float* W, int K, int N, bf16* WT, const float* gain, LAS float* scr, int gw, int NGW, int lane) {
    const int nitems = (K / 64) * (N / 64);
    for (int it = gw; it < nitems; it += NGW) transpose_item(W, K, N, WT, gain, scr, it, lane);
}
__device__ __forceinline__ void init_row_2048(const float* xrow, bf16* xh, float* ssp, int lane) {
    const f32x4* xr = (const f32x4*)xrow + lane;
    u32x2 w[8]; float s = 0.f;
#pragma unroll
    for (int j = 0; j < 8; ++j) { const f32x4 v = xr[64 * j]; w[j].x = cvt_pk_bf16(v.x, v.y); w[j].y = cvt_pk_bf16(v.z, v.w);
        const float y0 = bflo(w[j].x), y1 = bfhi(w[j].x), y2 = bflo(w[j].y), y3 = bfhi(w[j].y); s += (y0 * y0 + y1 * y1) + (y2 * y2 + y3 * y3); }
    s = wave_sum(s);
    u32x2* oh = (u32x2*)xh + lane;
#pragma unroll
    for (int j = 0; j < 8; ++j) oh[64 * j] = w[j];
    if (lane < 32) ssp[lane] = (lane == 0) ? s : 0.f;
}
__device__ __forceinline__ void init_rows2_2048(const float* xrow0, const float* xrow1, bf16* xh0, bf16* xh1, float* ssp0, float* ssp1, int lane) {
    f32x4 v0[8], v1[8];
#pragma unroll
    for (int j = 0; j < 8; ++j) { v0[j] = ((const f32x4*)xrow0 + lane)[64 * j]; v1[j] = ((const f32x4*)xrow1 + lane)[64 * j]; }
#pragma unroll
    for (int i = 0; i < 2; ++i) { u32x2 w[8]; float s = 0.f;
#pragma unroll
        for (int j = 0; j < 8; ++j) { const f32x4 v = i ? v1[j] : v0[j]; w[j].x = cvt_pk_bf16(v.x, v.y); w[j].y = cvt_pk_bf16(v.z, v.w);
            const float y0 = bflo(w[j].x), y1 = bfhi(w[j].x), y2 = bflo(w[j].y), y3 = bfhi(w[j].y); s += (y0 * y0 + y1 * y1) + (y2 * y2 + y3 * y3); }
        s = wave_sum(s);
        u32x2* oh = (u32x2*)(i ? xh1 : xh0) + lane;
#pragma unroll
        for (int j = 0; j < 8; ++j) oh[64 * j] = w[j];
        if (lane < 32) (i ? ssp1 : ssp0)[lane] = (lane == 0) ? s : 0.f; }
}
__device__ __forceinline__ void norm_row_2048(const float* xrow, const float* g, bf16* orow, float* copy, int lane) {
    const f32x4* xr = (const f32x4*)xrow + lane;
    f32x4 v[8]; float s = 0.f;
#pragma unroll
    for (int j = 0; j < 8; ++j) { v[j] = xr[64 * j]; s += (v[j].x * v[j].x + v[j].y * v[j].y) + (v[j].z * v[j].z + v[j].w * v[j].w); }
    const float rstd = 1.f / sqrtf(wave_sum(s) * (1.f / 2048.f) + EPS);
    if (copy) {
#pragma unroll
        for (int j = 0; j < 8; ++j) ((f32x4*)copy + lane)[64 * j] = v[j]; }
    u32x2* o8 = (u32x2*)orow + lane;
#pragma unroll
    for (int j = 0; j < 8; ++j) { const f32x4 gg = ((const f32x4*)g + lane)[64 * j]; u32x2 w; w.x = cvt_pk_bf16(v[j].x * rstd * gg.x, v[j].y * rstd * gg.y); w.y = cvt_pk_bf16(v[j].z * rstd * gg.z, v[j].w * rstd * gg.w); o8[64 * j] = w; }
}
__device__ __forceinline__ void final_norm_row(const bf16* xh, float* orow, const float* g, float ss, int lane) {
    const float rstd = 1.f / sqrtf(ss * (1.f / 2048.f) + EPS);
    const u32x2* ph = (const u32x2*)xh + lane; f32x4* po = (f32x4*)orow + lane;
#pragma unroll
    for (int j = 0; j < 8; ++j) { const u32x2 h = ph[64 * j]; const f32x4 gg = ((const f32x4*)g + lane)[64 * j];
        f32x4 o; o.x = bflo(h.x) * rstd * gg.x; o.y = bfhi(h.x) * rstd * gg.y; o.z = bflo(h.y) * rstd * gg.z; o.w = bfhi(h.y) * rstd * gg.w;
        po[64 * j] = o; }
}
template <int R>
__device__ __forceinline__ void final_norm_rows(const bf16* xh, float* out, const f32x4 (&gg)[8], const float* ssf, int m0, int mstep, int lane) {
    u32x2 h[R][8]; float ssv[R];
#pragma unroll
    for (int i = 0; i < R; ++i) { const size_t m = (size_t)(m0 + i * mstep); const u32x2* ph = (const u32x2*)(xh + m * DM) + lane;
        ssv[i] = lane < 32 ? ssf[m * 32 + lane] : 0.f;
#pragma unroll
        for (int j = 0; j < 8; ++j) h[i][j] = ph[64 * j]; }
#pragma unroll
    for (int i = 0; i < R; ++i) { const size_t m = (size_t)(m0 + i * mstep); f32x4* po = (f32x4*)(out + m * DM) + lane;
        const float rstd = 1.f / sqrtf(wave_sum(ssv[i]) * (1.f / 2048.f) + EPS);
#pragma unroll
        for (int j = 0; j < 8; ++j) { f32x4 o; o.x = bflo(h[i][j].x) * rstd * gg[j].x; o.y = bfhi(h[i][j].x) * rstd * gg[j].y; o.z = bflo(h[i][j].y) * rstd * gg[j].z; o.w = bfhi(h[i][j].y) * rstd * gg[j].w;
            po[64 * j] = o; } }
}
__device__ __forceinline__ void even_row_fix(bf16* row, int pos, const float* qn, const float* kvn, const float* gqn, const float* gkn, const float* tab_mla, int lane) {
    const float* cosm = tab_mla; const float* sinm = tab_mla + 4096 * 32;
#pragma unroll
    for (int part = 0; part < 2; ++part) {
        u32x4* p = (u32x4*)(row + part * 512) + lane; const u32x4 w = *p; const float* g = (part ? kvn : qn) + lane * 8;
        float x[8] = {bflo(w.x), bfhi(w.x), bflo(w.y), bfhi(w.y), bflo(w.z), bfhi(w.z), bflo(w.w), bfhi(w.w)};
        float s = 0.f;
#pragma unroll
        for (int e = 0; e < 8; ++e) s += x[e] * x[e];
        const float rstd = 1.f / sqrtf(wave_sum(s) * (1.f / 512.f) + EPS);
        const f32x4 g0 = *(const f32x4*)g, g1 = *(const f32x4*)(g + 4);
        u32x4 o; o.x = cvt_pk_bf16(x[0] * rstd * g0.x, x[1] * rstd * g0.y); o.y = cvt_pk_bf16(x[2] * rstd * g0.z, x[3] * rstd * g0.w);
        o.z = cvt_pk_bf16(x[4] * rstd * g1.x, x[5] * rstd * g1.y); o.w = cvt_pk_bf16(x[6] * rstd * g1.z, x[7] * rstd * g1.w);
        *p = o;
    }
    { bf16* p = row + 1024 + lane; const float x = bf2f(*p); const float y = other_half(x, lane < 32); const int f = lane & 31;
      const float c = cosm[pos * 32 + f], s = sinm[pos * 32 + f];
      const float r = (lane < 32) ? (x * c - y * s) : (x * c + y * s);
      *p = (bf16)(cvt_pk_bf16(r, 0.f) & 0xffffu); }
    const int prow = pos >> 6, pcol = pos & 63;
    const int e0 = 2 * lane, f0 = e0 & 31; const int tp = (e0 < 64) ? prow : pcol;
    const float c0 = cosm[tp * 32 + f0], s0 = sinm[tp * 32 + f0], c1 = cosm[tp * 32 + f0 + 1], s1 = sinm[tp * 32 + f0 + 1];
    const bool first = ((e0 & 32) == 0);
#pragma unroll 2
    for (int h = 0; h < 10; ++h) {
        unsigned* p = (unsigned*)(row + (h < 8 ? 1088 + h * 128 : 2112 + (h - 8) * 128)) + lane; const unsigned w = *p; const float* g = (h < 8 ? gqn : gkn) + e0;
        float x0 = bflo(w), x1 = bfhi(w);
        const float rstd = 1.f / sqrtf(wave_sum(x0 * x0 + x1 * x1) * (1.f / 128.f) + EPS);
        x0 = x0 * rstd * g[0]; x1 = x1 * rstd * g[1];
        const float y0 = swz_xor<16>(x0), y1 = swz_xor<16>(x1);
        const float r0 = first ? (x0 * c0 - y0 * s0) : (x0 * c0 + y0 * s0);
        const float r1 = first ? (x1 * c1 - y1 * s1) : (x1 * c1 + y1 * s1);
        *p = cvt_pk_bf16(r0, r1);
    }
}
__device__ __forceinline__ void even_row_fix_k(bf16* row, int pos, const float* gkn, const float* tab_mla, int lane) {
    const float* cosm = tab_mla; const float* sinm = tab_mla + 4096 * 32;
    { bf16* p = row + 1024 + lane; const float x = bf2f(*p); const float y = other_half(x, lane < 32); const int f = lane & 31;
      const float c = cosm[pos * 32 + f], s = sinm[pos * 32 + f];
      const float r = (lane < 32) ? (x * c - y * s) : (x * c + y * s);
      *p = (bf16)(cvt_pk_bf16(r, 0.f) & 0xffffu); }
    const int prow = pos >> 6, pcol = pos & 63;
    const int e0 = 2 * lane, f0 = e0 & 31; const int tp = (e0 < 64) ? prow : pcol;
    const float c0 = cosm[tp * 32 + f0], s0 = sinm[tp * 32 + f0], c1 = cosm[tp * 32 + f0 + 1], s1 = sinm[tp * 32 + f0 + 1];
    const bool first = ((e0 & 32) == 0);
#pragma unroll
    for (int h = 0; h < 2; ++h) {
        unsigned* p = (unsigned*)(row + 2112 + h * 128) + lane; const unsigned w = *p; const float* g = gkn + e0;
        float x0 = bflo(w), x1 = bfhi(w);
        const float rstd = 1.f / sqrtf(wave_sum(x0 * x0 + x1 * x1) * (1.f / 128.f) + EPS);
        x0 = x0 * rstd * g[0]; x1 = x1 * rstd * g[1];
        const float y0 = swz_xor<16>(x0), y1 = swz_xor<16>(x1);
        const float r0 = first ? (x0 * c0 - y0 * s0) : (x0 * c0 + y0 * s0);
        const float r1 = first ? (x1 * c1 - y1 * s1) : (x1 * c1 + y1 * s1);
        *p = cvt_pk_bf16(r0, r1);
    }
}
template <int R>
__device__ __forceinline__ void even_rows_fix_k(bf16* proj, int m0, int mstep, const float* gkn, const float* tab_mla, int lane) {
    const float* cosm = tab_mla; const float* sinm = tab_mla + 4096 * 32;
    const int f = lane & 31, e0 = 2 * lane, f0 = e0 & 31; const bool first = ((e0 & 32) == 0);
    const float g0 = gkn[e0], g1 = gkn[e0 + 1];
    unsigned short kx[R]; unsigned w0[R], w1[R]; float kc[R], ks[R], c0[R], s0[R], c1[R], s1[R];
#pragma unroll
    for (int i = 0; i < R; ++i) { const int m = m0 + i * mstep, pos = m & (SEQ - 1); bf16* row = proj + (size_t)m * AB_PAD;
        kx[i] = *(row + 1024 + lane); kc[i] = cosm[pos * 32 + f]; ks[i] = sinm[pos * 32 + f];
        const int tp = (e0 < 64) ? (pos >> 6) : (pos & 63);
        c0[i] = cosm[tp * 32 + f0]; s0[i] = sinm[tp * 32 + f0]; c1[i] = cosm[tp * 32 + f0 + 1]; s1[i] = sinm[tp * 32 + f0 + 1];
        w0[i] = *((const unsigned*)(row + 2112) + lane); w1[i] = *((const unsigned*)(row + 2112 + 128) + lane); }
#pragma unroll
    for (int i = 0; i < R; ++i) { const int m = m0 + i * mstep; bf16* row = proj + (size_t)m * AB_PAD;
        { const float x = bf2f(kx[i]); const float y = other_half(x, lane < 32);
          const float r = (lane < 32) ? (x * kc[i] - y * ks[i]) : (x * kc[i] + y * ks[i]);
          *(row + 1024 + lane) = (bf16)(cvt_pk_bf16(r, 0.f) & 0xffffu); }
#pragma unroll
        for (int h = 0; h < 2; ++h) { const unsigned w = h ? w1[i] : w0[i];
            float x0 = bflo(w), x1 = bfhi(w);
            const float rstd = 1.f / sqrtf(wave_sum(x0 * x0 + x1 * x1) * (1.f / 128.f) + EPS);
            x0 = x0 * rstd * g0; x1 = x1 * rstd * g1;
            const float y0 = swz_xor<16>(x0), y1 = swz_xor<16>(x1);
            const float r0 = first ? (x0 * c0[i] - y0 * s0[i]) : (x0 * c0[i] + y0 * s0[i]);
            const float r1 = first ? (x1 * c1[i] - y1 * s1[i]) : (x1 * c1[i] + y1 * s1[i]);
            *((unsigned*)(row + 2112 + h * 128) + lane) = cvt_pk_bf16(r0, r1); } }
}
__device__ __forceinline__ void mla_q_rope_row(bf16* row, int pos, const float* tab_mla, int lane) {
    const int h = lane >> 3, s4 = (lane & 7) * 4;
    u32x2* p1 = (u32x2*)(row + h * 192 + 128 + s4); u32x2* p2 = (u32x2*)(row + h * 192 + 160 + s4);
    const u32x2 w1 = *p1, w2 = *p2;
    const f32x4 c = *(const f32x4*)(tab_mla + pos * 32 + s4), s = *(const f32x4*)(tab_mla + 4096 * 32 + pos * 32 + s4);
    const float x1[4] = {bflo(w1.x), bfhi(w1.x), bflo(w1.y), bfhi(w1.y)}, x2[4] = {bflo(w2.x), bfhi(w2.x), bflo(w2.y), bfhi(w2.y)};
    float a[4], b[4];
#pragma unroll
    for (int e = 0; e < 4; ++e) { a[e] = x1[e] * c[e] - x2[e] * s[e]; b[e] = x2[e] * c[e] + x1[e] * s[e]; }
    u32x2 o1, o2; o1.x = cvt_pk_bf16(a[0], a[1]); o1.y = cvt_pk_bf16(a[2], a[3]); o2.x = cvt_pk_bf16(b[0], b[1]); o2.y = cvt_pk_bf16(b[2], b[3]);
    *p1 = o1; *p2 = o2;
}
__device__ __forceinline__ void rope1d_row(bf16* row, int pos, const float* tab_1d, int lane) {
    const int h = lane >> 3, s8 = (lane & 7) * 8;
    u32x4* p1 = (u32x4*)(row + h * 128 + s8); u32x4* p2 = (u32x4*)(row + h * 128 + 64 + s8);
    const u32x4 w1 = *p1, w2 = *p2;
    const float* ct = tab_1d + pos * 64 + s8; const float* st = tab_1d + 4096 * 64 + pos * 64 + s8;
    const f32x4 c0 = *(const f32x4*)ct, c1 = *(const f32x4*)(ct + 4), s0 = *(const f32x4*)st, s1 = *(const f32x4*)(st + 4);
    const float c[8] = {c0.x, c0.y, c0.z, c0.w, c1.x, c1.y, c1.z, c1.w}, s[8] = {s0.x, s0.y, s0.z, s0.w, s1.x, s1.y, s1.z, s1.w};
    const float x1[8] = {bflo(w1.x), bfhi(w1.x), bflo(w1.y), bfhi(w1.y), bflo(w1.z), bfhi(w1.z), bflo(w1.w), bfhi(w1.w)};
    const float x2[8] = {bflo(w2.x), bfhi(w2.x), bflo(w2.y), bfhi(w2.y), bflo(w2.z), bfhi(w2.z), bflo(w2.w), bfhi(w2.w)};
    float a[8], b[8];
#pragma unroll
    for (int e = 0; e < 8; ++e) { a[e] = x1[e] * c[e] - x2[e] * s[e]; b[e] = x2[e] * c[e] + x1[e] * s[e]; }
    u32x4 o1, o2; o1.x = cvt_pk_bf16(a[0], a[1]); o1.y = cvt_pk_bf16(a[2], a[3]); o1.z = cvt_pk_bf16(a[4], a[5]); o1.w = cvt_pk_bf16(a[6], a[7]);
    o2.x = cvt_pk_bf16(b[0], b[1]); o2.y = cvt_pk_bf16(b[2], b[3]); o2.z = cvt_pk_bf16(b[4], b[5]); o2.w = cvt_pk_bf16(b[6], b[7]);
    *p1 = o1; *p2 = o2;
}
__device__ __forceinline__ void rope1d_rows4(bf16* base, size_t ld, int m0, int mstep, const float* tab_1d, int lane) {
    const int h = lane >> 3, s8 = (lane & 7) * 8;
    u32x4 w1[4], w2[4]; f32x4 c0[4], c1[4], s0[4], s1[4];
#pragma unroll
    for (int i = 0; i < 4; ++i) { const int m = m0 + i * mstep, pos = m & (SEQ - 1); bf16* row = base + (size_t)m * ld;
        w1[i] = *(const u32x4*)(row + h * 128 + s8); w2[i] = *(const u32x4*)(row + h * 128 + 64 + s8);
        const float* ct = tab_1d + pos * 64 + s8; const float* st = tab_1d + 4096 * 64 + pos * 64 + s8;
        c0[i] = *(const f32x4*)ct; c1[i] = *(const f32x4*)(ct + 4); s0[i] = *(const f32x4*)st; s1[i] = *(const f32x4*)(st + 4); }
#pragma unroll
    for (int i = 0; i < 4; ++i) { const int m = m0 + i * mstep; bf16* row = base + (size_t)m * ld;
        const float c[8] = {c0[i].x, c0[i].y, c0[i].z, c0[i].w, c1[i].x, c1[i].y, c1[i].z, c1[i].w}, s[8] = {s0[i].x, s0[i].y, s0[i].z, s0[i].w, s1[i].x, s1[i].y, s1[i].z, s1[i].w};
        const float x1[8] = {bflo(w1[i].x), bfhi(w1[i].x), bflo(w1[i].y), bfhi(w1[i].y), bflo(w1[i].z), bfhi(w1[i].z), bflo(w1[i].w), bfhi(w1[i].w)};
        const float x2[8] = {bflo(w2[i].x), bfhi(w2[i].x), bflo(w2[i].y), bfhi(w2[i].y), bflo(w2[i].z), bfhi(w2[i].z), bflo(w2[i].w), bfhi(w2[i].w)};
        float a[8], b[8];
#pragma unroll
        for (int e = 0; e < 8; ++e) { a[e] = x1[e] * c[e] - x2[e] * s[e]; b[e] = x2[e] * c[e] + x1[e] * s[e]; }
        u32x4 o1, o2; o1.x = cvt_pk_bf16(a[0], a[1]); o1.y = cvt_pk_bf16(a[2], a[3]); o1.z = cvt_pk_bf16(a[4], a[5]); o1.w = cvt_pk_bf16(a[6], a[7]);
        o2.x = cvt_pk_bf16(b[0], b[1]); o2.y = cvt_pk_bf16(b[2], b[3]); o2.z = cvt_pk_bf16(b[4], b[5]); o2.w = cvt_pk_bf16(b[6], b[7]);
        *(u32x4*)(row + h * 128 + s8) = o1; *(u32x4*)(row + h * 128 + 64 + s8) = o2; }
}
__device__ __forceinline__ void diff_combine_row(const bf16* oc, bf16* out, float lam, float post, const float* subln, int lane) {
    const f32x4 g = *(const f32x4*)(subln + lane * 4);
#pragma unroll
    for (int h = 0; h < 4; ++h) {
        const u32x2 w0 = *((const u32x2*)(oc + h * 512) + lane), w1 = *((const u32x2*)(oc + h * 512 + 256) + lane);
        float d[4] = {bflo(w0.x) - lam * bflo(w1.x), bfhi(w0.x) - lam * bfhi(w1.x), bflo(w0.y) - lam * bflo(w1.y), bfhi(w0.y) - lam * bfhi(w1.y)};
        const float rstd = 1.f / sqrtf(wave_sum((d[0] * d[0] + d[1] * d[1]) + (d[2] * d[2] + d[3] * d[3])) * (1.f / 256.f) + EPS);
        u32x2 o; o.x = cvt_pk_bf16(d[0] * rstd * g.x * post, d[1] * rstd * g.y * post); o.y = cvt_pk_bf16(d[2] * rstd * g.z * post, d[3] * rstd * g.w * post);
        *((u32x2*)(out + h * 256) + lane) = o;
    }
}
template <int R>
__device__ __forceinline__ void diff_combine_rows(const bf16* ocb, bf16* outb, size_t ldo, int m0, int mstep, float lam, float post, const float* subln, int lane) {
    const f32x4 g = *(const f32x4*)(subln + lane * 4);
    u32x2 w0[R][4], w1[R][4];
#pragma unroll
    for (int i = 0; i < R; ++i) { const bf16* oc = ocb + (size_t)(m0 + i * mstep) * 2048;
#pragma unroll
        for (int h = 0; h < 4; ++h) { w0[i][h] = *((const u32x2*)(oc + h * 512) + lane); w1[i][h] = *((const u32x2*)(oc + h * 512 + 256) + lane); } }
#pragma unroll
    for (int i = 0; i < R; ++i) { bf16* out = outb + (size_t)(m0 + i * mstep) * ldo;
#pragma unroll
        for (int h = 0; h < 4; ++h) { const u32x2 a = w0[i][h], b = w1[i][h];
            float d[4] = {bflo(a.x) - lam * bflo(b.x), bfhi(a.x) - lam * bfhi(b.x), bflo(a.y) - lam * bflo(b.y), bfhi(a.y) - lam * bfhi(b.y)};
            const float rstd = 1.f / sqrtf(wave_sum((d[0] * d[0] + d[1] * d[1]) + (d[2] * d[2] + d[3] * d[3])) * (1.f / 256.f) + EPS);
            u32x2 o; o.x = cvt_pk_bf16(d[0] * rstd * g.x * post, d[1] * rstd * g.y * post); o.y = cvt_pk_bf16(d[2] * rstd * g.z * post, d[3] * rstd * g.w * post);
            *((u32x2*)(out + h * 256) + lane) = o; } }
}
__device__ __forceinline__ void sincos_d(double a, double& sn, double& cs) {
    const double k = __builtin_rint(a * 0.15915494309189533577);
    const double r = __builtin_fma(-k, 6.283185307179586476925, a) - k * 2.4492935982947064e-16 * 0.0;
    const double r2 = r * r;
    double s = -1.0 / 51090942171709440000.0;
    s = s * r2 + 1.0 / 121645100408832000.0; s = s * r2 - 1.0 / 355687428096000.0; s = s * r2 + 1.0 / 1307674368000.0; s = s * r2 - 1.0 / 6227020800.0;
    s = s * r2 + 1.0 / 39916800.0; s = s * r2 - 1.0 / 362880.0; s = s * r2 + 1.0 / 5040.0; s = s * r2 - 1.0 / 120.0; s = s * r2 + 1.0 / 6.0; s = s * r2 - 1.0;
    sn = -s * r;
    double c = 1.0 / 1124000727777607680000.0;
    c = c * r2 - 1.0 / 2432902008176640000.0; c = c * r2 + 1.0 / 6402373705728000.0; c = c * r2 - 1.0 / 20922789888000.0; c = c * r2 + 1.0 / 87178291200.0;
    c = c * r2 - 1.0 / 479001600.0; c = c * r2 + 1.0 / 3628800.0; c = c * r2 - 1.0 / 40320.0; c = c * r2 + 1.0 / 720.0; c = c * r2 - 1.0 / 24.0; c = c * r2 + 0.5; c = c * r2 - 1.0;
    cs = -c;
}

__device__ __forceinline__ void* ld_ptr(LAS unsigned long long* P, int i) {
    const unsigned long long v = P[i];
    const unsigned lo = __builtin_amdgcn_readfirstlane((unsigned)v), hi = __builtin_amdgcn_readfirstlane((unsigned)(v >> 32));
    return (void*)(GAS void*)(uintptr_t)(((unsigned long long)hi << 32) | lo);
}
struct Args { const float* in[27]; float* out; unsigned char* ws; int ph_lo, ph_hi; };
enum { I_XP = 0, I_XS, I_MP, I_MS, I_NORM_MIX, I_W_IN_AB, I_MLA_QN, I_W_QB, I_MLA_KVN, I_W_KVB, I_GQA_QN, I_GQA_KN, I_W_OUT_AB, I_W_IN_CD, I_RPB, I_DLAM, I_SUBLN, I_W_OUT_CD,
       I_NORM_XA, I_NORM_MEM, I_W_XQ, I_W_XKV, I_W_XO, I_NORM_MLP, I_W_UP, I_W_DOWN, I_FINAL };

__global__ void __launch_bounds__(512, 2) fwd(Args args) {
    extern __shared__ __attribute__((aligned(16))) unsigned char lds_raw[];
    LAS unsigned char* lds = (LAS unsigned char*)lds_raw;
    volatile LAS unsigned* MISC = (volatile LAS unsigned*)(lds + MISC_OFF);
    const int tid0 = threadIdx.x, wave = __builtin_amdgcn_readfirstlane(tid0 >> 6);
    const int G = gridDim.x; const int bx = blockIdx.x; const int vcu = (G % 8 == 0) ? (bx % 8) * (G / 8) + bx / 8 : bx;
    const int gw = vcu * 8 + wave, NGW = G * 8;
    for (int u = tid0; u < (LDS_BYTES - RING_BYTES) / 4; u += 512) ((LAS unsigned*)(lds + RING_BYTES))[u] = 0u;
    __syncthreads();
    LAS unsigned long long* PTRS = (LAS unsigned long long*)(lds + PTR_OFF);
    if (tid0 == 0) {
#pragma unroll
        for (int i = 0; i < 27; ++i) PTRS[i] = (unsigned long long)(uintptr_t)args.in[i];
        PTRS[27] = (unsigned long long)(uintptr_t)args.out; PTRS[28] = (unsigned long long)(uintptr_t)args.ws;
    }
    const int lo = args.ph_lo, hi = args.ph_hi; int ph = 0;
    __syncthreads();
#define INP(i) ((const float*)ld_ptr(PTRS, (i)))
#define WSP ((unsigned char*)ld_ptr(PTRS, 28))
#define XP ((float*)ld_ptr(PTRS, 27))
    XcdBarrier bar = xcd_barrier_post((unsigned*)(WSP + WS_CTL) + CW_BAR, MISC + 8, wave);
#ifndef PH_MASK
#define PH_MASK 0xffffffffu
#endif
#define PEN(k) (((PH_MASK) >> (k)) & 1u)
#ifndef PROBE_REP
#define PROBE_REP 0u
#endif
#define REPS(k) (1 + (int)(((PROBE_REP) >> (k)) & 1u))
#define PH_ON (ph >= lo && ph < hi)
#define PH_LANE const int lane = lane_id_fresh(), tid = wave * 64 + lane; (void)tid; (void)lane; int gw_s_ = gw; asm volatile("" : "+s"(gw_s_)); const int gw = gw_s_; (void)gw
#define PH_END do { if (ph >= lo && ph + 1 < hi) xcd_barrier(bar, wave); ++ph; } while (0)

#define X XP
#define H ((bf16*)(WSP + WS_H))
#define BIG (WSP + WS_BIG)
#define WB (WSP + WS_WB)
#define tab_mla ((float*)(WSP + WS_TAB_MLA))
#define tab_1d ((float*)(WSP + WS_TAB_1D))
#define MN ((bf16*)(WSP + WS_MN))
#define MKV ((bf16*)(WSP + WS_MKV))
#define HFIN H
#define PSQ(i) ((float*)(WSP + WS_PS + (size_t)(i) * PS_BYTES))
#define PSC(i) ((float*)(WSP + WS_PS + 3 * PS_BYTES + (size_t)(i) * PSC_BYTES))
#define XBH ((bf16*)XP)
#define XBA XBH
    LAS float* scr = (LAS float*)(lds + wave * TR_BYTES);

    if (PH_ON && PEN(0)) for (int rep_ = 0; rep_ < REPS(0); ++rep_) { PH_LANE;
        const int gt = vcu * 512 + tid, NT_ = G * 512;
        for (int i = gt; i < 4096 * 32; i += NT_) { const int pos = i >> 5, f = i & 31; double inv = 1.0; for (int k = 0; k < f; ++k) inv *= 0.7498942093324558273;
            const float ang = (float)pos * (float)inv; double sn, cs; sincos_d((double)ang, sn, cs); tab_mla[i] = (float)cs; tab_mla[4096 * 32 + i] = (float)sn; }
        for (int i = gt; i < 4096 * 64; i += NT_) { const int pos = i >> 6, f = i & 63; double inv = 1.0; for (int k = 0; k < f; ++k) inv *= 0.8659643233600653524;
            const float ang = (float)pos * (float)inv; double sn, cs; sincos_d((double)ang, sn, cs); tab_1d[i] = (float)cs; tab_1d[4096 * 64 + i] = (float)sn; }
        float* ss0 = PSQ(0);
        int m = gw;
        for (; m + NGW < T; m += 2 * NGW) { const int m1 = m + NGW;
            const float* src0 = (m < T_PROMPT) ? INP(I_XP) + (size_t)m * DM : INP(I_XS) + (size_t)(m - T_PROMPT) * DM;
            const float* src1 = (m1 < T_PROMPT) ? INP(I_XP) + (size_t)m1 * DM : INP(I_XS) + (size_t)(m1 - T_PROMPT) * DM;
            init_rows2_2048(src0, src1, XBH + (size_t)m * DM, XBH + (size_t)m1 * DM, ss0 + (size_t)m * 32, ss0 + (size_t)m1 * 32, lane); }
        for (; m < T; m += NGW) { const float* src = (m < T_PROMPT) ? INP(I_XP) + (size_t)m * DM : INP(I_XS) + (size_t)(m - T_PROMPT) * DM;
            init_row_2048(src, XBH + (size_t)m * DM, ss0 + (size_t)m * 32, lane); }
    }

    for (int layer = 0; layer < DEPTH; ++layer) {
        const int j = layer >> 1; const bool even = (layer & 1) == 0;
#define W_IN ((bf16*)(WB + WB_IN))
#define W_QB ((bf16*)(WB + WB_QB))
#define W_KVB ((bf16*)(WB + WB_KVB))
#define W_OUT ((bf16*)(WB + WB_OUT))
#define W_XQ ((bf16*)(WB + WB_XQ))
#define W_XKV ((bf16*)(WB + WB_XKV))
#define W_XO ((bf16*)(WB + WB_XO))
#define W_UP ((bf16*)(WB + WB_UP))
#define W_DOWN ((bf16*)(WB + WB_DOWN))

#define CONVERT_LATE do { __syncthreads(); { PH_LANE; \
            convert_matrix((even ? INP(I_W_OUT_AB) : INP(I_W_OUT_CD)) + (size_t)j * DM * DM, DM, DM, W_OUT, nullptr, scr, gw, NGW, lane); \
            convert_matrix(INP(I_W_XQ) + (size_t)layer * DM * 512, DM, 512, W_XQ, INP(I_NORM_XA) + layer * DM, scr, gw, NGW, lane); \
            convert_matrix(INP(I_W_XKV) + (size_t)layer * DM * 1024, DM, 1024, W_XKV, nullptr, scr, gw, NGW, lane); \
            convert_matrix(INP(I_W_XO) + (size_t)layer * 512 * DM, 512, DM, W_XO, nullptr, scr, gw, NGW, lane); \
            convert_matrix(INP(I_W_UP) + (size_t)layer * DM * DFF, DM, DFF, W_UP, INP(I_NORM_MLP) + layer * DM, scr, gw, NGW, lane); \
            convert_matrix(INP(I_W_DOWN) + (size_t)layer * DFF * DM, DFF, DM, W_DOWN, nullptr, scr, gw, NGW, lane); } __syncthreads(); } while (0)
#define CONV_SLOT (bx % ((NSEQ * 8 * 16 / G) < 6 ? ((NSEQ * 8 * 16 / G) < 1 ? 1 : (NSEQ * 8 * 16 / G)) : 6))
        if (PH_ON && PEN(1)) for (int rep_ = 0; rep_ < REPS(1); ++rep_) { PH_LANE;
            const float* gmix = INP(I_NORM_MIX) + layer * DM;
            if (even) {
                convert_matrix(INP(I_W_IN_AB) + (size_t)j * DM * AB_IN, DM, AB_IN, W_IN, gmix, scr, gw, NGW, lane);
                for (size_t i = (size_t)gw * 64 + lane; i < (size_t)(AB_PAD - AB_IN) * DM / 8; i += (size_t)NGW * 64) { u32x4 z = (u32x4){0u, 0u, 0u, 0u}; asm volatile("" : "+v"(z)); ((u32x4*)(W_IN + (size_t)AB_IN * DM))[i] = z; }
                convert_matrix(INP(I_W_QB) + (size_t)j * 512 * 1536, 512, 1536, W_QB, INP(I_MLA_QN) + j * 512, scr, gw, NGW, lane);
                convert_matrix(INP(I_W_KVB) + (size_t)j * 512 * 2048, 512, 2048, W_KVB, INP(I_MLA_KVN) + j * 512, scr, gw, NGW, lane);
            } else {
                convert_matrix(INP(I_W_IN_CD) + (size_t)j * DM * CD_IN, DM, CD_IN, W_IN, gmix, scr, gw, NGW, lane);
            }
            const float* gm = INP(I_NORM_MEM) + layer * DM;
            for (int r = gw; r < TM; r += NGW) { const float* src = (r < 8 * MEMLEN) ? INP(I_MP) + (size_t)r * DM : INP(I_MS) + (size_t)(r - 8 * MEMLEN) * DM;
                norm_row_2048(src, gm, MN + (size_t)r * DM, nullptr, lane); }
        }
        PH_END;

        if (even) {
            bf16* PROJ = (bf16*)(BIG + BIG_PROJ); bf16* Q = (bf16*)(BIG + BIG_Q); bf16* KV = (bf16*)(BIG + BIG_KV);
            if (PH_ON && PEN(2)) for (int rep_ = 0; rep_ < REPS(2); ++rep_) { PH_LANE;
                pg8::Gemm g{XBH, W_IN, T, AB_PAD, DM, DM, DM}; pg8::StaticOrder S; S.init(T, AB_PAD, G, bx, 3);
                pg8::EpiBf16<0, 32> E{PROJ, AB_PAD, 0, 0, PSQ(0), 1.f / 2048.f, PSC(0), PSC_BYTES / 4};
                pg8::gemm_phase(lds, g, S, E, wave);
            }
            PH_END;
            if (PH_ON && PEN(3)) for (int rep_ = 0; rep_ < REPS(3); ++rep_) { PH_LANE;
                const float* gkn = INP(I_GQA_KN) + j * 128;
                int m = gw;
                for (; m + 7 * NGW < T; m += 8 * NGW) even_rows_fix_k<8>(PROJ, m, NGW, gkn, tab_mla, lane);
                for (; m < T; m += NGW) even_row_fix_k(PROJ + (size_t)m * AB_PAD, m & (SEQ - 1), gkn, tab_mla, lane);
            }
            if (PH_ON && PEN(4)) for (int rep_ = 0; rep_ < REPS(4); ++rep_) { PH_LANE;
#pragma unroll 1
                for (int gi = 0; gi < 2; ++gi) {
                    pg8::Gemm g{PROJ + (gi ? 512 : 0), gi ? W_KVB : W_QB, T, gi ? 2048 : 1536, 512, AB_PAD, 512}; pg8::StaticOrder S; S.init(T, g.N, G, bx, 4);
                    pg8::EpiBf16<0, 8> E{gi ? KV : Q, g.N, 0, 0, PSC(gi), 1.f / 512.f, nullptr, 0};
                    pg8::gemm_phase(lds, g, S, E, wave);
                }
            }
            PH_END;
            if (PH_ON) {
                for (int rep_ = 0; rep_ < REPS(6); ++rep_)
                for (int u = vcu, it_ = 0; u < NSEQ * 8 * 16; u += G, ++it_) { const int qb = u & 15, h = (u >> 4) & 7, b = u >> 7; const size_t t0 = (size_t)b * SEQ;
                    att::dense_unit<192, 1, 1>(Q + (t0 + qb * 256) * 1536 + h * 192, 1536, KV + t0 * 2048 + h * 256, 2048, PROJ + t0 * AB_PAD + 1024, AB_PAD,
                                         KV + t0 * 2048 + h * 256 + 128, 2048, H + (t0 + qb * 256) * DM + h * 128, DM, SEQ, (LAS char*)lds, wave, qb * 256, tab_mla, nullptr);
                    if (rep_ == 0 && it_ == CONV_SLOT) CONVERT_LATE; }
                for (int rep_ = 0; rep_ < REPS(21); ++rep_)
                for (int u = vcu; u < NSEQ * 8 * 16; u += G) { const int qb = u & 15, h = (u >> 4) & 7, b = u >> 7; const size_t t0 = (size_t)b * SEQ; const int kvh = h >> 2;
                    att::dense_unit3<3>(PROJ + (t0 + qb * 256) * AB_PAD + 1088 + h * 128, AB_PAD, PROJ + t0 * AB_PAD + 2112 + kvh * 128, AB_PAD,
                                         PROJ + t0 * AB_PAD + 2368 + kvh * 128, AB_PAD, H + (t0 + qb * 256) * DM + 1024 + h * 128, DM, SEQ, (LAS char*)lds, wave, qb * 256, tab_mla, INP(I_GQA_QN) + j * 128); }
            }
            PH_END;
        } else {
            bf16* NQ = (bf16*)(BIG + 0 * BIG_SPLIT); bf16* NK = (bf16*)(BIG + 1 * BIG_SPLIT); bf16* NV = (bf16*)(BIG + 2 * BIG_SPLIT);
            bf16* DQ = (bf16*)(BIG + 3 * BIG_SPLIT); bf16* DK = (bf16*)(BIG + 4 * BIG_SPLIT); bf16* DV = (bf16*)(BIG + 5 * BIG_SPLIT); bf16* OC = NQ;
            if (PH_ON && PEN(7)) for (int rep_ = 0; rep_ < REPS(7); ++rep_) { PH_LANE;
                pg8::Gemm g{XBH, W_IN, T, CD_IN, DM, DM, DM}; pg8::StaticOrder S; S.init(T, CD_IN, G, bx, 4);
                pg8::EpiBf16<0, 32> E{NQ, 1024, 1024, BIG_SPLIT / 2, PSQ(0), 1.f / 2048.f, nullptr, 0};
                pg8::gemm_phase(lds, g, S, E, wave);
            }
            PH_END;
            if (PH_ON && PEN(9)) for (int rep_ = 0; rep_ < REPS(9); ++rep_) { PH_LANE;
                const float* rpb = INP(I_RPB) + (size_t)j * 8 * 465;
                const int nslot = (NSEQ * 8 * 16 / G) < 6 ? ((NSEQ * 8 * 16 / G) < 1 ? 1 : (NSEQ * 8 * 16 / G)) : 6;
                for (int u = vcu, it_ = 0; u < NSEQ * 8 * 16; u += G, ++it_) { const int qb = u & 15, h = (u >> 4) & 7, b = u >> 7; const size_t t0 = (size_t)b * SEQ;
                    att::na_unit2(NQ + (t0 + qb * 256) * 1024 + h * 128, 1024, NK + t0 * 1024 + h * 128, NV + t0 * 1024 + h * 128, 1024,
                                 H + (t0 + qb * 256) * DM + h * 128, DM, qb * 4, rpb + h * 465, (LAS char*)lds, wave);
                    if (rep_ == 0 && PEN(8) && it_ == bx % nslot) {
                        int m = gw;
                        for (; m + 3 * NGW < T; m += 4 * NGW) rope1d_rows4(DK, 1024, m, NGW, tab_1d, lane);
                        for (; m < T; m += NGW) rope1d_row(DK + (size_t)m * 1024, m & (SEQ - 1), tab_1d, lane);
                    } }
            }
            PH_END;
            if (PH_ON && PEN(10)) for (int rep_ = 0; rep_ < REPS(10); ++rep_) { PH_LANE;
                const float* lp = INP(I_DLAM) + j * 512;
                const float a0 = lp[lane] * lp[128 + lane] + lp[64 + lane] * lp[128 + 64 + lane], a1 = lp[256 + lane] * lp[384 + lane] + lp[256 + 64 + lane] * lp[384 + 64 + lane];
                const float lam_init = (layer == 1) ? 0.35550906759096934f : 0.5560582041556406f;
                const float lam = expf(wave_sum(a0)) - expf(wave_sum(a1)) + lam_init;
                const float* subln = INP(I_SUBLN) + j * 256;
                const int npair = NSEQ * 4 * 16, nps = (npair / G) < 3 ? ((npair / G) < 1 ? 1 : (npair / G)) : 3;
                for (int p = vcu, it_ = 0; p < npair; p += G, ++it_) { const int qb = p & 15, h = (p >> 4) & 3, b = p >> 6; const size_t t0 = (size_t)b * SEQ;
                    bf16* oc0 = OC + (t0 + qb * 256) * 2048 + h * 512;
                    att::DiffFuse df{oc0, H + (t0 + qb * 256) * DM + 1024 + h * 256, DM, lam, 1.f - lam_init, subln};
                    att::dense_unit_dv256<0>(DQ + (t0 + qb * 256) * 1024 + (2 * h) * 128, 1024, DK + t0 * 1024 + (2 * h) * 128, 1024, DV + t0 * 1024 + h * 256, 1024,
                                             oc0, 2048, SEQ, (LAS char*)lds, wave, qb * 256, tab_1d, df);
                    att::dense_unit_dv256<1>(DQ + (t0 + qb * 256) * 1024 + (2 * h + 1) * 128, 1024, DK + t0 * 1024 + (2 * h + 1) * 128, 1024, DV + t0 * 1024 + h * 256, 1024,
                                             oc0, 2048, SEQ, (LAS char*)lds, wave, qb * 256, tab_1d, df);
                    if (rep_ == 0 && it_ == bx % nps) CONVERT_LATE; }
            }
            PH_END;
        }
        if (PH_ON && PEN(12)) for (int rep_ = 0; rep_ < REPS(12); ++rep_) { PH_LANE;
            pg8::Gemm g{H, W_OUT, T, DM, DM, DM, DM}; pg8::StaticOrder S; S.init(T, DM, G, bx, 4);
            pg8::EpiResidX E{XBH, XBH, PSQ(1), DM, (rep_ == REPS(12) - 1) ? 1.f : 0.f};
            pg8::gemm_phase(lds, g, S, E, wave, ((bx >> 3) & 7) * SKEW_TICKS);
        }
        PH_END;
        {
            bf16* XQ = (bf16*)(BIG + BIG_XQ); bf16* XO = (bf16*)(BIG + BIG_XO);
            if (PH_ON && PEN(14)) for (int rep_ = 0; rep_ < REPS(14); ++rep_) { PH_LANE;
#pragma unroll 1
                for (int gi = 0; gi < 2; ++gi) {
                    pg8::Gemm g{gi ? MN : XBA, gi ? W_XKV : W_XQ, gi ? TM : T, gi ? 1024 : 512, DM, DM, DM}; pg8::StaticOrder S; S.init(g.M, g.N, G, gi ? (bx + (G >> 1)) % G : bx);
                    pg8::EpiBf16<0, 32> E{gi ? MKV : XQ, g.N, 0, 0, PSQ(1), 1.f / 2048.f, nullptr, 0, gi};
                    pg8::gemm_phase(lds, g, S, E, wave);
                }
            }
            PH_END;
            if (PH_ON && PEN(15)) for (int rep_ = 0; rep_ < REPS(15); ++rep_) { PH_LANE;
                for (int u = vcu; u < NSEQ * 4 * 16; u += G) { const int qb = u & 15, h = (u >> 4) & 3, b = u >> 6; const size_t t0 = (size_t)b * SEQ;
                    att::dense_unit3<0>(XQ + (t0 + qb * 256) * 512 + h * 128, 512, MKV + (size_t)b * MEMLEN * 1024 + h * 128, 1024,
                                         MKV + (size_t)b * MEMLEN * 1024 + 512 + h * 128, 1024, XO + (t0 + qb * 256) * 512 + h * 128, 512, MEMLEN, (LAS char*)lds, wave, 0, nullptr, nullptr); }
            }
            PH_END;
            if (PH_ON && PEN(16)) for (int rep_ = 0; rep_ < REPS(16); ++rep_) { PH_LANE;
                pg8::Gemm g{XO, W_XO, T, DM, 512, 512, 512}; pg8::StaticOrder S; S.init(T, DM, G, bx, 4);
                pg8::EpiResidX E{XBH, XBH, PSQ(2), DM, (rep_ == REPS(16) - 1) ? 1.f : 0.f};
                pg8::gemm_phase(lds, g, S, E, wave, ((bx >> 3) & 7) * SKEW_TICKS);
            }
            PH_END;
        }
        {
#pragma unroll 1
            for (int ch = -1; ch < N_MLP_CHUNKS; ++ch) {
                if (PH_ON && PEN(19)) for (int rep_ = 0; rep_ < REPS(19); ++rep_) { PH_LANE;
                    if (ch >= 0) {
                        pg8::Gemm g{(bf16*)(BIG + (size_t)(ch & 1) * U_BYTES), W_DOWN, MLP_CHUNK, DM, DFF, DFF, DFF}; pg8::StaticOrder S; S.init(MLP_CHUNK, DM, G, bx, 4);
                        const size_t co = (size_t)ch * MLP_CHUNK * DM; const bool lastl = (layer == DEPTH - 1);
                        pg8::EpiResidX E{XBH + co, (lastl ? HFIN : XBH) + co, PSQ(0) + (size_t)ch * MLP_CHUNK * 32, DM, (rep_ == REPS(19) - 1) ? 1.f : 0.f};
                        pg8::gemm_phase(lds, g, S, E, wave);
                    }
                    if (ch + 1 < N_MLP_CHUNKS) { const int cn = ch + 1;
                        pg8::Gemm g{XBA + (size_t)cn * MLP_CHUNK * DM, W_UP, MLP_CHUNK, DFF, DM, DM, DM}; pg8::StaticOrder S; S.init(MLP_CHUNK, DFF, G, bx, 8);
                        pg8::EpiBf16<2, 32> E{(bf16*)(BIG + (size_t)(cn & 1) * U_BYTES), DFF, 0, 0, PSQ(2) + (size_t)cn * MLP_CHUNK * 32, 1.f / 2048.f, nullptr, 0};
                        pg8::gemm_phase(lds, g, S, E, wave);
                    }
                }
                PH_END;
            }
        }
    }
    if (PH_ON && PEN(20)) for (int rep_ = 0; rep_ < REPS(20); ++rep_) { PH_LANE; const float* g = INP(I_FINAL); const float* ssf = PSQ(0);
        f32x4 gg[8];
#pragma unroll
        for (int jj = 0; jj < 8; ++jj) gg[jj] = ((const f32x4*)g + lane)[64 * jj];
        int m = gw;
        for (; m + 3 * NGW < T; m += 4 * NGW) final_norm_rows<4>(HFIN, X, gg, ssf, m, NGW, lane);
        for (; m < T; m += NGW) final_norm_row(HFIN + (size_t)m * DM, X + (size_t)m * DM, g, wave_sum(lane < 32 ? ssf[(size_t)m * 32 + lane] : 0.f), lane); }
#undef PH_ON
#undef PH_END
}

extern "C" void kernel_launch(void* const* d_in, const int* in_sizes, int n_in, void* d_out, int out_size, void* d_ws, size_t ws_size, hipStream_t stream) {
    static int grid = 0;
    if (grid == 0) {
        if (n_in != 27 || out_size != T * DM || ws_size < WS_END) { fprintf(stderr, "kernel_launch: shape mismatch: n_in %d out %d ws %zu (need %zu)\n", n_in, out_size, ws_size, (size_t)WS_END); grid = -1; return; }
        int dev = 0, cus = 0, per_cu = 0;
        if (hipGetDevice(&dev) != hipSuccess || hipDeviceGetAttribute(&cus, hipDeviceAttributeMultiprocessorCount, dev) != hipSuccess) { grid = -1; return; }
        if (hipFuncSetAttribute((const void*)fwd, hipFuncAttributeMaxDynamicSharedMemorySize, LDS_BYTES) != hipSuccess) { fprintf(stderr, "kernel_launch: hipFuncSetAttribute failed\n"); grid = -1; return; }
        if (hipOccupancyMaxActiveBlocksPerMultiprocessor(&per_cu, (const void*)fwd, 512, LDS_BYTES) != hipSuccess || per_cu < 1) { fprintf(stderr, "kernel_launch: occupancy query says %d\n", per_cu); }
        (void)hipGetLastError();
        grid = cus;
    }
    if (grid < 0) return;
    if (hipMemsetAsync((char*)d_ws + WS_CTL, 0, CTL_ZERO_BYTES, stream) != hipSuccess) return;
    Args a{};
    for (int i = 0; i < 27; ++i) a.in[i] = (const float*)d_in[i];
    a.out = (float*)d_out; a.ws = (unsigned char*)d_ws; a.ph_lo = 0; a.ph_hi = 1 << 30;
    hipLaunchKernelGGL(fwd, dim3(grid), dim3(512), LDS_BYTES, stream, a);
    const hipError_t le = hipPeekAtLastError();
    if (le != hipSuccess) fprintf(stderr, "kernel_launch: launch failed: %s\n", hipGetErrorName(le));
}
```

```cpp
#include <hip/hip_runtime.h>
#include <cstdio>
#include <cstdint>

#define LAS __attribute__((address_space(3)))
#define GAS __attribute__((address_space(1)))
typedef unsigned short bf16;
typedef short bf16x8 __attribute__((ext_vector_type(8)));
typedef short s16x4 __attribute__((ext_vector_type(4)));
typedef float f32x4 __attribute__((ext_vector_type(4)));
typedef float f32x2 __attribute__((ext_vector_type(2)));
typedef float f32x16 __attribute__((ext_vector_type(16)));
typedef unsigned u32x4 __attribute__((ext_vector_type(4)));
typedef unsigned u32x2 __attribute__((ext_vector_type(2)));

constexpr int DM = 2048, SEQ = 4096, NSEQ = 12, T = NSEQ * SEQ  , T_PROMPT = 8 * SEQ;
constexpr int DEPTH = 4, MEMLEN = 256, TM = NSEQ * MEMLEN  ;
constexpr int AB_IN = 2624, AB_PAD = 2816, CD_IN = 6144, DFF = 8192;
constexpr int MLP_CHUNK = 8192, N_MLP_CHUNKS = T / MLP_CHUNK;
constexpr size_t U_BYTES = (size_t)MLP_CHUNK * DFF * 2;
constexpr float EPS = 1e-6f;

__device__ __forceinline__ unsigned cvt_pk_bf16(float lo, float hi) { unsigned r; asm volatile("v_cvt_pk_bf16_f32 %0, %1, %2" : "=v"(r) : "v"(lo), "v"(hi)); return r; }
__device__ __forceinline__ float bf2f(unsigned short b) { return __builtin_bit_cast(float, ((unsigned)b) << 16); }
__device__ __forceinline__ float bflo(unsigned w) { return __builtin_bit_cast(float, w << 16); }
__device__ __forceinline__ float bfhi(unsigned w) { return __builtin_bit_cast(float, w & 0xffff0000u); }
__device__ __forceinline__ int lane_id_fresh() { int l; asm volatile("v_mbcnt_lo_u32_b32 %0, -1, 0\n\tv_mbcnt_hi_u32_b32 %0, -1, %0" : "=v"(l)); return l; }
template <int XOR> __device__ __forceinline__ float swz_xor(float v) { return __builtin_bit_cast(float, __builtin_amdgcn_ds_swizzle(__builtin_bit_cast(int, v), (XOR << 10) | 0x1f)); }
__device__ __forceinline__ float wave_sum(float v) {
    v += swz_xor<1>(v); v += swz_xor<2>(v); v += swz_xor<4>(v); v += swz_xor<8>(v); v += swz_xor<16>(v);
    auto rr = __builtin_amdgcn_permlane32_swap(__float_as_uint(v), __float_as_uint(v), false, false);
    return __uint_as_float(rr[0]) + __uint_as_float(rr[1]);
}
__device__ __forceinline__ float other_half(float v, bool lower) {
    auto rr = __builtin_amdgcn_permlane32_swap(__float_as_uint(v), __float_as_uint(v), false, false);
    return lower ? __uint_as_float(rr[1]) : __uint_as_float(rr[0]);
}

namespace pg8 {
constexpr int BM = 256, BK = 64, HALF = 128, HTB = HALF * BK * 2, STAGE_BYTES = 8 * HTB, NXCD = 8, WGM = 8;
__host__ __device__ __forceinline__ int lds_byte(int r, int c) { const int st = (r >> 4) * 2 + (c >> 5), rr = r & 15, cc = c & 31, ob = rr * 64 + cc * 2; return st * 1024 + (ob ^ (((ob >> 9) & 1) << 5)); }
__host__ __device__ __forceinline__ void stage_rc(int b, int& R, int& C) { const int st = b / 1024, sb = b % 1024, swz = sb ^ (((sb >> 9) & 1) << 5); R = (st >> 1) * 16 + swz / 64; C = (st & 1) * 32 + (swz % 64) / 2; }
__host__ __device__ __forceinline__ int perm32(int rho) { const int n = rho >> 4, i = rho & 15; return 8 * (i >> 2) + 4 * n + (i & 3); }

struct Unit { int pm, pn; };
struct Gemm { const bf16* A; const bf16* Bt; int M, N, K, lda, ldb; };

struct StaticOrder {
    int nM, nN, nwg, G, c, wgm;
    __device__ void init(int M, int N, int G_, int c_, int wgm_ = WGM) { nM = M / BM; nN = N / BM; nwg = nM * nN; G = G_; c = c_; wgm = wgm_; }
    __device__ bool next(int i, Unit& u) const {
        const long L = (long)i * G + c; if (L >= nwg) return false;
        int wgid = (int)L; { const int q = nwg / NXCD, r = nwg % NXCD, xcd = wgid % NXCD, off = wgid / NXCD; wgid = (xcd < r ? xcd * (q + 1) : r * (q + 1) + (xcd - r) * q) + off; }
        const int nig = wgm * nN, gid = wgid / nig, fm = gid * wgm, gsz = (nM - fm) < wgm ? (nM - fm) : wgm;
        u.pm = fm + ((wgid % nig) % gsz); u.pn = (wgid % nig) / gsz; return true;
    }
};

template <int W> __device__ __forceinline__ float row_ss(const float* ps, int row, int fq) {
    float s;
    if constexpr (W == 32) { const f32x4 a = *(const f32x4*)(ps + (size_t)row * 32 + fq * 8), b = *(const f32x4*)(ps + (size_t)row * 32 + fq * 8 + 4); s = ((a.x + a.y) + (a.z + a.w)) + ((b.x + b.y) + (b.z + b.w)); }
    else { const f32x2 a = *(const f32x2*)(ps + (size_t)row * 8 + fq * 2); s = a.x + a.y; }
    s += swz_xor<16>(s); s += other_half(s, fq < 2); return s;
}
__device__ __forceinline__ void store_row_sums(const float (&s8)[8], float* slot0, int slots_per_row, int row0, int fq) {
#pragma unroll
    for (int k = 0; k < 2; ++k) {
        const float v = fq == 0 ? s8[4 * k] : (fq == 1 ? s8[4 * k + 1] : (fq == 2 ? s8[4 * k + 2] : s8[4 * k + 3]));
        slot0[(size_t)(row0 + k * HALF + fq * 16) * slots_per_row] = v; }
}
constexpr int RS_LDS_OFF = 135168 + 2048;
template <int ACT  , int RSW> struct EpiBf16 {
    static constexpr bool PERM = true;
    bf16* O; int ldc; int split_cols; size_t split_stride; const float* rs_in; float rs_inv_dim; float* ss_out; size_t ss_stride; int rs_off;
    struct RsPf { f32x4 a[2], b[2]; f32x2 c[2]; };
    __device__ __forceinline__ void rs_issue(RsPf& p, int pm, int wr, int wc, int fr, int fq) const {
#pragma unroll
        for (int ai = 0; ai < 2; ++ai) { const size_t row = (size_t)pm * BM + wr * 64 + fr + ai * HALF + wc * 16;
            if constexpr (RSW == 32) { const float* q = rs_in + row * 32 + fq * 8;
                asm volatile("global_load_dwordx4 %0, %2, off\n\tglobal_load_dwordx4 %1, %2, off offset:16" : "=&v"(p.a[ai]), "=&v"(p.b[ai]) : "v"(q) : "memory"); }
            else { const float* q = rs_in + row * 8 + fq * 2;
                asm volatile("global_load_dwordx2 %0, %1, off" : "=&v"(p.c[ai]) : "v"(q) : "memory"); } }
    }
    template <int NYOUNGER>
    __device__ __forceinline__ void rs_finish(RsPf p, LAS unsigned char* lds, int parity, int wr, int wc, int fr, int fq) const {
        static_assert(NYOUNGER == 8 || NYOUNGER == 16, "count");
        if constexpr (RSW == 32) {
            if constexpr (NYOUNGER == 16) asm volatile("s_waitcnt vmcnt(16)" : "+v"(p.a[0]), "+v"(p.b[0]), "+v"(p.a[1]), "+v"(p.b[1]) :: "memory");
            else asm volatile("s_waitcnt vmcnt(8)" : "+v"(p.a[0]), "+v"(p.b[0]), "+v"(p.a[1]), "+v"(p.b[1]) :: "memory");
        } else {
            if constexpr (NYOUNGER == 16) asm volatile("s_waitcnt vmcnt(16)" : "+v"(p.c[0]), "+v"(p.c[1]) :: "memory");
            else asm volatile("s_waitcnt vmcnt(8)" : "+v"(p.c[0]), "+v"(p.c[1]) :: "memory");
        }
        LAS float* rsl = (LAS float*)(lds + RS_LDS_OFF) + parity * 256;
#pragma unroll
        for (int ai = 0; ai < 2; ++ai) { float s;
            if constexpr (RSW == 32) s = ((p.a[ai].x + p.a[ai].y) + (p.a[ai].z + p.a[ai].w)) + ((p.b[ai].x + p.b[ai].y) + (p.b[ai].z + p.b[ai].w)); else s = p.c[ai].x + p.c[ai].y;
            s += swz_xor<16>(s); s += other_half(s, fq < 2);
            const float rs = 1.f / sqrtf(s * rs_inv_dim + EPS);
            if (fq == 0) rsl[wr * 64 + fr + ai * HALF + wc * 16] = rs; }
        asm volatile("s_waitcnt lgkmcnt(0)" ::: "memory");
    }
    __device__ __forceinline__ void operator()(const f32x4 (&acc)[2][2][4][2], const Unit& u, int wr, int wc, int fr, int fq, LAS unsigned char* lds, int parity, const Unit& nx, bool has_next) const {
        RsPf pf; rs_issue(pf, has_next ? nx.pm : u.pm, wr, wc, fr, fq);
        const LAS float* rsl = (const LAS float*)(lds + RS_LDS_OFF) + parity * 256 + wr * 64 + fr;
        const int row0 = u.pm * BM + wr * 64 + fr; int colt = u.pn * BM; bf16* base = O;
        if (split_cols) { const int t = colt / split_cols; base += (size_t)t * split_stride; colt -= t * split_cols; }
        const int col0 = colt + wc * 32 + 8 * fq;
        const bool do_ss = (ss_out != nullptr) && (u.pn < 4);
        float* ssp = do_ss ? ss_out + (size_t)(u.pn >> 1) * ss_stride + (u.pn & 1) * 4 + wc : nullptr;
        float s8[8] = {0.f, 0.f, 0.f, 0.f, 0.f, 0.f, 0.f, 0.f};
#pragma unroll
        for (int ai = 0; ai < 2; ++ai)
#pragma unroll
            for (int m = 0; m < 4; ++m) { const int row = row0 + ai * HALF + m * 16; bf16* rowp = base + (size_t)row * ldc + col0;
                float rs = rsl[ai * HALF + m * 16]; rs = rs_off ? 1.f : rs;
                float ss = 0.f;
#pragma unroll
                for (int bj = 0; bj < 2; ++bj) { f32x4 v0 = acc[ai][bj][m][0] * rs, v1 = acc[ai][bj][m][1] * rs;
                    if (ACT == 2) {
#pragma unroll
                        for (int j = 0; j < 4; ++j) { const float a = fmaxf(v0[j], 0.f), b = fmaxf(v1[j], 0.f); v0[j] = a * a; v1[j] = b * b; } }
                    u32x4 w; w.x = cvt_pk_bf16(v0[0], v0[1]); w.y = cvt_pk_bf16(v0[2], v0[3]); w.z = cvt_pk_bf16(v1[0], v1[1]); w.w = cvt_pk_bf16(v1[2], v1[3]);
                    *(u32x4*)(rowp + bj * HALF) = w;
                    if (do_ss) { const float a0 = bflo(w.x), a1 = bfhi(w.x), a2 = bflo(w.y), a3 = bfhi(w.y), a4 = bflo(w.z), a5 = bfhi(w.z), a6 = bflo(w.w), a7 = bfhi(w.w);
                        ss += (a0 * a0 + a1 * a1) + (a2 * a2 + a3 * a3) + (a4 * a4 + a5 * a5) + (a6 * a6 + a7 * a7); } }
                if (do_ss) { ss += swz_xor<16>(ss); ss += other_half(ss, fq < 2); s8[ai * 4 + m] = ss; } }
        if (do_ss) store_row_sums(s8, ssp, 8, row0, fq);
        rs_finish<16>(pf, lds, parity ^ 1, wr, wc, fr, fq);
    }
};
struct EpiResidX {
    static constexpr bool PERM = true;
    const bf16* XBin; bf16* XBout; float* ps; int ldc; float scale;
    struct RsPf {};
    __device__ __forceinline__ void rs_issue(RsPf&, int, int, int, int, int) const {}
    template <int NYOUNGER> __device__ __forceinline__ void rs_finish(const RsPf&, LAS unsigned char*, int, int, int, int, int) const {}
    __device__ __forceinline__ void operator()(const f32x4 (&acc)[2][2][4][2], const Unit& u, int wr, int wc, int fr, int fq, LAS unsigned char*, int, const Unit&, bool) const {
        const int row0 = u.pm * BM + wr * 64 + fr, col0 = u.pn * BM + wc * 32 + 8 * fq;
        float* psp = ps + u.pn * 4 + wc;
        float s8[8];
        u32x4 ch[2][4][2];
#pragma unroll
        for (int ai = 0; ai < 2; ++ai)
#pragma unroll
            for (int m = 0; m < 4; ++m) { const bf16* q = XBin + (size_t)(row0 + ai * HALF + m * 16) * ldc + col0;
                asm volatile("global_load_dwordx4 %0, %2, off\n\tglobal_load_dwordx4 %1, %2, off offset:256" : "=&v"(ch[ai][m][0]), "=&v"(ch[ai][m][1]) : "v"(q) : "memory"); }
        static_assert(HALF * 2 == 256, "the second load's immediate offset");
#pragma unroll
        for (int ai = 0; ai < 2; ++ai)
#pragma unroll
            for (int m = 0; m < 4; ++m) { const int row = row0 + ai * HALF + m * 16; const size_t off = (size_t)row * ldc + col0;
                float ss = 0.f;
                asm volatile("s_waitcnt vmcnt(14)" : "+v"(ch[ai][m][0]), "+v"(ch[ai][m][1]) :: "memory");
#pragma unroll
                for (int bj = 0; bj < 2; ++bj) { const u32x4 h4 = ch[ai][m][bj]; const f32x4 a0 = acc[ai][bj][m][0] * scale, a1 = acc[ai][bj][m][1] * scale;
                    u32x4 wh; wh.x = cvt_pk_bf16(bflo(h4.x) + a0[0], bfhi(h4.x) + a0[1]); wh.y = cvt_pk_bf16(bflo(h4.y) + a0[2], bfhi(h4.y) + a0[3]);
                    wh.z = cvt_pk_bf16(bflo(h4.z) + a1[0], bfhi(h4.z) + a1[1]); wh.w = cvt_pk_bf16(bflo(h4.w) + a1[2], bfhi(h4.w) + a1[3]);
                    *(u32x4*)(XBout + off + bj * HALF) = wh;
                    const float y0 = bflo(wh.x), y1 = bfhi(wh.x), y2 = bflo(wh.y), y3 = bfhi(wh.y), y4 = bflo(wh.z), y5 = bfhi(wh.z), y6 = bflo(wh.w), y7 = bfhi(wh.w);
                    ss += (y0 * y0 + y1 * y1) + (y2 * y2 + y3 * y3) + (y4 * y4 + y5 * y5) + (y6 * y6 + y7 * y7); }
                ss += swz_xor<16>(ss); ss += other_half(ss, fq < 2); s8[ai * 4 + m] = ss; }
        store_row_sums(s8, psp, 32, row0, fq);
    }
};

template <class Epi>
__device__ __forceinline__ void gemm_phase(LAS unsigned char* lds, const Gemm g, const StaticOrder& S, const Epi& E, int wid, int skew_ticks = 0) {
    if (skew_ticks > 0) {
        const unsigned long long t0 = __builtin_amdgcn_s_memrealtime();
        while (__builtin_amdgcn_s_memrealtime() - t0 < (unsigned long long)skew_ticks) __builtin_amdgcn_s_sleep(8);
    }
    const int lane = lane_id_fresh(), tid = wid * 64 + lane, wr = wid >> 2, wc = wid & 3, fr = lane & 15, fq = lane >> 4;
    const int K = g.K, nt = K / BK;
    unsigned voffA[2], voffB[2];
#pragma unroll
    for (int i = 0; i < 2; ++i) { int R, C; stage_rc(tid * 16 + i * 8192, R, C); const int Rb = Epi::PERM ? ((R & ~31) + perm32(R & 31)) : R;
        voffA[i] = (unsigned)(R * g.lda + C) * 2u; voffB[i] = (unsigned)(Rb * g.ldb + C) * 2u; }
    const size_t kstep = (size_t)(BK * 2);
    const size_t hstepA = (size_t)HALF * g.lda * 2, hstepB = (size_t)HALF * g.ldb * 2;
    const size_t tstepA = 2 * hstepA, tstepB = 2 * hstepB;
    const unsigned ldsw = (unsigned)wid * 1024u;
    const int aoff = lds_byte(wr * 64 + fr, fq * 8), boff = lds_byte(wc * 32 + fr, fq * 8);
#define PG8_SA(b, h) (((b) * 2 + (h)) * HTB)
#define PG8_SB(b, h) ((4 + (b) * 2 + (h)) * HTB)
#define PG8_STAGE(bufoff, gbase, voff) do { _Pragma("unroll") for (int _i = 0; _i < 2; ++_i) \
        __builtin_amdgcn_global_load_lds((const unsigned*)((const char*)(gbase) + (voff)[_i]), (LAS unsigned*)(lds + (bufoff) + ldsw + _i * 8192), 16, 0, 0); } while (0)
#define PG8_LDA(dst, b, h) do { _Pragma("unroll") for (int m = 0; m < 4; ++m) _Pragma("unroll") for (int k = 0; k < 2; ++k) dst[m][k] = *(const LAS bf16x8*)(lds + PG8_SA(b, h) + aoff + m * 2048 + k * 1024); } while (0)
#define PG8_LDB(dst, b, h) do { _Pragma("unroll") for (int n = 0; n < 2; ++n) _Pragma("unroll") for (int k = 0; k < 2; ++k) dst[n][k] = *(const LAS bf16x8*)(lds + PG8_SB(b, h) + boff + n * 2048 + k * 1024); } while (0)
#define PG8_MMA(ai, bj, At, Bt) do { __builtin_amdgcn_s_setprio(1); _Pragma("unroll") for (int m = 0; m < 4; ++m) _Pragma("unroll") for (int n = 0; n < 2; ++n) _Pragma("unroll") for (int k = 0; k < 2; ++k) \
        acc[ai][bj][m][n] = __builtin_amdgcn_mfma_f32_16x16x32_bf16(Bt[n][k], At[m][k], acc[ai][bj][m][n], 0, 0, 0); __builtin_amdgcn_s_setprio(0); } while (0)
#define PG8_WAIT_V(n) asm volatile("s_waitcnt vmcnt(" #n ")" ::: "memory")
#define PG8_WAIT_L(n) asm volatile("s_waitcnt lgkmcnt(" #n ")" ::: "memory")
#define PG8_BAR __builtin_amdgcn_s_barrier()
#define PG8_SCHED __builtin_amdgcn_sched_barrier(0)
    Unit cur, nxt; int ui = 0;
    if (!S.next(0, cur)) return;
    f32x4 acc[2][2][4][2];
#pragma unroll
    for (int a = 0; a < 2; ++a)
#pragma unroll
        for (int b = 0; b < 2; ++b)
#pragma unroll
            for (int m = 0; m < 4; ++m)
#pragma unroll
                for (int n = 0; n < 2; ++n) acc[a][b][m][n] = (f32x4){0.f, 0.f, 0.f, 0.f};
    bf16x8 At[4][2], B0[2][2], B1[2][2];
    const char* cA = (const char*)g.A + (size_t)cur.pm * tstepA; const char* cB = (const char*)g.Bt + (size_t)cur.pn * tstepB;
    typename Epi::RsPf pf0; E.rs_issue(pf0, cur.pm, wr, wc, fr, fq);
    PG8_STAGE(PG8_SB(0, 0), cB, voffB); PG8_STAGE(PG8_SB(0, 1), cB + hstepB, voffB); PG8_STAGE(PG8_SA(0, 0), cA, voffA); PG8_STAGE(PG8_SA(0, 1), cA + hstepA, voffA);
    if (wr == 1) PG8_BAR;
    PG8_WAIT_V(2); PG8_BAR;
    E.template rs_finish<8>(pf0, lds, 0, wr, wc, fr, fq);
    PG8_STAGE(PG8_SB(1, 0), cB + kstep, voffB); PG8_STAGE(PG8_SA(1, 0), cA + kstep, voffA); PG8_STAGE(PG8_SB(1, 1), cB + hstepB + kstep, voffB);
    PG8_WAIT_V(6); PG8_BAR;
    for (;;) {
        const bool has_next = S.next(ui + 1, nxt);
        const char* nA = has_next ? (const char*)g.A + (size_t)nxt.pm * tstepA : cA; const char* nB = has_next ? (const char*)g.Bt + (size_t)nxt.pn * tstepB : cB;
        for (int t = 0; t < nt; t += 2) {
            const bool last = (t == nt - 2);
            const char* a1 = cA + (size_t)(t + 1) * kstep;
            const char* a2 = last ? nA : cA + (size_t)(t + 2) * kstep; const char* b2 = last ? nB : cB + (size_t)(t + 2) * kstep;
            const char* a3 = a2 + kstep; const char* b3 = b2 + kstep;
            PG8_LDB(B0, 0, 0); PG8_LDB(B1, 0, 1); PG8_SCHED; PG8_LDA(At, 0, 0); PG8_STAGE(PG8_SA(1, 1), a1 + hstepA, voffA);
            PG8_WAIT_V(8); PG8_WAIT_L(0); PG8_BAR; PG8_MMA(0, 0, At, B0); PG8_MMA(0, 1, At, B1); PG8_BAR; PG8_SCHED;
            PG8_LDA(At, 0, 1); PG8_STAGE(PG8_SB(0, 0), b2, voffB); PG8_STAGE(PG8_SB(0, 1), b2 + hstepB, voffB); PG8_STAGE(PG8_SA(0, 0), a2, voffA);
            PG8_WAIT_V(8); PG8_WAIT_L(0); PG8_BAR; PG8_MMA(1, 0, At, B0); PG8_MMA(1, 1, At, B1); PG8_BAR; PG8_SCHED;
            PG8_LDB(B0, 1, 0); PG8_LDB(B1, 1, 1); PG8_SCHED; PG8_LDA(At, 1, 0); PG8_STAGE(PG8_SA(0, 1), a2 + hstepA, voffA);
            PG8_WAIT_V(8); PG8_WAIT_L(0); PG8_BAR; PG8_MMA(0, 0, At, B0); PG8_MMA(0, 1, At, B1); PG8_BAR; PG8_SCHED;
            PG8_LDA(At, 1, 1); PG8_STAGE(PG8_SB(1, 0), b3, voffB); PG8_STAGE(PG8_SB(1, 1), b3 + hstepB, voffB); PG8_STAGE(PG8_SA(1, 0), a3, voffA);
            PG8_WAIT_V(8); PG8_WAIT_L(0); PG8_BAR; PG8_MMA(1, 0, At, B0); PG8_MMA(1, 1, At, B1); PG8_BAR; PG8_SCHED;
        }
        if (wr == 0) PG8_BAR;
        E(acc, cur, wr, wc, fr, fq, lds, ui & 1, nxt, has_next);
        if (!has_next) break;
#pragma unroll
        for (int a = 0; a < 2; ++a)
#pragma unroll
            for (int b = 0; b < 2; ++b)
#pragma unroll
                for (int m = 0; m < 4; ++m)
#pragma unroll
                    for (int n = 0; n < 2; ++n) acc[a][b][m][n] = (f32x4){0.f, 0.f, 0.f, 0.f};
        cur = nxt; cA = nA; cB = nB; ++ui;
        if (wr == 1) PG8_BAR;
    }
    PG8_WAIT_V(0);
    PG8_BAR;
#undef PG8_SA
#undef PG8_SB
#undef PG8_STAGE
#undef PG8_LDA
#undef PG8_LDB
#undef PG8_MMA
#undef PG8_WAIT_V
#undef PG8_WAIT_L
#undef PG8_BAR
#undef PG8_SCHED
}
}

namespace att {
#define SBAR() __builtin_amdgcn_sched_barrier(0)
constexpr int SHM_V = 64 * 128 * 2;
__device__ __forceinline__ int crow(int r, int hi) { return (r & 3) + 8 * (r >> 2) + 4 * hi; }
template <int DQK> struct Cfg {
    static constexpr int KP = DQK * 2, SHM_K = 64 * KP, OFF_K = 2 * SHM_V, OFF_WS = OFF_K + 2 * SHM_K, NPARK = (DQK == 192 ? 6 : 0), NREG = DQK / 16 - NPARK, OFF_QS = OFF_WS + 8 * 256, TOTAL = OFF_QS + 8 * 1024 * NPARK;
    static constexpr float SCALE = (DQK == 192) ? 0.07216878364870322f : 0.08838834764831845f;
    static constexpr float C = SCALE * 1.4426950408889634f;
};
constexpr float THR = 8.f;

template <int DQK>
__device__ __forceinline__ void partialSM(f32x16& p0, f32x16& p1, float& m_reg, float& mn, float& alpha) {
    constexpr float C = Cfg<DQK>::C, SCALE = Cfg<DQK>::SCALE;
    float pmax = p0[0];
#pragma unroll
    for (int r = 1; r < 16; ++r) pmax = fmaxf(pmax, p0[r]);
#pragma unroll
    for (int r = 0; r < 16; ++r) pmax = fmaxf(pmax, p1[r]);
    { auto rr = __builtin_amdgcn_permlane32_swap(__float_as_uint(pmax), __float_as_uint(pmax), false, false);
      pmax = fmaxf(__uint_as_float(rr[0]), __uint_as_float(rr[1])); }
    if (__builtin_expect(__all(pmax - m_reg <= THR / SCALE), 1)) { mn = m_reg; alpha = 1.f; }
    else { mn = fmaxf(m_reg, pmax); alpha = __builtin_amdgcn_exp2f((m_reg - mn) * C); m_reg = mn; }
    const float mnC = -mn * C;
#pragma unroll
    for (int r = 0; r < 16; ++r) p0[r] = fmaf(p0[r], C, mnC);
#pragma unroll
    for (int r = 0; r < 16; ++r) p1[r] = fmaf(p1[r], C, mnC);
#pragma unroll
    for (int r = 0; r < 16; ++r) p0[r] = __builtin_amdgcn_exp2f(p0[r]);
}
__device__ __forceinline__ void finishSM(f32x16& p0, f32x16& p1, float alpha, float& l_reg, bf16x8& pa0, bf16x8& pa1, bf16x8& pa2, bf16x8& pa3) {
#pragma unroll
    for (int r = 0; r < 16; ++r) p1[r] = __builtin_amdgcn_exp2f(p1[r]);
    float ps = 0;
#pragma unroll
    for (int r = 0; r < 16; ++r) ps += p0[r];
#pragma unroll
    for (int r = 0; r < 16; ++r) ps += p1[r];
    { auto rr = __builtin_amdgcn_permlane32_swap(__float_as_uint(ps), __float_as_uint(ps), false, false);
      ps = __uint_as_float(rr[0]) + __uint_as_float(rr[1]); }
    l_reg = l_reg * alpha + ps;
#define PK4(P, BASE, OUT) do { unsigned a0 = cvt_pk_bf16(P[BASE + 0], P[BASE + 1]), a1 = cvt_pk_bf16(P[BASE + 2], P[BASE + 3]);   \
    unsigned b0 = cvt_pk_bf16(P[BASE + 4], P[BASE + 5]), b1 = cvt_pk_bf16(P[BASE + 6], P[BASE + 7]);                              \
    auto r0 = __builtin_amdgcn_permlane32_swap(a0, b0, false, false); auto r1 = __builtin_amdgcn_permlane32_swap(a1, b1, false, false); \
    u32x4 w = {r0[0], r1[0], r0[1], r1[1]}; OUT = __builtin_bit_cast(bf16x8, w); } while (0)
    PK4(p0, 0, pa0); PK4(p0, 8, pa1); PK4(p1, 0, pa2); PK4(p1, 8, pa3);
#undef PK4
}
#define KSWZ(KP, row, colB) ((row) * (KP) + ((colB) ^ (((KP) == 256 ? ((row) & 15) : (((row) >> 1) & 7)) << 4)))
template <int DQK, int NREG = Cfg<DQK>::NREG>
__device__ __forceinline__ void qkt(f32x16& p0, f32x16& p1, const LAS char* Ks, const bf16x8* qr, const LAS char* Qs, int r32, int hi) {
    constexpr int KP = Cfg<DQK>::KP;
    p0 = f32x16{}; p1 = f32x16{};
#pragma unroll
    for (int d0 = 0; d0 < DQK / 16; ++d0) { const int cb = (d0 * 16 + hi * 8) * 2;
        const bf16x8 b0 = *(const LAS bf16x8*)(Ks + KSWZ(KP, r32, cb));
        const bf16x8 b1 = *(const LAS bf16x8*)(Ks + KSWZ(KP, 32 + r32, cb));
        bf16x8 q;
        if (d0 < NREG) q = qr[d0]; else q = *(const LAS bf16x8*)(Qs + (d0 - NREG) * 1024);
        p0 = __builtin_amdgcn_mfma_f32_32x32x16_bf16(b0, q, p0, 0, 0, 0);
        p1 = __builtin_amdgcn_mfma_f32_32x32x16_bf16(b1, q, p1, 0, 0, 0); }
}
__device__ __forceinline__ int v_st(int k, int c) { const int kk = (k & ~0xC) | ((k & 4) << 1) | ((k & 8) >> 1); return ((kk >> 3) * 4 + (c >> 5)) * 512 + ((kk & 7) * 32 + (c & 31)) * 2; }
__device__ __forceinline__ int v_rd_base(int lane) { return ((lane & 3) << 3) | (((lane >> 2) & 3) << 6) | (((lane >> 4) & 1) << 5) | (((lane >> 5) & 1) << 8); }
constexpr int v_rd_off(int d0, int ks, int half) { return d0 * 512 + ks * 4096 + half * 2048; }
template <int OFF> __device__ __forceinline__ s16x4 tr_read(int vb) {
    s16x4 r; asm volatile("ds_read_b64_tr_b16 %0, %1 offset:%2" : "=&v"(r) : "v"(vb), "i"(OFF) : "memory"); return r;
}
template <int D0> __device__ __forceinline__ void pv_one(f32x16& od, int vb, bf16x8 pa0, bf16x8 pa1, bf16x8 pa2, bf16x8 pa3) {
    const s16x4 l0 = tr_read<v_rd_off(D0, 0, 0)>(vb), h0 = tr_read<v_rd_off(D0, 0, 1)>(vb), l1 = tr_read<v_rd_off(D0, 1, 0)>(vb), h1 = tr_read<v_rd_off(D0, 1, 1)>(vb);
    const s16x4 l2 = tr_read<v_rd_off(D0, 2, 0)>(vb), h2 = tr_read<v_rd_off(D0, 2, 1)>(vb), l3 = tr_read<v_rd_off(D0, 3, 0)>(vb), h3 = tr_read<v_rd_off(D0, 3, 1)>(vb);
    asm volatile("s_waitcnt lgkmcnt(0)" ::: "memory"); SBAR();
#define PKV(L, H) (bf16x8){L[0], L[1], L[2], L[3], H[0], H[1], H[2], H[3]}
    od = __builtin_amdgcn_mfma_f32_32x32x16_bf16(pa0, PKV(l0, h0), od, 0, 0, 0);
    od = __builtin_amdgcn_mfma_f32_32x32x16_bf16(pa1, PKV(l1, h1), od, 0, 0, 0);
    od = __builtin_amdgcn_mfma_f32_32x32x16_bf16(pa2, PKV(l2, h2), od, 0, 0, 0);
    od = __builtin_amdgcn_mfma_f32_32x32x16_bf16(pa3, PKV(l3, h3), od, 0, 0, 0);
#undef PKV
}
__device__ __forceinline__ void pv_d0(f32x16* o, int vb, bf16x8 pa0, bf16x8 pa1, bf16x8 pa2, bf16x8 pa3) {
    pv_one<0>(o[0], vb, pa0, pa1, pa2, pa3); pv_one<1>(o[1], vb, pa0, pa1, pa2, pa3); pv_one<2>(o[2], vb, pa0, pa1, pa2, pa3); pv_one<3>(o[3], vb, pa0, pa1, pa2, pa3);
}
__device__ __forceinline__ void store_o(const f32x16* o, float l_reg, LAS float* li_l, LAS char* lds, bf16* Ob, int ldo, int wid, int lane, int r32, int hi) {
    if (hi == 0) li_l[r32] = l_reg;
    asm volatile("s_waitcnt lgkmcnt(0)" ::: "memory");
    float rli[16];
#pragma unroll
    for (int r = 0; r < 16; ++r) rli[r] = __builtin_amdgcn_rcpf(li_l[crow(r, hi)]);
    LAS unsigned short* slab = (LAS unsigned short*)(lds + wid * 8192);
#pragma unroll
    for (int r = 0; r < 16; ++r) { const int orow = crow(r, hi);
#pragma unroll
        for (int d0 = 0; d0 < 4; ++d0) slab[orow * 128 + d0 * 32 + r32] = (unsigned short)(cvt_pk_bf16(o[d0][r] * rli[r], 0.f) & 0xffffu); }
    asm volatile("s_waitcnt lgkmcnt(0)" ::: "memory");
#pragma unroll
    for (int i = 0; i < 8; ++i) { const int id = i * 64 + lane, row = id >> 4, c16 = id & 15;
        const u32x4 w = *(const LAS u32x4*)((LAS char*)slab + row * 256 + c16 * 16);
        *(u32x4*)(Ob + (unsigned)(wid * 32 + row) * (unsigned)ldo + c16 * 8) = w; }
}

__device__ __forceinline__ void unpack8(bf16x8 v, float (&x)[8]) {
#pragma unroll
    for (int e = 0; e < 8; ++e) x[e] = bf2f((unsigned short)v[e]);
}
__device__ __forceinline__ bf16x8 pack8(const float (&x)[8]) {
    u32x4 w; w.x = cvt_pk_bf16(x[0], x[1]); w.y = cvt_pk_bf16(x[2], x[3]); w.z = cvt_pk_bf16(x[4], x[5]); w.w = cvt_pk_bf16(x[6], x[7]); return __builtin_bit_cast(bf16x8, w);
}
__device__ __forceinline__ void rope_pair(bf16x8& f1, bf16x8& f2, const float* ct, const float* st, float mul, const float* g1, const float* g2) {
    float x1[8], x2[8], a[8], b[8]; unpack8(f1, x1); unpack8(f2, x2);
    const f32x4 c0 = *(const f32x4*)ct, c1 = *(const f32x4*)(ct + 4), s0 = *(const f32x4*)st, s1 = *(const f32x4*)(st + 4);
    const float c[8] = {c0.x, c0.y, c0.z, c0.w, c1.x, c1.y, c1.z, c1.w}, s[8] = {s0.x, s0.y, s0.z, s0.w, s1.x, s1.y, s1.z, s1.w};
    if (g1) {
        const f32x4 ga = *(const f32x4*)g1, gb = *(const f32x4*)(g1 + 4), gc = *(const f32x4*)g2, gd = *(const f32x4*)(g2 + 4);
        const float gg1[8] = {ga.x, ga.y, ga.z, ga.w, gb.x, gb.y, gb.z, gb.w}, gg2[8] = {gc.x, gc.y, gc.z, gc.w, gd.x, gd.y, gd.z, gd.w};
#pragma unroll
        for (int e = 0; e < 8; ++e) { x1[e] = x1[e] * mul * gg1[e]; x2[e] = x2[e] * mul * gg2[e]; }
    }
#pragma unroll
    for (int e = 0; e < 8; ++e) { a[e] = x1[e] * c[e] - x2[e] * s[e]; b[e] = x2[e] * c[e] + x1[e] * s[e]; }
    f1 = pack8(a); f2 = pack8(b);
}
template <int ND0, int QMODE>
__device__ __forceinline__ void load_q(bf16x8 (&qraw)[ND0], const bf16* __restrict__ Qb, int ldq, int wid, int r32, int hi, int qpos0, const float* __restrict__ tab, const float* __restrict__ qgain) {
    const unsigned qo = (unsigned)(wid * 32 + r32) * (unsigned)ldq + hi * 8;
#pragma unroll
    for (int d0 = 0; d0 < ND0; ++d0) qraw[d0] = *(const bf16x8*)(Qb + qo + d0 * 16);
    const int pos = qpos0 + wid * 32 + r32;
    if constexpr (QMODE == 1) {
        const float* ct = tab + pos * 32 + hi * 8; const float* st = ct + 4096 * 32;
        rope_pair(qraw[8], qraw[10], ct, st, 1.f, nullptr, nullptr); rope_pair(qraw[9], qraw[11], ct + 16, st + 16, 1.f, nullptr, nullptr);
    } else if constexpr (QMODE == 2) {
        const float* ct = tab + pos * 64 + hi * 8; const float* st = ct + 4096 * 64;
#pragma unroll
        for (int g = 0; g < 4; ++g) rope_pair(qraw[g], qraw[g + 4], ct + g * 16, st + g * 16, 1.f, nullptr, nullptr);
    } else if constexpr (QMODE == 3) {
        float ss = 0.f;
#pragma unroll
        for (int d0 = 0; d0 < 8; ++d0) { float x[8]; unpack8(qraw[d0], x);
#pragma unroll
            for (int e = 0; e < 8; ++e) ss += x[e] * x[e]; }
        ss += other_half(ss, hi == 0);
        const float rstd = 1.f / sqrtf(ss * (1.f / 128.f) + EPS);
        const float* ctr = tab + (pos >> 6) * 32 + hi * 8; const float* str = ctr + 4096 * 32; const float* ctc = tab + (pos & 63) * 32 + hi * 8; const float* stc = ctc + 4096 * 32;
        const float* gq = qgain + hi * 8;
#pragma unroll
        for (int g = 0; g < 2; ++g) { rope_pair(qraw[g], qraw[g + 2], ctr + g * 16, str + g * 16, rstd, gq + g * 16, gq + (g + 2) * 16);
                                      rope_pair(qraw[4 + g], qraw[6 + g], ctc + g * 16, stc + g * 16, rstd, gq + (4 + g) * 16, gq + (6 + g) * 16); }
    }
}
template <int DQK, int SDEPTH, int QMODE>
__device__ __forceinline__ void dense_unit(const bf16* __restrict__ Qb, int ldq, const bf16* __restrict__ Kh, int ldk, const bf16* __restrict__ K2h, int ldk2,
                                           const bf16* __restrict__ Vh, int ldv, bf16* __restrict__ Ob, int ldo, int seq, LAS char* lds, int wid,
                                           int qpos0, const float* __restrict__ tab, const float* __restrict__ qgain) {
    using CF = Cfg<DQK>; constexpr int KP = CF::KP, SHM_K = CF::SHM_K, ND0 = DQK / 16;
    const int lane = lane_id_fresh(), tid = wid * 64 + lane, r32 = lane & 31, hi = lane >> 5;
    LAS char* V_lds = lds; LAS char* K_lds = lds + CF::OFF_K;
    LAS float* ws = (LAS float*)(lds + CF::OFF_WS) + wid * 64; LAS float* li_l = ws; LAS float* al_l = ws + 32;
    float m_reg = -1e30f, l_reg = 0; f32x16 o[4] = {}; bf16x8 qr[CF::NREG];
    const LAS char* Qs = lds + CF::OFF_QS + wid * (1024 * CF::NPARK) + lane * 16;
    { bf16x8 qraw[ND0]; load_q<ND0, QMODE>(qraw, Qb, ldq, wid, r32, hi, qpos0, tab, qgain);
#pragma unroll
      for (int d0 = 0; d0 < CF::NREG; ++d0) qr[d0] = qraw[d0];
      if constexpr (CF::NPARK > 0) {
#pragma unroll
          for (int d0 = CF::NREG; d0 < ND0; ++d0) *(LAS bf16x8*)((LAS char*)Qs + (d0 - CF::NREG) * 1024) = qraw[d0]; } }
    const int sr = tid >> 4, sc = (tid & 15) * 8, vst0 = v_st(sr, sc), vst1 = v_st(32 + sr, sc);
    const int kst0 = KSWZ(KP, sr, sc * 2), kst1 = KSWZ(KP, 32 + sr, sc * 2);
    const int kr2 = tid >> 3, c2 = (tid & 7) * 8, kst2 = KSWZ(KP, kr2, (128 + c2) * 2);
    const unsigned vo = (unsigned)sr * (unsigned)ldv + sc, ko = (unsigned)sr * (unsigned)ldk + sc, k2o = (unsigned)kr2 * (unsigned)ldk2 + c2;
    const int vb0 = (int)(unsigned)(uintptr_t)V_lds + v_rd_base(lane);
    struct { bf16x8 vs0, vs1, ks0, ks1, k2; } sr_[SDEPTH];
#define SLOAD(i, k0) do { const bf16* Vt_ = Vh + (size_t)(k0) * ldv; const bf16* Kt_ = Kh + (size_t)(k0) * ldk; \
    sr_[i].vs0 = *(const bf16x8*)(Vt_ + vo); sr_[i].vs1 = *(const bf16x8*)(Vt_ + (size_t)32 * ldv + vo); \
    sr_[i].ks0 = *(const bf16x8*)(Kt_ + ko); sr_[i].ks1 = *(const bf16x8*)(Kt_ + (size_t)32 * ldk + ko); \
    if constexpr (DQK == 192) sr_[i].k2 = *(const bf16x8*)(K2h + (size_t)(k0) * ldk2 + k2o); } while (0)
#define SWRITE(b, i) do { *(LAS bf16x8*)(V_lds + (b) * SHM_V + vst0) = sr_[i].vs0; *(LAS bf16x8*)(V_lds + (b) * SHM_V + vst1) = sr_[i].vs1; \
    *(LAS bf16x8*)(K_lds + (b) * SHM_K + kst0) = sr_[i].ks0; *(LAS bf16x8*)(K_lds + (b) * SHM_K + kst1) = sr_[i].ks1; \
    if constexpr (DQK == 192) *(LAS bf16x8*)(K_lds + (b) * SHM_K + kst2) = sr_[i].k2; } while (0)
#define SWAIT() do { if constexpr (SDEPTH == 1) asm volatile("s_waitcnt vmcnt(0)" ::: "memory"); else if constexpr (DQK == 192) asm volatile("s_waitcnt vmcnt(5)" ::: "memory"); else asm volatile("s_waitcnt vmcnt(4)" ::: "memory"); } while (0)
#define RESC(a) do { if (__any((a) < 1.f)) { if (hi == 0) al_l[r32] = (a); asm volatile("s_waitcnt lgkmcnt(0)" ::: "memory"); \
    _Pragma("unroll") for (int d = 0; d < 4; ++d) _Pragma("unroll") for (int r = 0; r < 16; ++r) o[d][r] *= al_l[crow(r, hi)]; } } while (0)
    f32x16 pA0, pA1, pB0, pB1; float mnA, mnB, alA, alB; bf16x8 pa0, pa1, pa2, pa3; const int NT = seq / 64;
    constexpr int SE = 0, SO = SDEPTH - 1;
    __syncthreads();
    SLOAD(SE, 0); asm volatile("s_waitcnt vmcnt(0)" ::: "memory"); SWRITE(0, SE); __syncthreads();
    qkt<DQK>(pA0, pA1, K_lds, qr, Qs, r32, hi); partialSM<DQK>(pA0, pA1, m_reg, mnA, alA);
    SLOAD(SO, 64); if constexpr (SDEPTH == 2) { if (2 < NT) SLOAD(SE, 128); }
    SWAIT(); SWRITE(1, SO); __syncthreads();
    for (int j = 1; j + 1 < NT; j += 2) {
        SBAR(); qkt<DQK>(pB0, pB1, K_lds + SHM_K, qr, Qs, r32, hi);
        finishSM(pA0, pA1, alA, l_reg, pa0, pa1, pa2, pa3); SBAR();
        SLOAD(SO, (j + SDEPTH) * 64); SBAR();
        pv_d0(o, vb0, pa0, pa1, pa2, pa3); partialSM<DQK>(pB0, pB1, m_reg, mnB, alB);
        __syncthreads(); SWAIT(); SWRITE(0, SE);
        RESC(alB); __syncthreads();
        SBAR(); qkt<DQK>(pA0, pA1, K_lds, qr, Qs, r32, hi);
        finishSM(pB0, pB1, alB, l_reg, pa0, pa1, pa2, pa3); SBAR();
        if (SDEPTH == 1 || j + 3 < NT) SLOAD(SE, (j + 1 + SDEPTH) * 64); SBAR();
        pv_d0(o, vb0 + SHM_V, pa0, pa1, pa2, pa3); partialSM<DQK>(pA0, pA1, m_reg, mnA, alA);
        __syncthreads(); SWAIT(); SWRITE(1, SO);
        RESC(alA); __syncthreads();
    }
    SBAR(); qkt<DQK>(pB0, pB1, K_lds + SHM_K, qr, Qs, r32, hi);
    finishSM(pA0, pA1, alA, l_reg, pa0, pa1, pa2, pa3); SBAR();
    pv_d0(o, vb0, pa0, pa1, pa2, pa3); partialSM<DQK>(pB0, pB1, m_reg, mnB, alB);
    __syncthreads(); RESC(alB);
    finishSM(pB0, pB1, alB, l_reg, pa0, pa1, pa2, pa3); SBAR();
    pv_d0(o, vb0 + SHM_V, pa0, pa1, pa2, pa3);
    __syncthreads();
    store_o(o, l_reg, li_l, lds, Ob, ldo, wid, lane, r32, hi);
#undef SLOAD
#undef SWRITE
#undef SWAIT
}

constexpr int R3_SLOT = 32768, R3_OFF_WS = 3 * R3_SLOT, R3_TOTAL = R3_OFF_WS + 8 * 256;
template <int QMODE>
__device__ __forceinline__ void dense_unit3(const bf16* __restrict__ Qb, int ldq, const bf16* __restrict__ Kh, int ldk, const bf16* __restrict__ Vh, int ldv, bf16* __restrict__ Ob, int ldo, int seq,
                                            LAS char* lds, int wid, int qpos0, const float* __restrict__ tab, const float* __restrict__ qgain) {
    constexpr int KP = 256;
    const int lane = lane_id_fresh(), tid = wid * 64 + lane, r32 = lane & 31, hi = lane >> 5;
    LAS float* ws = (LAS float*)(lds + R3_OFF_WS) + wid * 64; LAS float* li_l = ws; LAS float* al_l = ws + 32;
    float m_reg = -1e30f, l_reg = 0; f32x16 o[4] = {}; bf16x8 qr[8];
    load_q<8, QMODE>(qr, Qb, ldq, wid, r32, hi, qpos0, tab, qgain);
    const int sr = tid >> 4, sc = (tid & 15) * 8, vst0 = v_st(sr, sc), vst1 = v_st(32 + sr, sc);
    const int kst0 = 16384 + KSWZ(KP, sr, sc * 2), kst1 = 16384 + KSWZ(KP, 32 + sr, sc * 2);
    const unsigned vo = (unsigned)sr * (unsigned)ldv + sc, ko = (unsigned)sr * (unsigned)ldk + sc;
    const int vbase = (int)(unsigned)(uintptr_t)lds + v_rd_base(lane);
    struct { bf16x8 vs0, vs1, ks0, ks1; } sr_[2];
#define SLOAD3(i, k0) do { const bf16* Vt_ = Vh + (size_t)(k0) * ldv; const bf16* Kt_ = Kh + (size_t)(k0) * ldk; \
    sr_[i].vs0 = *(const bf16x8*)(Vt_ + vo); sr_[i].vs1 = *(const bf16x8*)(Vt_ + (size_t)32 * ldv + vo); \
    sr_[i].ks0 = *(const bf16x8*)(Kt_ + ko); sr_[i].ks1 = *(const bf16x8*)(Kt_ + (size_t)32 * ldk + ko); } while (0)
#define SWRITE3(soff, i) do { *(LAS bf16x8*)(lds + (soff) + vst0) = sr_[i].vs0; *(LAS bf16x8*)(lds + (soff) + vst1) = sr_[i].vs1; \
    *(LAS bf16x8*)(lds + (soff) + kst0) = sr_[i].ks0; *(LAS bf16x8*)(lds + (soff) + kst1) = sr_[i].ks1; } while (0)
#define SWAIT3() asm volatile("s_waitcnt vmcnt(4)" ::: "memory")
#define RESC3(a) do { if (__any((a) < 1.f)) { if (hi == 0) al_l[r32] = (a); asm volatile("s_waitcnt lgkmcnt(0)" ::: "memory"); \
    _Pragma("unroll") for (int d = 0; d < 4; ++d) _Pragma("unroll") for (int r = 0; r < 16; ++r) o[d][r] *= al_l[crow(r, hi)]; } } while (0)
    f32x16 pA0, pA1, pB0, pB1; float mnA, mnB, alA, alB; bf16x8 pa0, pa1, pa2, pa3; const int NT = seq / 64;
    __syncthreads();
    SLOAD3(0, 0); SLOAD3(1, 64);
    SWAIT3(); SWRITE3(0, 0);
    if (2 < NT) SLOAD3(0, 128);
    __syncthreads();
    qkt<128>(pA0, pA1, lds + 16384, qr, nullptr, r32, hi); partialSM<128>(pA0, pA1, m_reg, mnA, alA);
    SWAIT3(); SWRITE3(R3_SLOT, 1);
    int sK = R3_SLOT, sV = 0, sW = 2 * R3_SLOT;
    for (int t = 1; t + 1 < NT; t += 2) {
        __syncthreads();
        SBAR(); qkt<128>(pB0, pB1, lds + sK + 16384, qr, nullptr, r32, hi);
        finishSM(pA0, pA1, alA, l_reg, pa0, pa1, pa2, pa3); SBAR();
        if (t + 2 < NT) SLOAD3(1, (t + 2) * 64); SBAR();
        pv_d0(o, vbase + sV, pa0, pa1, pa2, pa3); partialSM<128>(pB0, pB1, m_reg, mnB, alB);
        SWAIT3(); SWRITE3(sW, 0);
        RESC3(alB);
        { const int n = sV; sV = sK; sK = sW; sW = n; }
        __syncthreads();
        SBAR(); qkt<128>(pA0, pA1, lds + sK + 16384, qr, nullptr, r32, hi);
        finishSM(pB0, pB1, alB, l_reg, pa0, pa1, pa2, pa3); SBAR();
        if (t + 3 < NT) SLOAD3(0, (t + 3) * 64); SBAR();
        pv_d0(o, vbase + sV, pa0, pa1, pa2, pa3); partialSM<128>(pA0, pA1, m_reg, mnA, alA);
        SWAIT3(); if (t + 2 < NT) SWRITE3(sW, 1);
        RESC3(alA);
        { const int n = sV; sV = sK; sK = sW; sW = n; }
    }
    __syncthreads();
    SBAR(); qkt<128>(pB0, pB1, lds + sK + 16384, qr, nullptr, r32, hi);
    finishSM(pA0, pA1, alA, l_reg, pa0, pa1, pa2, pa3); SBAR();
    pv_d0(o, vbase + sV, pa0, pa1, pa2, pa3); partialSM<128>(pB0, pB1, m_reg, mnB, alB);
    RESC3(alB);
    finishSM(pB0, pB1, alB, l_reg, pa0, pa1, pa2, pa3); SBAR();
    pv_d0(o, vbase + sK, pa0, pa1, pa2, pa3);
    __syncthreads();
    store_o(o, l_reg, li_l, lds, Ob, ldo, wid, lane, r32, hi);
#undef SLOAD3
#undef SWRITE3
#undef SWAIT3
#undef RESC3
}

constexpr int DV_SLOT = 49152, DV_OFF_K = 32768, DV_OFF_WS = 131072, DV_TOTAL = DV_OFF_WS + 8 * 256;
struct DiffFuse { const bf16* O0b; bf16* Hb; int ldh; float lam, post; const float* subln; };
template <int FUSE>
__device__ __forceinline__ void dense_unit_dv256(const bf16* __restrict__ Qb, int ldq, const bf16* __restrict__ Kh, int ldk, const bf16* __restrict__ Vh, int ldv, bf16* __restrict__ Ob, int ldo, int seq,
                                                 LAS char* lds, int wid, int qpos0, const float* __restrict__ tab, const DiffFuse& df) {
    constexpr int KP = 256;
    const int lane = lane_id_fresh(), tid = wid * 64 + lane, r32 = lane & 31, hi = lane >> 5;
    LAS float* ws = (LAS float*)(lds + DV_OFF_WS) + wid * 64; LAS float* li_l = ws; LAS float* al_l = ws + 32;
    __syncthreads();
    float m_reg = -1e30f, l_reg = 0; f32x16 o[8] = {}; bf16x8 qr[4];
    const LAS char* Qs = lds + 2 * DV_SLOT + wid * 4096 + lane * 16;
    { bf16x8 qraw[8]; load_q<8, 2>(qraw, Qb, ldq, wid, r32, hi, qpos0, tab, nullptr);
#pragma unroll
      for (int d0 = 0; d0 < 4; ++d0) qr[d0] = qraw[d0];
#pragma unroll
      for (int d0 = 4; d0 < 8; ++d0) *(LAS bf16x8*)((LAS char*)Qs + (d0 - 4) * 1024) = qraw[d0]; }
    const int sr = tid >> 4, sc = (tid & 15) * 8, vst0 = v_st(sr, sc), vst1 = v_st(32 + sr, sc);
    const int kst0 = DV_OFF_K + KSWZ(KP, sr, sc * 2), kst1 = DV_OFF_K + KSWZ(KP, 32 + sr, sc * 2);
    const unsigned vo = (unsigned)sr * (unsigned)ldv + sc, ko = (unsigned)sr * (unsigned)ldk + sc;
    const int vbase = (int)(unsigned)(uintptr_t)lds + v_rd_base(lane);
    bf16x8 sv0, sv1, sv2, sv3, sk0, sk1;
#define DLOAD(k0) do { const bf16* Vt_ = Vh + (size_t)(k0) * ldv; const bf16* Kt_ = Kh + (size_t)(k0) * ldk; \
    sv0 = *(const bf16x8*)(Vt_ + vo); sv1 = *(const bf16x8*)(Vt_ + (size_t)32 * ldv + vo); sv2 = *(const bf16x8*)(Vt_ + vo + 128); sv3 = *(const bf16x8*)(Vt_ + (size_t)32 * ldv + vo + 128); \
    sk0 = *(const bf16x8*)(Kt_ + ko); sk1 = *(const bf16x8*)(Kt_ + (size_t)32 * ldk + ko); } while (0)
#define DWRITE(soff) do { *(LAS bf16x8*)(lds + (soff) + vst0) = sv0; *(LAS bf16x8*)(lds + (soff) + vst1) = sv1; *(LAS bf16x8*)(lds + (soff) + 16384 + vst0) = sv2; *(LAS bf16x8*)(lds + (soff) + 16384 + vst1) = sv3; \
    *(LAS bf16x8*)(lds + (soff) + kst0) = sk0; *(LAS bf16x8*)(lds + (soff) + kst1) = sk1; } while (0)
    const int NT = seq / 64;
    __syncthreads();
    DLOAD(0); asm volatile("s_waitcnt vmcnt(0)" ::: "memory"); DWRITE(0);
    __syncthreads();
    int sC = 0, sN = DV_SLOT;
    for (int t = 0; t < NT; ++t) {
        f32x16 p0, p1; float mn, al; bf16x8 pa0, pa1, pa2, pa3;
        SBAR(); qkt<128, 4>(p0, p1, lds + sC + DV_OFF_K, qr, Qs, r32, hi);
        partialSM<128>(p0, p1, m_reg, mn, al);
        if (__any(al < 1.f)) { if (hi == 0) al_l[r32] = al; asm volatile("s_waitcnt lgkmcnt(0)" ::: "memory");
#pragma unroll
            for (int d = 0; d < 8; ++d)
#pragma unroll
                for (int r = 0; r < 16; ++r) o[d][r] *= al_l[crow(r, hi)]; }
        finishSM(p0, p1, al, l_reg, pa0, pa1, pa2, pa3); SBAR();
        if (t + 1 < NT) DLOAD((t + 1) * 64);
        SBAR();
        pv_d0(o, vbase + sC, pa0, pa1, pa2, pa3);
        pv_d0(o + 4, vbase + sC + 16384, pa0, pa1, pa2, pa3);
        if (t + 1 < NT) { asm volatile("s_waitcnt vmcnt(0)" ::: "memory"); DWRITE(sN); }
        __syncthreads();
        { const int n = sC; sC = sN; sN = n; }
    }
    u32x4 w0[FUSE ? 16 : 1];
    if constexpr (FUSE == 1) {
#pragma unroll
        for (int i = 0; i < 16; ++i) { const int row = (i * 64 + lane) >> 5; w0[i] = *(const u32x4*)(df.O0b + (unsigned)(wid * 32 + row) * (unsigned)ldo + (lane & 31) * 8); } }
    if (hi == 0) li_l[r32] = l_reg;
    asm volatile("s_waitcnt lgkmcnt(0)" ::: "memory");
    float rli[16];
#pragma unroll
    for (int r = 0; r < 16; ++r) rli[r] = __builtin_amdgcn_rcpf(li_l[crow(r, hi)]);
    LAS unsigned short* slab = (LAS unsigned short*)(lds + wid * 16384);
#pragma unroll
    for (int r = 0; r < 16; ++r) { const int orow = crow(r, hi);
#pragma unroll
        for (int d0 = 0; d0 < 8; ++d0) slab[orow * 256 + d0 * 32 + r32] = (unsigned short)(cvt_pk_bf16(o[d0][r] * rli[r], 0.f) & 0xffffu); }
    asm volatile("s_waitcnt lgkmcnt(0)" ::: "memory");
    if constexpr (FUSE == 0) {
#pragma unroll
        for (int i = 0; i < 16; ++i) { const int id = i * 64 + lane, row = id >> 5, c16 = id & 31;
            const u32x4 w = *(const LAS u32x4*)((LAS char*)slab + row * 512 + c16 * 16);
            *(u32x4*)(Ob + (unsigned)(wid * 32 + row) * (unsigned)ldo + c16 * 8) = w; }
    } else {
        const int c16 = lane & 31;
        const f32x4 g0 = *(const f32x4*)(df.subln + c16 * 8), g1 = *(const f32x4*)(df.subln + c16 * 8 + 4);
        const float gg[8] = {g0.x, g0.y, g0.z, g0.w, g1.x, g1.y, g1.z, g1.w};
#pragma unroll
        for (int i = 0; i < 16; ++i) { const int row = (i * 64 + lane) >> 5;
            const u32x4 w1 = *(const LAS u32x4*)((LAS char*)slab + row * 512 + c16 * 16);
            const u32x4 a = w0[i];
            float d[8] = {bflo(a.x) - df.lam * bflo(w1.x), bfhi(a.x) - df.lam * bfhi(w1.x), bflo(a.y) - df.lam * bflo(w1.y), bfhi(a.y) - df.lam * bfhi(w1.y),
                          bflo(a.z) - df.lam * bflo(w1.z), bfhi(a.z) - df.lam * bfhi(w1.z), bflo(a.w) - df.lam * bflo(w1.w), bfhi(a.w) - df.lam * bfhi(w1.w)};
            float ss = ((d[0] * d[0] + d[1] * d[1]) + (d[2] * d[2] + d[3] * d[3])) + ((d[4] * d[4] + d[5] * d[5]) + (d[6] * d[6] + d[7] * d[7]));
            ss += swz_xor<1>(ss); ss += swz_xor<2>(ss); ss += swz_xor<4>(ss); ss += swz_xor<8>(ss); ss += swz_xor<16>(ss);
            const float rs = df.post / sqrtf(ss * (1.f / 256.f) + EPS);
            u32x4 o4; o4.x = cvt_pk_bf16(d[0] * rs * gg[0], d[1] * rs * gg[1]); o4.y = cvt_pk_bf16(d[2] * rs * gg[2], d[3] * rs * gg[3]);
            o4.z = cvt_pk_bf16(d[4] * rs * gg[4], d[5] * rs * gg[5]); o4.w = cvt_pk_bf16(d[6] * rs * gg[6], d[7] * rs * gg[7]);
            *(u32x4*)(df.Hb + (unsigned)(wid * 32 + row) * (unsigned)df.ldh + c16 * 8) = o4; }
    }
#undef DLOAD
#undef DWRITE
}

constexpr int NA_OFF_K = SHM_V, NA_OFF_RPB = 65536, NA_OFF_WS = 65536 + 2048, NA_TOTAL = NA_OFF_WS + 8 * 256;
__device__ __forceinline__ int clampi(int v, int lo, int hi) { return v < lo ? lo : (v > hi ? hi : v); }
__device__ __forceinline__ void na_unit(const bf16* __restrict__ Qb, int ldq, const bf16* __restrict__ Kseq, const bf16* __restrict__ Vseq, int ldk,
                                        bf16* __restrict__ Ob, int ldo, int r0, const float* __restrict__ rpb_h, LAS char* lds, int wid) {
    constexpr int KP = 256;
    const int lane = lane_id_fresh(), tid = wid * 64 + lane, r32 = lane & 31, hi = lane >> 5;
    LAS char* V_lds = lds; LAS char* K_lds = lds + NA_OFF_K; LAS float* rpb_l = (LAS float*)(lds + NA_OFF_RPB);
    LAS float* ws = (LAS float*)(lds + NA_OFF_WS) + wid * 64; LAS float* li_l = ws; LAS float* al_l = ws + 32;
    float m_reg = -1e30f, l_reg = 0; f32x16 o[4] = {}; bf16x8 qr[8];
    { const unsigned qo = (unsigned)(wid * 32 + r32) * (unsigned)ldq + hi * 8;
#pragma unroll
      for (int d0 = 0; d0 < 8; ++d0) qr[d0] = *(const bf16x8*)(Qb + qo + d0 * 16); }
    const int sr = tid >> 4, sc = (tid & 15) * 8, vst0 = v_st(sr, sc), vst1 = v_st(32 + sr, sc);
    const int kst0 = KSWZ(KP, sr, sc * 2), kst1 = KSWZ(KP, 32 + sr, sc * 2);
    const unsigned ko = (unsigned)sr * (unsigned)ldk + sc;
    const int vb0 = (int)(unsigned)(uintptr_t)V_lds + v_rd_base(lane);
    const int kr_lo = clampi(r0 - 4, 0, 56), kr_hi = clampi(r0 + 3 - 4, 0, 56) + 8;
    const int qrw = r0 + (wid >> 1), srw = clampi(qrw - 4, 0, 56);
    const int qc = (wid & 1) * 32 + r32, scq = clampi(qc - 8, 0, 48);
    __syncthreads();
    if (tid < 465) rpb_l[tid] = rpb_h[tid] * 11.313708498984761f;
    bf16x8 va0, va1, ka0, ka1, vb0_, vb1_, kb0, kb1;
#define NA_LOAD(V0, V1, K0, K1, kr_) do { const bf16* Kt = Kseq + (size_t)((kr_) * 64) * ldk; const bf16* Vt = Vseq + (size_t)((kr_) * 64) * ldk; \
      V0 = *(const bf16x8*)(Vt + ko); V1 = *(const bf16x8*)(Vt + (size_t)32 * ldk + ko); K0 = *(const bf16x8*)(Kt + ko); K1 = *(const bf16x8*)(Kt + (size_t)32 * ldk + ko); } while (0)
#define NA_STEP(V0, V1, K0, K1, kr_) do { \
        __syncthreads();                                            \
        *(LAS bf16x8*)(V_lds + vst0) = V0; *(LAS bf16x8*)(V_lds + vst1) = V1; *(LAS bf16x8*)(K_lds + kst0) = K0; *(LAS bf16x8*)(K_lds + kst1) = K1; \
        __syncthreads(); \
        if ((kr_) + 2 < kr_hi) NA_LOAD(V0, V1, K0, K1, (kr_) + 2);     \
        if ((kr_) >= srw && (kr_) < srw + 8) {                      \
            f32x16 p0, p1; float mn, al; bf16x8 pa0, pa1, pa2, pa3; \
            qkt<128>(p0, p1, K_lds, qr, nullptr, r32, hi); \
            const LAS float* bt = rpb_l + ((kr_) - qrw + 7) * 31 + (15 - qc); \
            _Pragma("unroll") for (int r = 0; r < 16; ++r) { const int kc = crow(r, hi); const bool in = (kc >= scq) && (kc < scq + 16); const float b = bt[in ? kc : qc]; p0[r] = in ? p0[r] + b : -1e30f; } \
            _Pragma("unroll") for (int r = 0; r < 16; ++r) { const int kc = 32 + crow(r, hi); const bool in = (kc >= scq) && (kc < scq + 16); const float b = bt[in ? kc : qc]; p1[r] = in ? p1[r] + b : -1e30f; } \
            partialSM<128>(p0, p1, m_reg, mn, al); \
            RESC(al); \
            finishSM(p0, p1, al, l_reg, pa0, pa1, pa2, pa3); SBAR(); \
            pv_d0(o, vb0, pa0, pa1, pa2, pa3); \
        } } while (0)
    NA_LOAD(va0, va1, ka0, ka1, kr_lo);
    if (kr_lo + 1 < kr_hi) NA_LOAD(vb0_, vb1_, kb0, kb1, kr_lo + 1);
    for (int kr = kr_lo; kr < kr_hi; kr += 2) {
        NA_STEP(va0, va1, ka0, ka1, kr);
        if (kr + 1 < kr_hi) NA_STEP(vb0_, vb1_, kb0, kb1, kr + 1);
    }
#undef NA_LOAD
#undef NA_STEP
    __syncthreads();
    store_o(o, l_reg, li_l, lds, Ob, ldo, wid, lane, r32, hi);
}
template <int D0> __device__ __forceinline__ void na2_pv(f32x16& od, int vbA, int vbB, bf16x8 pa0, bf16x8 pa1) {
    const s16x4 l0 = tr_read<v_rd_off(D0, 0, 0)>(vbA), h0 = tr_read<v_rd_off(D0, 0, 1)>(vbA), l1 = tr_read<v_rd_off(D0, 0, 0)>(vbB), h1 = tr_read<v_rd_off(D0, 0, 1)>(vbB);
    asm volatile("s_waitcnt lgkmcnt(0)" ::: "memory"); SBAR();
    od = __builtin_amdgcn_mfma_f32_32x32x16_bf16(pa0, (bf16x8){l0[0], l0[1], l0[2], l0[3], h0[0], h0[1], h0[2], h0[3]}, od, 0, 0, 0);
    od = __builtin_amdgcn_mfma_f32_32x32x16_bf16(pa1, (bf16x8){l1[0], l1[1], l1[2], l1[3], h1[0], h1[1], h1[2], h1[3]}, od, 0, 0, 0);
}
__device__ __forceinline__ void na_unit2(const bf16* __restrict__ Qb, int ldq, const bf16* __restrict__ Kseq, const bf16* __restrict__ Vseq, int ldk,
                                         bf16* __restrict__ Ob, int ldo, int r0, const float* __restrict__ rpb_h, LAS char* lds, int wid) {
    constexpr int KP = 256; constexpr float NEG = -3.0e38f;
    const int lane = lane_id_fresh(), tid = wid * 64 + lane, r32 = lane & 31, hi = lane >> 5;
    LAS char* V_lds = lds; LAS char* K_lds = lds + NA_OFF_K; LAS float* rpb_l = (LAS float*)(lds + NA_OFF_RPB);
    LAS float* ws = (LAS float*)(lds + NA_OFF_WS) + wid * 64; LAS float* li_l = ws; LAS float* al_l = ws + 32;
    float m_reg = -1e30f, l_reg = 0; f32x16 o[4] = {}; bf16x8 qr[8];
    const int typ = wid & 3, rp = wid >> 2, c15 = r32 & 15;
    const int g0 = (typ == 3) ? 0 : typ, g1 = (typ == 3) ? 3 : typ + 1;
    const int qc = (typ == 3) ? (c15 < 8 ? c15 : 48 + c15) : 8 + 16 * typ + c15;
    const int qrl = 2 * rp + (r32 >> 4), qrow = r0 + qrl;
    { const unsigned qo = (unsigned)(qrl * 64 + qc) * (unsigned)ldq + hi * 8;
#pragma unroll
      for (int d0 = 0; d0 < 8; ++d0) qr[d0] = *(const bf16x8*)(Qb + qo + d0 * 16); }
    const int sr = tid >> 4, sc = (tid & 15) * 8, vst0 = v_st(sr, sc), vst1 = v_st(32 + sr, sc);
    const int kst0 = KSWZ(KP, sr, sc * 2), kst1 = KSWZ(KP, 32 + sr, sc * 2);
    const unsigned ko = (unsigned)sr * (unsigned)ldk + sc;
    const int vbA = (int)(unsigned)(uintptr_t)V_lds + v_rd_base(lane) + g0 * 4096, vbB = (int)(unsigned)(uintptr_t)V_lds + v_rd_base(lane) + g1 * 4096;
    const int krow = 16 * (r32 < 16 ? g0 : g1) + c15;
    const LAS char* Kl = K_lds + krow * KP;
    const int kr_lo = clampi(r0 - 4, 0, 56), kr_hi = clampi(r0 + 3 - 4, 0, 56) + 8;
    const int s_lo = clampi(r0 + 2 * rp - 4, 0, 56), s_hi = clampi(r0 + 2 * rp + 1 - 4, 0, 56) + 8;
    const int srq = clampi(qrow - 4, 0, 56), scq = clampi(qc - 8, 0, 48);
    __syncthreads();
    if (tid < 465) rpb_l[tid] = rpb_h[tid] * 11.313708498984761f;
    bf16x8 va0, va1, ka0, ka1, vb0_, vb1_, kb0, kb1;
#define NA_LOAD(V0, V1, K0, K1, kr_) do { const bf16* Kt = Kseq + (size_t)((kr_) * 64) * ldk; const bf16* Vt = Vseq + (size_t)((kr_) * 64) * ldk; \
      V0 = *(const bf16x8*)(Vt + ko); V1 = *(const bf16x8*)(Vt + (size_t)32 * ldk + ko); K0 = *(const bf16x8*)(Kt + ko); K1 = *(const bf16x8*)(Kt + (size_t)32 * ldk + ko); } while (0)
#define NA_STEP(V0, V1, K0, K1, kr_) do { \
        __syncthreads();                                            \
        *(LAS bf16x8*)(V_lds + vst0) = V0; *(LAS bf16x8*)(V_lds + vst1) = V1; *(LAS bf16x8*)(K_lds + kst0) = K0; *(LAS bf16x8*)(K_lds + kst1) = K1; \
        __syncthreads(); \
        if ((kr_) + 2 < kr_hi) NA_LOAD(V0, V1, K0, K1, (kr_) + 2);     \
        if ((kr_) >= s_lo && (kr_) < s_hi) {                        \
            f32x16 p = {}; \
            _Pragma("unroll") for (int d0 = 0; d0 < 8; ++d0) { const int cb = (d0 * 16 + hi * 8) * 2; \
                const bf16x8 kf = *(const LAS bf16x8*)(Kl + (cb ^ (c15 << 4))); p = __builtin_amdgcn_mfma_f32_32x32x16_bf16(kf, qr[d0], p, 0, 0, 0); } \
            const bool rowin = ((kr_) >= srq) && ((kr_) < srq + 8); \
            const LAS float* bt = rpb_l + clampi((kr_) - qrow + 7, 0, 14) * 31 + (15 - qc); \
            _Pragma("unroll") for (int r = 0; r < 16; ++r) { const int kc = 16 * (r < 8 ? g0 : g1) + (r & 3) + 8 * ((r >> 2) & 1) + 4 * hi; \
                const bool in = rowin && (kc >= scq) && (kc < scq + 16); const float b = bt[in ? kc : qc]; p[r] = in ? p[r] + b : NEG; } \
              \
            float pmax = p[0]; _Pragma("unroll") for (int r = 1; r < 16; ++r) pmax = fmaxf(pmax, p[r]); \
            { auto rr = __builtin_amdgcn_permlane32_swap(__float_as_uint(pmax), __float_as_uint(pmax), false, false); pmax = fmaxf(__uint_as_float(rr[0]), __uint_as_float(rr[1])); } \
            float mn, al; \
            if (__builtin_expect(__all(pmax - m_reg <= THR / Cfg<128>::SCALE), 1)) { mn = m_reg; al = 1.f; } \
            else { mn = fmaxf(m_reg, pmax); al = __builtin_amdgcn_exp2f((m_reg - mn) * Cfg<128>::C); m_reg = mn; } \
            const float mnC = -mn * Cfg<128>::C; float ps = 0; \
            _Pragma("unroll") for (int r = 0; r < 16; ++r) { p[r] = __builtin_amdgcn_exp2f(fmaf(p[r], Cfg<128>::C, mnC)); ps += p[r]; } \
            { auto rr = __builtin_amdgcn_permlane32_swap(__float_as_uint(ps), __float_as_uint(ps), false, false); ps = __uint_as_float(rr[0]) + __uint_as_float(rr[1]); } \
            RESC(al); \
            l_reg = l_reg * al + ps; \
            bf16x8 pa0, pa1; \
            { unsigned a0 = cvt_pk_bf16(p[0], p[1]), a1 = cvt_pk_bf16(p[2], p[3]), b0 = cvt_pk_bf16(p[4], p[5]), b1 = cvt_pk_bf16(p[6], p[7]); \
              auto x0 = __builtin_amdgcn_permlane32_swap(a0, b0, false, false); auto x1 = __builtin_amdgcn_permlane32_swap(a1, b1, false, false); \
              u32x4 w = {x0[0], x1[0], x0[1], x1[1]}; pa0 = __builtin_bit_cast(bf16x8, w); } \
            { unsigned a0 = cvt_pk_bf16(p[8], p[9]), a1 = cvt_pk_bf16(p[10], p[11]), b0 = cvt_pk_bf16(p[12], p[13]), b1 = cvt_pk_bf16(p[14], p[15]); \
              auto x0 = __builtin_amdgcn_permlane32_swap(a0, b0, false, false); auto x1 = __builtin_amdgcn_permlane32_swap(a1, b1, false, false); \
              u32x4 w = {x0[0], x1[0], x0[1], x1[1]}; pa1 = __builtin_bit_cast(bf16x8, w); } \
            SBAR(); \
            na2_pv<0>(o[0], vbA, vbB, pa0, pa1); na2_pv<1>(o[1], vbA, vbB, pa0, pa1); na2_pv<2>(o[2], vbA, vbB, pa0, pa1); na2_pv<3>(o[3], vbA, vbB, pa0, pa1); \
        } } while (0)
    NA_LOAD(va0, va1, ka0, ka1, kr_lo);
    if (kr_lo + 1 < kr_hi) NA_LOAD(vb0_, vb1_, kb0, kb1, kr_lo + 1);
    for (int kr = kr_lo; kr < kr_hi; kr += 2) {
        NA_STEP(va0, va1, ka0, ka1, kr);
        if (kr + 1 < kr_hi) NA_STEP(vb0_, vb1_, kb0, kb1, kr + 1);
    }
#undef NA_LOAD
#undef NA_STEP
    __syncthreads();
    if (hi == 0) li_l[r32] = l_reg;
    asm volatile("s_waitcnt lgkmcnt(0)" ::: "memory");
    float rli[16];
#pragma unroll
    for (int r = 0; r < 16; ++r) rli[r] = __builtin_amdgcn_rcpf(li_l[crow(r, hi)]);
    LAS unsigned short* slab = (LAS unsigned short*)(lds + wid * 8192);
#pragma unroll
    for (int r = 0; r < 16; ++r) { const int orow = crow(r, hi);
#pragma unroll
        for (int d0 = 0; d0 < 4; ++d0) slab[orow * 128 + d0 * 32 + r32] = (unsigned short)(cvt_pk_bf16(o[d0][r] * rli[r], 0.f) & 0xffffu); }
    asm volatile("s_waitcnt lgkmcnt(0)" ::: "memory");
#pragma unroll
    for (int i = 0; i < 8; ++i) { const int id = i * 64 + lane, q = id >> 4, c16 = id & 15, q15 = q & 15;
        const int col = (typ == 3) ? (q15 < 8 ? q15 : 48 + q15) : 8 + 16 * typ + q15;
        const u32x4 w = *(const LAS u32x4*)((LAS char*)slab + q * 256 + c16 * 16);
        *(u32x4*)(Ob + (unsigned)((2 * rp + (q >> 4)) * 64 + col) * (unsigned)ldo + c16 * 8) = w; }
}
#undef RESC
}

constexpr size_t MiB = 1u << 20;
constexpr size_t WS_CTL = 0, CTL_ZERO_BYTES = 64 * 1024;
constexpr size_t WS_TAB_MLA = 5 * MiB;
constexpr size_t WS_TAB_1D = 6 * MiB;
constexpr size_t WS_MN = 8 * MiB;
constexpr size_t WS_MKV = 20 * MiB;
constexpr size_t WS_WB = 32 * MiB;
constexpr size_t WB_IN = 0, WB_QB = 24 * MiB, WB_KVB = 26 * MiB, WB_OUT = 28 * MiB, WB_XQ = 36 * MiB, WB_XKV = 38 * MiB, WB_XO = 42 * MiB, WB_UP = 44 * MiB, WB_DOWN = 76 * MiB;
constexpr size_t WS_H = 144 * MiB;
constexpr size_t WS_BIG = 336 * MiB;
constexpr size_t BIG_PROJ = 0, BIG_Q = 264 * MiB, BIG_KV = 408 * MiB;
constexpr size_t BIG_SPLIT = 96 * MiB;
constexpr size_t BIG_XQ = 0, BIG_XO = 48 * MiB;
constexpr size_t BIG_U = 0;
constexpr size_t BIG_XBA = 400 * MiB;
constexpr size_t WS_PS = WS_BIG + 600 * MiB;
constexpr size_t PS_BYTES = (size_t)T * 32 * 4, PSC_BYTES = (size_t)T * 8 * 4;
constexpr size_t WS_END = WS_PS + 3 * PS_BYTES + 2 * PSC_BYTES;
constexpr int CW_BAR = 4096;
static_assert((size_t)(CW_BAR + 3456) * 4 <= CTL_ZERO_BYTES, "barrier words inside the zeroed region");
constexpr int SKEW_TICKS = 0;

constexpr int RING_BYTES = 135168, MISC_OFF = RING_BYTES + 320, PTR_OFF = RING_BYTES + 1024, LDS_BYTES = 147456;
static_assert(pg8::RS_LDS_OFF == RING_BYTES + 2048 && pg8::RS_LDS_OFF + 2048 <= LDS_BYTES && PTR_OFF + 29 * 8 <= pg8::RS_LDS_OFF, "row-scale staging area");
static_assert(att::DV_TOTAL <= RING_BYTES && att::Cfg<192>::TOTAL <= RING_BYTES && att::NA_TOTAL <= RING_BYTES && pg8::STAGE_BYTES <= RING_BYTES, "LDS map");

#define XB_TMO      128
#define XB_XCNT(j)  (256  + 64 * (j))
#define XB_XSUB(j)  (1280 + 64 * (j))
#define XB_XGEN(j)  (2304 + 64 * (j))
#define XB_TOP      3328
#define XB_TOPGEN   3392
#define XCD_BAR_WORDS 3456
#define XB_SPIN_CAP (1u << 18)
__device__ __forceinline__ unsigned xb_ld(unsigned* p)              { return __hip_atomic_load(p, __ATOMIC_RELAXED, __HIP_MEMORY_SCOPE_AGENT); }
__device__ __forceinline__ unsigned xb_add(unsigned* p, unsigned v) { return __hip_atomic_fetch_add(p, v, __ATOMIC_RELAXED, __HIP_MEMORY_SCOPE_AGENT); }
__device__ __forceinline__ unsigned xb_xcc_id() { return (unsigned)__builtin_amdgcn_s_getreg((3 << 11) | 20) & 0xFu; }
#define XB_SPIN(cond, bar) do { unsigned _sp = 0; while (cond) { __builtin_amdgcn_s_sleep(1); \
    if ((++_sp & 255u) == 0u) { if (xb_ld(&(bar)[XB_TMO])) break; if (_sp > XB_SPIN_CAP) { atomicAdd(&(bar)[XB_TMO], 1u); break; } } } } while (0)
struct XcdBarrier { unsigned* bar; unsigned x; volatile LAS unsigned* st; };
__device__ __forceinline__ XcdBarrier xcd_barrier_post(unsigned* bar, volatile LAS unsigned* st, int wave) {
    XcdBarrier b; b.bar = bar; b.x = xb_xcc_id(); b.st = st;
    if (wave == 0 && lane_id_fresh() == 0) (void)xb_add(&bar[XB_XCNT(b.x)], 1u);
    return b;
}
__device__ __forceinline__ void xcd_barrier_complete(unsigned* bar, unsigned x, unsigned& nloc, unsigned& nx) {
    const unsigned G = gridDim.x * gridDim.y * gridDim.z;
    unsigned sum, cnt, mine, sp = 0u;
    for (;;) {
        sum = 0u; cnt = 0u; mine = 0u;
#pragma unroll
        for (unsigned j = 0; j < 16; ++j) { const unsigned c = xb_ld(&bar[XB_XCNT(j)]); sum += c; cnt += (c > 0u) ? 1u : 0u; mine = (j == x) ? c : mine; }
        if (sum == G) break;
        __builtin_amdgcn_s_sleep(1);
        if ((++sp & 255u) == 0u) { if (xb_ld(&bar[XB_TMO])) break; if (sp > XB_SPIN_CAP) { atomicAdd(&bar[XB_TMO], 1u); break; } }
    }
    nloc = mine > 0u ? mine : 1u; nx = cnt > 0u ? cnt : 1u;
}
__device__ __forceinline__ void xcd_barrier(const XcdBarrier& b, int wave) {
    asm volatile("s_waitcnt vmcnt(0)" ::: "memory");
    __syncthreads();
    if (wave == 0 && lane_id_fresh() == 0) {
        unsigned long long bar_i = (unsigned long long)(uintptr_t)b.bar; asm volatile("" : "+s"(bar_i));
        unsigned* bar = (unsigned*)(GAS unsigned*)(uintptr_t)bar_i;
        __builtin_amdgcn_s_waitcnt(0);
        unsigned nloc = b.st[0], nx = b.st[1];
        if (nloc == 0u) { xcd_barrier_complete(bar, b.x, nloc, nx); b.st[0] = nloc; b.st[1] = nx; }
        const unsigned old = xb_add(&bar[XB_XSUB(b.x)], 1u);
        const unsigned gen = old / nloc;
        if (old + 1u == (gen + 1u) * nloc) {
            __builtin_amdgcn_fence(__ATOMIC_RELEASE, "agent");
            asm volatile("s_waitcnt vmcnt(0)" ::: "memory");
            const unsigned og = xb_add(&bar[XB_TOP], 1u);
            const unsigned tg = og / nx;
            if (og + 1u == (tg + 1u) * nx) xb_add(&bar[XB_TOPGEN], 1u);
            else XB_SPIN(xb_ld(&bar[XB_TOPGEN]) == tg, bar);
            __builtin_amdgcn_fence(__ATOMIC_ACQUIRE, "agent");
            xb_add(&bar[XB_XGEN(b.x)], 1u);
            asm volatile("s_waitcnt vmcnt(0)" ::: "memory");
        } else {
            XB_SPIN(xb_ld(&bar[XB_XGEN(b.x)]) == gen, bar);
            __builtin_amdgcn_fence(__ATOMIC_ACQUIRE, "agent");
            asm volatile("s_waitcnt vmcnt(0)" ::: "memory");
        }
    }
    __syncthreads();
}

#define LDS_WAIT() asm volatile("s_waitcnt lgkmcnt(0)" ::: "memory")
constexpr int TR_PITCH = 65, TR_BYTES = 64 * TR_PITCH * 4;
static_assert(8 * TR_BYTES <= RING_BYTES, "transpose scratch");
__device__ __forceinline__ void transpose_item(const float* W, int K, int N, bf16* WT, const float* gain, LAS float* scr, int item, int lane) {
    const int nblk = N / 64, kb = item / nblk, nb = item % nblk, k0 = 64 * kb, n0 = 64 * nb;
    const int lr = lane >> 4, lc = (lane & 15) * 4;
#pragma unroll
    for (int h = 0; h < 2; ++h) {
        f32x4 v[8];
#pragma unroll
        for (int i = 0; i < 8; ++i) v[i] = *(const f32x4*)(W + (size_t)(k0 + 32 * h + 4 * i + lr) * N + n0 + lc);
#pragma unroll
        for (int i = 0; i < 8; ++i) { const int kk = 32 * h + 4 * i + lr; const float gk = gain ? gain[k0 + kk] : 1.f; LAS float* d = scr + kk * TR_PITCH + lc;
            d[0] = v[i].x * gk; d[1] = v[i].y * gk; d[2] = v[i].z * gk; d[3] = v[i].w * gk; }
    }
    LDS_WAIT(); asm volatile("" ::: "memory");
    const int c = lane & 7;
#pragma unroll
    for (int j = 0; j < 8; ++j) { const int n = (lane >> 3) + 8 * j; const LAS float* s = scr + (8 * c) * TR_PITCH + n;
        u32x4 o; o.x = cvt_pk_bf16(s[0 * TR_PITCH], s[1 * TR_PITCH]); o.y = cvt_pk_bf16(s[2 * TR_PITCH], s[3 * TR_PITCH]); o.z = cvt_pk_bf16(s[4 * TR_PITCH], s[5 * TR_PITCH]); o.w = cvt_pk_bf16(s[6 * TR_PITCH], s[7 * TR_PITCH]);
        *(u32x4*)(WT + (size_t)(n0 + n) * K + k0 + 8 * c) = o; }
    LDS_WAIT(); asm volatile("" ::: "memory");
}
__device__ __forceinline__ void convert_matrix(const float* W, int K, int N, bf16* WT, const float* gain, LAS float* scr, int gw, int NGW, int lane) {
    const int nitems = (K / 64) * (N / 64);
    for (int it = gw; it < nitems; it += NGW) transpose_item(W, K, N, WT, gain, scr, it, lane);
}
__device__ __forceinline__ void init_row_2048(const float* xrow, bf16* xh, float* ssp, int lane) {
    const f32x4* xr = (const f32x4*)xrow + lane;
    u32x2 w[8]; float s = 0.f;
#pragma unroll
    for (int j = 0; j < 8; ++j) { const f32x4 v = xr[64 * j]; w[j].x = cvt_pk_bf16(v.x, v.y); w[j].y = cvt_pk_bf16(v.z, v.w);
        const float y0 = bflo(w[j].x), y1 = bfhi(w[j].x), y2 = bflo(w[j].y), y3 = bfhi(w[j].y); s += (y0 * y0 + y1 * y1) + (y2 * y2 + y3 * y3); }
    s = wave_sum(s);
    u32x2* oh = (u32x2*)xh + lane;
#pragma unroll
    for (int j = 0; j < 8; ++j) oh[64 * j] = w[j];
    if (lane < 32) ssp[lane] = (lane == 0) ? s : 0.f;
}
__device__ __forceinline__ void init_rows2_2048(const float* xrow0, const float* xrow1, bf16* xh0, bf16* xh1, float* ssp0, float* ssp1, int lane) {
    f32x4 v0[8], v1[8];
#pragma unroll
    for (int j = 0; j < 8; ++j) { v0[j] = ((const f32x4*)xrow0 + lane)[64 * j]; v1[j] = ((const f32x4*)xrow1 + lane)[64 * j]; }
#pragma unroll
    for (int i = 0; i < 2; ++i) { u32x2 w[8]; float s = 0.f;
#pragma unroll
        for (int j = 0; j < 8; ++j) { const f32x4 v = i ? v1[j] : v0[j]; w[j].x = cvt_pk_bf16(v.x, v.y); w[j].y = cvt_pk_bf16(v.z, v.w);
            const float y0 = bflo(w[j].x), y1 = bfhi(w[j].x), y2 = bflo(w[j].y), y3 = bfhi(w[j].y); s += (y0 * y0 + y1 * y1) + (y2 * y2 + y3 * y3); }
        s = wave_sum(s);
        u32x2* oh = (u32x2*)(i ? xh1 : xh0) + lane;
#pragma unroll
        for (int j = 0; j < 8; ++j) oh[64 * j] = w[j];
        if (lane < 32) (i ? ssp1 : ssp0)[lane] = (lane == 0) ? s : 0.f; }
}
__device__ __forceinline__ void norm_row_2048(const float* xrow, const float* g, bf16* orow, float* copy, int lane) {
    const f32x4* xr = (const f32x4*)xrow + lane;
    f32x4 v[8]; float s = 0.f;
#pragma unroll
    for (int j = 0; j < 8; ++j) { v[j] = xr[64 * j]; s += (v[j].x * v[j].x + v[j].y * v[j].y) + (v[j].z * v[j].z + v[j].w * v[j].w); }
    const float rstd = 1.f / sqrtf(wave_sum(s) * (1.f / 2048.f) + EPS);
    if (copy) {
#pragma unroll
        for (int j = 0; j < 8; ++j) ((f32x4*)copy + lane)[64 * j] = v[j]; }
    u32x2* o8 = (u32x2*)orow + lane;
#pragma unroll
    for (int j = 0; j < 8; ++j) { const f32x4 gg = ((const f32x4*)g + lane)[64 * j]; u32x2 w; w.x = cvt_pk_bf16(v[j].x * rstd * gg.x, v[j].y * rstd * gg.y); w.y = cvt_pk_bf16(v[j].z * rstd * gg.z, v[j].w * rstd * gg.w); o8[64 * j] = w; }
}
__device__ __forceinline__ void final_norm_row(const bf16* xh, float* orow, const float* g, float ss, int lane) {
    const float rstd = 1.f / sqrtf(ss * (1.f / 2048.f) + EPS);
    const u32x2* ph = (const u32x2*)xh + lane; f32x4* po = (f32x4*)orow + lane;
#pragma unroll
    for (int j = 0; j < 8; ++j) { const u32x2 h = ph[64 * j]; const f32x4 gg = ((const f32x4*)g + lane)[64 * j];
        f32x4 o; o.x = bflo(h.x) * rstd * gg.x; o.y = bfhi(h.x) * rstd * gg.y; o.z = bflo(h.y) * rstd * gg.z; o.w = bfhi(h.y) * rstd * gg.w;
        po[64 * j] = o; }
}
template <int R>
__device__ __forceinline__ void final_norm_rows(const bf16* xh, float* out, const f32x4 (&gg)[8], const float* ssf, int m0, int mstep, int lane) {
    u32x2 h[R][8]; float ssv[R];
#pragma unroll
    for (int i = 0; i < R; ++i) { const size_t m = (size_t)(m0 + i * mstep); const u32x2* ph = (const u32x2*)(xh + m * DM) + lane;
        ssv[i] = lane < 32 ? ssf[m * 32 + lane] : 0.f;
#pragma unroll
        for (int j = 0; j < 8; ++j) h[i][j] = ph[64 * j]; }
#pragma unroll
    for (int i = 0; i < R; ++i) { const size_t m = (size_t)(m0 + i * mstep); f32x4* po = (f32x4*)(out + m * DM) + lane;
        const float rstd = 1.f / sqrtf(wave_sum(ssv[i]) * (1.f / 2048.f) + EPS);
#pragma unroll
        for (int j = 0; j < 8; ++j) { f32x4 o; o.x = bflo(h[i][j].x) * rstd * gg[j].x; o.y = bfhi(h[i][j].x) * rstd * gg[j].y; o.z = bflo(h[i][j].y) * rstd * gg[j].z; o.w = bfhi(h[i][j].y) * rstd * gg[j].w;
            po[64 * j] = o; } }
}
__device__ __forceinline__ void even_row_fix(bf16* row, int pos, const float* qn, const float* kvn, const float* gqn, const float* gkn, const float* tab_mla, int lane) {
    const float* cosm = tab_mla; const float* sinm = tab_mla + 4096 * 32;
#pragma unroll
    for (int part = 0; part < 2; ++part) {
        u32x4* p = (u32x4*)(row + part * 512) + lane; const u32x4 w = *p; const float* g = (part ? kvn : qn) + lane * 8;
        float x[8] = {bflo(w.x), bfhi(w.x), bflo(w.y), bfhi(w.y), bflo(w.z), bfhi(w.z), bflo(w.w), bfhi(w.w)};
        float s = 0.f;
#pragma unroll
        for (int e = 0; e < 8; ++e) s += x[e] * x[e];
        const float rstd = 1.f / sqrtf(wave_sum(s) * (1.f / 512.f) + EPS);
        const f32x4 g0 = *(const f32x4*)g, g1 = *(const f32x4*)(g + 4);
        u32x4 o; o.x = cvt_pk_bf16(x[0] * rstd * g0.x, x[1] * rstd * g0.y); o.y = cvt_pk_bf16(x[2] * rstd * g0.z, x[3] * rstd * g0.w);
        o.z = cvt_pk_bf16(x[4] * rstd * g1.x, x[5] * rstd * g1.y); o.w = cvt_pk_bf16(x[6] * rstd * g1.z, x[7] * rstd * g1.w);
        *p = o;
    }
    { bf16* p = row + 1024 + lane; const float x = bf2f(*p); const float y = other_half(x, lane < 32); const int f = lane & 31;
      const float c = cosm[pos * 32 + f], s = sinm[pos * 32 + f];
      const float r = (lane < 32) ? (x * c - y * s) : (x * c + y * s);
      *p = (bf16)(cvt_pk_bf16(r, 0.f) & 0xffffu); }
    const int prow = pos >> 6, pcol = pos & 63;
    const int e0 = 2 * lane, f0 = e0 & 31; const int tp = (e0 < 64) ? prow : pcol;
    const float c0 = cosm[tp * 32 + f0], s0 = sinm[tp * 32 + f0], c1 = cosm[tp * 32 + f0 + 1], s1 = sinm[tp * 32 + f0 + 1];
    const bool first = ((e0 & 32) == 0);
#pragma unroll 2
    for (int h = 0; h < 10; ++h) {
        unsigned* p = (unsigned*)(row + (h < 8 ? 1088 + h * 128 : 2112 + (h - 8) * 128)) + lane; const unsigned w = *p; const float* g = (h < 8 ? gqn : gkn) + e0;
        float x0 = bflo(w), x1 = bfhi(w);
        const float rstd = 1.f / sqrtf(wave_sum(x0 * x0 + x1 * x1) * (1.f / 128.f) + EPS);
        x0 = x0 * rstd * g[0]; x1 = x1 * rstd * g[1];
        const float y0 = swz_xor<16>(x0), y1 = swz_xor<16>(x1);
        const float r0 = first ? (x0 * c0 - y0 * s0) : (x0 * c0 + y0 * s0);
        const float r1 = first ? (x1 * c1 - y1 * s1) : (x1 * c1 + y1 * s1);
        *p = cvt_pk_bf16(r0, r1);
    }
}
__device__ __forceinline__ void even_row_fix_k(bf16* row, int pos, const float* gkn, const float* tab_mla, int lane) {
    const float* cosm = tab_mla; const float* sinm = tab_mla + 4096 * 32;
    { bf16* p = row + 1024 + lane; const float x = bf2f(*p); const float y = other_half(x, lane < 32); const int f = lane & 31;
      const float c = cosm[pos * 32 + f], s = sinm[pos * 32 + f];
      const float r = (lane < 32) ? (x * c - y * s) : (x * c + y * s);
      *p = (bf16)(cvt_pk_bf16(r, 0.f) & 0xffffu); }
    const int prow = pos >> 6, pcol = pos & 63;
    const int e0 = 2 * lane, f0 = e0 & 31; const int tp = (e0 < 64) ? prow : pcol;
    const float c0 = cosm[tp * 32 + f0], s0 = sinm[tp * 32 + f0], c1 = cosm[tp * 32 + f0 + 1], s1 = sinm[tp * 32 + f0 + 1];
    const bool first = ((e0 & 32) == 0);
#pragma unroll
    for (int h = 0; h < 2; ++h) {
        unsigned* p = (unsigned*)(row + 2112 + h * 128) + lane; const unsigned w = *p; const float* g = gkn + e0;
        float x0 = bflo(w), x1 = bfhi(w);
        const float rstd = 1.f / sqrtf(wave_sum(x0 * x0 + x1 * x1) * (1.f / 128.f) + EPS);
        x0 = x0 * rstd * g[0]; x1 = x1 * rstd * g[1];
        const float y0 = swz_xor<16>(x0), y1 = swz_xor<16>(x1);
        const float r0 = first ? (x0 * c0 - y0 * s0) : (x0 * c0 + y0 * s0);
        const float r1 = first ? (x1 * c1 - y1 * s1) : (x1 * c1 + y1 * s1);
        *p = cvt_pk_bf16(r0, r1);
    }
}
template <int R>
__device__ __forceinline__ void even_rows_fix_k(bf16* proj, int m0, int mstep, const float* gkn, const float* tab_mla, int lane) {
    const float* cosm = tab_mla; const float* sinm = tab_mla + 4096 * 32;
    const int f = lane & 31, e0 = 2 * lane, f0 = e0 & 31; const bool first = ((e0 & 32) == 0);
    const float g0 = gkn[e0], g1 = gkn[e0 + 1];
    unsigned short kx[R]; unsigned w0[R], w1[R]; float kc[R], ks[R], c0[R], s0[R], c1[R], s1[R];
#pragma unroll
    for (int i = 0; i < R; ++i) { const int m = m0 + i * mstep, pos = m & (SEQ - 1); bf16* row = proj + (size_t)m * AB_PAD;
        kx[i] = *(row + 1024 + lane); kc[i] = cosm[pos * 32 + f]; ks[i] = sinm[pos * 32 + f];
        const int tp = (e0 < 64) ? (pos >> 6) : (pos & 63);
        c0[i] = cosm[tp * 32 + f0]; s0[i] = sinm[tp * 32 + f0]; c1[i] = cosm[tp * 32 + f0 + 1]; s1[i] = sinm[tp * 32 + f0 + 1];
        w0[i] = *((const unsigned*)(row + 2112) + lane); w1[i] = *((const unsigned*)(row + 2112 + 128) + lane); }
#pragma unroll
    for (int i = 0; i < R; ++i) { const int m = m0 + i * mstep; bf16* row = proj + (size_t)m * AB_PAD;
        { const float x = bf2f(kx[i]); const float y = other_half(x, lane < 32);
          const float r = (lane < 32) ? (x * kc[i] - y * ks[i]) : (x * kc[i] + y * ks[i]);
          *(row + 1024 + lane) = (bf16)(cvt_pk_bf16(r, 0.f) & 0xffffu); }
#pragma unroll
        for (int h = 0; h < 2; ++h) { const unsigned w = h ? w1[i] : w0[i];
            float x0 = bflo(w), x1 = bfhi(w);
            const float rstd = 1.f / sqrtf(wave_sum(x0 * x0 + x1 * x1) * (1.f / 128.f) + EPS);
            x0 = x0 * rstd * g0; x1 = x1 * rstd * g1;
            const float y0 = swz_xor<16>(x0), y1 = swz_xor<16>(x1);
            const float r0 = first ? (x0 * c0[i] - y0 * s0[i]) : (x0 * c0[i] + y0 * s0[i]);
            const float r1 = first ? (x1 * c1[i] - y1 * s1[i]) : (x1 * c1[i] + y1 * s1[i]);
            *((unsigned*)(row + 2112 + h * 128) + lane) = cvt_pk_bf16(r0, r1); } }
}
__device__ __forceinline__ void mla_q_rope_row(bf16* row, int pos, const float* tab_mla, int lane) {
    const int h = lane >> 3, s4 = (lane & 7) * 4;
    u32x2* p1 = (u32x2*)(row + h * 192 + 128 + s4); u32x2* p2 = (u32x2*)(row + h * 192 + 160 + s4);
    const u32x2 w1 = *p1, w2 = *p2;
    const f32x4 c = *(const f32x4*)(tab_mla + pos * 32 + s4), s = *(const f32x4*)(tab_mla + 4096 * 32 + pos * 32 + s4);
    const float x1[4] = {bflo(w1.x), bfhi(w1.x), bflo(w1.y), bfhi(w1.y)}, x2[4] = {bflo(w2.x), bfhi(w2.x), bflo(w2.y), bfhi(w2.y)};
    float a[4], b[4];
#pragma unroll
    for (int e = 0; e < 4; ++e) { a[e] = x1[e] * c[e] - x2[e] * s[e]; b[e] = x2[e] * c[e] + x1[e] * s[e]; }
    u32x2 o1, o2; o1.x = cvt_pk_bf16(a[0], a[1]); o1.y = cvt_pk_bf16(a[2], a[3]); o2.x = cvt_pk_bf16(b[0], b[1]); o2.y = cvt_pk_bf16(b[2], b[3]);
    *p1 = o1; *p2 = o2;
}
__device__ __forceinline__ void rope1d_row(bf16* row, int pos, const float* tab_1d, int lane) {
    const int h = lane >> 3, s8 = (lane & 7) * 8;
    u32x4* p1 = (u32x4*)(row + h * 128 + s8); u32x4* p2 = (u32x4*)(row + h * 128 + 64 + s8);
    const u32x4 w1 = *p1, w2 = *p2;
    const float* ct = tab_1d + pos * 64 + s8; const float* st = tab_1d + 4096 * 64 + pos * 64 + s8;
    const f32x4 c0 = *(const f32x4*)ct, c1 = *(const f32x4*)(ct + 4), s0 = *(const f32x4*)st, s1 = *(const f32x4*)(st + 4);
    const float c[8] = {c0.x, c0.y, c0.z, c0.w, c1.x, c1.y, c1.z, c1.w}, s[8] = {s0.x, s0.y, s0.z, s0.w, s1.x, s1.y, s1.z, s1.w};
    const float x1[8] = {bflo(w1.x), bfhi(w1.x), bflo(w1.y), bfhi(w1.y), bflo(w1.z), bfhi(w1.z), bflo(w1.w), bfhi(w1.w)};
    const float x2[8] = {bflo(w2.x), bfhi(w2.x), bflo(w2.y), bfhi(w2.y), bflo(w2.z), bfhi(w2.z), bflo(w2.w), bfhi(w2.w)};
    float a[8], b[8];
#pragma unroll
    for (int e = 0; e < 8; ++e) { a[e] = x1[e] * c[e] - x2[e] * s[e]; b[e] = x2[e] * c[e] + x1[e] * s[e]; }
    u32x4 o1, o2; o1.x = cvt_pk_bf16(a[0], a[1]); o1.y = cvt_pk_bf16(a[2], a[3]); o1.z = cvt_pk_bf16(a[4], a[5]); o1.w = cvt_pk_bf16(a[6], a[7]);
    o2.x = cvt_pk_bf16(b[0], b[1]); o2.y = cvt_pk_bf16(b[2], b[3]); o2.z = cvt_pk_bf16(b[4], b[5]); o2.w = cvt_pk_bf16(b[6], b[7]);
    *p1 = o1; *p2 = o2;
}
__device__ __forceinline__ void rope1d_rows4(bf16* base, size_t ld, int m0, int mstep, const float* tab_1d, int lane) {
    const int h = lane >> 3, s8 = (lane & 7) * 8;
    u32x4 w1[4], w2[4]; f32x4 c0[4], c1[4], s0[4], s1[4];
#pragma unroll
    for (int i = 0; i < 4; ++i) { const int m = m0 + i * mstep, pos = m & (SEQ - 1); bf16* row = base + (size_t)m * ld;
        w1[i] = *(const u32x4*)(row + h * 128 + s8); w2[i] = *(const u32x4*)(row + h * 128 + 64 + s8);
        const float* ct = tab_1d + pos * 64 + s8; const float* st = tab_1d + 4096 * 64 + pos * 64 + s8;
        c0[i] = *(const f32x4*)ct; c1[i] = *(const f32x4*)(ct + 4); s0[i] = *(const f32x4*)st; s1[i] = *(const f32x4*)(st + 4); }
#pragma unroll
    for (int i = 0; i < 4; ++i) { const int m = m0 + i * mstep; bf16* row = base + (size_t)m * ld;
        const float c[8] = {c0[i].x, c0[i].y, c0[i].z, c0[i].w, c1[i].x, c1[i].y, c1[i].z, c1[i].w}, s[8] = {s0[i].x, s0[i].y, s0[i].z, s0[i].w, s1[i].x, s1[i].y, s1[i].z, s1[i].w};
        const float x1[8] = {bflo(w1[i].x), bfhi(w1[i].x), bflo(w1[i].y), bfhi(w1[i].y), bflo(w1[i].z), bfhi(w1[i].z), bflo(w1[i].w), bfhi(w1[i].w)};
        const float x2[8] = {bflo(w2[i].x), bfhi(w2[i].x), bflo(w2[i].y), bfhi(w2[i].y), bflo(w2[i].z), bfhi(w2[i].z), bflo(w2[i].w), bfhi(w2[i].w)};
        float a[8], b[8];
#pragma unroll
        for (int e = 0; e < 8; ++e) { a[e] = x1[e] * c[e] - x2[e] * s[e]; b[e] = x2[e] * c[e] + x1[e] * s[e]; }
        u32x4 o1, o2; o1.x = cvt_pk_bf16(a[0], a[1]); o1.y = cvt_pk_bf16(a[2], a[3]); o1.z = cvt_pk_bf16(a[4], a[5]); o1.w = cvt_pk_bf16(a[6], a[7]);
        o2.x = cvt_pk_bf16(b[0], b[1]); o2.y = cvt_pk_bf16(b[2], b[3]); o2.z = cvt_pk_bf16(b[4], b[5]); o2.w = cvt_pk_bf16(b[6], b[7]);
        *(u32x4*)(row + h * 128 + s8) = o1; *(u32x4*)(row + h * 128 + 64 + s8) = o2; }
}
__device__ __forceinline__ void diff_combine_row(const bf16* oc, bf16* out, float lam, float post, const float* subln, int lane) {
    const f32x4 g = *(const f32x4*)(subln + lane * 4);
#pragma unroll
    for (int h = 0; h < 4; ++h) {
        const u32x2 w0 = *((const u32x2*)(oc + h * 512) + lane), w1 = *((const u32x2*)(oc + h * 512 + 256) + lane);
        float d[4] = {bflo(w0.x) - lam * bflo(w1.x), bfhi(w0.x) - lam * bfhi(w1.x), bflo(w0.y) - lam * bflo(w1.y), bfhi(w0.y) - lam * bfhi(w1.y)};
        const float rstd = 1.f / sqrtf(wave_sum((d[0] * d[0] + d[1] * d[1]) + (d[2] * d[2] + d[3] * d[3])) * (1.f / 256.f) + EPS);
        u32x2 o; o.x = cvt_pk_bf16(d[0] * rstd * g.x * post, d[1] * rstd * g.y * post); o.y = cvt_pk_bf16(d[2] * rstd * g.z * post, d[3] * rstd * g.w * post);
        *((u32x2*)(out + h * 256) + lane) = o;
    }
}
template <int R>
__device__ __forceinline__ void diff_combine_rows(const bf16* ocb, bf16* outb, size_t ldo, int m0, int mstep, float lam, float post, const float* subln, int lane) {
    const f32x4 g = *(const f32x4*)(subln + lane * 4);
    u32x2 w0[R][4], w1[R][4];
#pragma unroll
    for (int i = 0; i < R; ++i) { const bf16* oc = ocb + (size_t)(m0 + i * mstep) * 2048;
#pragma unroll
        for (int h = 0; h < 4; ++h) { w0[i][h] = *((const u32x2*)(oc + h * 512) + lane); w1[i][h] = *((const u32x2*)(oc + h * 512 + 256) + lane); } }
#pragma unroll
    for (int i = 0; i < R; ++i) { bf16* out = outb + (size_t)(m0 + i * mstep) * ldo;
#pragma unroll
        for (int h = 0; h < 4; ++h) { const u32x2 a = w0[i][h], b = w1[i][h];
            float d[4] = {bflo(a.x) - lam * bflo(b.x), bfhi(a.x) - lam * bfhi(b.x), bflo(a.y) - lam * bflo(b.y), bfhi(a.y) - lam * bfhi(b.y)};
            const float rstd = 1.f / sqrtf(wave_sum((d[0] * d[0] + d[1] * d[1]) + (d[2] * d[2] + d[3] * d[3])) * (1.f / 256.f) + EPS);
            u32x2 o; o.x = cvt_pk_bf16(d[0] * rstd * g.x * post, d[1] * rstd * g.y * post); o.y = cvt_pk_bf16(d[2] * rstd * g.z * post, d[3] * rstd * g.w * post);
            *((u32x2*)(out + h * 256) + lane) = o; } }
}
__device__ __forceinline__ void sincos_d(double a, double& sn, double& cs) {
    const double k = __builtin_rint(a * 0.15915494309189533577);
    const double r = __builtin_fma(-k, 6.283185307179586476925, a) - k * 2.4492935982947064e-16 * 0.0;
    const double r2 = r * r;
    double s = -1.0 / 51090942171709440000.0;
    s = s * r2 + 1.0 / 121645100408832000.0; s = s * r2 - 1.0 / 355687428096000.0; s = s * r2 + 1.0 / 1307674368000.0; s = s * r2 - 1.0 / 6227020800.0;
    s = s * r2 + 1.0 / 39916800.0; s = s * r2 - 1.0 / 362880.0; s = s * r2 + 1.0 / 5040.0; s = s * r2 - 1.0 / 120.0; s = s * r2 + 1.0 / 6.0; s = s * r2 - 1.0;
    sn = -s * r;
    double c = 1.0 / 1124000727777607680000.0;
    c = c * r2 - 1.0 / 2432902008176640000.0; c = c * r2 + 1.0 / 6402373705728000.0; c = c * r2 - 1.0 / 20922789888000.0; c = c * r2 + 1.0 / 87178291200.0;
    c = c * r2 - 1.0 / 479001600.0; c = c * r2 + 1.0 / 3628800.0; c = c * r2 - 1.0 / 40320.0; c = c * r2 + 1.0 / 720.0; c = c * r2 - 1.0 / 24.0; c = c * r2 + 0.5; c = c * r2 - 1.0;
    cs = -c;
}

__device__ __forceinline__ void* ld_ptr(LAS unsigned long long* P, int i) {
    const unsigned long long v = P[i];
    const unsigned lo = __builtin_amdgcn_readfirstlane((unsigned)v), hi = __builtin_amdgcn_readfirstlane((unsigned)(v >> 32));
    return (void*)(GAS void*)(uintptr_t)(((unsigned long long)hi << 32) | lo);
}
struct Args { const float* in[27]; float* out; unsigned char* ws; int ph_lo, ph_hi; };
enum { I_XP = 0, I_XS, I_MP, I_MS, I_NORM_MIX, I_W_IN_AB, I_MLA_QN, I_W_QB, I_MLA_KVN, I_W_KVB, I_GQA_QN, I_GQA_KN, I_W_OUT_AB, I_W_IN_CD, I_RPB, I_DLAM, I_SUBLN, I_W_OUT_CD,
       I_NORM_XA, I_NORM_MEM, I_W_XQ, I_W_XKV, I_W_XO, I_NORM_MLP, I_W_UP, I_W_DOWN, I_FINAL };

__global__ void __launch_bounds__(512, 2) fwd(Args args) {
    extern __shared__ __attribute__((aligned(16))) unsigned char lds_raw[];
    LAS unsigned char* lds = (LAS unsigned char*)lds_raw;
    volatile LAS unsigned* MISC = (volatile LAS unsigned*)(lds + MISC_OFF);
    const int tid0 = threadIdx.x, wave = __builtin_amdgcn_readfirstlane(tid0 >> 6);
    const int G = gridDim.x; const int bx = blockIdx.x; const int vcu = (G % 8 == 0) ? (bx % 8) * (G / 8) + bx / 8 : bx;
    const int gw = vcu * 8 + wave, NGW = G * 8;
    for (int u = tid0; u < (LDS_BYTES - RING_BYTES) / 4; u += 512) ((LAS unsigned*)(lds + RING_BYTES))[u] = 0u;
    __syncthreads();
    LAS unsigned long long* PTRS = (LAS unsigned long long*)(lds + PTR_OFF);
    if (tid0 == 0) {
#pragma unroll
        for (int i = 0; i < 27; ++i) PTRS[i] = (unsigned long long)(uintptr_t)args.in[i];
        PTRS[27] = (unsigned long long)(uintptr_t)args.out; PTRS[28] = (unsigned long long)(uintptr_t)args.ws;
    }
    const int lo = args.ph_lo, hi = args.ph_hi; int ph = 0;
    __syncthreads();
#define INP(i) ((const float*)ld_ptr(PTRS, (i)))
#define WSP ((unsigned char*)ld_ptr(PTRS, 28))
#define XP ((float*)ld_ptr(PTRS, 27))
    XcdBarrier bar = xcd_barrier_post((unsigned*)(WSP + WS_CTL) + CW_BAR, MISC + 8, wave);
#ifndef PH_MASK
#define PH_MASK 0xffffffffu
#endif
#define PEN(k) (((PH_MASK) >> (k)) & 1u)
#ifndef PROBE_REP
#define PROBE_REP 0u
#endif
#define REPS(k) (1 + (int)(((PROBE_REP) >> (k)) & 1u))
#define PH_ON (ph >= lo && ph < hi)
#define PH_LANE const int lane = lane_id_fresh(), tid = wave * 64 + lane; (void)tid; (void)lane; int gw_s_ = gw; asm volatile("" : "+s"(gw_s_)); const int gw = gw_s_; (void)gw
#define PH_END do { if (ph >= lo && ph + 1 < hi) xcd_barrier(bar, wave); ++ph; } while (0)

#define X XP
#define H ((bf16*)(WSP + WS_H))
#define BIG (WSP + WS_BIG)
#define WB (WSP + WS_WB)
#define tab_mla ((float*)(WSP + WS_TAB_MLA))
#define tab_1d ((float*)(WSP + WS_TAB_1D))
#define MN ((bf16*)(WSP + WS_MN))
#define MKV ((bf16*)(WSP + WS_MKV))
#define HFIN H
#define PSQ(i) ((float*)(WSP + WS_PS + (size_t)(i) * PS_BYTES))
#define PSC(i) ((float*)(WSP + WS_PS + 3 * PS_BYTES + (size_t)(i) * PSC_BYTES))
#define XBH ((bf16*)XP)
#define XBA XBH
    LAS float* scr = (LAS float*)(lds + wave * TR_BYTES);

    if (PH_ON && PEN(0)) for (int rep_ = 0; rep_ < REPS(0); ++rep_) { PH_LANE;
        const int gt = vcu * 512 + tid, NT_ = G * 512;
        for (int i = gt; i < 4096 * 32; i += NT_) { const int pos = i >> 5, f = i & 31; double inv = 1.0; for (int k = 0; k < f; ++k) inv *= 0.7498942093324558273;
            const float ang = (float)pos * (float)inv; double sn, cs; sincos_d((double)ang, sn, cs); tab_mla[i] = (float)cs; tab_mla[4096 * 32 + i] = (float)sn; }
        for (int i = gt; i < 4096 * 64; i += NT_) { const int pos = i >> 6, f = i & 63; double inv = 1.0; for (int k = 0; k < f; ++k) inv *= 0.8659643233600653524;
            const float ang = (float)pos * (float)inv; double sn, cs; sincos_d((double)ang, sn, cs); tab_1d[i] = (float)cs; tab_1d[4096 * 64 + i] = (float)sn; }
        float* ss0 = PSQ(0);
        int m = gw;
        for (; m + NGW < T; m += 2 * NGW) { const int m1 = m + NGW;
            const float* src0 = (m < T_PROMPT) ? INP(I_XP) + (size_t)m * DM : INP(I_XS) + (size_t)(m - T_PROMPT) * DM;
            const float* src1 = (m1 < T_PROMPT) ? INP(I_XP) + (size_t)m1 * DM : INP(I_XS) + (size_t)(m1 - T_PROMPT) * DM;
            init_rows2_2048(src0, src1, XBH + (size_t)m * DM, XBH + (size_t)m1 * DM, ss0 + (size_t)m * 32, ss0 + (size_t)m1 * 32, lane); }
        for (; m < T; m += NGW) { const float* src = (m < T_PROMPT) ? INP(I_XP) + (size_t)m * DM : INP(I_XS) + (size_t)(m - T_PROMPT) * DM;
            init_row_2048(src, XBH + (size_t)m * DM, ss0 + (size_t)m * 32, lane); }
    }

    for (int layer = 0; layer < DEPTH; ++layer) {
        const int j = layer >> 1; const bool even = (layer & 1) == 0;
#define W_IN ((bf16*)(WB + WB_IN))
#define W_QB ((bf16*)(WB + WB_QB))
#define W_KVB ((bf16*)(WB + WB_KVB))
#define W_OUT ((bf16*)(WB + WB_OUT))
#define W_XQ ((bf16*)(WB + WB_XQ))
#define W_XKV ((bf16*)(WB + WB_XKV))
#define W_XO ((bf16*)(WB + WB_XO))
#define W_UP ((bf16*)(WB + WB_UP))
#define W_DOWN ((bf16*)(WB + WB_DOWN))

#define CONVERT_LATE do { __syncthreads(); { PH_LANE; \
            convert_matrix((even ? INP(I_W_OUT_AB) : INP(I_W_OUT_CD)) + (size_t)j * DM * DM, DM, DM, W_OUT, nullptr, scr, gw, NGW, lane); \
            convert_matrix(INP(I_W_XQ) + (size_t)layer * DM * 512, DM, 512, W_XQ, INP(I_NORM_XA) + layer * DM, scr, gw, NGW, lane); \
            convert_matrix(INP(I_W_XKV) + (size_t)layer * DM * 1024, DM, 1024, W_XKV, nullptr, scr, gw, NGW, lane); \
            convert_matrix(INP(I_W_XO) + (size_t)layer * 512 * DM, 512, DM, W_XO, nullptr, scr, gw, NGW, lane); \
            convert_matrix(INP(I_W_UP) + (size_t)layer * DM * DFF, DM, DFF, W_UP, INP(I_NORM_MLP) + layer * DM, scr, gw, NGW, lane); \
            convert_matrix(INP(I_W_DOWN) + (size_t)layer * DFF * DM, DFF, DM, W_DOWN, nullptr, scr, gw, NGW, lane); } __syncthreads(); } while (0)
#define CONV_SLOT (bx % ((NSEQ * 8 * 16 / G) < 6 ? ((NSEQ * 8 * 16 / G) < 1 ? 1 : (NSEQ * 8 * 16 / G)) : 6))
        if (PH_ON && PEN(1)) for (int rep_ = 0; rep_ < REPS(1); ++rep_) { PH_LANE;
            const float* gmix = INP(I_NORM_MIX) + layer * DM;
            if (even) {
                convert_matrix(INP(I_W_IN_AB) + (size_t)j * DM * AB_IN, DM, AB_IN, W_IN, gmix, scr, gw, NGW, lane);
                for (size_t i = (size_t)gw * 64 + lane; i < (size_t)(AB_PAD - AB_IN) * DM / 8; i += (size_t)NGW * 64) { u32x4 z = (u32x4){0u, 0u, 0u, 0u}; asm volatile("" : "+v"(z)); ((u32x4*)(W_IN + (size_t)AB_IN * DM))[i] = z; }
                convert_matrix(INP(I_W_QB) + (size_t)j * 512 * 1536, 512, 1536, W_QB, INP(I_MLA_QN) + j * 512, scr, gw, NGW, lane);
                convert_matrix(INP(I_W_KVB) + (size_t)j * 512 * 2048, 512, 2048, W_KVB, INP(I_MLA_KVN) + j * 512, scr, gw, NGW, lane);
            } else {
                convert_matrix(INP(I_W_IN_CD) + (size_t)j * DM * CD_IN, DM, CD_IN, W_IN, gmix, scr, gw, NGW, lane);
            }
            const float* gm = INP(I_NORM_MEM) + layer * DM;
            for (int r = gw; r < TM; r += NGW) { const float* src = (r < 8 * MEMLEN) ? INP(I_MP) + (size_t)r * DM : INP(I_MS) + (size_t)(r - 8 * MEMLEN) * DM;
                norm_row_2048(src, gm, MN + (size_t)r * DM, nullptr, lane); }
        }
        PH_END;

        if (even) {
            bf16* PROJ = (bf16*)(BIG + BIG_PROJ); bf16* Q = (bf16*)(BIG + BIG_Q); bf16* KV = (bf16*)(BIG + BIG_KV);
            if (PH_ON && PEN(2)) for (int rep_ = 0; rep_ < REPS(2); ++rep_) { PH_LANE;
                pg8::Gemm g{XBH, W_IN, T, AB_PAD, DM, DM, DM}; pg8::StaticOrder S; S.init(T, AB_PAD, G, bx, 4);
                pg8::EpiBf16<0, 32> E{PROJ, AB_PAD, 0, 0, PSQ(0), 1.f / 2048.f, PSC(0), PSC_BYTES / 4};
                pg8::gemm_phase(lds, g, S, E, wave);
            }
            PH_END;
            if (PH_ON && PEN(3)) for (int rep_ = 0; rep_ < REPS(3); ++rep_) { PH_LANE;
                const float* gkn = INP(I_GQA_KN) + j * 128;
                int m = gw;
                for (; m + 7 * NGW < T; m += 8 * NGW) even_rows_fix_k<8>(PROJ, m, NGW, gkn, tab_mla, lane);
                for (; m < T; m += NGW) even_row_fix_k(PROJ + (size_t)m * AB_PAD, m & (SEQ - 1), gkn, tab_mla, lane);
            }
            if (PH_ON && PEN(4)) for (int rep_ = 0; rep_ < REPS(4); ++rep_) { PH_LANE;
#pragma unroll 1
                for (int gi = 0; gi < 2; ++gi) {
                    pg8::Gemm g{PROJ + (gi ? 512 : 0), gi ? W_KVB : W_QB, T, gi ? 2048 : 1536, 512, AB_PAD, 512}; pg8::StaticOrder S; S.init(T, g.N, G, bx, 4);
                    pg8::EpiBf16<0, 8> E{gi ? KV : Q, g.N, 0, 0, PSC(gi), 1.f / 512.f, nullptr, 0};
                    pg8::gemm_phase(lds, g, S, E, wave);
                }
            }
            PH_END;
            if (PH_ON) {
                for (int rep_ = 0; rep_ < REPS(6); ++rep_)
                for (int u = vcu, it_ = 0; u < NSEQ * 8 * 16; u += G, ++it_) { const int qb = u & 15, h = (u >> 4) & 7, b = u >> 7; const size_t t0 = (size_t)b * SEQ;
                    att::dense_unit<192, 1, 1>(Q + (t0 + qb * 256) * 1536 + h * 192, 1536, KV + t0 * 2048 + h * 256, 2048, PROJ + t0 * AB_PAD + 1024, AB_PAD,
                                         KV + t0 * 2048 + h * 256 + 128, 2048, H + (t0 + qb * 256) * DM + h * 128, DM, SEQ, (LAS char*)lds, wave, qb * 256, tab_mla, nullptr);
                    if (rep_ == 0 && it_ == CONV_SLOT) CONVERT_LATE; }
                for (int rep_ = 0; rep_ < REPS(21); ++rep_)
                for (int u = vcu; u < NSEQ * 8 * 16; u += G) { const int qb = u & 15, h = (u >> 4) & 7, b = u >> 7; const size_t t0 = (size_t)b * SEQ; const int kvh = h >> 2;
                    att::dense_unit3<3>(PROJ + (t0 + qb * 256) * AB_PAD + 1088 + h * 128, AB_PAD, PROJ + t0 * AB_PAD + 2112 + kvh * 128, AB_PAD,
                                         PROJ + t0 * AB_PAD + 2368 + kvh * 128, AB_PAD, H + (t0 + qb * 256) * DM + 1024 + h * 128, DM, SEQ, (LAS char*)lds, wave, qb * 256, tab_mla, INP(I_GQA_QN) + j * 128); }
            }
            PH_END;
        } else {
            bf16* NQ = (bf16*)(BIG + 0 * BIG_SPLIT); bf16* NK = (bf16*)(BIG + 1 * BIG_SPLIT); bf16* NV = (bf16*)(BIG + 2 * BIG_SPLIT);
            bf16* DQ = (bf16*)(BIG + 3 * BIG_SPLIT); bf16* DK = (bf16*)(BIG + 4 * BIG_SPLIT); bf16* DV = (bf16*)(BIG + 5 * BIG_SPLIT); bf16* OC = NQ;
            if (PH_ON && PEN(7)) for (int rep_ = 0; rep_ < REPS(7); ++rep_) { PH_LANE;
                pg8::Gemm g{XBH, W_IN, T, CD_IN, DM, DM, DM}; pg8::StaticOrder S; S.init(T, CD_IN, G, bx, 4);
                pg8::EpiBf16<0, 32> E{NQ, 1024, 1024, BIG_SPLIT / 2, PSQ(0), 1.f / 2048.f, nullptr, 0};
                pg8::gemm_phase(lds, g, S, E, wave);
            }
            PH_END;
            if (PH_ON && PEN(9)) for (int rep_ = 0; rep_ < REPS(9); ++rep_) { PH_LANE;
                const float* rpb = INP(I_RPB) + (size_t)j * 8 * 465;
                const int nslot = (NSEQ * 8 * 16 / G) < 6 ? ((NSEQ * 8 * 16 / G) < 1 ? 1 : (NSEQ * 8 * 16 / G)) : 6;
                for (int u = vcu, it_ = 0; u < NSEQ * 8 * 16; u += G, ++it_) { const int qb = u & 15, h = (u >> 4) & 7, b = u >> 7; const size_t t0 = (size_t)b * SEQ;
                    att::na_unit2(NQ + (t0 + qb * 256) * 1024 + h * 128, 1024, NK + t0 * 1024 + h * 128, NV + t0 * 1024 + h * 128, 1024,
                                 H + (t0 + qb * 256) * DM + h * 128, DM, qb * 4, rpb + h * 465, (LAS char*)lds, wave);
                    if (rep_ == 0 && PEN(8) && it_ == bx % nslot) {
                        int m = gw;
                        for (; m + 3 * NGW < T; m += 4 * NGW) rope1d_rows4(DK, 1024, m, NGW, tab_1d, lane);
                        for (; m < T; m += NGW) rope1d_row(DK + (size_t)m * 1024, m & (SEQ - 1), tab_1d, lane);
                    } }
            }
            PH_END;
            if (PH_ON && PEN(10)) for (int rep_ = 0; rep_ < REPS(10); ++rep_) { PH_LANE;
                const float* lp = INP(I_DLAM) + j * 512;
                const float a0 = lp[lane] * lp[128 + lane] + lp[64 + lane] * lp[128 + 64 + lane], a1 = lp[256 + lane] * lp[384 + lane] + lp[256 + 64 + lane] * lp[384 + 64 + lane];
                const float lam_init = (layer == 1) ? 0.35550906759096934f : 0.5560582041556406f;
                const float lam = expf(wave_sum(a0)) - expf(wave_sum(a1)) + lam_init;
                const float* subln = INP(I_SUBLN) + j * 256;
                const int npair = NSEQ * 4 * 16, nps = (npair / G) < 3 ? ((npair / G) < 1 ? 1 : (npair / G)) : 3;
                for (int p = vcu, it_ = 0; p < npair; p += G, ++it_) { const int qb = p & 15, h = (p >> 4) & 3, b = p >> 6; const size_t t0 = (size_t)b * SEQ;
                    bf16* oc0 = OC + (t0 + qb * 256) * 2048 + h * 512;
                    att::DiffFuse df{oc0, H + (t0 + qb * 256) * DM + 1024 + h * 256, DM, lam, 1.f - lam_init, subln};
                    att::dense_unit_dv256<0>(DQ + (t0 + qb * 256) * 1024 + (2 * h) * 128, 1024, DK + t0 * 1024 + (2 * h) * 128, 1024, DV + t0 * 1024 + h * 256, 1024,
                                             oc0, 2048, SEQ, (LAS char*)lds, wave, qb * 256, tab_1d, df);
                    att::dense_unit_dv256<1>(DQ + (t0 + qb * 256) * 1024 + (2 * h + 1) * 128, 1024, DK + t0 * 1024 + (2 * h + 1) * 128, 1024, DV + t0 * 1024 + h * 256, 1024,
                                             oc0, 2048, SEQ, (LAS char*)lds, wave, qb * 256, tab_1d, df);
                    if (rep_ == 0 && it_ == bx % nps) CONVERT_LATE; }
            }
            PH_END;
        }
        if (PH_ON && PEN(12)) for (int rep_ = 0; rep_ < REPS(12); ++rep_) { PH_LANE;
            pg8::Gemm g{H, W_OUT, T, DM, DM, DM, DM}; pg8::StaticOrder S; S.init(T, DM, G, bx, 4);
            pg8::EpiResidX E{XBH, XBH, PSQ(1), DM, (rep_ == REPS(12) - 1) ? 1.f : 0.f};
            pg8::gemm_phase(lds, g, S, E, wave, ((bx >> 3) & 7) * SKEW_TICKS);
        }
        PH_END;
        {
            bf16* XQ = (bf16*)(BIG + BIG_XQ); bf16* XO = (bf16*)(BIG + BIG_XO);
            if (PH_ON && PEN(14)) for (int rep_ = 0; rep_ < REPS(14); ++rep_) { PH_LANE;
#pragma unroll 1
                for (int gi = 0; gi < 2; ++gi) {
                    pg8::Gemm g{gi ? MN : XBA, gi ? W_XKV : W_XQ, gi ? TM : T, gi ? 1024 : 512, DM, DM, DM}; pg8::StaticOrder S; S.init(g.M, g.N, G, gi ? (bx + (G >> 1)) % G : bx);
                    pg8::EpiBf16<0, 32> E{gi ? MKV : XQ, g.N, 0, 0, PSQ(1), 1.f / 2048.f, nullptr, 0, gi};
                    pg8::gemm_phase(lds, g, S, E, wave);
                }
            }
            PH_END;
            if (PH_ON && PEN(15)) for (int rep_ = 0; rep_ < REPS(15); ++rep_) { PH_LANE;
                for (int u = vcu; u < NSEQ * 4 * 16; u += G) { const int qb = u & 15, h = (u >> 4) & 3, b = u >> 6; const size_t t0 = (size_t)b * SEQ;
                    att::dense_unit3<0>(XQ + (t0 + qb * 256) * 512 + h * 128, 512, MKV + (size_t)b * MEMLEN * 1024 + h * 128, 1024,
                                         MKV + (size_t)b * MEMLEN * 1024 + 512 + h * 128, 1024, XO + (t0 + qb * 256) * 512 + h * 128, 512, MEMLEN, (LAS char*)lds, wave, 0, nullptr, nullptr); }
            }
            PH_END;
            if (PH_ON && PEN(16)) for (int rep_ = 0; rep_ < REPS(16); ++rep_) { PH_LANE;
                pg8::Gemm g{XO, W_XO, T, DM, 512, 512, 512}; pg8::StaticOrder S; S.init(T, DM, G, bx, 4);
                pg8::EpiResidX E{XBH, XBH, PSQ(2), DM, (rep_ == REPS(16) - 1) ? 1.f : 0.f};
                pg8::gemm_phase(lds, g, S, E, wave, ((bx >> 3) & 7) * SKEW_TICKS);
            }
            PH_END;
        }
        {
#pragma unroll 1
            for (int ch = -1; ch < N_MLP_CHUNKS; ++ch) {
                if (PH_ON && PEN(19)) for (int rep_ = 0; rep_ < REPS(19); ++rep_) { PH_LANE;
                    if (ch >= 0) {
                        pg8::Gemm g{(bf16*)(BIG + (size_t)(ch & 1) * U_BYTES), W_DOWN, MLP_CHUNK, DM, DFF, DFF, DFF}; pg8::StaticOrder S; S.init(MLP_CHUNK, DM, G, bx, 4);
                        const size_t co = (size_t)ch * MLP_CHUNK * DM; const bool lastl = (layer == DEPTH - 1);
                        pg8::EpiResidX E{XBH + co, (lastl ? HFIN : XBH) + co, PSQ(0) + (size_t)ch * MLP_CHUNK * 32, DM, (rep_ == REPS(19) - 1) ? 1.f : 0.f};
                        pg8::gemm_phase(lds, g, S, E, wave);
                    }
                    if (ch + 1 < N_MLP_CHUNKS) { const int cn = ch + 1;
                        pg8::Gemm g{XBA + (size_t)cn * MLP_CHUNK * DM, W_UP, MLP_CHUNK, DFF, DM, DM, DM}; pg8::StaticOrder S; S.init(MLP_CHUNK, DFF, G, bx, 8);
                        pg8::EpiBf16<2, 32> E{(bf16*)(BIG + (size_t)(cn & 1) * U_BYTES), DFF, 0, 0, PSQ(2) + (size_t)cn * MLP_CHUNK * 32, 1.f / 2048.f, nullptr, 0};
                        pg8::gemm_phase(lds, g, S, E, wave);
                    }
                }
                PH_END;
            }
        }
    }
    if (PH_ON && PEN(20)) for (int rep_ = 0; rep_ < REPS(20); ++rep_) { PH_LANE; const float* g = INP(I_FINAL); const float* ssf = PSQ(0);
        f32x4 gg[8];
#pragma unroll
        for (int jj = 0; jj < 8; ++jj) gg[jj] = ((const f32x4*)g + lane)[64 * jj];
        int m = gw;
        for (; m + 3 * NGW < T; m += 4 * NGW) final_norm_rows<4>(HFIN, X, gg, ssf, m, NGW, lane);
        for (; m < T; m += NGW) final_norm_row(HFIN + (size_t)m * DM, X + (size_t)m * DM, g, wave_sum(lane < 32 ? ssf[(size_t)m * 32 + lane] : 0.f), lane); }
#undef PH_ON
#undef PH_END
}

extern "C" void kernel_launch(void* const* d_in, const int* in_sizes, int n_in, void* d_out, int out_size, void* d_ws, size_t ws_size, hipStream_t stream) {
    static int grid = 0;
    if (grid == 0) {
        if (n_in != 27 || out_size != T * DM || ws_size < WS_END) { fprintf(stderr, "kernel_launch: shape mismatch: n_in %d out %d ws %zu (need %zu)\n", n_in, out_size, ws_size, (size_t)WS_END); grid = -1; return; }
        int dev = 0, cus = 0, per_cu = 0;
        if (hipGetDevice(&dev) != hipSuccess || hipDeviceGetAttribute(&cus, hipDeviceAttributeMultiprocessorCount, dev) != hipSuccess) { grid = -1; return; }
        if (hipFuncSetAttribute((const void*)fwd, hipFuncAttributeMaxDynamicSharedMemorySize, LDS_BYTES) != hipSuccess) { fprintf(stderr, "kernel_launch: hipFuncSetAttribute failed\n"); grid = -1; return; }
        if (hipOccupancyMaxActiveBlocksPerMultiprocessor(&per_cu, (const void*)fwd, 512, LDS_BYTES) != hipSuccess || per_cu < 1) { fprintf(stderr, "kernel_launch: occupancy query says %d\n", per_cu); }
        (void)hipGetLastError();
        grid = cus;
    }
    if (grid < 0) return;
    if (hipMemsetAsync((char*)d_ws + WS_CTL, 0, CTL_ZERO_BYTES, stream) != hipSuccess) return;
    Args a{};
    for (int i = 0; i < 27; ++i) a.in[i] = (const float*)d_in[i];
    a.out = (float*)d_out; a.ws = (unsigned char*)d_ws; a.ph_lo = 0; a.ph_hi = 1 << 30;
    hipLaunchKernelGGL(fwd, dim3(grid), dim3(512), LDS_BYTES, stream, a);
    const hipError_t le = hipPeekAtLastError();
    if (le != hipSuccess) fprintf(stderr, "kernel_launch: launch failed: %s\n", hipGetErrorName(le));
}
```
